# Optimizing an MI355X kernel written in HIP

```python
import math
import jax, jax.numpy as jnp
from jax import lax
import numpy as np

D_MODEL = 1024
BATCH = 16
SEQ = 2048
DEPTH = 2

CHUNK = 64
N_A = DEPTH // 2
N_B = DEPTH - N_A
N_DENSE = (DEPTH + 1) // 2
N_MOE = DEPTH // 2
GMLP_CHUNK = 128
A_FFN = 6 * D_MODEL
A_HALF = A_FFN // 2
A_GROUPS = 8
A_GROUP_DIM = A_HALF // A_GROUPS
B_HEAD_DIM = 64
B_HEADS = D_MODEL // B_HEAD_DIM
Q_BLOCK = 128
D_FF = ((8 * D_MODEL // 3 + 255) // 256) * 256
N_EXPERTS = 8
TOP_K = 2
D_EXPERT = 7 * D_MODEL // 2
RMS_EPS = 1e-6
NEG_INF = -1e30

kernel_name = "yoco_gmlp_fox_moe_trunk"


def rms_norm(x, g):
    xf = x.astype(jnp.float32)
    y = xf * lax.rsqrt(jnp.mean(xf * xf, axis=-1, keepdims=True) + RMS_EPS)
    return (y * g.astype(jnp.float32)).astype(x.dtype)


def swiglu(x, w_in, w_out):
    a, b = jnp.split(x @ w_in, 2, axis=-1)
    return (jax.nn.silu(a) * b) @ w_out


def mixer_a(x, w_in, v_norm_g, w_spatial, b_spatial, w_out):
    B, S, _ = x.shape
    uv = jax.nn.gelu(x @ w_in, approximate=False)
    u, v = jnp.split(uv, 2, axis=-1)
    v = rms_norm(v, v_norm_g)
    v = v.reshape(B, S // GMLP_CHUNK, GMLP_CHUNK, A_GROUPS, A_GROUP_DIM)
    pos = jnp.arange(GMLP_CHUNK)
    mask = (pos[None, :] // CHUNK) <= (pos[:, None] // CHUNK)
    w = jnp.where(mask[None], w_spatial, jnp.zeros_like(w_spatial))
    v = jnp.einsum('gij,bcjgd->bcigd', w, v) + b_spatial.T[None, None, :, :, None]
    return (u * v.reshape(B, S, A_HALF)) @ w_out


def shared_kv(h, norm_g, w_kvf, b_f, k_norm_g):
    B, S, _ = h.shape
    s = rms_norm(h, norm_g)
    kvf = s @ w_kvf
    k = kvf[..., :D_MODEL].reshape(B, S, B_HEADS, B_HEAD_DIM)
    v = kvf[..., D_MODEL:2 * D_MODEL].reshape(B, S, B_HEADS, B_HEAD_DIM)
    f = kvf[..., 2 * D_MODEL:]
    k = rms_norm(k, k_norm_g).transpose(0, 2, 1, 3)
    v = v.transpose(0, 2, 1, 3)
    log_f = jax.nn.log_sigmoid((f + b_f).astype(jnp.float32))
    cum_log_f = jnp.cumsum(log_f, axis=1).transpose(0, 2, 1)
    return k, v, cum_log_f


def mixer_b(x, k, v, cum_log_f, w_in, q_norm_g, w_out):
    B, S, _ = x.shape
    qg = x @ w_in
    q, gate = jnp.split(qg, 2, axis=-1)
    q = rms_norm(q.reshape(B, S, B_HEADS, B_HEAD_DIM), q_norm_g).transpose(0, 2, 1, 3)
    scale = B_HEAD_DIM ** -0.5
    outs = []
    for blk in range(S // Q_BLOCK):
        qs, qe = blk * Q_BLOCK, (blk + 1) * Q_BLOCK
        logits = jnp.einsum('bhqd,bhkd->bhqk', q[:, :, qs:qe], k[:, :, :qe]).astype(jnp.float32) * scale
        logits = logits + cum_log_f[:, :, qs:qe, None] - cum_log_f[:, :, None, :qe]
        causal = jnp.arange(qs, qe)[:, None] >= jnp.arange(qe)[None, :]
        logits = jnp.where(causal[None, None], logits, NEG_INF)
        p = jax.nn.softmax(logits, axis=-1).astype(v.dtype)
        outs.append(jnp.einsum('bhqk,bhkd->bhqd', p, v[:, :, :qe]))
    o = jnp.concatenate(outs, axis=2).transpose(0, 2, 1, 3).reshape(B, S, D_MODEL)
    o = o * jax.nn.sigmoid(gate)
    return o @ w_out


def moe_swiglu(x, w_router, w_in, w_out):
    B, S, D = x.shape
    xt = x.reshape(B * S, D)
    logits = (xt @ w_router).astype(jnp.float32)
    top_v, top_i = lax.top_k(logits, TOP_K)
    top_w = jax.nn.softmax(top_v, axis=-1)
    gates = jnp.sum(jax.nn.one_hot(top_i, N_EXPERTS, dtype=jnp.float32) * top_w[..., None], axis=1)
    y = jnp.zeros_like(xt)
    for e in range(N_EXPERTS):
        y = y + gates[:, e:e + 1].astype(xt.dtype) * swiglu(xt, w_in[e], w_out[e])
    return y.reshape(B, S, D)


def setup_inputs(seed: int = 0) -> dict:
    key = jax.random.key(seed)
    ks = jax.random.split(key, 24)

    def dense(k, shape, fan_in, s=1.0):
        return jax.random.normal(k, shape, jnp.float32) * (s * fan_in ** -0.5)

    def gain(k, shape):
        return 1.0 + 0.02 * jax.random.normal(k, shape, jnp.float32)

    return {
        "x": jax.random.normal(ks[0], (BATCH, SEQ, D_MODEL), jnp.float32),
        "a_norm_g": gain(ks[1], (N_A, D_MODEL)),
        "a_w_in": dense(ks[2], (N_A, D_MODEL, A_FFN), D_MODEL),
        "a_v_norm_g": gain(ks[3], (N_A, A_HALF)),
        "a_w_spatial": dense(ks[4], (N_A, A_GROUPS, GMLP_CHUNK, GMLP_CHUNK), GMLP_CHUNK, 0.5),
        "a_b_spatial": 1.0 + 0.1 * jax.random.normal(ks[5], (N_A, A_GROUPS, GMLP_CHUNK), jnp.float32),
        "a_w_out": dense(ks[6], (N_A, A_HALF, D_MODEL), A_HALF),
        "f_norm_g": gain(ks[7], (N_DENSE, D_MODEL)),
        "f_w_in": dense(ks[8], (N_DENSE, D_MODEL, 2 * D_FF), D_MODEL),
        "f_w_out": dense(ks[9], (N_DENSE, D_FF, D_MODEL), D_FF),
        "kv_norm_g": gain(ks[10], (D_MODEL,)),
        "kv_w": dense(ks[11], (D_MODEL, 2 * D_MODEL + B_HEADS), D_MODEL),
        "kv_b_f": 4.0 + 0.1 * jax.random.normal(ks[12], (B_HEADS,), jnp.float32),
        "k_norm_g": gain(ks[13], (B_HEAD_DIM,)),
        "b_norm_g": gain(ks[14], (N_B, D_MODEL)),
        "b_w_in": dense(ks[15], (N_B, D_MODEL, 2 * D_MODEL), D_MODEL),
        "q_norm_g": gain(ks[16], (N_B, B_HEAD_DIM)),
        "b_w_out": dense(ks[17], (N_B, D_MODEL, D_MODEL), D_MODEL),
        "m_norm_g": gain(ks[18], (N_MOE, D_MODEL)),
        "m_w_router": dense(ks[19], (N_MOE, D_MODEL, N_EXPERTS), D_MODEL),
        "m_w_in": dense(ks[20], (N_MOE, N_EXPERTS, D_MODEL, 2 * D_EXPERT), D_MODEL),
        "m_w_out": dense(ks[21], (N_MOE, N_EXPERTS, D_EXPERT, D_MODEL), D_EXPERT),
    }


def reference(x, a_norm_g, a_w_in, a_v_norm_g, a_w_spatial, a_b_spatial, a_w_out,
              f_norm_g, f_w_in, f_w_out,
              kv_norm_g, kv_w, kv_b_f, k_norm_g,
              b_norm_g, b_w_in, q_norm_g, b_w_out,
              m_norm_g, m_w_router, m_w_in, m_w_out):
    h = x
    k = v = cum_log_f = None
    for layer in range(DEPTH):
        if layer < N_A:
            i = layer
            h = h + mixer_a(rms_norm(h, a_norm_g[i]), a_w_in[i], a_v_norm_g[i],
                            a_w_spatial[i], a_b_spatial[i], a_w_out[i])
        else:
            if layer == N_A:
                k, v, cum_log_f = shared_kv(h, kv_norm_g, kv_w, kv_b_f, k_norm_g)
            i = layer - N_A
            h = h + mixer_b(rms_norm(h, b_norm_g[i]), k, v, cum_log_f,
                            b_w_in[i], q_norm_g[i], b_w_out[i])
        if layer % 2 == 0:
            j = layer // 2
            h = h + swiglu(rms_norm(h, f_norm_g[j]), f_w_in[j], f_w_out[j])
        else:
            j = layer // 2
            h = h + moe_swiglu(rms_norm(h, m_norm_g[j]), m_w_router[j], m_w_in[j], m_w_out[j])
    return h
```

```cpp
#include <hip/hip_runtime.h>
#include <hip/hip_bf16.h>
#include <cstdio>
#include <cstdint>
#include <cmath>
namespace pg8 {
#define PG8_LAS __attribute__((address_space(3)))
typedef unsigned short bf16_t;
typedef short bf16x8 __attribute__((ext_vector_type(8)));
typedef float f32x4 __attribute__((ext_vector_type(4)));
typedef unsigned u32x4 __attribute__((ext_vector_type(4)));
constexpr int BM = 256, BK = 64, HALF = 128, HTB = HALF * BK * 2  , STAGE_BYTES = 8 * HTB, NXCD = 8, WGM = 8;

__host__ __device__ __forceinline__ int lds_byte(int r, int c) { const int st = (r >> 4) * 2 + (c >> 5), rr = r & 15, cc = c & 31, ob = rr * 64 + cc * 2; return st * 1024 + (ob ^ (((ob >> 9) & 1) << 5)); }
__host__ __device__ __forceinline__ void stage_rc(int b, int& R, int& C) { const int st = b / 1024, sb = b % 1024, swz = sb ^ (((sb >> 9) & 1) << 5); R = (st >> 1) * 16 + swz / 64; C = (st & 1) * 32 + (swz % 64) / 2; }
__host__ __device__ __forceinline__ int perm32(int rho) { const int n = rho >> 4, i = rho & 15; return 8 * (i >> 2) + 4 * n + (i & 3); }

struct Unit { int pm, pn; };
struct Gemm { const bf16_t* A; const bf16_t* Bt; int M, N, K, lda; };

struct StaticOrder {
    int nM, nN, nwg, G, c;
    __host__ __device__ void init(int M, int N, int G_, int c_) { nM = M / BM; nN = N / BM; nwg = nM * nN; G = G_; c = c_; }
    __host__ __device__ bool next(int i, Unit& u) const {
        const long L = (long)i * G + c; if (L >= nwg) return false;
        int wgid = (int)L; { const int q = nwg / NXCD, r = nwg % NXCD, xcd = wgid % NXCD, off = wgid / NXCD; wgid = (xcd < r ? xcd * (q + 1) : r * (q + 1) + (xcd - r) * q) + off; }
        const int nig = WGM * nN, gid = wgid / nig, fm = gid * WGM, gsz = (nM - fm) < WGM ? (nM - fm) : WGM;
        u.pm = fm + ((wgid % nig) % gsz); u.pn = (wgid % nig) / gsz; return true;
    }
    __device__ __forceinline__ void a_ready(const Unit&) const {}
    __device__ __forceinline__ void done(const Unit&) const {}
};

__device__ __forceinline__ unsigned cvt_pk_bf16(float lo, float hi) { unsigned r; asm volatile("v_cvt_pk_bf16_f32 %0, %1, %2" : "=v"(r) : "v"(lo), "v"(hi)); return r; }
typedef float f32x2 __attribute__((ext_vector_type(2)));
__device__ __forceinline__ f32x2 gelu_pk(f32x2 v) {
    const f32x2 av = __builtin_elementwise_abs(v), d = av * 0.2316418882f + 1.0f;
    f32x2 t; t.x = __builtin_amdgcn_rcpf(d.x); t.y = __builtin_amdgcn_rcpf(d.y);
    f32x2 q = t * 0.5307027145f + (-0.7265760135f); q = q * t + 0.7107068705f; q = q * t + (-0.142248368f); q = q * t + 0.127414796f; q = q * t;
    const f32x2 s = (v * v) * (-0.72134752044f);
    f32x2 e; e.x = __builtin_amdgcn_exp2f(s.x); e.y = __builtin_amdgcn_exp2f(s.y);
    const f32x2 m = v * (q * e), r = v - m;
    f32x2 o; o.x = v.x < 0.f ? m.x : r.x; o.y = v.y < 0.f ? m.y : r.y; return o;
}

template <int ACT  > struct EpiBf16 {
    static constexpr bool PERM = true, AFTER_DRAIN = false; static_assert(ACT == 0 || ACT == 1, "EpiBf16: ACT is 0 (none) or 1 (gelu_pk)");
    bf16_t* O; int ldc; const float* bias; int split_cols; size_t split_stride; float scale0;
    __device__ __forceinline__ void operator()(const f32x4 (&acc)[2][2][4][2], const Unit& u, int wr, int wc, int fr, int fq) const {
        const int row0 = u.pm * BM + wr * 64 + fr; int colt = u.pn * BM; bf16_t* base = O;
        float sc = 1.f; if (split_cols) { const int t = colt / split_cols; base += (size_t)t * split_stride; colt -= t * split_cols; if (t == 0) sc = scale0; }
        const int col0 = colt + wc * 32 + 8 * fq, bcol0 = u.pn * BM + wc * 32 + 8 * fq;
        f32x4 bv[2][2];
#pragma unroll
        for (int bj = 0; bj < 2; ++bj)
#pragma unroll
            for (int n = 0; n < 2; ++n) bv[bj][n] = bias ? *(const f32x4*)(bias + bcol0 + bj * HALF + 4 * n) : (f32x4){0.f, 0.f, 0.f, 0.f};
#pragma unroll
        for (int ai = 0; ai < 2; ++ai)
#pragma unroll
            for (int m = 0; m < 4; ++m) { bf16_t* rowp = base + (size_t)(row0 + ai * HALF + m * 16) * ldc + col0;
#pragma unroll
                for (int bj = 0; bj < 2; ++bj) { f32x4 v0 = acc[ai][bj][m][0] + bv[bj][0], v1 = acc[ai][bj][m][1] + bv[bj][1];
                    if (ACT == 1) { f32x2 a = gelu_pk((f32x2){v0[0], v0[1]}), b = gelu_pk((f32x2){v0[2], v0[3]}), c = gelu_pk((f32x2){v1[0], v1[1]}), d = gelu_pk((f32x2){v1[2], v1[3]});
                        v0 = (f32x4){a.x, a.y, b.x, b.y}; v1 = (f32x4){c.x, c.y, d.x, d.y}; }
                    v0 = v0 * sc; v1 = v1 * sc; u32x4 w; w.x = cvt_pk_bf16(v0[0], v0[1]); w.y = cvt_pk_bf16(v0[2], v0[3]); w.z = cvt_pk_bf16(v1[0], v1[1]); w.w = cvt_pk_bf16(v1[2], v1[3]);
                    *(u32x4*)(rowp + bj * HALF) = w; } }
    }
};

struct EpiF32Res {
    static constexpr bool PERM = false, AFTER_DRAIN = false;
    const float* base; float* out; int ldc; const float* gate; int gstride;
    __device__ __forceinline__ void operator()(const f32x4 (&acc)[2][2][4][2], const Unit& u, int wr, int wc, int fr, int fq) const {
        const int row0 = u.pm * BM + wr * 64 + fr, col0 = u.pn * BM + wc * 32 + 4 * fq;
#pragma unroll
        for (int ai = 0; ai < 2; ++ai)
#pragma unroll
            for (int m = 0; m < 4; ++m) { const int row = row0 + ai * HALF + m * 16; const size_t off = (size_t)row * ldc + col0;
                const float gs = gate ? gate[(size_t)row * gstride] : 1.0f;
#pragma unroll
                for (int bj = 0; bj < 2; ++bj)
#pragma unroll
                    for (int n = 0; n < 2; ++n) { const f32x4 bs = *(const f32x4*)(base + off + bj * HALF + n * 16); *(f32x4*)(out + off + bj * HALF + n * 16) = bs + acc[ai][bj][m][n] * gs; }
                asm volatile("" ::: "memory"); }
    }
};
struct EpiSwiGLU {
    static constexpr bool PERM = true, AFTER_DRAIN = false;
    bf16_t* O; int ldc;
    static __device__ __forceinline__ float silu(float x) { return x * __builtin_amdgcn_rcpf(1.0f + __builtin_amdgcn_exp2f(-1.4426950408889634f * x)); }
    __device__ __forceinline__ void operator()(const f32x4 (&acc)[2][2][4][2], const Unit& u, int wr, int wc, int fr, int fq) const {
        const int row0 = u.pm * BM + wr * 64 + fr, col0 = u.pn * HALF + wc * 32 + 8 * fq;
#pragma unroll
        for (int ai = 0; ai < 2; ++ai)
#pragma unroll
            for (int m = 0; m < 4; ++m) { bf16_t* rowp = O + (size_t)(row0 + ai * HALF + m * 16) * ldc + col0;
                const f32x4 a0 = acc[ai][0][m][0], a1 = acc[ai][0][m][1], b0 = acc[ai][1][m][0], b1 = acc[ai][1][m][1];
                u32x4 w; w.x = cvt_pk_bf16(silu(a0[0]) * b0[0], silu(a0[1]) * b0[1]); w.y = cvt_pk_bf16(silu(a0[2]) * b0[2], silu(a0[3]) * b0[3]);
                w.z = cvt_pk_bf16(silu(a1[0]) * b1[0], silu(a1[1]) * b1[1]); w.w = cvt_pk_bf16(silu(a1[2]) * b1[2], silu(a1[3]) * b1[3]);
                *(u32x4*)rowp = w; }
    }
};
template <class Epi, class Sched, bool ALIGN_EPI = false, bool SP2 = false>
__device__ __forceinline__ void gemm_phase(PG8_LAS unsigned char* lds, const Gemm g, const Sched& S, const Epi& E) {
    int tid_ = threadIdx.x; asm volatile("" : "+v"(tid_));
    const int tid = tid_, wid = __builtin_amdgcn_readfirstlane(tid >> 6), lane = tid & 63, wr = wid >> 2, wc = wid & 3, fr = lane & 15, fq = lane >> 4;
    const int K = g.K, nt = K / BK;
    unsigned voffA[2], voffB[2];
#pragma unroll
    for (int i = 0; i < 2; ++i) { int R, C; stage_rc(tid * 16 + i * 8192, R, C); const int Rb = Epi::PERM ? ((R & ~31) + perm32(R & 31)) : R;
        voffA[i] = (unsigned)(R * g.lda + C) * 2u; voffB[i] = (unsigned)(Rb * K + C) * 2u; }
    const size_t kstep = (size_t)(BK * 2);
    const size_t hstepA = (size_t)HALF * g.lda * 2, hstep = (size_t)HALF * K * 2;
    const size_t tstepA = 2 * hstepA, tstep = 2 * hstep;
    const unsigned ldsw = (unsigned)wid * 1024u;
    const int aoff = lds_byte(wr * 64 + fr, fq * 8), boff = lds_byte(wc * 32 + fr, fq * 8);
#define PG8_SA(b, h) (((b) * 2 + (h)) * HTB)
#define PG8_SB(b, h) ((4 + (b) * 2 + (h)) * HTB)
#define PG8_STAGE(bufoff, gbase, voff) do { _Pragma("unroll") for (int _i = 0; _i < 2; ++_i) \
        __builtin_amdgcn_global_load_lds((const unsigned*)((const char*)(gbase) + (voff)[_i]), (PG8_LAS unsigned*)(lds + (bufoff) + ldsw + _i * 8192), 16, 0, 0); } while (0)
#define PG8_LDA(dst, b, h) do { _Pragma("unroll") for (int m = 0; m < 4; ++m) _Pragma("unroll") for (int k = 0; k < 2; ++k) dst[m][k] = *(const PG8_LAS bf16x8*)(lds + PG8_SA(b, h) + aoff + m * 2048 + k * 1024); } while (0)
#define PG8_LDB(dst, b, h) do { _Pragma("unroll") for (int n = 0; n < 2; ++n) _Pragma("unroll") for (int k = 0; k < 2; ++k) dst[n][k] = *(const PG8_LAS bf16x8*)(lds + PG8_SB(b, h) + boff + n * 2048 + k * 1024); } while (0)
#define PG8_MMA(ai, bj, At, Bt) do { __builtin_amdgcn_s_setprio(1); _Pragma("unroll") for (int m = 0; m < 4; ++m) _Pragma("unroll") for (int n = 0; n < 2; ++n) _Pragma("unroll") for (int k = 0; k < 2; ++k) \
        acc[ai][bj][m][n] = __builtin_amdgcn_mfma_f32_16x16x32_bf16(Bt[n][k], At[m][k], acc[ai][bj][m][n], 0, 0, 0); __builtin_amdgcn_s_setprio(0); } while (0)
#define PG8_WAIT_V(n) asm volatile("s_waitcnt vmcnt(" #n ")" ::: "memory")
#define PG8_WAIT_L(n) asm volatile("s_waitcnt lgkmcnt(" #n ")" ::: "memory")
#define PG8_BAR __builtin_amdgcn_s_barrier()
#define PG8_SCHED __builtin_amdgcn_sched_barrier(0)
    Unit cur, nxt; int ui = 0;
    if (!S.next(0, cur)) return;
    f32x4 acc[2][2][4][2];
#pragma unroll
    for (int a = 0; a < 2; ++a)
#pragma unroll
        for (int b = 0; b < 2; ++b)
#pragma unroll
            for (int m = 0; m < 4; ++m)
#pragma unroll
                for (int n = 0; n < 2; ++n) acc[a][b][m][n] = (f32x4){0.f, 0.f, 0.f, 0.f};
    bf16x8 At[4][2], B0[2][2], B1[2][2];
    const char* cA = (const char*)g.A + (size_t)cur.pm * tstepA; const char* cB = (const char*)g.Bt + (size_t)cur.pn * tstep;
    S.a_ready(cur);
    if constexpr (SP2) {
        PG8_STAGE(PG8_SB(0, 0), cB, voffB); PG8_STAGE(PG8_SB(0, 1), cB + hstep, voffB); PG8_STAGE(PG8_SA(0, 0), cA, voffA); PG8_STAGE(PG8_SA(0, 1), cA + hstepA, voffA);
        if (wr == 1) PG8_BAR;
        PG8_WAIT_V(2); PG8_BAR;
        PG8_STAGE(PG8_SB(1, 0), cB + kstep, voffB); PG8_STAGE(PG8_SA(1, 0), cA + kstep, voffA); PG8_STAGE(PG8_SB(1, 1), cB + hstep + kstep, voffB);
        PG8_WAIT_V(6); PG8_BAR;
    } else {
        PG8_STAGE(PG8_SB(0, 0), cB, voffB); PG8_STAGE(PG8_SA(0, 0), cA, voffA); PG8_STAGE(PG8_SB(0, 1), cB + hstep, voffB); PG8_STAGE(PG8_SA(0, 1), cA + hstepA, voffA);
        if (wr == 1) PG8_BAR;
        PG8_WAIT_V(4); PG8_BAR;
        PG8_STAGE(PG8_SB(1, 0), cB + kstep, voffB); PG8_STAGE(PG8_SA(1, 0), cA + kstep, voffA); PG8_STAGE(PG8_SB(1, 1), cB + hstep + kstep, voffB);
        PG8_WAIT_V(6); PG8_BAR;
    }
    for (;;) {
        const bool has_next = S.next(ui + 1, nxt);
        const char* nA = has_next ? (const char*)g.A + (size_t)nxt.pm * tstepA : cA; const char* nB = has_next ? (const char*)g.Bt + (size_t)nxt.pn * tstep : cB;
        for (int t = 0; t < nt; t += 2) {
            const bool last = (t == nt - 2);
            const char* a1 = cA + (size_t)(t + 1) * kstep;
            const char* a2 = last ? nA : cA + (size_t)(t + 2) * kstep; const char* b2 = last ? nB : cB + (size_t)(t + 2) * kstep;
            const char* a3 = a2 + kstep; const char* b3 = b2 + kstep;
            if (last && has_next) S.a_ready(nxt);
            if constexpr (SP2) {
            PG8_LDB(B0, 0, 0); PG8_LDB(B1, 0, 1); PG8_SCHED; PG8_LDA(At, 0, 0); PG8_STAGE(PG8_SA(1, 1), a1 + hstepA, voffA);
            PG8_WAIT_V(8); PG8_WAIT_L(0); PG8_BAR; PG8_MMA(0, 0, At, B0); PG8_MMA(0, 1, At, B1); PG8_BAR; PG8_SCHED;
            PG8_LDA(At, 0, 1); PG8_STAGE(PG8_SB(0, 0), b2, voffB); PG8_STAGE(PG8_SB(0, 1), b2 + hstep, voffB); PG8_STAGE(PG8_SA(0, 0), a2, voffA);
            PG8_WAIT_V(8); PG8_WAIT_L(0); PG8_BAR; PG8_MMA(1, 0, At, B0); PG8_MMA(1, 1, At, B1); PG8_BAR; PG8_SCHED;
            PG8_LDB(B0, 1, 0); PG8_LDB(B1, 1, 1); PG8_SCHED; PG8_LDA(At, 1, 0); PG8_STAGE(PG8_SA(0, 1), a2 + hstepA, voffA);
            PG8_WAIT_V(8); PG8_WAIT_L(0); PG8_BAR; PG8_MMA(0, 0, At, B0); PG8_MMA(0, 1, At, B1); PG8_BAR; PG8_SCHED;
            PG8_LDA(At, 1, 1); PG8_STAGE(PG8_SB(1, 0), b3, voffB); PG8_STAGE(PG8_SB(1, 1), b3 + hstep, voffB); PG8_STAGE(PG8_SA(1, 0), a3, voffA);
            PG8_WAIT_V(8); PG8_WAIT_L(0); PG8_BAR; PG8_MMA(1, 0, At, B0); PG8_MMA(1, 1, At, B1); PG8_BAR; PG8_SCHED;
            } else {
            PG8_LDB(B0, 0, 0); PG8_SCHED; PG8_LDA(At, 0, 0); PG8_STAGE(PG8_SA(1, 1), a1 + hstepA, voffA);
            PG8_WAIT_L(8); PG8_BAR; PG8_WAIT_L(0); PG8_MMA(0, 0, At, B0); PG8_BAR; PG8_SCHED;
            PG8_LDB(B1, 0, 1); PG8_STAGE(PG8_SB(0, 0), b2, voffB);
            PG8_BAR; PG8_WAIT_L(0); PG8_MMA(0, 1, At, B1); PG8_BAR;
            PG8_LDA(At, 0, 1); PG8_STAGE(PG8_SA(0, 0), a2, voffA);
            PG8_BAR; PG8_WAIT_L(0); PG8_MMA(1, 0, At, B0); PG8_BAR; PG8_SCHED;
            PG8_STAGE(PG8_SB(0, 1), b2 + hstep, voffB);
            PG8_WAIT_V(6); PG8_BAR; PG8_MMA(1, 1, At, B1); PG8_BAR;
            PG8_LDB(B0, 1, 0); PG8_SCHED; PG8_LDA(At, 1, 0); PG8_STAGE(PG8_SA(0, 1), a2 + hstepA, voffA);
            PG8_WAIT_L(8); PG8_BAR; PG8_WAIT_L(0); PG8_MMA(0, 0, At, B0); PG8_BAR; PG8_SCHED;
            PG8_LDB(B1, 1, 1); PG8_STAGE(PG8_SB(1, 0), b3, voffB);
            PG8_BAR; PG8_WAIT_L(0); PG8_MMA(0, 1, At, B1); PG8_BAR;
            PG8_LDA(At, 1, 1); PG8_STAGE(PG8_SA(1, 0), a3, voffA);
            PG8_BAR; PG8_WAIT_L(0); PG8_MMA(1, 0, At, B0); PG8_BAR; PG8_SCHED;
            PG8_STAGE(PG8_SB(1, 1), b3 + hstep, voffB);
            PG8_WAIT_V(6); PG8_BAR; PG8_MMA(1, 1, At, B1); PG8_BAR;
            }
        }
        if constexpr (ALIGN_EPI) { if (wr == 0) PG8_BAR; }
        if constexpr (!Epi::AFTER_DRAIN) { E(acc, cur, wr, wc, fr, fq); S.done(cur); }
        if (!has_next) break;
#pragma unroll
        for (int a = 0; a < 2; ++a)
#pragma unroll
            for (int b = 0; b < 2; ++b)
#pragma unroll
                for (int m = 0; m < 4; ++m)
#pragma unroll
                    for (int n = 0; n < 2; ++n) acc[a][b][m][n] = (f32x4){0.f, 0.f, 0.f, 0.f};
        cur = nxt; cA = nA; cB = nB; ++ui;
        if constexpr (ALIGN_EPI) { if (wr == 1) PG8_BAR; }
    }
    PG8_WAIT_V(0);
    if constexpr (!ALIGN_EPI) { if (wr == 0) PG8_BAR; }
    PG8_BAR;
    if constexpr (Epi::AFTER_DRAIN) { E.fused(acc, cur, wr, wc, fr, fq, lds, wid, lane); S.done(cur); }
#undef PG8_SA
#undef PG8_SB
#undef PG8_STAGE
#undef PG8_LDA
#undef PG8_LDB
#undef PG8_MMA
#undef PG8_WAIT_V
#undef PG8_WAIT_L
#undef PG8_BAR
#undef PG8_SCHED
}
}
namespace attn_body {
using bf16=__hip_bfloat16;
using bf16x8=__attribute__((ext_vector_type(8)))short;
using s16x4=__attribute__((ext_vector_type(4)))short;
using f32x16=__attribute__((ext_vector_type(16)))float;
using u32x4=__attribute__((ext_vector_type(4)))unsigned;
using f32x4v=__attribute__((ext_vector_type(4)))float;
constexpr int BATCH=16,NHEAD=16,SEQ=2048,D=64,DM=NHEAD*D;
constexpr int NW=8,QBLK=32,QB=QBLK*NW,KVBLK=64,NQB=SEQ/QB;
constexpr int ATTN_PITCH=DM, ATTN_UNIT_ROWS=QB;
__device__ __forceinline__ int crow(int r,int hi){return (r&3)+8*(r>>2)+4*hi;}
#define SBAR() __builtin_amdgcn_sched_barrier(0)
__device__ __forceinline__ void cmask(f32x16&p0,f32x16&p1,int jb,int qrel,int hi){
  const float NEG=-INFINITY; int kb=64*jb+4*hi;
  #pragma unroll
  for(int r=0;r<16;++r){int kv=kb+(r&3)+8*(r>>2); if(kv>qrel)p0[r]=NEG; if(kv+32>qrel)p1[r]=NEG;}
}

constexpr int NSLOT=3, SLOTB=8192;
constexpr int LDS_K=0, LDS_V=NSLOT*SLOTB, LDS_WS=2*NSLOT*SLOTB, LDS_OST=LDS_WS+NW*64*4, LDS_FB=LDS_OST+NW*4096, LDS_BYTES=LDS_FB+SEQ*16;
constexpr float C2=0.125f*1.4426950408889634f;
__device__ __forceinline__ void glds16(const void*gsrc,unsigned lds_dst){unsigned keep;
  asm volatile("s_mov_b32 %0, m0\n\ts_mov_b32 m0, %2\n\ts_nop 0\n\tglobal_load_lds_dwordx4 %1, off\n\ts_mov_b32 m0, %0":"=&s"(keep):"v"(gsrc),"s"(lds_dst):"memory");}
__device__ __forceinline__ float max3f(float a,float b,float c){float r;asm("v_max3_f32 %0, %1, %2, %3":"=v"(r):"v"(a),"v"(b),"v"(c));return r;}
__device__ __forceinline__ float max2f(float a,float b){float r;asm("v_max_f32_e32 %0, %1, %2":"=v"(r):"v"(a),"v"(b));return r;}
__device__ __forceinline__ float fadd_s(float a,float b){float r;asm("v_add_f32_e32 %0, %1, %2":"=v"(r):"v"(a),"v"(b));return r;}
__device__ __forceinline__ float fsub_s(float a,float b){float r;asm("v_sub_f32_e32 %0, %1, %2":"=v"(r):"v"(a),"v"(b));return r;}
typedef float f32x2_t __attribute__((ext_vector_type(2))); typedef __bf16 bf16x2_t __attribute__((ext_vector_type(2)));
__device__ __forceinline__ unsigned cvtpk_s(float lo,float hi){f32x2_t v={lo,hi};bf16x2_t b=__builtin_convertvector(v,bf16x2_t);return __builtin_bit_cast(unsigned,b);}
#define WAIT_BAR(N) asm volatile("s_waitcnt vmcnt(" #N ") lgkmcnt(0)\n\ts_barrier":::"memory")

__device__ __forceinline__ bf16x8 mk_qbias(float mhat,int hi){
  const float x=-mhat; const unsigned h=cvtpk_s(x,0.f)&0xffffu; const float r1=x-__uint_as_float(h<<16); const unsigned m=cvtpk_s(r1,0.f)&0xffffu; const float r2=r1-__uint_as_float(m<<16); const unsigned l=cvtpk_s(r2,0.f)&0xffffu;
  u32x4 w; w[0]=0x3F803F80u; w[1]=0x3F80u|(h<<16); w[2]=m|(l<<16); w[3]=0u; if(hi){w[0]=0u;w[1]=0u;w[2]=0u;} return __builtin_bit_cast(bf16x8,w);
}
__device__ __forceinline__ void qkt(f32x16&p0,f32x16&p1,const char*Kslot,const bf16x8*qr,bf16x8 fk0,bf16x8 fk1,bf16x8 qbias,int r32,int hi){
  const char*kb=Kslot+hi*1024+r32*16;
  p0=__builtin_amdgcn_mfma_f32_32x32x16_bf16(fk0,qbias,f32x16{},0,0,0);p1=__builtin_amdgcn_mfma_f32_32x32x16_bf16(fk1,qbias,f32x16{},0,0,0);
  #pragma unroll
  for(int d0=0;d0<4;++d0){
    const bf16x8 b0=*reinterpret_cast<const bf16x8*>(kb+d0*2048);
    const bf16x8 b1=*reinterpret_cast<const bf16x8*>(kb+d0*2048+512);
    p0=__builtin_amdgcn_mfma_f32_32x32x16_bf16(b0,qr[d0],p0,0,0,0);p1=__builtin_amdgcn_mfma_f32_32x32x16_bf16(b1,qr[d0],p1,0,0,0);}
}
typedef __attribute__((address_space(3))) const char* lds_cptr;
typedef short v4i16_t __attribute__((ext_vector_type(4)));
__device__ __forceinline__ void kload8(bf16x8*kf,lds_cptr kp){
  kf[0]=*(const __attribute__((address_space(3))) bf16x8*)(kp);      kf[1]=*(const __attribute__((address_space(3))) bf16x8*)(kp+512);
  kf[2]=*(const __attribute__((address_space(3))) bf16x8*)(kp+2048); kf[3]=*(const __attribute__((address_space(3))) bf16x8*)(kp+2560);
  kf[4]=*(const __attribute__((address_space(3))) bf16x8*)(kp+4096); kf[5]=*(const __attribute__((address_space(3))) bf16x8*)(kp+4608);
  kf[6]=*(const __attribute__((address_space(3))) bf16x8*)(kp+6144); kf[7]=*(const __attribute__((address_space(3))) bf16x8*)(kp+6656);
}
__device__ __forceinline__ void kload2(bf16x8*kf,lds_cptr kp,int j){ kf[2*j]=*(const __attribute__((address_space(3))) bf16x8*)(kp+j*2048); kf[2*j+1]=*(const __attribute__((address_space(3))) bf16x8*)(kp+j*2048+512); }
__device__ __forceinline__ s16x4 vtr(lds_cptr p){ return __builtin_bit_cast(s16x4,__builtin_amdgcn_ds_read_tr16_b64_v4i16((__attribute__((address_space(3))) v4i16_t*)p)); }
__device__ __forceinline__ float rowmax(const f32x16&p0,const f32x16&p1){
  float a=max3f(p0[0],p0[1],p1[0]),b=max3f(p0[2],p0[3],p1[1]);a=max3f(a,p1[2],p1[3]);
  #pragma unroll
  for(int r=4;r<16;r+=4){a=max3f(a,p0[r],p0[r+1]);b=max3f(b,p0[r+2],p0[r+3]);a=max3f(a,p1[r],p1[r+1]);b=max3f(b,p1[r+2],p1[r+3]);}
  const float m=max2f(a,b);
  auto rr=__builtin_amdgcn_permlane32_swap(__float_as_uint(m),__float_as_uint(m),false,false);
  return max2f(__uint_as_float(rr[0]),__uint_as_float(rr[1]));
}
__device__ __forceinline__ void pv(f32x16*o,int vb,bf16x8 pa0,bf16x8 pa1,bf16x8 pa2,bf16x8 pa3){
  #pragma unroll
  for(int d0=0;d0<2;++d0){s16x4 lo[4],hi[4];
    #pragma unroll
    for(int ks=0;ks<4;++ks){
      asm volatile("ds_read_b64_tr_b16 %0,%1 offset:%c2":"=&v"(lo[ks]):"v"(vb),"i"(d0*4096+ks*1024):"memory");
      asm volatile("ds_read_b64_tr_b16 %0,%1 offset:%c2":"=&v"(hi[ks]):"v"(vb),"i"(d0*4096+ks*1024+512):"memory");}
    asm volatile("s_waitcnt lgkmcnt(0)":::"memory");SBAR();
    #define PK(k) (bf16x8){lo[k][0],lo[k][1],lo[k][2],lo[k][3],hi[k][0],hi[k][1],hi[k][2],hi[k][3]}
    o[d0]=__builtin_amdgcn_mfma_f32_32x32x16_bf16(pa0,PK(0),o[d0],0,0,0);
    o[d0]=__builtin_amdgcn_mfma_f32_32x32x16_bf16(pa1,PK(1),o[d0],0,0,0);
    o[d0]=__builtin_amdgcn_mfma_f32_32x32x16_bf16(pa2,PK(2),o[d0],0,0,0);
    o[d0]=__builtin_amdgcn_mfma_f32_32x32x16_bf16(pa3,PK(3),o[d0],0,0,0);
    #undef PK
  }
}

#ifndef ATTN_STORE16
#define ATTN_STORE16(p,v) (*(u32x4*)(p)=(v))
#endif
template<int THRL> __device__ __forceinline__ void attn_unit(int b,int h,int qb,const bf16*Q,const bf16*__restrict__ K,const bf16*__restrict__ V,const bf16*__restrict__ G,bf16*O,char*shm){
  int tid_=threadIdx.x; asm volatile("":"+v"(tid_)); const int tid=tid_,lane=tid&63,r32=lane&31,hi=lane>>5; const int wid=__builtin_amdgcn_readfirstlane(tid>>6);
  const long rowbase=(long)b*SEQ; const int q0=qb*QB;
  const bf16*Qw=Q+(rowbase+q0+wid*QBLK)*DM+h*D;
  const bf16*Kh=K+rowbase*DM+h*D,*Vh=V+rowbase*DM+h*D;
  const unsigned lds0=(unsigned)(uintptr_t)shm;
  float*wsf=(float*)(shm+LDS_WS)+wid*64;
  const bf16*ksrc=Kh+(long)lane*DM+wid*8;
  const bf16*vsrc=Vh+(long)(16*(wid&3)+(lane>>2))*DM+(wid>>2)*32+(lane&3)*8;
  const unsigned kdst=lds0+LDS_K+wid*1024, vdst=lds0+LDS_V+wid*1024;
  #define DMA_K(t,slot) glds16(ksrc+(long)(t)*KVBLK*DM,(unsigned)__builtin_amdgcn_readfirstlane(kdst+(slot)))
  #define DMA_V(t,slot) glds16(vsrc+(long)(t)*KVBLK*DM,(unsigned)__builtin_amdgcn_readfirstlane(vdst+(slot)))
  const int vb0=(int)(lds0+LDS_V)+((lane>>4)&1)*32+(lane&3)*8+(4*hi+((lane&15)>>2))*64;
  const char*Kbase=shm+LDS_K; bf16x8 kf[8];
  const lds_cptr shm3=(lds_cptr)shm; const lds_cptr kp0=shm3+LDS_K+hi*1024+r32*16; const lds_cptr vp0=shm3+LDS_V+((lane>>4)&1)*32+(lane&3)*8+(4*hi+((lane&15)>>2))*64;
  const int NT=(q0+QB)/KVBLK;
  DMA_K(0,0);DMA_V(0,0);DMA_K(1,SLOTB);
  bf16x8 qr[4];
  #pragma unroll
  for(int d0=0;d0<4;++d0)qr[d0]=*reinterpret_cast<const bf16x8*>(&Qw[(long)r32*DM+d0*16+hi*8]);
  float mhat=0.f,l_reg=0.f;f32x16 o[2];o[0]=f32x16{};o[1]=f32x16{};bf16x8 qbias=mk_qbias(0.f,hi);asm volatile("":"+v"(qbias));
  const int qrel=wid*QBLK+r32;
  #define CMASK(P0,P1,t) do{int jb_=(t)-(NT-4); if(jb_>=0)cmask(P0,P1,jb_,qrel,hi);}while(0)
  const lds_cptr fbt=shm3+LDS_FB+r32*16;
  #define FKLD(t,blk) (*(const __attribute__((address_space(3))) bf16x8*)(fbt+((t)*64+(blk)*32)*16))
  bool resc=false;
  #define START(P0,P1) do{ const float rm=rowmax(P0,P1); resc=false; \
    { const float dl=rm; mhat=fadd_s(mhat,dl); \
      _Pragma("unroll") for(int r=0;r<16;++r){P0[r]=fsub_s(P0[r],dl);P1[r]=fsub_s(P1[r],dl);} \
      qbias=mk_qbias(mhat,hi); asm volatile("":"+v"(qbias)); } \
    _Pragma("unroll") for(int r=0;r<16;++r)P0[r]=__builtin_amdgcn_exp2f(P0[r]); }while(0)
  #define RESC() do{ if(resc){ asm volatile("s_waitcnt lgkmcnt(0)":::"memory"); \
      _Pragma("unroll") for(int d_=0;d_<2;++d_) _Pragma("unroll") for(int r=0;r<16;++r)o[d_][r]*=wsf[crow(r,hi)]; } }while(0)
  f32x16 pA0,pA1,pB0,pB1;
  int sl_prev=0,sl_cur=0,sl_next=SLOTB;
  #define ROT() do{sl_prev=sl_cur;sl_cur=sl_next;sl_next=(sl_next==(NSLOT-1)*SLOTB)?0:sl_next+SLOTB;}while(0)
  DMA_K(2,2*SLOTB);
  WAIT_BAR(3);
  qkt(pA0,pA1,Kbase,qr,FKLD(0,0),FKLD(0,1),qbias,r32,hi);asm volatile("s_nop 15\n\ts_nop 7":"+v"(pA0),"+v"(pA1));CMASK(pA0,pA1,0);
  START(pA0,pA1);
  _Pragma("unroll") for(int r=0;r<16;++r)pA1[r]=__builtin_amdgcn_exp2f(pA1[r]);
  WAIT_BAR(0);
  DMA_K(3,0);DMA_V(1,SLOTB);
  ROT();
  kload8(kf,kp0+sl_cur);
  WAIT_BAR(2);
  s16x4 vlo[8],vhi[8]; u32x4 pw0,pw1,pw2,pw3;
  #define PKW(P,B) cvtpk_s(P[B],P[B+1])
  #define PAF(k) __builtin_bit_cast(bf16x8,pw##k)
  #define VFR(i) (bf16x8){vlo[i][0],vlo[i][1],vlo[i][2],vlo[i][3],vhi[i][0],vhi[i][1],vhi[i][2],vhi[i][3]}
  #define PIN(x) asm volatile("":"+v"(x))
  #define MX3(a,b,c) __builtin_fmaxf(__builtin_fmaxf((a),(b)),(c))
  #define GAPA(MF,A0,A1,A2,A3,W0,W1,PW) do{ MF; sacc+=A0; sacc+=A1; sacc+=A2; sacc+=A3; PIN(sacc); W0; W1; PIN(PW); SBAR(); }while(0)
  #define EX(v) __builtin_amdgcn_exp2f(v)
  #define GAPB(MF,X,B) do{ MF; X[B]=EX(X[B]); X[B+1]=EX(X[B+1]); X[B+2]=EX(X[B+2]); X[B+3]=EX(X[B+3]); PIN(X); SBAR(); }while(0)
  #define VRD(i) do{ vlo[i]=vtr(vp_+(((i)>>2)*4096+((i)&3)*1024)); vhi[i]=vtr(vp_+(((i)>>2)*4096+((i)&3)*1024+512)); }while(0)
  #define KRD(G,j) do{ if(G){ kload2(kf,kp0+sl_next,j); SBAR(); } }while(0)
  #define STEP(C0,C1,P0,P1,t,GK,GV,GL) do{ SBAR(); \
    const lds_cptr vp_=vp0+sl_prev; const bf16x8 fk0_=FKLD(t,0), fk1_=FKLD(t,1); \
    VRD(0); SBAR(); float sacc=(P0[0]+P0[1]); \
    GAPA(C0=__builtin_amdgcn_mfma_f32_32x32x16_bf16(kf[0],qr[0],f32x16{},0,0,0), P0[2],P0[3],P0[4],P0[5],     pw0[0]=PKW(P0,0), pw0[1]=PKW(P0,2), pw0); \
    VRD(4); SBAR(); GAPA(C1=__builtin_amdgcn_mfma_f32_32x32x16_bf16(kf[1],qr[0],f32x16{},0,0,0), P0[6],P0[7],P0[8],P0[9],     pw0[2]=PKW(P0,4), pw0[3]=PKW(P0,6), pw0); \
    VRD(1); SBAR(); GAPA(C0=__builtin_amdgcn_mfma_f32_32x32x16_bf16(kf[2],qr[1],C0,0,0,0),   P0[10],P0[11],P0[12],P0[13], pw1[0]=PKW(P0,8), pw1[1]=PKW(P0,10), pw1); \
    VRD(5); SBAR(); GAPA(C1=__builtin_amdgcn_mfma_f32_32x32x16_bf16(kf[3],qr[1],C1,0,0,0),   P0[14],P0[15],P1[0],P1[1],   pw1[2]=PKW(P0,12),pw1[3]=PKW(P0,14), pw1); \
    VRD(2); SBAR(); GAPA(C0=__builtin_amdgcn_mfma_f32_32x32x16_bf16(kf[4],qr[2],C0,0,0,0),   P1[2],P1[3],P1[4],P1[5],     pw2[0]=PKW(P1,0), pw2[1]=PKW(P1,2), pw2); \
    VRD(6); SBAR(); GAPA(C1=__builtin_amdgcn_mfma_f32_32x32x16_bf16(kf[5],qr[2],C1,0,0,0),   P1[6],P1[7],P1[8],P1[9],     pw2[2]=PKW(P1,4), pw2[3]=PKW(P1,6), pw2); \
    VRD(3); SBAR(); GAPA(C0=__builtin_amdgcn_mfma_f32_32x32x16_bf16(kf[6],qr[3],C0,0,0,0),   P1[10],P1[11],P1[12],P1[13], pw3[0]=PKW(P1,8), pw3[1]=PKW(P1,10), pw3); \
    VRD(7); SBAR(); GAPA(C1=__builtin_amdgcn_mfma_f32_32x32x16_bf16(kf[7],qr[3],C1,0,0,0),   P1[14],P1[15],0.f,0.f,       pw3[2]=PKW(P1,12),pw3[3]=PKW(P1,14), pw3); \
    C0=__builtin_amdgcn_mfma_f32_32x32x16_bf16(fk0_,qbias,C0,0,0,0); C1=__builtin_amdgcn_mfma_f32_32x32x16_bf16(fk1_,qbias,C1,0,0,0); \
    l_reg+=sacc; \
    if(GK){DMA_K((t)+3,sl_cur);} if(GV){DMA_V((t)+1,sl_next);} \
    CMASK(C0,C1,t); \
    { float a=MX3(C0[0],C0[1],C1[0]),b=MX3(C0[2],C0[3],C1[1]); a=MX3(a,C1[2],C1[3]); \
      _Pragma("unroll") for(int r=4;r<16;r+=4){a=MX3(a,C0[r],C0[r+1]);b=MX3(b,C0[r+2],C0[r+3]);a=MX3(a,C1[r],C1[r+1]);b=MX3(b,C1[r+2],C1[r+3]);} \
      float rm=__builtin_fmaxf(a,b); { auto rr=__builtin_amdgcn_permlane32_swap(__float_as_uint(rm),__float_as_uint(rm),false,false); rm=__builtin_fmaxf(__uint_as_float(rr[0]),__uint_as_float(rr[1])); } \
      resc=false; \
      if(__builtin_expect(__any(rm>(float)THRL),0)){ const float dl=__builtin_fmaxf(rm,0.f); mhat+=dl; \
        _Pragma("unroll") for(int r=0;r<16;++r){C0[r]-=dl;C1[r]-=dl;} \
        qbias=mk_qbias(mhat,hi); asm volatile("":"+v"(qbias)); \
        const float f=__builtin_amdgcn_exp2f(-dl); l_reg*=f; if(hi==0)wsf[r32]=f; resc=true; } } \
    SBAR(); \
    GAPB(o[0]=__builtin_amdgcn_mfma_f32_32x32x16_bf16(PAF(0),VFR(0),o[0],0,0,0), C0,0); \
    GAPB(o[1]=__builtin_amdgcn_mfma_f32_32x32x16_bf16(PAF(0),VFR(4),o[1],0,0,0), C0,4); \
    KRD(GL,0); GAPB(o[0]=__builtin_amdgcn_mfma_f32_32x32x16_bf16(PAF(1),VFR(1),o[0],0,0,0), C0,8); \
    KRD(GL,1); GAPB(o[1]=__builtin_amdgcn_mfma_f32_32x32x16_bf16(PAF(1),VFR(5),o[1],0,0,0), C0,12); \
    KRD(GL,2); GAPB(o[0]=__builtin_amdgcn_mfma_f32_32x32x16_bf16(PAF(2),VFR(2),o[0],0,0,0), C1,0); \
    KRD(GL,3); GAPB(o[1]=__builtin_amdgcn_mfma_f32_32x32x16_bf16(PAF(2),VFR(6),o[1],0,0,0), C1,4); \
    GAPB(o[0]=__builtin_amdgcn_mfma_f32_32x32x16_bf16(PAF(3),VFR(3),o[0],0,0,0), C1,8); \
    GAPB(o[1]=__builtin_amdgcn_mfma_f32_32x32x16_bf16(PAF(3),VFR(7),o[1],0,0,0), C1,12); \
    }while(0)
  int t=1;
  #undef CMASK
  #define CMASK(P0,P1,t) do{}while(0)
  for(;t+5<NT;t+=2){
    STEP(pB0,pB1,pA0,pA1,t,true,true,true);     WAIT_BAR(2); RESC(); ROT();
    STEP(pA0,pA1,pB0,pB1,t+1,true,true,true);   WAIT_BAR(2); RESC(); ROT();
  }
  #undef CMASK
  #define CMASK(P0,P1,t) do{int jb_=(t)-(NT-4); if(jb_>=0)cmask(P0,P1,jb_,qrel,hi);}while(0)
  #define ENDW(tt) do{ if((tt)+3<NT){WAIT_BAR(2);} else if((tt)+2<NT){WAIT_BAR(1);} else {WAIT_BAR(0);} }while(0)
  for(;t+1<NT;t+=2){
    STEP(pB0,pB1,pA0,pA1,t,(t+3<NT),(t+1<NT),(t+1<NT));       ENDW(t);   RESC(); ROT();
    STEP(pA0,pA1,pB0,pB1,t+1,(t+4<NT),(t+2<NT),(t+2<NT));     ENDW(t+1); RESC(); ROT();
  }
  STEP(pB0,pB1,pA0,pA1,NT-1,false,false,false); RESC();
  { float sacc=pB0[0]+pB0[1]; _Pragma("unroll") for(int r=2;r<16;++r)sacc+=pB0[r]; _Pragma("unroll") for(int r=0;r<16;++r)sacc+=pB1[r]; l_reg+=sacc;
    pw0=(u32x4){PKW(pB0,0),PKW(pB0,2),PKW(pB0,4),PKW(pB0,6)};pw1=(u32x4){PKW(pB0,8),PKW(pB0,10),PKW(pB0,12),PKW(pB0,14)};pw2=(u32x4){PKW(pB1,0),PKW(pB1,2),PKW(pB1,4),PKW(pB1,6)};pw3=(u32x4){PKW(pB1,8),PKW(pB1,10),PKW(pB1,12),PKW(pB1,14)};
    SBAR(); pv(o,vb0+sl_cur,PAF(0),PAF(1),PAF(2),PAF(3)); }
  #undef PKW
  #undef PAF
  #undef VFR
  #undef PIN
  #undef MX3
  #undef GAPA
  #undef GAPB
  #undef EX
  #undef VRD
  #undef KRD
  #undef STEP
  #undef ENDW
  {auto rr=__builtin_amdgcn_permlane32_swap(__float_as_uint(l_reg),__float_as_uint(l_reg),false,false);l_reg=__uint_as_float(rr[0])+__uint_as_float(rr[1]);}
  if(hi==0)wsf[32+r32]=l_reg;asm volatile("s_waitcnt lgkmcnt(0)":::"memory");
  float rli[16];
  #pragma unroll
  for(int r=0;r<16;++r)rli[r]=__builtin_amdgcn_rcpf(wsf[32+crow(r,hi)]);
  bf16*Ow=O+(rowbase+q0+wid*QBLK)*DM+h*D;
  { bf16*stg=(bf16*)(shm+LDS_OST)+wid*2048;
    #pragma unroll
    for(int r=0;r<16;++r){const int orow=crow(r,hi);
      #pragma unroll
      for(int d0=0;d0<2;++d0)stg[orow*64+d0*32+r32]=__float2bfloat16(o[d0][r]*rli[r]);}
    asm volatile("s_waitcnt lgkmcnt(0)":::"memory");
    const bf16*Gw=G+(rowbase+q0+wid*QBLK)*DM+h*D;
    #pragma unroll
    for(int i=0;i<4;++i){const int row=i*8+(lane>>3),ch=lane&7; const u32x4 v=*(const u32x4*)(stg+row*64+ch*8); const u32x4 gg=*(const u32x4*)(Gw+(long)row*DM+ch*8); u32x4 w;
      #pragma unroll
      for(int c=0;c<4;++c){ const float lo=__uint_as_float(v[c]<<16)*__uint_as_float(gg[c]<<16), hh=__uint_as_float(v[c]&0xffff0000u)*__uint_as_float(gg[c]&0xffff0000u); w[c]=cvtpk_s(lo,hh); }
      ATTN_STORE16(Ow+(long)row*DM+ch*8,w);} }
  asm volatile("s_waitcnt lgkmcnt(0)\n\ts_barrier":::"memory");
  #undef DMA_K
  #undef DMA_V
  #undef CMASK
  #undef FKLD
  #undef START
  #undef RESC
  #undef ROT
}
constexpr int ATTN_LDS_BYTES=LDS_BYTES;
struct AttnTensors { const bf16* Q; const bf16* K; const bf16* V; const bf16* G; bf16* O; const float* F; };
struct AttnUnit { int bh; int qb; };
struct StaticOrder {
  int vcu, G;
  __device__ __forceinline__ bool next(int i,AttnUnit&u)const{ u.bh=vcu+(i>>3)*G; if(u.bh>=BATCH*NHEAD)return false; u.qb=(i+(vcu&7))&7; return true; }
};
template<class Sched,int THRL=8> __device__ __forceinline__ void attn_phase(char*lds,const AttnTensors&T,const Sched&S){
  AttnUnit u; int cur=-1;
  for(int i=0;S.next(i,u);++i){
    if(u.bh!=cur){ cur=u.bh; u32x4*fb=(u32x4*)(lds+LDS_FB); const float*Fs=T.F+(size_t)u.bh*SEQ;
      for(int s_=threadIdx.x;s_<SEQ;s_+=NW*64){ const float x=-1.4426950408889634f*Fs[s_]; const unsigned h=cvtpk_s(x,0.f)&0xffffu; const float r1=x-__uint_as_float(h<<16); const unsigned m=cvtpk_s(r1,0.f)&0xffffu;
        const float r2=r1-__uint_as_float(m<<16); const unsigned l=cvtpk_s(r2,0.f)&0xffffu; u32x4 w; w[0]=h|(m<<16); w[1]=l|(0x3F80u<<16); w[2]=0x3F803F80u; w[3]=0u; fb[s_]=w; }
      asm volatile("s_waitcnt vmcnt(0) lgkmcnt(0)\n\ts_barrier":::"memory"); }
    attn_unit<THRL>(u.bh/NHEAD,u.bh%NHEAD,u.qb,T.Q,T.K,T.V,T.G,T.O,lds);
  }
}
#undef SBAR
#undef WAIT_BAR
}
#define GAS __attribute__((address_space(1)))
#define LAS __attribute__((address_space(3)))
typedef unsigned short bf16;
typedef unsigned v4u __attribute__((ext_vector_type(4)));
typedef float f32x4 __attribute__((ext_vector_type(4)));
typedef short bf16x8 __attribute__((ext_vector_type(8)));
typedef GAS unsigned gu32;
typedef GAS unsigned long long gu64;
#define RLX_AGENT __ATOMIC_RELAXED, __HIP_MEMORY_SCOPE_AGENT
#define LDS_WAIT() asm volatile("s_waitcnt lgkmcnt(0)" ::: "memory")
#define VM_WAIT() asm volatile("s_waitcnt vmcnt(0)" ::: "memory")
__device__ __forceinline__ unsigned long long rt() { return __builtin_amdgcn_s_memrealtime(); }
__device__ __forceinline__ unsigned f2bf(float f) { unsigned u = __builtin_bit_cast(unsigned, f); return (u + 0x7fffu + ((u >> 16) & 1u)) >> 16; }
__device__ __forceinline__ unsigned pk2(float lo, float hi) { return f2bf(lo) | (f2bf(hi) << 16); }

#define XB_TMO      128
#define XB_XCNT(j)  (256  + 64 * (j))
#define XB_XSUB(j)  (1280 + 64 * (j))
#define XB_XGEN(j)  (2304 + 64 * (j))
#define XB_TOP      3328
#define XB_TOPGEN   3392
#define XCD_BAR_WORDS 3456
#define XB_SPIN_CAP (1u << 18)

__device__ __forceinline__ unsigned xb_ld(unsigned* p)              { return __hip_atomic_load(p, __ATOMIC_RELAXED, __HIP_MEMORY_SCOPE_AGENT); }
__device__ __forceinline__ unsigned xb_add(unsigned* p, unsigned v) { return __hip_atomic_fetch_add(p, v, __ATOMIC_RELAXED, __HIP_MEMORY_SCOPE_AGENT); }
__device__ __forceinline__ unsigned xb_xcc_id() { return (unsigned)__builtin_amdgcn_s_getreg((3 << 11) | 20) & 0xFu; }
#define XB_SPIN(cond, bar) do { unsigned _sp = 0; while (cond) { __builtin_amdgcn_s_sleep(1); \
    if ((++_sp & 255u) == 0u) { if (xb_ld(&(bar)[XB_TMO])) break; if (_sp > XB_SPIN_CAP) { atomicAdd(&(bar)[XB_TMO], 1u); break; } } } } while (0)

struct XcdBarrier {
    unsigned* bar; unsigned x;
    volatile LAS unsigned* st;
};

__device__ __forceinline__ XcdBarrier xcd_barrier_post(unsigned* bar, volatile LAS unsigned* st) {
    XcdBarrier b; b.bar = bar; b.x = xb_xcc_id(); b.st = st;
    if (threadIdx.x == 0) (void)xb_add(&bar[XB_XCNT(b.x)], 1u);
    return b;
}
__device__ __forceinline__ void xcd_barrier_complete(unsigned* bar, unsigned x, unsigned& nloc, unsigned& nx) {
    const unsigned G = gridDim.x * gridDim.y * gridDim.z;
    unsigned sum, cnt, mine, sp = 0u;
    for (;;) {
        sum = 0u; cnt = 0u; mine = 0u;
#pragma unroll
        for (unsigned j = 0; j < 16; ++j) { const unsigned c = xb_ld(&bar[XB_XCNT(j)]); sum += c; cnt += (c > 0u) ? 1u : 0u; mine = (j == x) ? c : mine; }
        if (sum == G) break;
        __builtin_amdgcn_s_sleep(1);
        if ((++sp & 255u) == 0u) { if (xb_ld(&bar[XB_TMO])) break; if (sp > XB_SPIN_CAP) { atomicAdd(&bar[XB_TMO], 1u); break; } }
    }
    nloc = mine > 0u ? mine : 1u; nx = cnt > 0u ? cnt : 1u;
}

__device__ __forceinline__ void xcd_barrier(const XcdBarrier& b) {
    asm volatile("s_waitcnt vmcnt(0)" ::: "memory");
    __syncthreads();
    if (threadIdx.x == 0) {
        unsigned* bar = b.bar;
        __builtin_amdgcn_s_waitcnt(0);
        unsigned nloc = b.st[0], nx = b.st[1];
        if (nloc == 0u) { xcd_barrier_complete(bar, b.x, nloc, nx); b.st[0] = nloc; b.st[1] = nx; }
        const unsigned old = xb_add(&bar[XB_XSUB(b.x)], 1u);
        const unsigned gen = old / nloc;
        if (old + 1u == (gen + 1u) * nloc) {
            __builtin_amdgcn_fence(__ATOMIC_RELEASE, "agent");
            asm volatile("s_waitcnt vmcnt(0)" ::: "memory");
            const unsigned og = xb_add(&bar[XB_TOP], 1u);
            const unsigned tg = og / nx;
            if (og + 1u == (tg + 1u) * nx) xb_add(&bar[XB_TOPGEN], 1u);
            else XB_SPIN(xb_ld(&bar[XB_TOPGEN]) == tg, bar);
            __builtin_amdgcn_fence(__ATOMIC_ACQUIRE, "agent");
            xb_add(&bar[XB_XGEN(b.x)], 1u);
            asm volatile("s_waitcnt vmcnt(0)" ::: "memory");
        } else {
            XB_SPIN(xb_ld(&bar[XB_XGEN(b.x)]) == gen, bar);
            __builtin_amdgcn_fence(__ATOMIC_ACQUIRE, "agent");
            asm volatile("s_waitcnt vmcnt(0)" ::: "memory");
        }
    }
    __syncthreads();
}

constexpr int NWAVES = 8;
constexpr int DM = 1024, BATCH = 16, SEQ = 2048, MROWS = BATCH * SEQ;
constexpr int A_FFN = 6144, A_HALF = 3072, A_GROUPS = 8, A_GD = 384, GCH = 128, CHK = 64;
constexpr int D_FF = 2816, NEXP = 8, D_EXP = 3584, NHEAD = 16, HD = 64;
constexpr int KVW_LD = 2 * DM + NHEAD;
constexpr float RMS_EPS = 1e-6f;
enum { I_X = 0, I_A_NORM_G, I_A_W_IN, I_A_V_NORM_G, I_A_W_SP, I_A_B_SP, I_A_W_OUT, I_F_NORM_G, I_F_W_IN, I_F_W_OUT, I_KV_NORM_G, I_KV_W, I_KV_B_F, I_K_NORM_G,
       I_B_NORM_G, I_B_W_IN, I_Q_NORM_G, I_B_W_OUT, I_M_NORM_G, I_M_W_ROUTER, I_M_W_IN, I_M_W_OUT, N_IN };

constexpr size_t MiB = 1u << 20;
constexpr size_t WS_CTL = 0, CTL_ZERO_BYTES = 1 * MiB;
constexpr size_t WS_RV = 1 * MiB;
constexpr size_t WS_FG = 2 * MiB;
constexpr size_t WS_F = 4 * MiB;
constexpr size_t WS_GATES = 6 * MiB;
constexpr size_t WS_WA_IN = 8 * MiB, WS_WA_OUT = 20 * MiB, WS_WF_IN = 26 * MiB, WS_WF_OUT = 37 * MiB, WS_WKV = 43 * MiB, WS_WBIN = 47 * MiB, WS_WBOUT = 51 * MiB;
constexpr size_t WS_WM_IN = 53 * MiB, WS_WM_OUT = 165 * MiB;
constexpr size_t WS_XN = 222 * MiB, WS_XQ = 286 * MiB;
constexpr size_t WS_BIG = 350 * MiB;
constexpr size_t WS_END = 734 * MiB;
constexpr int CW_BAR = 4096;

constexpr int RING_OFF = 0, RING_BYTES = 131072;
constexpr int LDSCTL_OFF = RING_BYTES, MISC_OFF = LDSCTL_OFF + 320;
constexpr int LDS_BYTES = 147456;

struct Frame {
    LAS unsigned char* lds; volatile LAS unsigned* MISC; gu32* ctl;
    int tid, lane, wave, vcu, G;
};
__device__ __forceinline__ float wave_sum(float v) {
#pragma unroll
    for (int o = 1; o < 64; o <<= 1) v += __shfl_xor(v, o);
    return v;
}
template <class RowMap>
__device__ __forceinline__ void tr_item(const float* W, int ldw, int K, bf16* WT, LAS float* scr, int k0, int n0, int lane, const RowMap& rowmap) {
#pragma unroll 8
    for (int i = 0; i < 32; ++i) { const int kk = 2 * i + (lane >> 5); scr[kk * 33 + (lane & 31)] = W[(size_t)(k0 + kk) * ldw + n0 + (lane & 31)]; }
    LDS_WAIT(); asm volatile("" ::: "memory");
    const int c = lane & 7;
#pragma unroll
    for (int j = 0; j < 4; ++j) { const int n = (lane >> 3) + 8 * j; const LAS float* s = scr + (8 * c) * 33 + n;
        v4u o; o.x = pk2(s[0 * 33], s[1 * 33]); o.y = pk2(s[2 * 33], s[3 * 33]); o.z = pk2(s[4 * 33], s[5 * 33]); o.w = pk2(s[6 * 33], s[7 * 33]);
        *(GAS v4u*)(WT + (size_t)rowmap(n0 + n) * K + k0 + 8 * c) = o; }
    LDS_WAIT(); asm volatile("" ::: "memory");
}
struct MapId { __device__ __forceinline__ int operator()(int n) const { return n; } };
struct MapGlu { int half; __device__ __forceinline__ int operator()(int n) const { const int b = n >= half ? 1 : 0, x = n - b * half; return (x >> 7) * 256 + b * 128 + (x & 127); } };
template <class RowMap>
__device__ __forceinline__ void tr_matrix(Frame& F, const float* W, int ldw, int K, int ncols, bf16* WT, const RowMap& rm, int& gwoff) {
    LAS float* scr = (LAS float*)(F.lds + RING_OFF + F.wave * 16384);
    const int NGW = F.G * NWAVES, nblk = ncols / 32, items = (K / 64) * nblk;
    int gw = F.vcu * NWAVES + F.wave - gwoff; if (gw < 0) gw += NGW;
    for (int it = gw; it < items; it += NGW) tr_item(W, ldw, K, WT, scr, 64 * (it / nblk), 32 * (it % nblk), F.lane, rm);
    gwoff = (gwoff + items) % NGW;
}
__device__ __forceinline__ float rms_row_load(const float* xrow, int lane, f32x4 (&v)[4]) {
    const GAS f32x4* xr = (const GAS f32x4*)xrow + lane; float s = 0.f;
#pragma unroll
    for (int j = 0; j < 4; ++j) { v[j] = xr[64 * j]; s += (v[j].x * v[j].x + v[j].y * v[j].y) + (v[j].z * v[j].z + v[j].w * v[j].w); }
    return 1.0f / sqrtf(wave_sum(s) * (1.f / DM) + RMS_EPS);
}
__device__ __forceinline__ void rms_row_store(const f32x4 (&v)[4], float rstd, const float* g, bf16* orow, int lane, float extra = 1.0f) {
    const GAS f32x4* gr = (const GAS f32x4*)g + lane; GAS unsigned long long* o8 = (GAS unsigned long long*)orow + lane;
#pragma unroll
    for (int j = 0; j < 4; ++j) { const f32x4 gg = gr[64 * j]; const f32x4 y = (v[j] * rstd) * gg * extra;
        o8[64 * j] = (unsigned long long)pk2(y.x, y.y) | ((unsigned long long)pk2(y.z, y.w) << 32); }
}
__device__ __forceinline__ float bflo(unsigned u) { return __uint_as_float(u << 16); }
__device__ __forceinline__ float bfhi(unsigned u) { return __uint_as_float(u & 0xffff0000u); }
__device__ __forceinline__ float log_sigmoid(float x) { return x >= 0.f ? -log1pf(expf(-x)) : x - log1pf(expf(x)); }

enum { PH_PRO = 0, PH_GEMM1, PH_RV, PH_SPATIAL, PH_GEMM2, PH_NORM_F, PH_FFN_UP, PH_FFN_DOWN, PH_NORM_KV, PH_KVQ, PH_HEADNORM, PH_ATTN, PH_OPROJ, PH_ROUTER, PH_MOE0, PH_END = PH_MOE0 + 2 * NEXP };
#ifndef MK_ONE_LAUNCH
#define MK_ONE_LAUNCH 0
#endif
#ifndef MK_PH_STOP
#define MK_PH_STOP PH_END
#endif

struct Args { const float* in[N_IN]; float* out; unsigned char* ws; int ph_lo, ph_hi, li, pad; };
__global__ void __launch_bounds__(NWAVES * 64, 2) yoco_fwd(Args args) {
    extern __shared__ __attribute__((aligned(16))) unsigned char lds[];
    Frame F;
    F.lds = (LAS unsigned char*)lds; F.MISC = (volatile LAS unsigned*)(F.lds + MISC_OFF);
    F.tid = threadIdx.x; F.lane = F.tid & 63; F.wave = __builtin_amdgcn_readfirstlane(F.tid >> 6);
    F.G = gridDim.x; { const int bx = blockIdx.x; F.vcu = (F.G % 8 == 0) ? (bx % 8) * (F.G / 8) + bx / 8 : bx; }
    unsigned char* ws = args.ws; F.ctl = (gu32*)(ws + WS_CTL);
    for (int u = F.tid; u < (LDS_BYTES - LDSCTL_OFF) / 4; u += NWAVES * 64) ((LAS unsigned*)(F.lds + LDSCTL_OFF))[u] = 0u;
    __syncthreads();
    XcdBarrier bar; bar.bar = (unsigned*)(F.ctl + CW_BAR) + args.li * XCD_BAR_WORDS; bar.x = 0; bar.st = nullptr;
    if (MK_ONE_LAUNCH) bar = xcd_barrier_post((unsigned*)(F.ctl + CW_BAR) + args.li * XCD_BAR_WORDS, F.MISC + 8);
#define GRID_BAR() do { if (MK_ONE_LAUNCH) xcd_barrier(bar); } while (0)
    const int lo = args.ph_lo, hi = args.ph_hi;
#ifndef MK_PHMASK
#define MK_PHMASK 0xffffffffu
#endif
#define IN(k) (((MK_PHMASK >> ((k) < 14 ? (k) : 14 + (((k) - 14) & 1))) & 1u) && lo <= (k) && (k) < hi)
#define BOTH(k) (IN(k) && IN((k) + 1))
    const float* x = args.in[I_X]; float* H = args.out;
    bf16* WA_IN = (bf16*)(ws + WS_WA_IN); bf16* WA_OUT = (bf16*)(ws + WS_WA_OUT); bf16* WF_IN = (bf16*)(ws + WS_WF_IN); bf16* WF_OUT = (bf16*)(ws + WS_WF_OUT);
    bf16* WKV = (bf16*)(ws + WS_WKV); bf16* WBIN = (bf16*)(ws + WS_WBIN); bf16* WBOUT = (bf16*)(ws + WS_WBOUT); bf16* WM_IN = (bf16*)(ws + WS_WM_IN); bf16* WM_OUT = (bf16*)(ws + WS_WM_OUT);
    bf16* XN = (bf16*)(ws + WS_XN); bf16* XQ = (bf16*)(ws + WS_XQ); bf16* BIG = (bf16*)(ws + WS_BIG);
    float* RV = (float*)(ws + WS_RV); float* FG = (float*)(ws + WS_FG); float* FC = (float*)(ws + WS_F); float* GATES = (float*)(ws + WS_GATES);
    bf16* KB = BIG; bf16* VB = BIG + (size_t)MROWS * DM; bf16* QB = BIG + (size_t)2 * MROWS * DM; bf16* GB = BIG + (size_t)3 * MROWS * DM;
    const int gw = F.vcu * NWAVES + F.wave, NGW = F.G * NWAVES;

    if (IN(PH_PRO)) {
        int go = 0;
        tr_matrix(F, args.in[I_A_W_IN], A_FFN, DM, A_FFN, WA_IN, MapId{}, go);
        tr_matrix(F, args.in[I_A_W_OUT], DM, A_HALF, DM, WA_OUT, MapId{}, go);
        tr_matrix(F, args.in[I_F_W_IN], 2 * D_FF, DM, 2 * D_FF, WF_IN, MapGlu{D_FF}, go);
        tr_matrix(F, args.in[I_F_W_OUT], DM, D_FF, DM, WF_OUT, MapId{}, go);
        tr_matrix(F, args.in[I_KV_W], KVW_LD, DM, 2 * DM, WKV, MapId{}, go);
        tr_matrix(F, args.in[I_B_W_IN], 2 * DM, DM, 2 * DM, WBIN, MapId{}, go);
        tr_matrix(F, args.in[I_B_W_OUT], DM, DM, DM, WBOUT, MapId{}, go);
        for (int e = 0; e < NEXP; ++e) {
            tr_matrix(F, args.in[I_M_W_IN] + (size_t)e * DM * 2 * D_EXP, 2 * D_EXP, DM, 2 * D_EXP, WM_IN + (size_t)e * 2 * D_EXP * DM, MapGlu{D_EXP}, go);
            tr_matrix(F, args.in[I_M_W_OUT] + (size_t)e * D_EXP * DM, DM, D_EXP, DM, WM_OUT + (size_t)e * DM * D_EXP, MapId{}, go);
        }
        for (int m = gw; m < MROWS; m += NGW) { f32x4 v[4]; const float r = rms_row_load(x + (size_t)m * DM, F.lane, v); rms_row_store(v, r, args.in[I_A_NORM_G], XN + (size_t)m * DM, F.lane); }
        if (BOTH(PH_PRO)) GRID_BAR();
    }
    if (IN(PH_GEMM1)) {
        pg8::Gemm g{XN, WA_IN, MROWS, A_FFN, DM, DM}; pg8::StaticOrder S; S.init(MROWS, A_FFN, F.G, (int)blockIdx.x);
        pg8::EpiBf16<1> E{BIG, A_FFN, nullptr, 0, 0, 1.f};
        pg8::gemm_phase<pg8::EpiBf16<1>, pg8::StaticOrder, true, true>(F.lds + RING_OFF, g, S, E);
        if (BOTH(PH_GEMM1)) GRID_BAR();
    }
    if (IN(PH_RV)) {
        for (int m = gw; m < MROWS; m += NGW) { const GAS v4u* vr = (const GAS v4u*)(BIG + (size_t)m * A_FFN + A_HALF) + F.lane; float s = 0.f;
#pragma unroll
            for (int j = 0; j < 6; ++j) { const v4u w = vr[64 * j];
#pragma unroll
                for (int c = 0; c < 4; ++c) { const float a = bflo(w[c]), b = bfhi(w[c]); s += a * a + b * b; } }
            s = wave_sum(s); if (F.lane == 0) RV[m] = 1.0f / sqrtf(s * (1.f / A_HALF) + RMS_EPS); }
        if (BOTH(PH_RV)) GRID_BAR();
    }
    if (IN(PH_SPATIAL)) {
        LAS float* Ws = (LAS float*)(F.lds + RING_OFF);
        const float* wsp = args.in[I_A_W_SP]; const float* bsp = args.in[I_A_B_SP]; const float* gvn = args.in[I_A_V_NORM_G];
        for (int u = F.vcu; u < (MROWS / GCH) * A_GROUPS; u += F.G) {
            const int cc = u / A_GROUPS, g = u % A_GROUPS; const size_t r0 = (size_t)cc * GCH;
            __syncthreads();
            for (int e = F.tid; e < GCH * GCH; e += NWAVES * 64) { const int i = e >> 7, j = e & 127; Ws[e] = ((j / CHK) <= (i / CHK)) ? wsp[(size_t)g * GCH * GCH + e] * RV[r0 + j] : 0.f; }
            __syncthreads();
            if (F.tid < A_GD) {
                const int c = g * A_GD + F.tid; const float gvc = gvn[c];
                float vr[GCH];
#pragma unroll
                for (int j = 0; j < GCH; ++j) vr[j] = bflo((unsigned)BIG[(r0 + j) * A_FFN + A_HALF + c]) * gvc;
                for (int i = 0; i < GCH; ++i) { float a = 0.f;
#pragma unroll
                    for (int j = 0; j < GCH; j += 4) { const f32x4 w = *(const LAS f32x4*)(Ws + i * GCH + j); a += w.x * vr[j] + w.y * vr[j + 1] + w.z * vr[j + 2] + w.w * vr[j + 3]; }
                    bf16* up = BIG + (r0 + i) * A_FFN + c; const float uu = bflo((unsigned)*up); *up = (bf16)f2bf(uu * (a + bsp[g * GCH + i])); }
            }
        }
        if (BOTH(PH_SPATIAL)) GRID_BAR();
    }
    if (IN(PH_GEMM2)) {
        pg8::Gemm g{BIG, WA_OUT, MROWS, DM, A_HALF, A_FFN}; pg8::StaticOrder S; S.init(MROWS, DM, F.G, (int)blockIdx.x);
        pg8::EpiF32Res E{x, H, DM, nullptr, 0};
        pg8::gemm_phase<pg8::EpiF32Res, pg8::StaticOrder, true, true>(F.lds + RING_OFF, g, S, E);
        if (BOTH(PH_GEMM2)) GRID_BAR();
    }
    if (IN(PH_NORM_F)) {
        for (int m = gw; m < MROWS; m += NGW) { f32x4 v[4]; const float r = rms_row_load(H + (size_t)m * DM, F.lane, v); rms_row_store(v, r, args.in[I_F_NORM_G], XN + (size_t)m * DM, F.lane); }
        if (BOTH(PH_NORM_F)) GRID_BAR();
    }
    if (IN(PH_FFN_UP)) {
        pg8::Gemm g{XN, WF_IN, MROWS, 2 * D_FF, DM, DM}; pg8::StaticOrder S; S.init(MROWS, 2 * D_FF, F.G, (int)blockIdx.x);
        pg8::EpiSwiGLU E{BIG, D_FF};
        pg8::gemm_phase<pg8::EpiSwiGLU, pg8::StaticOrder, true, true>(F.lds + RING_OFF, g, S, E);
        if (BOTH(PH_FFN_UP)) GRID_BAR();
    }
    if (IN(PH_FFN_DOWN)) {
        pg8::Gemm g{BIG, WF_OUT, MROWS, DM, D_FF, D_FF}; pg8::StaticOrder S; S.init(MROWS, DM, F.G, (int)blockIdx.x);
        pg8::EpiF32Res E{H, H, DM, nullptr, 0};
        pg8::gemm_phase<pg8::EpiF32Res, pg8::StaticOrder, true, true>(F.lds + RING_OFF, g, S, E);
        if (BOTH(PH_FFN_DOWN)) GRID_BAR();
    }
    if (IN(PH_NORM_KV)) {
        LAS float* Wf = (LAS float*)(F.lds + RING_OFF);
        __syncthreads();
        for (int e = F.tid; e < DM * NHEAD; e += NWAVES * 64) Wf[e] = args.in[I_KV_W][(size_t)(e >> 4) * KVW_LD + 2 * DM + (e & 15)];
        __syncthreads();
        for (int m = gw; m < MROWS; m += NGW) { f32x4 v[4]; const float r = rms_row_load(H + (size_t)m * DM, F.lane, v);
            rms_row_store(v, r, args.in[I_KV_NORM_G], XN + (size_t)m * DM, F.lane); rms_row_store(v, r, args.in[I_B_NORM_G], XQ + (size_t)m * DM, F.lane);
            float a[NHEAD];
#pragma unroll
            for (int h = 0; h < NHEAD; ++h) a[h] = 0.f;
            const GAS f32x4* gr = (const GAS f32x4*)args.in[I_KV_NORM_G] + F.lane;
#pragma unroll
            for (int j = 0; j < 4; ++j) { const f32x4 s4 = (v[j] * r) * gr[64 * j];
#pragma unroll
                for (int e = 0; e < 4; ++e) { const int k = 4 * F.lane + 256 * j + e; const float sk = s4[e];
#pragma unroll
                    for (int q = 0; q < 4; ++q) { const f32x4 w = *(const LAS f32x4*)(Wf + k * NHEAD + 4 * q); a[4 * q] += sk * w.x; a[4 * q + 1] += sk * w.y; a[4 * q + 2] += sk * w.z; a[4 * q + 3] += sk * w.w; } asm volatile("" ::: "memory"); } }
            float mine = 0.f;
#pragma unroll
            for (int h = 0; h < NHEAD; ++h) { const float t = wave_sum(a[h]); if (F.lane == h) mine = t; }
            if (F.lane < NHEAD) FG[(size_t)m * NHEAD + F.lane] = mine; }
        if (BOTH(PH_NORM_KV)) GRID_BAR();
    }
    if (IN(PH_KVQ)) {
        { pg8::Gemm g{XN, WKV, MROWS, 2 * DM, DM, DM}; pg8::StaticOrder S; S.init(MROWS, 2 * DM, F.G, (int)blockIdx.x);
          pg8::EpiBf16<0> E{KB, DM, nullptr, DM, (size_t)MROWS * DM, 1.f};
          pg8::gemm_phase<pg8::EpiBf16<0>, pg8::StaticOrder, true, true>(F.lds + RING_OFF, g, S, E); }
        { pg8::Gemm g{XQ, WBIN, MROWS, 2 * DM, DM, DM}; pg8::StaticOrder S; S.init(MROWS, 2 * DM, F.G, (int)blockIdx.x);
          pg8::EpiBf16<0> E{QB, DM, nullptr, DM, (size_t)MROWS * DM, 1.f};
          pg8::gemm_phase<pg8::EpiBf16<0>, pg8::StaticOrder, true, true>(F.lds + RING_OFF, g, S, E); }
        if (BOTH(PH_KVQ)) GRID_BAR();
    }
    if (IN(PH_HEADNORM)) {
        for (int m = gw; m < MROWS; m += NGW) {
#pragma unroll
            for (int which = 0; which < 2; ++which) { bf16* p = (which ? QB : KB) + (size_t)m * DM + 16 * F.lane; const float* gn = args.in[which ? I_Q_NORM_G : I_K_NORM_G] + 16 * (F.lane & 3);
                const v4u w0 = *(const GAS v4u*)p, w1 = *(const GAS v4u*)(p + 8); float f[16];
#pragma unroll
                for (int c = 0; c < 4; ++c) { f[2 * c] = bflo(w0[c]); f[2 * c + 1] = bfhi(w0[c]); f[8 + 2 * c] = bflo(w1[c]); f[8 + 2 * c + 1] = bfhi(w1[c]); }
                float s = 0.f;
#pragma unroll
                for (int c = 0; c < 16; ++c) s += f[c] * f[c];
                s += __shfl_xor(s, 1); s += __shfl_xor(s, 2);
                const float r = 1.0f / sqrtf(s * (1.f / HD) + RMS_EPS), ex = which ? attn_body::C2 : 1.0f;
                v4u o0, o1;
#pragma unroll
                for (int c = 0; c < 4; ++c) { o0[c] = pk2(f[2 * c] * r * gn[2 * c] * ex, f[2 * c + 1] * r * gn[2 * c + 1] * ex); o1[c] = pk2(f[8 + 2 * c] * r * gn[8 + 2 * c] * ex, f[8 + 2 * c + 1] * r * gn[8 + 2 * c + 1] * ex); }
                *(GAS v4u*)p = o0; *(GAS v4u*)(p + 8) = o1; }
            { bf16* p = GB + (size_t)m * DM + 16 * F.lane; const v4u w0 = *(const GAS v4u*)p, w1 = *(const GAS v4u*)(p + 8); v4u o0, o1;
#pragma unroll
              for (int c = 0; c < 4; ++c) { o0[c] = pk2(1.0f / (1.0f + expf(-bflo(w0[c]))), 1.0f / (1.0f + expf(-bfhi(w0[c])))); o1[c] = pk2(1.0f / (1.0f + expf(-bflo(w1[c]))), 1.0f / (1.0f + expf(-bfhi(w1[c])))); }
              *(GAS v4u*)p = o0; *(GAS v4u*)(p + 8) = o1; }
        }
        LAS float* wtot = (LAS float*)(F.lds + RING_OFF);
        for (int bh = F.vcu; bh < BATCH * NHEAD; bh += F.G) { const int b = bh / NHEAD, h = bh % NHEAD; const float bf = args.in[I_KV_B_F][h];
            float p[4]; float run = 0.f;
#pragma unroll
            for (int i = 0; i < 4; ++i) { run += log_sigmoid(FG[((size_t)b * SEQ + 4 * F.tid + i) * NHEAD + h] + bf); p[i] = run; }
            float inc = run;
#pragma unroll
            for (int o = 1; o < 64; o <<= 1) { const float t = __shfl_up(inc, o); if (F.lane >= o) inc += t; }
            __syncthreads();
            if (F.lane == 63) wtot[F.wave] = inc;
            __syncthreads();
            float base = inc - run;
            for (int w = 0; w < F.wave; ++w) base += wtot[w];
#pragma unroll
            for (int i = 0; i < 4; ++i) FC[(size_t)bh * SEQ + 4 * F.tid + i] = base + p[i];
        }
        if (BOTH(PH_HEADNORM)) GRID_BAR();
    }
    if (IN(PH_ATTN)) {
        __syncthreads();
        const attn_body::AttnTensors AT{(const attn_body::bf16*)QB, (const attn_body::bf16*)KB, (const attn_body::bf16*)VB, (const attn_body::bf16*)GB, (attn_body::bf16*)QB, FC};
        const attn_body::StaticOrder AS{F.vcu, F.G}; attn_body::attn_phase<attn_body::StaticOrder>((char*)lds + RING_OFF, AT, AS);
        if (BOTH(PH_ATTN)) GRID_BAR();
    }
    if (IN(PH_OPROJ)) {
        pg8::Gemm g{QB, WBOUT, MROWS, DM, DM, DM}; pg8::StaticOrder S; S.init(MROWS, DM, F.G, (int)blockIdx.x);
        pg8::EpiF32Res E{H, H, DM, nullptr, 0};
        pg8::gemm_phase<pg8::EpiF32Res, pg8::StaticOrder, true, true>(F.lds + RING_OFF, g, S, E);
        if (BOTH(PH_OPROJ)) GRID_BAR();
    }
    if (IN(PH_ROUTER)) {
        LAS float* Wr = (LAS float*)(F.lds + RING_OFF);
        __syncthreads();
        for (int e = F.tid; e < DM * NEXP; e += NWAVES * 64) Wr[e] = args.in[I_M_W_ROUTER][e];
        __syncthreads();
        for (int m = gw; m < MROWS; m += NGW) { f32x4 v[4]; const float r = rms_row_load(H + (size_t)m * DM, F.lane, v);
            rms_row_store(v, r, args.in[I_M_NORM_G], XN + (size_t)m * DM, F.lane);
            float a[NEXP];
#pragma unroll
            for (int h = 0; h < NEXP; ++h) a[h] = 0.f;
            const GAS f32x4* gr = (const GAS f32x4*)args.in[I_M_NORM_G] + F.lane;
#pragma unroll
            for (int j = 0; j < 4; ++j) { const f32x4 s4 = (v[j] * r) * gr[64 * j];
#pragma unroll
                for (int e = 0; e < 4; ++e) { const int k = 4 * F.lane + 256 * j + e; const float sk = s4[e];
#pragma unroll
                    for (int q = 0; q < 2; ++q) { const f32x4 w = *(const LAS f32x4*)(Wr + k * NEXP + 4 * q); a[4 * q] += sk * w.x; a[4 * q + 1] += sk * w.y; a[4 * q + 2] += sk * w.z; a[4 * q + 3] += sk * w.w; } } }
#pragma unroll
            for (int h = 0; h < NEXP; ++h) a[h] = wave_sum(a[h]);
            int i1 = 0; float v1 = a[0];
#pragma unroll
            for (int h = 1; h < NEXP; ++h) if (a[h] > v1) { v1 = a[h]; i1 = h; }
            int i2 = -1; float v2 = -INFINITY;
#pragma unroll
            for (int h = 0; h < NEXP; ++h) if (h != i1 && a[h] > v2) { v2 = a[h]; i2 = h; }
            const float e2 = expf(v2 - v1), w1 = 1.0f / (1.0f + e2), w2 = e2 / (1.0f + e2);
            if (F.lane < NEXP) GATES[(size_t)m * NEXP + F.lane] = (F.lane == i1) ? w1 : (F.lane == i2) ? w2 : 0.f; }
        if (BOTH(PH_ROUTER)) GRID_BAR();
    }
    for (int e = 0; e < NEXP; ++e) {
        if (IN(PH_MOE0 + 2 * e)) {
            pg8::Gemm g{XN, WM_IN + (size_t)e * 2 * D_EXP * DM, MROWS, 2 * D_EXP, DM, DM}; pg8::StaticOrder S; S.init(MROWS, 2 * D_EXP, F.G, (int)blockIdx.x);
            pg8::EpiSwiGLU E{BIG, D_EXP};
            pg8::gemm_phase<pg8::EpiSwiGLU, pg8::StaticOrder, true, true>(F.lds + RING_OFF, g, S, E);
            if (BOTH(PH_MOE0 + 2 * e)) GRID_BAR();
        }
        if (IN(PH_MOE0 + 2 * e + 1)) {
            pg8::Gemm g{BIG, WM_OUT + (size_t)e * DM * D_EXP, MROWS, DM, D_EXP, D_EXP}; pg8::StaticOrder S; S.init(MROWS, DM, F.G, (int)blockIdx.x);
            pg8::EpiF32Res E{H, H, DM, GATES + e, NEXP};
            pg8::gemm_phase<pg8::EpiF32Res, pg8::StaticOrder, true, true>(F.lds + RING_OFF, g, S, E);
            if (BOTH(PH_MOE0 + 2 * e + 1)) GRID_BAR();
        }
    }
#undef IN
#undef BOTH
}

extern "C" void kernel_launch(void* const* d_in, const int* in_sizes, int n_in, void* d_out, int out_size, void* d_ws, size_t ws_size, hipStream_t stream) {
    static int grid = 0;
    if (grid == 0) {
        if (n_in != N_IN || in_sizes[0] != MROWS * DM || out_size != MROWS * DM || ws_size < WS_END) { fprintf(stderr, "kernel_launch: unexpected shapes / workspace (n_in %d, in0 %d, out %d, ws %zu < %zu)\n", n_in, n_in > 0 ? in_sizes[0] : -1, out_size, ws_size, (size_t)WS_END); grid = -1; return; }
        int dev = 0, cus = 0, per_cu = 0;
        if (hipGetDevice(&dev) != hipSuccess || hipDeviceGetAttribute(&cus, hipDeviceAttributeMultiprocessorCount, dev) != hipSuccess) { grid = -1; return; }
        if (hipFuncSetAttribute((const void*)yoco_fwd, hipFuncAttributeMaxDynamicSharedMemorySize, LDS_BYTES) != hipSuccess) { fprintf(stderr, "kernel_launch: hipFuncSetAttribute failed\n"); grid = -1; return; }
        if (hipOccupancyMaxActiveBlocksPerMultiprocessor(&per_cu, (const void*)yoco_fwd, NWAVES * 64, LDS_BYTES) != hipSuccess || per_cu < 1) fprintf(stderr, "kernel_launch: occupancy query reports %d\n", per_cu);
        (void)hipGetLastError();
        grid = cus;
    }
    if (grid < 0) return;
    if (hipMemsetAsync((char*)d_ws + WS_CTL, 0, CTL_ZERO_BYTES, stream) != hipSuccess) return;
    Args a{};
    for (int i = 0; i < N_IN; ++i) a.in[i] = (const float*)d_in[i];
    a.out = (float*)d_out; a.ws = (unsigned char*)d_ws;
#if MK_ONE_LAUNCH
    a.ph_lo = 0; a.ph_hi = MK_PH_STOP; a.li = 0;
    hipLaunchKernelGGL(yoco_fwd, dim3(grid), dim3(NWAVES * 64), LDS_BYTES, stream, a);
#else
    for (int p = 0; p < MK_PH_STOP; ++p) { a.ph_lo = p; a.ph_hi = p + 1; a.li = 0; hipLaunchKernelGGL(yoco_fwd, dim3(grid), dim3(NWAVES * 64), LDS_BYTES, stream, a); }
#endif
}
```

```cpp
#include <hip/hip_runtime.h>
#include <hip/hip_bf16.h>
#include <cstdio>
#include <cstdint>
#include <cmath>
namespace pg8 {
#define PG8_LAS __attribute__((address_space(3)))
typedef unsigned short bf16_t;
typedef short bf16x8 __attribute__((ext_vector_type(8)));
typedef float f32x4 __attribute__((ext_vector_type(4)));
typedef unsigned u32x4 __attribute__((ext_vector_type(4)));
constexpr int BM = 256, BK = 64, HALF = 128, HTB = HALF * BK * 2  , STAGE_BYTES = 8 * HTB, NXCD = 8, WGM = 8;

__host__ __device__ __forceinline__ int lds_byte(int r, int c) { const int st = (r >> 4) * 2 + (c >> 5), rr = r & 15, cc = c & 31, ob = rr * 64 + cc * 2; return st * 1024 + (ob ^ (((ob >> 9) & 1) << 5)); }
__host__ __device__ __forceinline__ void stage_rc(int b, int& R, int& C) { const int st = b / 1024, sb = b % 1024, swz = sb ^ (((sb >> 9) & 1) << 5); R = (st >> 1) * 16 + swz / 64; C = (st & 1) * 32 + (swz % 64) / 2; }
__host__ __device__ __forceinline__ int perm32(int rho) { const int n = rho >> 4, i = rho & 15; return 8 * (i >> 2) + 4 * n + (i & 3); }

__device__ __forceinline__ const char* uni_ptr(const char* p) { const unsigned long long v = (unsigned long long)p; const unsigned lo = __builtin_amdgcn_readfirstlane((unsigned)v), hi = __builtin_amdgcn_readfirstlane((unsigned)(v >> 32)); return (const char*)(((unsigned long long)hi << 32) | lo); }
struct Unit { int pm, pn, kp; };
struct Gemm { const bf16_t* A; const bf16_t* Bt; int M, N, K, lda; size_t bstride; const unsigned* rowlist; int ldb; const unsigned* wlist; int scale_b; };

struct StaticOrder {
    int nM, nN, nwg, G, c;
    __host__ __device__ __forceinline__ void init(int M, int N, int G_, int c_) { nM = M / BM; nN = N / BM; nwg = nM * nN; G = G_; c = c_; }
    __host__ __device__ __forceinline__ bool next(int i, Unit& u) const {
        const long L = (long)i * G + c; if (L >= nwg) return false;
        int wgid = (int)L; { const int q = nwg / NXCD, r = nwg % NXCD, xcd = wgid % NXCD, off = wgid / NXCD; wgid = (xcd < r ? xcd * (q + 1) : r * (q + 1) + (xcd - r) * q) + off; }
        const int nig = WGM * nN, gid = wgid / nig, fm = gid * WGM, gsz = (nM - fm) < WGM ? (nM - fm) : WGM;
        u.pm = fm + ((wgid % nig) % gsz); u.pn = (wgid % nig) / gsz; u.kp = 0; return true;
    }
    __device__ __forceinline__ void a_ready(const Unit&) const {}
    __device__ __forceinline__ void done(const Unit&) const {}
    __device__ __forceinline__ int expert(int) const { return 0; }
    __device__ __forceinline__ size_t kbytes(const Unit&, int) const { return 0; }
    __device__ __forceinline__ int listoff(int) const { return 0; }
    __device__ __forceinline__ int rows(int) const { return 256; }
};
struct GroupedOrder : StaticOrder {
    int ts[9], cnt[8], cap;
    __device__ __forceinline__ int listoff(int pm) const { const int e = expert(pm); int t0 = 0;
#pragma unroll
        for (int k = 1; k < 8; ++k) t0 = (e == k) ? ts[k] : t0;
        return e * cap + (pm - t0) * 256; }
    __device__ __forceinline__ int rows(int pm) const { const int e = expert(pm); int t0 = 0, c = cnt[0];
#pragma unroll
        for (int k = 1; k < 8; ++k) { t0 = (e == k) ? ts[k] : t0; c = (e == k) ? cnt[k] : c; }
        const int r = c - (pm - t0) * 256; return r < 0 ? 0 : (r > 256 ? 256 : r); }
    __device__ __forceinline__ int expert(int pm) const { int e = 0;
#pragma unroll
        for (int k = 1; k < 8; ++k) e += (pm >= ts[k]) ? 1 : 0;
        return e; }
};

__device__ __forceinline__ unsigned cvt_pk_bf16(float lo, float hi) { unsigned r; asm volatile("v_cvt_pk_bf16_f32 %0, %1, %2" : "=v"(r) : "v"(lo), "v"(hi)); return r; }
typedef float f32x2 __attribute__((ext_vector_type(2)));
__device__ __forceinline__ f32x2 gelu_pk(f32x2 v) {
    const f32x2 av = __builtin_elementwise_abs(v), d = av * 0.2316418882f + 1.0f;
    f32x2 t; t.x = __builtin_amdgcn_rcpf(d.x); t.y = __builtin_amdgcn_rcpf(d.y);
    f32x2 q = t * 0.5307027145f + (-0.7265760135f); q = q * t + 0.7107068705f; q = q * t + (-0.142248368f); q = q * t + 0.127414796f; q = q * t;
    const f32x2 s = (v * v) * (-0.72134752044f);
    f32x2 e; e.x = __builtin_amdgcn_exp2f(s.x); e.y = __builtin_amdgcn_exp2f(s.y);
    const f32x2 m = v * (q * e), r = v - m;
    f32x2 o; o.x = v.x < 0.f ? m.x : r.x; o.y = v.y < 0.f ? m.y : r.y; return o;
}
constexpr float GELU_K = 0.84932180f;
__device__ __forceinline__ void gelu_w_pk4(const f32x2 (&w)[4], f32x2 (&o)[4]) {
    constexpr float C[9] = {5.886622071e-01f, -5.522741079e-01f, 4.032063782e-01f, -2.406371087e-01f, 1.149394065e-01f, -4.112898186e-02f, 1.002788637e-02f, -1.450342475e-03f, 9.243155364e-05f};
    f32x2 y[4], p[4], e[4];
#pragma unroll
    for (int i = 0; i < 4; ++i) { y[i].x = __builtin_fabsf(w[i].x); y[i].y = __builtin_fabsf(w[i].y); }
#pragma unroll
    for (int i = 0; i < 4; ++i) p[i] = y[i] * C[8] + C[7];
#pragma unroll
    for (int c = 6; c >= 0; --c)
#pragma unroll
        for (int i = 0; i < 4; ++i) p[i] = p[i] * y[i] + C[c];
#pragma unroll
    for (int i = 0; i < 4; ++i) { const f32x2 s = w[i] * w[i]; e[i].x = __builtin_amdgcn_exp2f(-s.x); e[i].y = __builtin_amdgcn_exp2f(-s.y); }
#pragma unroll
    for (int i = 0; i < 4; ++i) { const f32x2 h = 0.588705011f - p[i] * e[i]; o[i] = w[i] * 0.588705011f + y[i] * h; }
}

template <int ACT  > struct EpiBf16 {
    static constexpr bool PERM = true, AFTER_DRAIN = false; static_assert(ACT == 0 || ACT == 1, "EpiBf16: ACT is 0 (none) or 1 (gelu_pk)");
    bf16_t* O; int ldc; const float* bias; int split_cols; size_t split_stride; float scale0;
    __device__ __forceinline__ void operator()(const f32x4 (&acc)[2][2][4][2], const Unit& u, int wr, int wc, int fr, int fq, int ui = 0, const PG8_LAS unsigned* tab = nullptr) const {
        const int row0 = u.pm * BM + wr * 64 + fr; int colt = u.pn * BM; bf16_t* base = O;
        float sc = 1.f; if (split_cols) { const int t = colt / split_cols; base += (size_t)t * split_stride; colt -= t * split_cols; if (t == 0) sc = scale0; }
        const int col0 = colt + wc * 32 + 8 * fq, bcol0 = u.pn * BM + wc * 32 + 8 * fq;
        f32x4 bv[2][2];
#pragma unroll
        for (int bj = 0; bj < 2; ++bj)
#pragma unroll
            for (int n = 0; n < 2; ++n) bv[bj][n] = bias ? *(const f32x4*)(bias + bcol0 + bj * HALF + 4 * n) : (f32x4){0.f, 0.f, 0.f, 0.f};
#pragma unroll
        for (int ai = 0; ai < 2; ++ai)
#pragma unroll
            for (int m = 0; m < 4; ++m) { bf16_t* rowp = base + (size_t)(row0 + ai * HALF + m * 16) * ldc + col0;
#pragma unroll
                for (int bj = 0; bj < 2; ++bj) { f32x4 v0 = acc[ai][bj][m][0] + bv[bj][0], v1 = acc[ai][bj][m][1] + bv[bj][1];
                    if (ACT == 1) { f32x2 a = gelu_pk((f32x2){v0[0], v0[1]}), b = gelu_pk((f32x2){v0[2], v0[3]}), c = gelu_pk((f32x2){v1[0], v1[1]}), d = gelu_pk((f32x2){v1[2], v1[3]});
                        v0 = (f32x4){a.x, a.y, b.x, b.y}; v1 = (f32x4){c.x, c.y, d.x, d.y}; }
                    v0 = v0 * sc; v1 = v1 * sc; u32x4 w; w.x = cvt_pk_bf16(v0[0], v0[1]); w.y = cvt_pk_bf16(v0[2], v0[3]); w.z = cvt_pk_bf16(v1[0], v1[1]); w.w = cvt_pk_bf16(v1[2], v1[3]);
                    *(u32x4*)(rowp + bj * HALF) = w; } }
    }
};


struct DownMain : GroupedOrder {
    int v, lim;
    __device__ __forceinline__ bool next(int i, Unit& u) const { const int L = i * G + v; if (L >= lim) return false; u.pm = L >> 2; u.pn = L & 3; u.kp = 0; return true; }
};
struct DownTail : GroupedOrder {
    int v, lim, ntask, S;
    __device__ __forceinline__ bool next(int i, Unit& u) const { const int t = i * G + v; if (t >= ntask) return false; const int L = lim + t / S; u.pm = L >> 2; u.pn = L & 3; u.kp = t % S; return true; }
    __device__ __forceinline__ size_t kbytes(const Unit& u, int K) const { return (size_t)u.kp * K * 2; }
};
struct DownMainQ : DownMain { __device__ __forceinline__ int listoff(int pm) const { return pm * 256; } __device__ __forceinline__ int rows(int) const { return 256; } };
struct DownTailQ : DownTail { __device__ __forceinline__ int listoff(int pm) const { return pm * 256; } __device__ __forceinline__ int rows(int) const { return 256; } };
struct DownMain8 : GroupedOrder {
    int v, lim;
    __device__ __forceinline__ bool next(int i, Unit& u) const { const int L = i * G + v; if (L >= lim) return false; u.pm = L >> 3; u.pn = L & 7; u.kp = 0; return true; }
    __device__ __forceinline__ int listoff(int pm) const { return pm * 256; }
    __device__ __forceinline__ int rows(int) const { return 256; }
};
struct DownTail8 : GroupedOrder {
    int v, lim, ntask, S;
    __device__ __forceinline__ bool next(int i, Unit& u) const { const int t = i * G + v; if (t >= ntask) return false; const int L = lim + t / S; u.pm = L >> 3; u.pn = L & 7; u.kp = t % S; return true; }
    __device__ __forceinline__ size_t kbytes(const Unit& u, int K) const { return (size_t)u.kp * K * 2; }
    __device__ __forceinline__ int listoff(int pm) const { return pm * 256; }
    __device__ __forceinline__ int rows(int) const { return 256; }
};
struct EpiF32Res {
    static constexpr bool PERM = false, AFTER_DRAIN = false;
    const float* base; float* out; int ldc; const float* gate; int gstride;
    __device__ __forceinline__ void operator()(const f32x4 (&acc)[2][2][4][2], const Unit& u, int wr, int wc, int fr, int fq, int ui = 0, const PG8_LAS unsigned* tab = nullptr) const {
        const int row0 = u.pm * BM + wr * 64 + fr, col0 = u.pn * BM + wc * 32 + 4 * fq;
#pragma unroll
        for (int ai = 0; ai < 2; ++ai) {
            f32x4 bs[4][2][2];
#pragma unroll
            for (int m = 0; m < 4; ++m) { const size_t off = (size_t)(row0 + ai * HALF + m * 16) * ldc + col0;
#pragma unroll
                for (int bj = 0; bj < 2; ++bj)
#pragma unroll
                    for (int n = 0; n < 2; ++n) bs[m][bj][n] = *(const f32x4*)(base + off + bj * HALF + n * 16); }
#pragma unroll
            for (int m = 0; m < 4; ++m) { const int row = row0 + ai * HALF + m * 16; const size_t off = (size_t)row * ldc + col0;
                const float gs = gate ? gate[(size_t)row * gstride] : 1.0f;
#pragma unroll
                for (int bj = 0; bj < 2; ++bj)
#pragma unroll
                    for (int n = 0; n < 2; ++n) *(f32x4*)(out + off + bj * HALF + n * 16) = bs[m][bj][n] + acc[ai][bj][m][n] * gs; }
            asm volatile("" ::: "memory"); }
    }
};
__device__ __forceinline__ float part16_rstd(const float* part, int row, int fq, float inv_n, float eps) {
    const f32x4 p = *(const f32x4*)(part + (size_t)row * 16 + 4 * fq); float t = (p[0] + p[1]) + (p[2] + p[3]); t += __shfl_xor(t, 16); t += __shfl_xor(t, 32); return 1.0f / sqrtf(t * inv_n + eps); }
template <bool BASE_BF16> struct EpiResBf {
    static constexpr bool PERM = true, AFTER_DRAIN = false;
    const void* base; bf16_t* hb; float* part; int ldc;
    __device__ __forceinline__ void operator()(const f32x4 (&acc)[2][2][4][2], const Unit& u, int wr, int wc, int fr, int fq, int ui = 0, const PG8_LAS unsigned* tab = nullptr) const {
        const int row0 = u.pm * BM + wr * 64 + fr, col0 = u.pn * BM + wc * 32 + 8 * fq;
#pragma unroll
        for (int ai = 0; ai < 2; ++ai) {
            f32x4 bs[4][2][2];
#pragma unroll
            for (int m = 0; m < 4; ++m) { const size_t off = (size_t)(row0 + ai * HALF + m * 16) * ldc + col0;
#pragma unroll
                for (int bj = 0; bj < 2; ++bj) {
                    if (BASE_BF16) { const u32x4 w = *(const u32x4*)((const bf16_t*)base + off + bj * HALF);
                        bs[m][bj][0] = (f32x4){__uint_as_float(w.x << 16), __uint_as_float(w.x & 0xffff0000u), __uint_as_float(w.y << 16), __uint_as_float(w.y & 0xffff0000u)};
                        bs[m][bj][1] = (f32x4){__uint_as_float(w.z << 16), __uint_as_float(w.z & 0xffff0000u), __uint_as_float(w.w << 16), __uint_as_float(w.w & 0xffff0000u)}; }
                    else { bs[m][bj][0] = *(const f32x4*)((const float*)base + off + bj * HALF); bs[m][bj][1] = *(const f32x4*)((const float*)base + off + bj * HALF + 4); } } }
#pragma unroll
            for (int m = 0; m < 4; ++m) { const int row = row0 + ai * HALF + m * 16; const size_t off = (size_t)row * ldc + col0; float ss = 0.f;
#pragma unroll
                for (int bj = 0; bj < 2; ++bj) { const f32x4 o0 = bs[m][bj][0] + acc[ai][bj][m][0], o1 = bs[m][bj][1] + acc[ai][bj][m][1];
                    ss += ((o0[0] * o0[0] + o0[1] * o0[1]) + (o0[2] * o0[2] + o0[3] * o0[3])) + ((o1[0] * o1[0] + o1[1] * o1[1]) + (o1[2] * o1[2] + o1[3] * o1[3]));
                    u32x4 w; w.x = cvt_pk_bf16(o0[0], o0[1]); w.y = cvt_pk_bf16(o0[2], o0[3]); w.z = cvt_pk_bf16(o1[0], o1[1]); w.w = cvt_pk_bf16(o1[2], o1[3]); *(u32x4*)(hb + off + bj * HALF) = w; }
                if (part) { ss += __shfl_xor(ss, 16); ss += __shfl_xor(ss, 32); if (fq == 0) part[(size_t)row * 16 + 4 * u.pn + wc] = ss; } }
            asm volatile("" ::: "memory"); }
    }
};
struct EpiGeluSq {
    static constexpr bool PERM = true, AFTER_DRAIN = false;
    bf16_t* O; int ldc; float* vpart; int pn_sq; const PG8_LAS float* rtab;
    __device__ __forceinline__ void operator()(const f32x4 (&acc)[2][2][4][2], const Unit& u, int wr, int wc, int fr, int fq, int ui = 0, const PG8_LAS unsigned* tab = nullptr) const {
        const int row0 = u.pm * BM + wr * 64 + fr, col0 = u.pn * BM + wc * 32 + 8 * fq; const bool sq = u.pn >= pn_sq;
#pragma unroll
        for (int ai = 0; ai < 2; ++ai)
#pragma unroll
            for (int m = 0; m < 4; ++m) { const int row = row0 + ai * HALF + m * 16; bf16_t* rowp = O + (size_t)row * ldc + col0; f32x2 ss2 = {0.f, 0.f}; const float rr = rtab[ui * 256 + (row - u.pm * BM)] * GELU_K;
#pragma unroll
                for (int bj = 0; bj < 2; ++bj) { const f32x4 v0 = acc[ai][bj][m][0] * rr, v1 = acc[ai][bj][m][1] * rr;
                    const f32x2 wi[4] = {(f32x2){v0[0], v0[1]}, (f32x2){v0[2], v0[3]}, (f32x2){v1[0], v1[1]}, (f32x2){v1[2], v1[3]}}; f32x2 go[4]; gelu_w_pk4(wi, go); const f32x2 a = go[0], b = go[1], c = go[2], d = go[3];
                    if (sq) { ss2 = a * a + ss2; ss2 = b * b + ss2; ss2 = c * c + ss2; ss2 = d * d + ss2; }
                    u32x4 w; w.x = cvt_pk_bf16(a.x, a.y); w.y = cvt_pk_bf16(b.x, b.y); w.z = cvt_pk_bf16(c.x, c.y); w.w = cvt_pk_bf16(d.x, d.y);
                    *(u32x4*)(rowp + bj * HALF) = w; }
                float ss = ss2.x + ss2.y;
                if (sq) { ss += __shfl_xor(ss, 16); ss += __shfl_xor(ss, 32); if (fq == 0) vpart[(size_t)row * 48 + 4 * (u.pn - pn_sq) + wc] = ss; } }
    }
};

struct EpiHead4 {
    static constexpr bool PERM = true, AFTER_DRAIN = false;
    bf16_t* T; size_t tstride; const PG8_LAS float* g; float eps; const PG8_LAS float* rtab;
    __device__ __forceinline__ void operator()(const f32x4 (&acc)[2][2][4][2], const Unit& u, int wr, int wc, int fr, int fq, int ui = 0, const PG8_LAS unsigned* tab = nullptr) const {
        const int row0 = u.pm * BM + wr * 64 + fr, kind = u.pn >> 2; const bool nrm = (kind & 1) == 0; const int col0 = ((u.pn & 3) * 4 + wc) * 64 + 8 * fq;
        bf16_t* base = T + (size_t)kind * tstride;
        f32x4 gg[2][2];
#pragma unroll
        for (int bj = 0; bj < 2; ++bj)
#pragma unroll
            for (int n = 0; n < 2; ++n) gg[bj][n] = *(const PG8_LAS f32x4*)(g + 32 * (kind & 2) + 32 * bj + 8 * fq + 4 * n);
#pragma unroll
        for (int ai = 0; ai < 2; ++ai)
#pragma unroll
            for (int m = 0; m < 4; ++m) { bf16_t* rowp = base + (size_t)(row0 + ai * HALF + m * 16) * 1024 + col0; const float rr = rtab[ui * 256 + ai * HALF + wr * 64 + m * 16 + fr];
                f32x4 v[2][2];
#pragma unroll
                for (int bj = 0; bj < 2; ++bj)
#pragma unroll
                    for (int n = 0; n < 2; ++n) v[bj][n] = acc[ai][bj][m][n] * rr;
                if (nrm) { float ss = 0.f;
#pragma unroll
                    for (int bj = 0; bj < 2; ++bj)
#pragma unroll
                        for (int n = 0; n < 2; ++n) ss += (v[bj][n][0] * v[bj][n][0] + v[bj][n][1] * v[bj][n][1]) + (v[bj][n][2] * v[bj][n][2] + v[bj][n][3] * v[bj][n][3]);
                    ss += __shfl_xor(ss, 16); ss += __shfl_xor(ss, 32);
                    const float rs = 1.0f / sqrtf(ss * (1.0f / 64.0f) + eps);
#pragma unroll
                    for (int bj = 0; bj < 2; ++bj)
#pragma unroll
                        for (int n = 0; n < 2; ++n) v[bj][n] = v[bj][n] * rs * gg[bj][n];
                } else if (kind == 3) {
#pragma unroll
                    for (int bj = 0; bj < 2; ++bj)
#pragma unroll
                        for (int n = 0; n < 2; ++n)
#pragma unroll
                            for (int e = 0; e < 4; ++e) v[bj][n][e] = __builtin_amdgcn_rcpf(1.0f + __builtin_amdgcn_exp2f(-1.4426950408889634f * v[bj][n][e]));
                }
#pragma unroll
                for (int bj = 0; bj < 2; ++bj) { u32x4 w; w.x = cvt_pk_bf16(v[bj][0][0], v[bj][0][1]); w.y = cvt_pk_bf16(v[bj][0][2], v[bj][0][3]); w.z = cvt_pk_bf16(v[bj][1][0], v[bj][1][1]); w.w = cvt_pk_bf16(v[bj][1][2], v[bj][1][3]);
                    *(u32x4*)(rowp + 32 * bj) = w; } }
    }
};
struct EpiBf16RowScale {
    static constexpr bool PERM = true, AFTER_DRAIN = false;
    bf16_t* O; int ldc; const PG8_LAS float* rs; size_t kstride;
    __device__ __forceinline__ void operator()(const f32x4 (&acc)[2][2][4][2], const Unit& u, int wr, int wc, int fr, int fq, int ui = 0, const PG8_LAS unsigned* tab = nullptr) const {
        const int row0 = u.pm * BM + wr * 64 + fr, col0 = u.pn * BM + wc * 32 + 8 * fq;
#pragma unroll
        for (int ai = 0; ai < 2; ++ai)
#pragma unroll
            for (int m = 0; m < 4; ++m) { const int row = row0 + ai * HALF + m * 16; bf16_t* rowp = O + (size_t)u.kp * kstride + (size_t)row * ldc + col0; const float sc = rs[ui * 256 + (row - u.pm * BM)];
#pragma unroll
                for (int bj = 0; bj < 2; ++bj) { const f32x4 v0 = acc[ai][bj][m][0] * sc, v1 = acc[ai][bj][m][1] * sc;
                    u32x4 w; w.x = cvt_pk_bf16(v0[0], v0[1]); w.y = cvt_pk_bf16(v0[2], v0[3]); w.z = cvt_pk_bf16(v1[0], v1[1]); w.w = cvt_pk_bf16(v1[2], v1[3]);
                    *(u32x4*)(rowp + bj * HALF) = w; } }
    }
};
struct EpiSwiGLU {
    static constexpr bool PERM = true, AFTER_DRAIN = false;
    bf16_t* O; int ldc; const PG8_LAS float* rtab;
    static __device__ __forceinline__ float silu(float x) { return x * __builtin_amdgcn_rcpf(1.0f + __builtin_amdgcn_exp2f(-1.4426950408889634f * x)); }
    __device__ __forceinline__ void operator()(const f32x4 (&acc)[2][2][4][2], const Unit& u, int wr, int wc, int fr, int fq, int ui = 0, const PG8_LAS unsigned* tab = nullptr) const {
        const int row0 = u.pm * BM + wr * 64 + fr, col0 = u.pn * HALF + wc * 32 + 8 * fq;
#pragma unroll
        for (int ai = 0; ai < 2; ++ai)
#pragma unroll
            for (int m = 0; m < 4; ++m) { const int row = row0 + ai * HALF + m * 16; bf16_t* rowp = O + (size_t)row * ldc + col0;
                const float rs = rtab ? rtab[ui * 256 + (row - u.pm * BM)] : __uint_as_float(tab[256 + (row - u.pm * BM)]);
                const f32x4 a0 = acc[ai][0][m][0] * rs, a1 = acc[ai][0][m][1] * rs, b0 = acc[ai][1][m][0] * rs, b1 = acc[ai][1][m][1] * rs;
                const f32x4 t0 = a0 * (-1.4426950408889634f), t1 = a1 * (-1.4426950408889634f); f32x4 d0, d1;
#pragma unroll
                for (int e = 0; e < 4; ++e) { d0[e] = __builtin_amdgcn_exp2f(t0[e]); d1[e] = __builtin_amdgcn_exp2f(t1[e]); }
                d0 = d0 + 1.0f; d1 = d1 + 1.0f;
#pragma unroll
                for (int e = 0; e < 4; ++e) { d0[e] = __builtin_amdgcn_rcpf(d0[e]); d1[e] = __builtin_amdgcn_rcpf(d1[e]); }
                const f32x4 y0 = (a0 * b0) * d0, y1 = (a1 * b1) * d1;
                u32x4 w; w.x = cvt_pk_bf16(y0[0], y0[1]); w.y = cvt_pk_bf16(y0[2], y0[3]); w.z = cvt_pk_bf16(y1[0], y1[1]); w.w = cvt_pk_bf16(y1[2], y1[3]);
                *(u32x4*)rowp = w; }
    }
};
struct EpiSwiGLU8q {
    static constexpr bool PERM = true, AFTER_DRAIN = false;
    unsigned char* O; int ldc;
    __device__ __forceinline__ void operator()(const f32x4 (&acc)[2][2][4][2], const Unit& u, int wr, int wc, int fr, int fq, int ui = 0, const PG8_LAS unsigned* tab = nullptr) const {
        const int col0 = u.pn * HALF + wc * 32 + 8 * fq;
#pragma unroll
        for (int ai = 0; ai < 2; ++ai)
#pragma unroll
            for (int m = 0; m < 4; ++m) { const int r = ai * HALF + wr * 64 + m * 16 + fr; const float rs = __uint_as_float(tab[256 + r]);
                const f32x4 a0 = acc[ai][0][m][0] * rs, a1 = acc[ai][0][m][1] * rs, b0 = acc[ai][1][m][0] * rs, b1 = acc[ai][1][m][1] * rs;
                const f32x4 t0 = a0 * (-1.4426950408889634f), t1 = a1 * (-1.4426950408889634f); f32x4 d0, d1;
#pragma unroll
                for (int e = 0; e < 4; ++e) { d0[e] = __builtin_amdgcn_exp2f(t0[e]); d1[e] = __builtin_amdgcn_exp2f(t1[e]); }
                d0 = d0 + 1.0f; d1 = d1 + 1.0f;
#pragma unroll
                for (int e = 0; e < 4; ++e) { d0[e] = __builtin_amdgcn_rcpf(d0[e]); d1[e] = __builtin_amdgcn_rcpf(d1[e]); }
                const f32x4 y0 = (a0 * b0) * d0, y1 = (a1 * b1) * d1; unsigned w0 = 0u, w1 = 0u;
                w0 = __builtin_amdgcn_cvt_pk_fp8_f32(y0[0], y0[1], w0, false); w0 = __builtin_amdgcn_cvt_pk_fp8_f32(y0[2], y0[3], w0, true);
                w1 = __builtin_amdgcn_cvt_pk_fp8_f32(y1[0], y1[1], w1, false); w1 = __builtin_amdgcn_cvt_pk_fp8_f32(y1[2], y1[3], w1, true);
                uint2 w; w.x = w0; w.y = w1; *(uint2*)(O + (size_t)(u.pm * BM + r) * ldc + col0) = w; }
    }
};
struct EpiY8q {
    static constexpr bool PERM = true, AFTER_DRAIN = false;
    bf16_t* O; int ldc; size_t kstride;
    __device__ __forceinline__ void operator()(const f32x4 (&acc)[2][2][4][2], const Unit& u, int wr, int wc, int fr, int fq, int ui = 0, const PG8_LAS unsigned* tab = nullptr) const {
        const int col0 = u.pn * BM + wc * 32 + 8 * fq;
#pragma unroll
        for (int ai = 0; ai < 2; ++ai)
#pragma unroll
            for (int m = 0; m < 4; ++m) { const int r = ai * HALF + wr * 64 + m * 16 + fr; const float sc = __uint_as_float(tab[256 + r]); bf16_t* rowp = O + (size_t)u.kp * kstride + (size_t)(u.pm * BM + r) * ldc + col0;
#pragma unroll
                for (int bj = 0; bj < 2; ++bj) { const f32x4 v0 = acc[ai][bj][m][0] * sc, v1 = acc[ai][bj][m][1] * sc;
                    u32x4 w; w.x = cvt_pk_bf16(v0[0], v0[1]); w.y = cvt_pk_bf16(v0[2], v0[3]); w.z = cvt_pk_bf16(v1[0], v1[1]); w.w = cvt_pk_bf16(v1[2], v1[3]);
                    *(u32x4*)(rowp + bj * HALF) = w; } }
    }
};
template <class Epi, class Sched, bool ALIGN_EPI = false, bool SP2 = true, bool GATHER = false>
__device__ __forceinline__ void gemm_phase(PG8_LAS unsigned char* lds, const Gemm g, const Sched& S, const Epi& E, PG8_LAS unsigned* tt = nullptr) {
    static_assert(SP2, "only the two-MFMA-blocks-per-barrier-pair loop is kept in this file");
    int tid_ = threadIdx.x; asm volatile("" : "+v"(tid_));
    const int tid = tid_, wid = __builtin_amdgcn_readfirstlane(tid >> 6), lane = tid & 63, wr = wid >> 2, wc = wid & 3, fr = lane & 15, fq = lane >> 4;
    const int K = g.K, nt = K / BK, ldb = g.ldb ? g.ldb : K;
    unsigned c0[2], c1[2], n0[2], n1[2], voffB[2]; int rA[2]; unsigned cbA[2];
    const size_t kstep = (size_t)(BK * 2);
    const size_t hstepA = (size_t)HALF * g.lda * 2, hstep = (size_t)HALF * ldb * 2;
    const size_t tstepA = 2 * hstepA, tstep = 2 * hstep;
#pragma unroll
    for (int i = 0; i < 2; ++i) { int R, C; stage_rc(tid * 16 + i * 8192, R, C); const int Rb = Epi::PERM ? ((R & ~31) + perm32(R & 31)) : R; rA[i] = R; cbA[i] = (unsigned)C * 2u;
        c0[i] = (unsigned)(R * g.lda + C) * 2u; c1[i] = c0[i] + (unsigned)hstepA; n0[i] = c0[i]; n1[i] = c1[i]; voffB[i] = (unsigned)(Rb * ldb + C) * 2u; }
    const unsigned ldsw = (unsigned)wid * 1024u;
    const int aoff = lds_byte(wr * 64 + fr, fq * 8), boff = lds_byte(wc * 32 + fr, fq * 8);
#define PG8_SA(b, h) (((b) * 2 + (h)) * HTB)
#define PG8_SB(b, h) ((4 + (b) * 2 + (h)) * HTB)
#define PG8_STAGE(bufoff, gbase, voff) do { _Pragma("unroll") for (int _i = 0; _i < 2; ++_i) \
        __builtin_amdgcn_global_load_lds((const unsigned*)((const char*)(gbase) + (voff)[_i]), (PG8_LAS unsigned*)(lds + (bufoff) + ldsw + _i * 8192), 16, 0, 0); } while (0)
#define PG8_LDA(dst, b, h) do { _Pragma("unroll") for (int m = 0; m < 4; ++m) _Pragma("unroll") for (int k = 0; k < 2; ++k) dst[m][k] = *(const PG8_LAS bf16x8*)(lds + PG8_SA(b, h) + aoff + m * 2048 + k * 1024); } while (0)
#define PG8_LDB(dst, b, h) do { _Pragma("unroll") for (int n = 0; n < 2; ++n) _Pragma("unroll") for (int k = 0; k < 2; ++k) dst[n][k] = *(const PG8_LAS bf16x8*)(lds + PG8_SB(b, h) + boff + n * 2048 + k * 1024); } while (0)
#define PG8_MMA(ai, bj, At, Bt) do { __builtin_amdgcn_s_setprio(1); _Pragma("unroll") for (int m = 0; m < 4; ++m) _Pragma("unroll") for (int n = 0; n < 2; ++n) _Pragma("unroll") for (int k = 0; k < 2; ++k) \
        acc[ai][bj][m][n] = __builtin_amdgcn_mfma_f32_16x16x32_bf16(Bt[n][k], At[m][k], acc[ai][bj][m][n], 0, 0, 0); __builtin_amdgcn_s_setprio(0); } while (0)
#define PG8_WAIT_V(n) asm volatile("s_waitcnt vmcnt(" #n ")" ::: "memory")
#define PG8_WAIT_L(n) asm volatile("s_waitcnt lgkmcnt(" #n ")" ::: "memory")
#define PG8_BAR __builtin_amdgcn_s_barrier()
#define PG8_SCHED __builtin_amdgcn_sched_barrier(0)
#define PG8_GOFF(o0, o1, tab, nv) do { _Pragma("unroll") for (int _i = 0; _i < 2; ++_i) { const unsigned e0_ = (tab)[rA[_i]], e1_ = (tab)[HALF + rA[_i]]; \
        o0[_i] = ((rA[_i] < (nv)) ? (e0_ >> 1) : 0u) * (unsigned)(g.lda * 2) + cbA[_i]; o1[_i] = ((HALF + rA[_i] < (nv)) ? (e1_ >> 1) : 0u) * (unsigned)(g.lda * 2) + cbA[_i]; } } while (0)
    Unit cur, nxt; int ui = 0;
    if (!S.next(0, cur)) return;
    f32x4 acc[2][2][4][2];
#pragma unroll
    for (int a = 0; a < 2; ++a)
#pragma unroll
        for (int b = 0; b < 2; ++b)
#pragma unroll
            for (int m = 0; m < 4; ++m)
#pragma unroll
                for (int n = 0; n < 2; ++n) acc[a][b][m][n] = (f32x4){0.f, 0.f, 0.f, 0.f};
    bf16x8 At[4][2], B0[2][2], B1[2][2];
    int tbuf = 0, tnext = 1;
    if constexpr (GATHER) {
        { const int lo_ = S.listoff(cur.pm); if (tid < 256) tt[tid] = g.rowlist[lo_ + tid]; else tt[tid] = g.wlist[lo_ + tid - 256]; }
        asm volatile("s_waitcnt vmcnt(0) lgkmcnt(0)" ::: "memory"); PG8_BAR; asm volatile("" ::: "memory");
        PG8_GOFF(c0, c1, tt, S.rows(cur.pm));
    }
    const char* cA = (GATHER ? (const char*)g.A : (const char*)g.A + (size_t)cur.pm * tstepA) + S.kbytes(cur, K); const char* cB = (const char*)g.Bt + (size_t)S.expert(cur.pm) * g.bstride + (size_t)cur.pn * tstep + S.kbytes(cur, K);
    S.a_ready(cur);
    PG8_STAGE(PG8_SB(0, 0), cB, voffB); PG8_STAGE(PG8_SB(0, 1), cB + hstep, voffB); PG8_STAGE(PG8_SA(0, 0), cA, c0); PG8_STAGE(PG8_SA(0, 1), cA, c1);
    if (wr == 1) PG8_BAR;
    PG8_WAIT_V(2); PG8_BAR;
    PG8_STAGE(PG8_SB(1, 0), cB + kstep, voffB); PG8_STAGE(PG8_SA(1, 0), cA + kstep, c0);
    PG8_WAIT_V(4); PG8_BAR;
    for (;;) {
        const bool has_next = S.next(ui + 1, nxt);
        const char* nA = GATHER ? cA : (has_next ? (const char*)g.A + (size_t)nxt.pm * tstepA + S.kbytes(nxt, K) : cA); const char* nB = has_next ? (const char*)g.Bt + (size_t)S.expert(nxt.pm) * g.bstride + (size_t)nxt.pn * tstep + S.kbytes(nxt, K) : cB;
        if constexpr (GATHER) { if (has_next) {
            const unsigned* src_ = (wid < 4 ? g.rowlist : g.wlist) + S.listoff(nxt.pm) + (wid & 3) * 64 + lane;
            __builtin_amdgcn_global_load_lds(src_, (PG8_LAS unsigned*)(tt + tnext * 512 + wid * 64), 4, 0, 0); } }
        for (int t = 0; t < nt; t += 2) {
            const bool last = (t == nt - 2);
            if constexpr (GATHER) { if (last && has_next) PG8_GOFF(n0, n1, tt + tnext * 512, S.rows(nxt.pm)); }
            const char* a1 = uni_ptr(cA + (size_t)(t + 1) * kstep); const char* b1 = uni_ptr(cB + (size_t)(t + 1) * kstep);
            const char* a2 = uni_ptr(last ? nA : cA + (size_t)(t + 2) * kstep); const char* b2 = uni_ptr(last ? nB : cB + (size_t)(t + 2) * kstep);
            const char* a3 = a2 + kstep; const char* b3 = b2 + kstep;
            unsigned x0[2], x1[2];
#pragma unroll
            for (int i = 0; i < 2; ++i) { x0[i] = last ? n0[i] : c0[i]; x1[i] = last ? n1[i] : c1[i]; }
            if (last && has_next) S.a_ready(nxt);
            PG8_LDB(B0, 0, 0); PG8_LDB(B1, 0, 1); PG8_SCHED; PG8_LDA(At, 0, 0); PG8_STAGE(PG8_SB(1, 1), b1 + hstep, voffB); PG8_STAGE(PG8_SA(1, 1), a1, c1);
            PG8_WAIT_V(8); PG8_WAIT_L(0); PG8_BAR; PG8_MMA(0, 0, At, B0); PG8_MMA(0, 1, At, B1); PG8_BAR; PG8_SCHED;
            PG8_LDA(At, 0, 1); PG8_STAGE(PG8_SB(0, 0), b2, voffB); PG8_STAGE(PG8_SA(0, 0), a2, x0);
            PG8_WAIT_V(6); PG8_WAIT_L(0); PG8_BAR; PG8_MMA(1, 0, At, B0); PG8_MMA(1, 1, At, B1); PG8_BAR; PG8_SCHED;
            PG8_LDB(B0, 1, 0); PG8_LDB(B1, 1, 1); PG8_SCHED; PG8_LDA(At, 1, 0); PG8_STAGE(PG8_SB(0, 1), b2 + hstep, voffB); PG8_STAGE(PG8_SA(0, 1), a2, x1);
            PG8_WAIT_V(8); PG8_WAIT_L(0); PG8_BAR; PG8_MMA(0, 0, At, B0); PG8_MMA(0, 1, At, B1); PG8_BAR; PG8_SCHED;
            PG8_LDA(At, 1, 1); PG8_STAGE(PG8_SB(1, 0), b3, voffB); PG8_STAGE(PG8_SA(1, 0), a3, x0);
            PG8_WAIT_V(6); PG8_WAIT_L(0); PG8_BAR; PG8_MMA(1, 0, At, B0); PG8_MMA(1, 1, At, B1); PG8_BAR; PG8_SCHED;
        }
        if constexpr (ALIGN_EPI) { if (wr == 0) PG8_BAR; }
        if constexpr (!Epi::AFTER_DRAIN) { E(acc, cur, wr, wc, fr, fq, ui, GATHER ? tt + tbuf * 512 : nullptr); S.done(cur); }
        if (!has_next) break;
#pragma unroll
        for (int a = 0; a < 2; ++a)
#pragma unroll
            for (int b = 0; b < 2; ++b)
#pragma unroll
                for (int m = 0; m < 4; ++m)
#pragma unroll
                    for (int n = 0; n < 2; ++n) acc[a][b][m][n] = (f32x4){0.f, 0.f, 0.f, 0.f};
        cur = nxt; cA = nA; cB = nB; ++ui; tbuf = tnext; tnext = (tnext == 2) ? 0 : tnext + 1;
        if constexpr (GATHER) {
#pragma unroll
            for (int i = 0; i < 2; ++i) { c0[i] = n0[i]; c1[i] = n1[i]; } }
        if constexpr (ALIGN_EPI) { if (wr == 1) PG8_BAR; }
    }
    PG8_WAIT_V(0);
    if constexpr (!ALIGN_EPI) { if (wr == 0) PG8_BAR; }
    PG8_BAR;
    if constexpr (Epi::AFTER_DRAIN) { E.fused(acc, cur, wr, wc, fr, fq, lds, wid, lane); S.done(cur); }
#undef PG8_SA
#undef PG8_SB
#undef PG8_STAGE
#undef PG8_LDA
#undef PG8_LDB
#undef PG8_MMA
#undef PG8_WAIT_V
#undef PG8_WAIT_L
#undef PG8_BAR
#undef PG8_SCHED
#undef PG8_GOFF
}

template <class Epi, class Sched, bool ALIGN_EPI = true, bool SP2 = true, bool GATHER = true>
__device__ __forceinline__ void gemm_phase_f8q(PG8_LAS unsigned char* lds, const Gemm g, const Sched& S, const Epi& E, PG8_LAS unsigned* tt = nullptr) {
    static_assert(SP2, "only the two-MFMA-blocks-per-barrier-pair loop is kept in this file");
    typedef int v8i_t __attribute__((ext_vector_type(8))); typedef int v4i_t __attribute__((ext_vector_type(4)));
    int tid_ = threadIdx.x; asm volatile("" : "+v"(tid_));
    const int tid = tid_, wid = __builtin_amdgcn_readfirstlane(tid >> 6), lane = tid & 63, wr = wid >> 2, wc = wid & 3, fr = lane & 15, fq = lane >> 4;
    const int K = g.K, nt = K / BK, ldb = g.ldb ? g.ldb : K;
    unsigned c0[2], c1[2], n0[2], n1[2], voffB[2]; int rA[2]; unsigned cbA[2];
    const size_t kstep = (size_t)(BK * 2);
    const size_t hstepA = (size_t)HALF * g.lda * 2, hstep = (size_t)HALF * ldb * 2;
    const size_t tstepA = 2 * hstepA, tstep = 2 * hstep;
#pragma unroll
    for (int i = 0; i < 2; ++i) { const int R = (tid >> 3) + 64 * i, x = R & 15, C = (((tid & 7) ^ (((x >> 1) & 1) | (((x >> 3) & 1) << 2))) * 16); const int Rb = (R & ~31) + perm32(R & 31);
        rA[i] = R; cbA[i] = (unsigned)C; c0[i] = (unsigned)(R * g.lda) * 2u + (unsigned)C; c1[i] = c0[i] + (unsigned)hstepA; n0[i] = c0[i]; n1[i] = c1[i]; voffB[i] = (unsigned)(Rb * ldb) * 2u + (unsigned)C; }
    const unsigned ldsw = (unsigned)wid * 1024u;
    const int fsw = ((fr >> 1) & 1) | (((fr >> 3) & 1) << 2);
    const int aoffL = (wr * 64 + fr) * 128 + (((2 * fq) ^ fsw) * 16), aoffH = (wr * 64 + fr) * 128 + (((2 * fq + 1) ^ fsw) * 16);
    const int boffL = (wc * 32 + fr) * 128 + (((2 * fq) ^ fsw) * 16), boffH = (wc * 32 + fr) * 128 + (((2 * fq + 1) ^ fsw) * 16);
#define PG8_SA(b, h) (((b) * 2 + (h)) * HTB)
#define PG8_SB(b, h) ((4 + (b) * 2 + (h)) * HTB)
#define PG8_STAGE(bufoff, gbase, voff) do { _Pragma("unroll") for (int _i = 0; _i < 2; ++_i) \
        __builtin_amdgcn_global_load_lds((const unsigned*)((const char*)(gbase) + (voff)[_i]), (PG8_LAS unsigned*)(lds + (bufoff) + ldsw + _i * 8192), 16, 0, 0); } while (0)
#define PG8_LDA(dst, b, h) do { _Pragma("unroll") for (int m = 0; m < 4; ++m) { const v4i_t l_ = *(const PG8_LAS v4i_t*)(lds + PG8_SA(b, h) + aoffL + m * 2048), h_ = *(const PG8_LAS v4i_t*)(lds + PG8_SA(b, h) + aoffH + m * 2048); \
        dst[m] = (v8i_t){l_[0], l_[1], l_[2], l_[3], h_[0], h_[1], h_[2], h_[3]}; } } while (0)
#define PG8_LDB(dst, b, h) do { _Pragma("unroll") for (int n = 0; n < 2; ++n) { const v4i_t l_ = *(const PG8_LAS v4i_t*)(lds + PG8_SB(b, h) + boffL + n * 2048), h_ = *(const PG8_LAS v4i_t*)(lds + PG8_SB(b, h) + boffH + n * 2048); \
        dst[n] = (v8i_t){l_[0], l_[1], l_[2], l_[3], h_[0], h_[1], h_[2], h_[3]}; } } while (0)
#define PG8_MMA(ai, bj, At, Bt) do { __builtin_amdgcn_s_setprio(1); _Pragma("unroll") for (int m = 0; m < 4; ++m) _Pragma("unroll") for (int n = 0; n < 2; ++n) \
        asm volatile("v_mfma_scale_f32_16x16x128_f8f6f4 %0, %1, %2, %0, %3, %4 op_sel_hi:[0,0,0]" : "+v"(acc[ai][bj][m][n]) : "v"(Bt[n]), "v"(At[m]), "v"(sclB), "v"(sclA)); __builtin_amdgcn_s_setprio(0); } while (0)
#define PG8_WAIT_V(n) asm volatile("s_waitcnt vmcnt(" #n ")" ::: "memory")
#define PG8_WAIT_L(n) asm volatile("s_waitcnt lgkmcnt(" #n ")" ::: "memory")
#define PG8_BAR __builtin_amdgcn_s_barrier()
#define PG8_SCHED __builtin_amdgcn_sched_barrier(0)
#define PG8_GOFF(o0, o1, tab, nv) do { _Pragma("unroll") for (int _i = 0; _i < 2; ++_i) { const unsigned e0_ = (tab)[rA[_i]], e1_ = (tab)[HALF + rA[_i]]; \
        o0[_i] = ((rA[_i] < (nv)) ? (e0_ >> 1) : 0u) * (unsigned)(g.lda * 2) + cbA[_i]; o1[_i] = ((HALF + rA[_i] < (nv)) ? (e1_ >> 1) : 0u) * (unsigned)(g.lda * 2) + cbA[_i]; } } while (0)
    Unit cur, nxt; int ui = 0;
    if (!S.next(0, cur)) return;
    f32x4 acc[2][2][4][2];
#pragma unroll
    for (int a = 0; a < 2; ++a)
#pragma unroll
        for (int b = 0; b < 2; ++b)
#pragma unroll
            for (int m = 0; m < 4; ++m)
#pragma unroll
                for (int n = 0; n < 2; ++n) acc[a][b][m][n] = (f32x4){0.f, 0.f, 0.f, 0.f};
    const int sclB = g.scale_b, sclA = 0x7f7f7f7f;
    v8i_t At[4], B0[2], B1[2];
    int tbuf = 0, tnext = 1;
    if constexpr (GATHER) {
        { const int lo_ = S.listoff(cur.pm); if (tid < 256) tt[tid] = g.rowlist[lo_ + tid]; else tt[tid] = g.wlist[lo_ + tid - 256]; }
        asm volatile("s_waitcnt vmcnt(0) lgkmcnt(0)" ::: "memory"); PG8_BAR; asm volatile("" ::: "memory");
        PG8_GOFF(c0, c1, tt, S.rows(cur.pm));
    }
    const char* cA = (GATHER ? (const char*)g.A : (const char*)g.A + (size_t)cur.pm * tstepA) + S.kbytes(cur, K); const char* cB = (const char*)g.Bt + (size_t)S.expert(cur.pm) * g.bstride + (size_t)cur.pn * tstep + S.kbytes(cur, K);
    S.a_ready(cur);
    PG8_STAGE(PG8_SB(0, 0), cB, voffB); PG8_STAGE(PG8_SB(0, 1), cB + hstep, voffB); PG8_STAGE(PG8_SA(0, 0), cA, c0); PG8_STAGE(PG8_SA(0, 1), cA, c1);
    if (wr == 1) PG8_BAR;
    PG8_WAIT_V(2); PG8_BAR;
    PG8_STAGE(PG8_SB(1, 0), cB + kstep, voffB); PG8_STAGE(PG8_SA(1, 0), cA + kstep, c0);
    PG8_WAIT_V(4); PG8_BAR;
    for (;;) {
        const bool has_next = S.next(ui + 1, nxt);
        const char* nA = GATHER ? cA : (has_next ? (const char*)g.A + (size_t)nxt.pm * tstepA + S.kbytes(nxt, K) : cA); const char* nB = has_next ? (const char*)g.Bt + (size_t)S.expert(nxt.pm) * g.bstride + (size_t)nxt.pn * tstep + S.kbytes(nxt, K) : cB;
        if constexpr (GATHER) { if (has_next) {
            const unsigned* src_ = (wid < 4 ? g.rowlist : g.wlist) + S.listoff(nxt.pm) + (wid & 3) * 64 + lane;
            __builtin_amdgcn_global_load_lds(src_, (PG8_LAS unsigned*)(tt + tnext * 512 + wid * 64), 4, 0, 0); } }
        for (int t = 0; t < nt; t += 2) {
            const bool last = (t == nt - 2);
            if constexpr (GATHER) { if (last && has_next) PG8_GOFF(n0, n1, tt + tnext * 512, S.rows(nxt.pm)); }
            const char* a1 = uni_ptr(cA + (size_t)(t + 1) * kstep); const char* b1 = uni_ptr(cB + (size_t)(t + 1) * kstep);
            const char* a2 = uni_ptr(last ? nA : cA + (size_t)(t + 2) * kstep); const char* b2 = uni_ptr(last ? nB : cB + (size_t)(t + 2) * kstep);
            const char* a3 = a2 + kstep; const char* b3 = b2 + kstep;
            unsigned x0[2], x1[2];
#pragma unroll
            for (int i = 0; i < 2; ++i) { x0[i] = last ? n0[i] : c0[i]; x1[i] = last ? n1[i] : c1[i]; }
            if (last && has_next) S.a_ready(nxt);
            PG8_LDB(B0, 0, 0); PG8_LDB(B1, 0, 1); PG8_SCHED; PG8_LDA(At, 0, 0); PG8_STAGE(PG8_SB(1, 1), b1 + hstep, voffB); PG8_STAGE(PG8_SA(1, 1), a1, c1);
            PG8_WAIT_V(8); PG8_WAIT_L(0); PG8_BAR; PG8_MMA(0, 0, At, B0); PG8_MMA(0, 1, At, B1); PG8_BAR; PG8_SCHED;
            PG8_LDA(At, 0, 1); PG8_STAGE(PG8_SB(0, 0), b2, voffB); PG8_STAGE(PG8_SA(0, 0), a2, x0);
            PG8_WAIT_V(6); PG8_WAIT_L(0); PG8_BAR; PG8_MMA(1, 0, At, B0); PG8_MMA(1, 1, At, B1); PG8_BAR; PG8_SCHED;
            PG8_LDB(B0, 1, 0); PG8_LDB(B1, 1, 1); PG8_SCHED; PG8_LDA(At, 1, 0); PG8_STAGE(PG8_SB(0, 1), b2 + hstep, voffB); PG8_STAGE(PG8_SA(0, 1), a2, x1);
            PG8_WAIT_V(8); PG8_WAIT_L(0); PG8_BAR; PG8_MMA(0, 0, At, B0); PG8_MMA(0, 1, At, B1); PG8_BAR; PG8_SCHED;
            PG8_LDA(At, 1, 1); PG8_STAGE(PG8_SB(1, 0), b3, voffB); PG8_STAGE(PG8_SA(1, 0), a3, x0);
            PG8_WAIT_V(6); PG8_WAIT_L(0); PG8_BAR; PG8_MMA(1, 0, At, B0); PG8_MMA(1, 1, At, B1); PG8_BAR; PG8_SCHED;
        }
        if constexpr (ALIGN_EPI) { if (wr == 0) PG8_BAR; }
        asm volatile("s_nop 15\n\ts_nop 15" ::: "memory");
        if constexpr (!Epi::AFTER_DRAIN) { E(acc, cur, wr, wc, fr, fq, ui, GATHER ? tt + tbuf * 512 : nullptr); S.done(cur); }
        if (!has_next) break;
#pragma unroll
        for (int a = 0; a < 2; ++a)
#pragma unroll
            for (int b = 0; b < 2; ++b)
#pragma unroll
                for (int m = 0; m < 4; ++m)
#pragma unroll
                    for (int n = 0; n < 2; ++n) acc[a][b][m][n] = (f32x4){0.f, 0.f, 0.f, 0.f};
        cur = nxt; cA = nA; cB = nB; ++ui; tbuf = tnext; tnext = (tnext == 2) ? 0 : tnext + 1;
        if constexpr (GATHER) {
#pragma unroll
            for (int i = 0; i < 2; ++i) { c0[i] = n0[i]; c1[i] = n1[i]; } }
        if constexpr (ALIGN_EPI) { if (wr == 1) PG8_BAR; }
    }
    PG8_WAIT_V(0);
    if constexpr (!ALIGN_EPI) { if (wr == 0) PG8_BAR; }
    PG8_BAR;
    if constexpr (Epi::AFTER_DRAIN) { E.fused(acc, cur, wr, wc, fr, fq, lds, wid, lane); S.done(cur); }
#undef PG8_SA
#undef PG8_SB
#undef PG8_STAGE
#undef PG8_LDA
#undef PG8_LDB
#undef PG8_MMA
#undef PG8_WAIT_V
#undef PG8_WAIT_L
#undef PG8_BAR
#undef PG8_SCHED
#undef PG8_GOFF
}

struct EpiSwiGLU64 {
    unsigned char* O; int ldc;
    __device__ __forceinline__ void operator()(const f32x4 (&acc)[2][4][2], const Unit& u, int wr, int wc, int fr, int fq, const PG8_LAS unsigned* tab) const {
        const int col0 = u.pn * 64 + wc * 16 + 4 * fq;
#pragma unroll
        for (int ai = 0; ai < 2; ++ai)
#pragma unroll
            for (int m = 0; m < 4; ++m) { const int r = ai * HALF + wr * 64 + m * 16 + fr; const float rs = __uint_as_float(tab[256 + r]);
                const f32x4 a = acc[ai][m][0] * rs, b = acc[ai][m][1] * rs; const f32x4 t = a * (-1.4426950408889634f); f32x4 d;
#pragma unroll
                for (int e = 0; e < 4; ++e) d[e] = __builtin_amdgcn_exp2f(t[e]);
                d = d + 1.0f;
#pragma unroll
                for (int e = 0; e < 4; ++e) d[e] = __builtin_amdgcn_rcpf(d[e]);
                const f32x4 y = (a * b) * d; unsigned w = 0u; w = __builtin_amdgcn_cvt_pk_fp8_f32(y[0], y[1], w, false); w = __builtin_amdgcn_cvt_pk_fp8_f32(y[2], y[3], w, true);
                *(unsigned*)(O + (size_t)(u.pm * BM + r) * ldc + col0) = w; }
    }
};
struct EpiY64 {
    bf16_t* O; int ldc; size_t kstride;
    __device__ __forceinline__ void operator()(const f32x4 (&acc)[2][4][2], const Unit& u, int wr, int wc, int fr, int fq, const PG8_LAS unsigned* tab) const {
        const int col0 = u.pn * 128 + wc * 32 + 8 * fq;
#pragma unroll
        for (int ai = 0; ai < 2; ++ai)
#pragma unroll
            for (int m = 0; m < 4; ++m) { const int r = ai * HALF + wr * 64 + m * 16 + fr; const float gw = __uint_as_float(tab[256 + r]);
                const f32x4 a = acc[ai][m][0] * gw, b = acc[ai][m][1] * gw; u32x4 w; w.x = cvt_pk_bf16(a[0], a[1]); w.y = cvt_pk_bf16(a[2], a[3]); w.z = cvt_pk_bf16(b[0], b[1]); w.w = cvt_pk_bf16(b[2], b[3]);
                *(u32x4*)(O + (size_t)u.kp * kstride + (size_t)(u.pm * BM + r) * ldc + col0) = w; }
    }
};
template <class Epi, class Sched>
__device__ __forceinline__ void gemm_phase_f8n128(PG8_LAS unsigned char* lds, const Gemm g, const Sched& S, const Epi& E, PG8_LAS unsigned* tt) {
    typedef int v8i_t __attribute__((ext_vector_type(8))); typedef int v4i_t __attribute__((ext_vector_type(4)));
    int tid_ = threadIdx.x; asm volatile("" : "+v"(tid_));
    const int tid = tid_, wid = __builtin_amdgcn_readfirstlane(tid >> 6), lane = tid & 63, wr = wid >> 2, wc = wid & 3, fr = lane & 15, fq = lane >> 4;
    const int K = g.K, nt = K / BK, ldb = g.ldb ? g.ldb : K;
    unsigned c0[2], c1[2], n0[2], n1[2], voffB[2]; int rA[2]; unsigned cbA[2];
    const size_t kstep = (size_t)(BK * 2), tstepB = (size_t)HALF * ldb * 2;
#pragma unroll
    for (int i = 0; i < 2; ++i) { const int R = (tid >> 3) + 64 * i, x = R & 15, C = (((tid & 7) ^ (((x >> 1) & 1) | (((x >> 3) & 1) << 2))) * 16); const int Rb = (R & ~31) + perm32(R & 31);
        rA[i] = R; cbA[i] = (unsigned)C; c0[i] = c1[i] = n0[i] = n1[i] = 0u; voffB[i] = (unsigned)(Rb * ldb) * 2u + (unsigned)C; }
    const unsigned ldsw = (unsigned)wid * 1024u;
    const int fsw = ((fr >> 1) & 1) | (((fr >> 3) & 1) << 2);
    const int aoffL = (wr * 64 + fr) * 128 + (((2 * fq) ^ fsw) * 16), aoffH = (wr * 64 + fr) * 128 + (((2 * fq + 1) ^ fsw) * 16);
    const int boffL = (wc * 32 + fr) * 128 + (((2 * fq) ^ fsw) * 16), boffH = (wc * 32 + fr) * 128 + (((2 * fq + 1) ^ fsw) * 16);
#define F8_SA(b, h) (((b) * 3 + (h)) * HTB)
#define F8_SB(b) (((b) * 3 + 2) * HTB)
#define F8_STAGE1(bufoff, gbase, voff, i_) __builtin_amdgcn_global_load_lds((const unsigned*)((const char*)(gbase) + (voff)[i_]), (PG8_LAS unsigned*)(lds + (bufoff) + ldsw + (i_) * 8192), 16, 0, 0)
#define F8_STAGE(bufoff, gbase, voff) do { F8_STAGE1(bufoff, gbase, voff, 0); F8_STAGE1(bufoff, gbase, voff, 1); } while (0)
#define F8_LDA1(dst, b, h, m) do { const v4i_t l_ = *(const PG8_LAS v4i_t*)(lds + F8_SA(b, h) + aoffL + (m) * 2048), h_ = *(const PG8_LAS v4i_t*)(lds + F8_SA(b, h) + aoffH + (m) * 2048); \
        dst[m] = (v8i_t){l_[0], l_[1], l_[2], l_[3], h_[0], h_[1], h_[2], h_[3]}; } while (0)
#define F8_LDB1(dst, b, n) do { const v4i_t l_ = *(const PG8_LAS v4i_t*)(lds + F8_SB(b) + boffL + (n) * 2048), h_ = *(const PG8_LAS v4i_t*)(lds + F8_SB(b) + boffH + (n) * 2048); \
        dst[n] = (v8i_t){l_[0], l_[1], l_[2], l_[3], h_[0], h_[1], h_[2], h_[3]}; } while (0)
#define F8_LDA(dst, b, h) do { F8_LDA1(dst, b, h, 0); F8_LDA1(dst, b, h, 1); F8_LDA1(dst, b, h, 2); F8_LDA1(dst, b, h, 3); } while (0)
#define F8_LDB(dst, b) do { F8_LDB1(dst, b, 0); F8_LDB1(dst, b, 1); } while (0)
#define F8_MMA1(ai, m, At, Bf) do { _Pragma("unroll") for (int n = 0; n < 2; ++n) \
        acc[ai][m][n] = __builtin_amdgcn_mfma_scale_f32_16x16x128_f8f6f4(Bf[n], At[m], acc[ai][m][n], 0, 0, 0, g.scale_b, 0, 0x7f7f7f7f); } while (0)
#define F8_WAIT_V(n) asm volatile("s_waitcnt vmcnt(" #n ")" ::: "memory")
#define F8_WAIT_L(n) asm volatile("s_waitcnt lgkmcnt(" #n ")" ::: "memory")
#define F8_BAR __builtin_amdgcn_s_barrier()
#define F8_SCHED __builtin_amdgcn_sched_barrier(0)
#define F8_GOFF(o0, o1, tab, nv) do { _Pragma("unroll") for (int _i = 0; _i < 2; ++_i) { const unsigned e0_ = (tab)[rA[_i]], e1_ = (tab)[HALF + rA[_i]]; \
        o0[_i] = ((rA[_i] < (nv)) ? (e0_ >> 1) : 0u) * (unsigned)(g.lda * 2) + cbA[_i]; o1[_i] = ((HALF + rA[_i] < (nv)) ? (e1_ >> 1) : 0u) * (unsigned)(g.lda * 2) + cbA[_i]; } } while (0)
    Unit cur, nxt; int ui = 0;
    if (!S.next(0, cur)) return;
    f32x4 acc[2][4][2];
#pragma unroll
    for (int a = 0; a < 2; ++a)
#pragma unroll
        for (int m = 0; m < 4; ++m)
#pragma unroll
            for (int n = 0; n < 2; ++n) acc[a][m][n] = (f32x4){0.f, 0.f, 0.f, 0.f};
    v8i_t AtA[4], AtB[4], BfA[2], BfB[2];
    int tbuf = 0, tnext = 1;
    { const int lo_ = S.listoff(cur.pm); if (tid < 256) tt[tid] = g.rowlist[lo_ + tid]; else tt[tid] = g.wlist[lo_ + tid - 256]; }
    asm volatile("s_waitcnt vmcnt(0) lgkmcnt(0)" ::: "memory"); F8_BAR; asm volatile("" ::: "memory");
    F8_GOFF(c0, c1, tt, S.rows(cur.pm));
    const char* cA = (const char*)g.A + S.kbytes(cur, K); const char* cB = (const char*)g.Bt + (size_t)S.expert(cur.pm) * g.bstride + (size_t)cur.pn * tstepB + S.kbytes(cur, K);
    F8_STAGE(F8_SB(0), cB, voffB); F8_STAGE(F8_SA(0, 0), cA, c0); F8_STAGE(F8_SA(0, 1), cA, c1);
    F8_STAGE(F8_SB(1), cB + kstep, voffB); F8_STAGE(F8_SA(1, 0), cA + kstep, c0); F8_STAGE(F8_SA(1, 1), cA + kstep, c1);
    F8_WAIT_V(8); F8_BAR;
    F8_LDB(BfA, 0); F8_LDA(AtA, 0, 0);
    for (;;) {
        const bool has_next = S.next(ui + 1, nxt);
        const char* nA = has_next ? (const char*)g.A + S.kbytes(nxt, K) : cA; const char* nB = has_next ? (const char*)g.Bt + (size_t)S.expert(nxt.pm) * g.bstride + (size_t)nxt.pn * tstepB + S.kbytes(nxt, K) : cB;
        if (has_next) { const unsigned* src_ = (wid < 4 ? g.rowlist : g.wlist) + S.listoff(nxt.pm) + (wid & 3) * 64 + lane;
            __builtin_amdgcn_global_load_lds(src_, (PG8_LAS unsigned*)(tt + tnext * 512 + wid * 64), 4, 0, 0); }
#pragma unroll 1
        for (int t = 0; t < nt; t += 2) {
            const bool last = (t == nt - 2);
            if (last && has_next) F8_GOFF(n0, n1, tt + tnext * 512, S.rows(nxt.pm));
            const char* a2 = last ? nA : cA + (size_t)(t + 2) * kstep; const char* b2 = last ? nB : cB + (size_t)(t + 2) * kstep;
            const char* a3 = a2 + kstep; const char* b3 = b2 + kstep;
            unsigned x0[2], x1[2];
#pragma unroll
            for (int i = 0; i < 2; ++i) { x0[i] = (last && has_next) ? n0[i] : c0[i]; x1[i] = (last && has_next) ? n1[i] : c1[i]; }
#define F8_TOP F8_WAIT_V(6); F8_WAIT_L(0); F8_BAR; F8_SCHED
#define F8_SP1(b, Bf, bp, ap, xo) F8_TOP; \
            F8_MMA1(0, 0, AtA, Bf); F8_SCHED; F8_STAGE1(F8_SB(b), bp, voffB, 0); F8_LDA1(AtB, b, 1, 0); F8_SCHED; F8_MMA1(0, 1, AtA, Bf); F8_SCHED; F8_STAGE1(F8_SB(b), bp, voffB, 1); F8_LDA1(AtB, b, 1, 1); F8_SCHED; \
            F8_MMA1(0, 2, AtA, Bf); F8_SCHED; F8_STAGE1(F8_SA(b, 0), ap, xo, 0); F8_LDA1(AtB, b, 1, 2); F8_SCHED; F8_MMA1(0, 3, AtA, Bf); F8_SCHED; F8_STAGE1(F8_SA(b, 0), ap, xo, 1); F8_LDA1(AtB, b, 1, 3); F8_SCHED
#define F8_SP2(b, Bf, Bn, ap, xo) F8_TOP; \
            F8_MMA1(1, 0, AtB, Bf); F8_SCHED; F8_STAGE1(F8_SA(b, 1), ap, xo, 0); F8_LDB1(Bn, (b) ^ 1, 0); F8_LDA1(AtA, (b) ^ 1, 0, 0); F8_SCHED; F8_MMA1(1, 1, AtB, Bf); F8_SCHED; F8_STAGE1(F8_SA(b, 1), ap, xo, 1); F8_LDB1(Bn, (b) ^ 1, 1); F8_LDA1(AtA, (b) ^ 1, 0, 1); F8_SCHED; \
            F8_MMA1(1, 2, AtB, Bf); F8_SCHED; F8_LDA1(AtA, (b) ^ 1, 0, 2); F8_SCHED; F8_MMA1(1, 3, AtB, Bf); F8_SCHED; F8_LDA1(AtA, (b) ^ 1, 0, 3); F8_SCHED
            F8_SP1(0, BfA, b2, a2, x0); F8_SP2(0, BfA, BfB, a2, x1);
            F8_SP1(1, BfB, b3, a3, x0); F8_SP2(1, BfB, BfA, a3, x1);
#undef F8_TOP
#undef F8_SP1
#undef F8_SP2
        }
        F8_WAIT_L(0);
        E(acc, cur, wr, wc, fr, fq, tt + tbuf * 512);
        if (!has_next) break;
#pragma unroll
        for (int a = 0; a < 2; ++a)
#pragma unroll
            for (int m = 0; m < 4; ++m)
#pragma unroll
                for (int n = 0; n < 2; ++n) acc[a][m][n] = (f32x4){0.f, 0.f, 0.f, 0.f};
        cur = nxt; cA = nA; cB = nB; ++ui; tbuf = tnext; tnext = (tnext == 2) ? 0 : tnext + 1;
#pragma unroll
        for (int i = 0; i < 2; ++i) { c0[i] = n0[i]; c1[i] = n1[i]; }
    }
    F8_WAIT_V(0);
    F8_BAR;
#undef F8_SA
#undef F8_SB
#undef F8_STAGE1
#undef F8_STAGE
#undef F8_LDA1
#undef F8_LDB1
#undef F8_LDA
#undef F8_LDB
#undef F8_MMA1
#undef F8_WAIT_V
#undef F8_WAIT_L
#undef F8_BAR
#undef F8_SCHED
#undef F8_GOFF
}
}
namespace attn_body {
using bf16=__hip_bfloat16;
using bf16x8=__attribute__((ext_vector_type(8)))short;
using s16x4=__attribute__((ext_vector_type(4)))short;
using f32x16=__attribute__((ext_vector_type(16)))float;
using u32x4=__attribute__((ext_vector_type(4)))unsigned;
using f32x4v=__attribute__((ext_vector_type(4)))float;
constexpr int BATCH=16,NHEAD=16,SEQ=2048,D=64,DM=NHEAD*D;
constexpr int NW=8,QBLK=32,QB=QBLK*NW,KVBLK=64,NQB=SEQ/QB;
constexpr int ATTN_PITCH=DM, ATTN_UNIT_ROWS=QB;
__device__ __forceinline__ int crow(int r,int hi){return (r&3)+8*(r>>2)+4*hi;}
#define SBAR() __builtin_amdgcn_sched_barrier(0)
__device__ __forceinline__ void cmask(f32x16&p0,f32x16&p1,int jb,int qrel,int hi){
  const float NEG=-INFINITY; int kb=64*jb+4*hi;
  #pragma unroll
  for(int r=0;r<16;++r){int kv=kb+(r&3)+8*(r>>2); if(kv>qrel)p0[r]=NEG; if(kv+32>qrel)p1[r]=NEG;}
}

constexpr int NSLOT=3, SLOTB=8192;
constexpr int LDS_K=0, LDS_V=NSLOT*SLOTB, LDS_WS=2*NSLOT*SLOTB, LDS_OST=LDS_WS+NW*64*4, LDS_FB=LDS_OST+NW*4096, LDS_BYTES=LDS_FB+SEQ*16;
constexpr float C2=0.125f*1.4426950408889634f;
__device__ __forceinline__ void glds16(const void*gsrc,unsigned lds_dst){unsigned keep;
  asm volatile("s_mov_b32 %0, m0\n\ts_mov_b32 m0, %2\n\ts_nop 0\n\tglobal_load_lds_dwordx4 %1, off\n\ts_mov_b32 m0, %0":"=&s"(keep):"v"(gsrc),"s"(lds_dst):"memory");}
__device__ __forceinline__ float max3f(float a,float b,float c){float r;asm("v_max3_f32 %0, %1, %2, %3":"=v"(r):"v"(a),"v"(b),"v"(c));return r;}
__device__ __forceinline__ float max2f(float a,float b){float r;asm("v_max_f32_e32 %0, %1, %2":"=v"(r):"v"(a),"v"(b));return r;}
__device__ __forceinline__ float fadd_s(float a,float b){float r;asm("v_add_f32_e32 %0, %1, %2":"=v"(r):"v"(a),"v"(b));return r;}
__device__ __forceinline__ float fsub_s(float a,float b){float r;asm("v_sub_f32_e32 %0, %1, %2":"=v"(r):"v"(a),"v"(b));return r;}
typedef float f32x2_t __attribute__((ext_vector_type(2))); typedef __bf16 bf16x2_t __attribute__((ext_vector_type(2)));
__device__ __forceinline__ unsigned cvtpk_s(float lo,float hi){f32x2_t v={lo,hi};bf16x2_t b=__builtin_convertvector(v,bf16x2_t);return __builtin_bit_cast(unsigned,b);}
#define WAIT_BAR(N) asm volatile("s_waitcnt vmcnt(" #N ") lgkmcnt(0)\n\ts_barrier":::"memory")

__device__ __forceinline__ bf16x8 mk_qbias(float mhat,int hi){
  const float x=-mhat; const unsigned h=cvtpk_s(x,0.f)&0xffffu; const float r1=x-__uint_as_float(h<<16); const unsigned m=cvtpk_s(r1,0.f)&0xffffu; const float r2=r1-__uint_as_float(m<<16); const unsigned l=cvtpk_s(r2,0.f)&0xffffu;
  u32x4 w; w[0]=0x3F803F80u; w[1]=0x3F80u|(h<<16); w[2]=m|(l<<16); w[3]=0u; if(hi){w[0]=0u;w[1]=0u;w[2]=0u;} return __builtin_bit_cast(bf16x8,w);
}
__device__ __forceinline__ void qkt(f32x16&p0,f32x16&p1,const char*Kslot,const bf16x8*qr,bf16x8 fk0,bf16x8 fk1,bf16x8 qbias,int r32,int hi){
  const char*kb=Kslot+hi*1024+r32*16;
  p0=__builtin_amdgcn_mfma_f32_32x32x16_bf16(fk0,qbias,f32x16{},0,0,0);p1=__builtin_amdgcn_mfma_f32_32x32x16_bf16(fk1,qbias,f32x16{},0,0,0);
  #pragma unroll
  for(int d0=0;d0<4;++d0){
    const bf16x8 b0=*reinterpret_cast<const bf16x8*>(kb+d0*2048);
    const bf16x8 b1=*reinterpret_cast<const bf16x8*>(kb+d0*2048+512);
    p0=__builtin_amdgcn_mfma_f32_32x32x16_bf16(b0,qr[d0],p0,0,0,0);p1=__builtin_amdgcn_mfma_f32_32x32x16_bf16(b1,qr[d0],p1,0,0,0);}
}
typedef __attribute__((address_space(3))) const char* lds_cptr;
typedef short v4i16_t __attribute__((ext_vector_type(4)));
__device__ __forceinline__ void kload8(bf16x8*kf,lds_cptr kp){
  kf[0]=*(const __attribute__((address_space(3))) bf16x8*)(kp);      kf[1]=*(const __attribute__((address_space(3))) bf16x8*)(kp+512);
  kf[2]=*(const __attribute__((address_space(3))) bf16x8*)(kp+2048); kf[3]=*(const __attribute__((address_space(3))) bf16x8*)(kp+2560);
  kf[4]=*(const __attribute__((address_space(3))) bf16x8*)(kp+4096); kf[5]=*(const __attribute__((address_space(3))) bf16x8*)(kp+4608);
  kf[6]=*(const __attribute__((address_space(3))) bf16x8*)(kp+6144); kf[7]=*(const __attribute__((address_space(3))) bf16x8*)(kp+6656);
}
__device__ __forceinline__ void kload2(bf16x8*kf,lds_cptr kp,int j){ kf[2*j]=*(const __attribute__((address_space(3))) bf16x8*)(kp+j*2048); kf[2*j+1]=*(const __attribute__((address_space(3))) bf16x8*)(kp+j*2048+512); }
__device__ __forceinline__ s16x4 vtr(lds_cptr p){ return __builtin_bit_cast(s16x4,__builtin_amdgcn_ds_read_tr16_b64_v4i16((__attribute__((address_space(3))) v4i16_t*)p)); }
__device__ __forceinline__ float rowmax(const f32x16&p0,const f32x16&p1){
  float a=max3f(p0[0],p0[1],p1[0]),b=max3f(p0[2],p0[3],p1[1]);a=max3f(a,p1[2],p1[3]);
  #pragma unroll
  for(int r=4;r<16;r+=4){a=max3f(a,p0[r],p0[r+1]);b=max3f(b,p0[r+2],p0[r+3]);a=max3f(a,p1[r],p1[r+1]);b=max3f(b,p1[r+2],p1[r+3]);}
  const float m=max2f(a,b);
  auto rr=__builtin_amdgcn_permlane32_swap(__float_as_uint(m),__float_as_uint(m),false,false);
  return max2f(__uint_as_float(rr[0]),__uint_as_float(rr[1]));
}
__device__ __forceinline__ void pv(f32x16*o,int vb,bf16x8 pa0,bf16x8 pa1,bf16x8 pa2,bf16x8 pa3){
  #pragma unroll
  for(int d0=0;d0<2;++d0){s16x4 lo[4],hi[4];
    #pragma unroll
    for(int ks=0;ks<4;++ks){
      asm volatile("ds_read_b64_tr_b16 %0,%1 offset:%c2":"=&v"(lo[ks]):"v"(vb),"i"(d0*4096+ks*1024):"memory");
      asm volatile("ds_read_b64_tr_b16 %0,%1 offset:%c2":"=&v"(hi[ks]):"v"(vb),"i"(d0*4096+ks*1024+512):"memory");}
    asm volatile("s_waitcnt lgkmcnt(0)":::"memory");SBAR();
    #define PK(k) (bf16x8){lo[k][0],lo[k][1],lo[k][2],lo[k][3],hi[k][0],hi[k][1],hi[k][2],hi[k][3]}
    o[d0]=__builtin_amdgcn_mfma_f32_32x32x16_bf16(pa0,PK(0),o[d0],0,0,0);
    o[d0]=__builtin_amdgcn_mfma_f32_32x32x16_bf16(pa1,PK(1),o[d0],0,0,0);
    o[d0]=__builtin_amdgcn_mfma_f32_32x32x16_bf16(pa2,PK(2),o[d0],0,0,0);
    o[d0]=__builtin_amdgcn_mfma_f32_32x32x16_bf16(pa3,PK(3),o[d0],0,0,0);
    #undef PK
  }
}

#ifndef ATTN_STORE16
#define ATTN_STORE16(p,v) (*(u32x4*)(p)=(v))
#endif
template<int THRL> __device__ __forceinline__ void attn_unit(int b,int h,int qb,const bf16*Q,const bf16*__restrict__ K,const bf16*__restrict__ V,const bf16*__restrict__ G,bf16*O,char*shm){
  int tid_=threadIdx.x; asm volatile("":"+v"(tid_)); const int tid=tid_,lane=tid&63,r32=lane&31,hi=lane>>5; const int wid=__builtin_amdgcn_readfirstlane(tid>>6);
  const long rowbase=(long)b*SEQ; const int q0=qb*QB;
  const bf16*Qw=Q+(rowbase+q0+wid*QBLK)*DM+h*D;
  const bf16*Kh=K+rowbase*DM+h*D,*Vh=V+rowbase*DM+h*D;
  const unsigned lds0=(unsigned)(uintptr_t)shm;
  float*wsf=(float*)(shm+LDS_WS)+wid*64;
  const bf16*ksrc=Kh+(long)lane*DM+wid*8;
  const bf16*vsrc=Vh+(long)(16*(wid&3)+(lane>>2))*DM+(wid>>2)*32+(lane&3)*8;
  const unsigned kdst=lds0+LDS_K+wid*1024, vdst=lds0+LDS_V+wid*1024;
  #define DMA_K(t,slot) glds16(ksrc+(long)(t)*KVBLK*DM,(unsigned)__builtin_amdgcn_readfirstlane(kdst+(slot)))
  #define DMA_V(t,slot) glds16(vsrc+(long)(t)*KVBLK*DM,(unsigned)__builtin_amdgcn_readfirstlane(vdst+(slot)))
  const int vb0=(int)(lds0+LDS_V)+((lane>>4)&1)*32+(lane&3)*8+(4*hi+((lane&15)>>2))*64;
  const char*Kbase=shm+LDS_K; bf16x8 kf[8];
  const lds_cptr shm3=(lds_cptr)shm; const lds_cptr kp0=shm3+LDS_K+hi*1024+r32*16; const lds_cptr vp0=shm3+LDS_V+((lane>>4)&1)*32+(lane&3)*8+(4*hi+((lane&15)>>2))*64;
  const int NT=(q0+QB)/KVBLK;
  DMA_K(0,0);DMA_V(0,0);DMA_K(1,SLOTB);
  bf16x8 qr[4];
  #pragma unroll
  for(int d0=0;d0<4;++d0)qr[d0]=*reinterpret_cast<const bf16x8*>(&Qw[(long)r32*DM+d0*16+hi*8]);
  float mhat; { const u32x4 eq=*(const __attribute__((address_space(3))) u32x4*)(shm3+LDS_FB+(q0+wid*QBLK+r32)*16); mhat=__uint_as_float(eq[0]<<16)+__uint_as_float(eq[0]&0xffff0000u)+__uint_as_float(eq[1]<<16); }
  float l_reg=0.f;f32x16 o[2];o[0]=f32x16{};o[1]=f32x16{};bf16x8 qbias=mk_qbias(mhat,hi);asm volatile("":"+v"(qbias));
  const int qrel=wid*QBLK+r32;
  #define CMASK(P0,P1,t) do{int jb_=(t)-(NT-4); if(jb_>=0)cmask(P0,P1,jb_,qrel,hi);}while(0)
  const lds_cptr fbt=shm3+LDS_FB+r32*16;
  #define FKLD(t,blk) (*(const __attribute__((address_space(3))) bf16x8*)(fbt+((t)*64+(blk)*32)*16))
  bool resc=false;
  #define START(P0,P1) do{ const float rm=rowmax(P0,P1); resc=false; \
    { const float dl=rm; mhat=fadd_s(mhat,dl); \
      _Pragma("unroll") for(int r=0;r<16;++r){P0[r]=fsub_s(P0[r],dl);P1[r]=fsub_s(P1[r],dl);} \
      qbias=mk_qbias(mhat,hi); asm volatile("":"+v"(qbias)); } \
    _Pragma("unroll") for(int r=0;r<16;++r)P0[r]=__builtin_amdgcn_exp2f(P0[r]); }while(0)
  #define RESC() do{ if(resc){ asm volatile("s_waitcnt lgkmcnt(0)":::"memory"); \
      _Pragma("unroll") for(int d_=0;d_<2;++d_) _Pragma("unroll") for(int r=0;r<16;++r)o[d_][r]*=wsf[crow(r,hi)]; } }while(0)
  f32x16 pA0,pA1,pB0,pB1;
  int sl_prev=0,sl_cur=0,sl_next=SLOTB;
  #define ROT() do{sl_prev=sl_cur;sl_cur=sl_next;sl_next=(sl_next==(NSLOT-1)*SLOTB)?0:sl_next+SLOTB;}while(0)
  DMA_K(2,2*SLOTB);
  WAIT_BAR(3);
  qkt(pA0,pA1,Kbase,qr,FKLD(0,0),FKLD(0,1),qbias,r32,hi);asm volatile("s_nop 15\n\ts_nop 7":"+v"(pA0),"+v"(pA1));CMASK(pA0,pA1,0);
  START(pA0,pA1);
  _Pragma("unroll") for(int r=0;r<16;++r)pA1[r]=__builtin_amdgcn_exp2f(pA1[r]);
  WAIT_BAR(0);
  DMA_K(3,0);DMA_V(1,SLOTB);
  ROT();
  kload8(kf,kp0+sl_cur);
  WAIT_BAR(2);
  s16x4 vlo[8],vhi[8]; u32x4 pw0,pw1,pw2,pw3;
  #define PKW(P,B) cvtpk_s(P[B],P[B+1])
  #define PAF(k) __builtin_bit_cast(bf16x8,pw##k)
  #define VFR(i) (bf16x8){vlo[i][0],vlo[i][1],vlo[i][2],vlo[i][3],vhi[i][0],vhi[i][1],vhi[i][2],vhi[i][3]}
  #define PIN(x) asm volatile("":"+v"(x))
  #define MX3(a,b,c) __builtin_fmaxf(__builtin_fmaxf((a),(b)),(c))
  #define GAPA(MF,A0,A1,A2,A3,W0,W1,PW) do{ MF; sacc+=A0; sacc+=A1; sacc+=A2; sacc+=A3; PIN(sacc); W0; W1; PIN(PW); SBAR(); }while(0)
  #define EX(v) __builtin_amdgcn_exp2f(v)
  #define GAPB(MF,X,B) do{ MF; X[B]=EX(X[B]); X[B+1]=EX(X[B+1]); X[B+2]=EX(X[B+2]); X[B+3]=EX(X[B+3]); PIN(X); SBAR(); }while(0)
  #define VRD(i) do{ vlo[i]=vtr(vp_+(((i)>>2)*4096+((i)&3)*1024)); vhi[i]=vtr(vp_+(((i)>>2)*4096+((i)&3)*1024+512)); }while(0)
  #define KRD(G,j) do{ if(G){ kload2(kf,kp0+sl_next,j); SBAR(); } }while(0)
  #define STEP(C0,C1,P0,P1,t,GK,GV,GL) do{ SBAR(); \
    const lds_cptr vp_=vp0+sl_prev; const bf16x8 fk0_=FKLD(t,0), fk1_=FKLD(t,1); \
    VRD(0); SBAR(); float sacc=(P0[0]+P0[1]); \
    GAPA(C0=__builtin_amdgcn_mfma_f32_32x32x16_bf16(kf[0],qr[0],f32x16{},0,0,0), P0[2],P0[3],P0[4],P0[5],     pw0[0]=PKW(P0,0), pw0[1]=PKW(P0,2), pw0); \
    VRD(4); SBAR(); GAPA(C1=__builtin_amdgcn_mfma_f32_32x32x16_bf16(kf[1],qr[0],f32x16{},0,0,0), P0[6],P0[7],P0[8],P0[9],     pw0[2]=PKW(P0,4), pw0[3]=PKW(P0,6), pw0); \
    VRD(1); SBAR(); GAPA(C0=__builtin_amdgcn_mfma_f32_32x32x16_bf16(kf[2],qr[1],C0,0,0,0),   P0[10],P0[11],P0[12],P0[13], pw1[0]=PKW(P0,8), pw1[1]=PKW(P0,10), pw1); \
    VRD(5); SBAR(); GAPA(C1=__builtin_amdgcn_mfma_f32_32x32x16_bf16(kf[3],qr[1],C1,0,0,0),   P0[14],P0[15],P1[0],P1[1],   pw1[2]=PKW(P0,12),pw1[3]=PKW(P0,14), pw1); \
    VRD(2); SBAR(); GAPA(C0=__builtin_amdgcn_mfma_f32_32x32x16_bf16(kf[4],qr[2],C0,0,0,0),   P1[2],P1[3],P1[4],P1[5],     pw2[0]=PKW(P1,0), pw2[1]=PKW(P1,2), pw2); \
    VRD(6); SBAR(); GAPA(C1=__builtin_amdgcn_mfma_f32_32x32x16_bf16(kf[5],qr[2],C1,0,0,0),   P1[6],P1[7],P1[8],P1[9],     pw2[2]=PKW(P1,4), pw2[3]=PKW(P1,6), pw2); \
    VRD(3); SBAR(); GAPA(C0=__builtin_amdgcn_mfma_f32_32x32x16_bf16(kf[6],qr[3],C0,0,0,0),   P1[10],P1[11],P1[12],P1[13], pw3[0]=PKW(P1,8), pw3[1]=PKW(P1,10), pw3); \
    VRD(7); SBAR(); GAPA(C1=__builtin_amdgcn_mfma_f32_32x32x16_bf16(kf[7],qr[3],C1,0,0,0),   P1[14],P1[15],0.f,0.f,       pw3[2]=PKW(P1,12),pw3[3]=PKW(P1,14), pw3); \
    C0=__builtin_amdgcn_mfma_f32_32x32x16_bf16(fk0_,qbias,C0,0,0,0); C1=__builtin_amdgcn_mfma_f32_32x32x16_bf16(fk1_,qbias,C1,0,0,0); \
    l_reg+=sacc; \
    if(GK){DMA_K((t)+3,sl_cur);} if(GV){DMA_V((t)+1,sl_next);} \
    CMASK(C0,C1,t); \
    { float a=MX3(C0[0],C0[1],C1[0]),b=MX3(C0[2],C0[3],C1[1]); a=MX3(a,C1[2],C1[3]); \
      _Pragma("unroll") for(int r=4;r<16;r+=4){a=MX3(a,C0[r],C0[r+1]);b=MX3(b,C0[r+2],C0[r+3]);a=MX3(a,C1[r],C1[r+1]);b=MX3(b,C1[r+2],C1[r+3]);} \
      float rm=__builtin_fmaxf(a,b); { auto rr=__builtin_amdgcn_permlane32_swap(__float_as_uint(rm),__float_as_uint(rm),false,false); rm=__builtin_fmaxf(__uint_as_float(rr[0]),__uint_as_float(rr[1])); } \
      resc=false; \
      if(__builtin_expect(__any(rm>(float)THRL),0)){ const float dl=__builtin_fmaxf(rm,0.f); mhat+=dl; \
        _Pragma("unroll") for(int r=0;r<16;++r){C0[r]-=dl;C1[r]-=dl;} \
        qbias=mk_qbias(mhat,hi); asm volatile("":"+v"(qbias)); \
        const float f=__builtin_amdgcn_exp2f(-dl); l_reg*=f; if(hi==0)wsf[r32]=f; resc=true; } } \
    SBAR(); \
    GAPB(o[0]=__builtin_amdgcn_mfma_f32_32x32x16_bf16(PAF(0),VFR(0),o[0],0,0,0), C0,0); \
    GAPB(o[1]=__builtin_amdgcn_mfma_f32_32x32x16_bf16(PAF(0),VFR(4),o[1],0,0,0), C0,4); \
    KRD(GL,0); GAPB(o[0]=__builtin_amdgcn_mfma_f32_32x32x16_bf16(PAF(1),VFR(1),o[0],0,0,0), C0,8); \
    KRD(GL,1); GAPB(o[1]=__builtin_amdgcn_mfma_f32_32x32x16_bf16(PAF(1),VFR(5),o[1],0,0,0), C0,12); \
    KRD(GL,2); GAPB(o[0]=__builtin_amdgcn_mfma_f32_32x32x16_bf16(PAF(2),VFR(2),o[0],0,0,0), C1,0); \
    KRD(GL,3); GAPB(o[1]=__builtin_amdgcn_mfma_f32_32x32x16_bf16(PAF(2),VFR(6),o[1],0,0,0), C1,4); \
    GAPB(o[0]=__builtin_amdgcn_mfma_f32_32x32x16_bf16(PAF(3),VFR(3),o[0],0,0,0), C1,8); \
    GAPB(o[1]=__builtin_amdgcn_mfma_f32_32x32x16_bf16(PAF(3),VFR(7),o[1],0,0,0), C1,12); \
    }while(0)
  int t=1;
  #undef CMASK
  #define CMASK(P0,P1,t) do{}while(0)
  for(;t+5<NT;t+=2){
    STEP(pB0,pB1,pA0,pA1,t,true,true,true);     WAIT_BAR(2); RESC(); ROT();
    STEP(pA0,pA1,pB0,pB1,t+1,true,true,true);   WAIT_BAR(2); RESC(); ROT();
  }
  #undef CMASK
  #define CMASK(P0,P1,t) do{int jb_=(t)-(NT-4); if(jb_>=0)cmask(P0,P1,jb_,qrel,hi);}while(0)
  #define ENDW(tt) do{ if((tt)+3<NT){WAIT_BAR(2);} else if((tt)+2<NT){WAIT_BAR(1);} else {WAIT_BAR(0);} }while(0)
  for(;t+1<NT;t+=2){
    STEP(pB0,pB1,pA0,pA1,t,(t+3<NT),(t+1<NT),(t+1<NT));       ENDW(t);   RESC(); ROT();
    STEP(pA0,pA1,pB0,pB1,t+1,(t+4<NT),(t+2<NT),(t+2<NT));     ENDW(t+1); RESC(); ROT();
  }
  STEP(pB0,pB1,pA0,pA1,NT-1,false,false,false); RESC();
  u32x4 ggv[4];
  { const bf16*Gw_=G+(rowbase+q0+wid*QBLK)*DM+h*D;
    #pragma unroll
    for(int i=0;i<4;++i)ggv[i]=*(const u32x4*)(Gw_+(long)(i*8+(lane>>3))*DM+(lane&7)*8); }
  { float sacc=pB0[0]+pB0[1]; _Pragma("unroll") for(int r=2;r<16;++r)sacc+=pB0[r]; _Pragma("unroll") for(int r=0;r<16;++r)sacc+=pB1[r]; l_reg+=sacc;
    pw0=(u32x4){PKW(pB0,0),PKW(pB0,2),PKW(pB0,4),PKW(pB0,6)};pw1=(u32x4){PKW(pB0,8),PKW(pB0,10),PKW(pB0,12),PKW(pB0,14)};pw2=(u32x4){PKW(pB1,0),PKW(pB1,2),PKW(pB1,4),PKW(pB1,6)};pw3=(u32x4){PKW(pB1,8),PKW(pB1,10),PKW(pB1,12),PKW(pB1,14)};
    SBAR(); pv(o,vb0+sl_cur,PAF(0),PAF(1),PAF(2),PAF(3)); }
  #undef PKW
  #undef PAF
  #undef VFR
  #undef PIN
  #undef MX3
  #undef GAPA
  #undef GAPB
  #undef EX
  #undef VRD
  #undef KRD
  #undef STEP
  #undef ENDW
  {auto rr=__builtin_amdgcn_permlane32_swap(__float_as_uint(l_reg),__float_as_uint(l_reg),false,false);l_reg=__uint_as_float(rr[0])+__uint_as_float(rr[1]);}
  if(hi==0)wsf[32+r32]=l_reg;asm volatile("s_waitcnt lgkmcnt(0)":::"memory");
  float rli[16];
  #pragma unroll
  for(int r=0;r<16;++r)rli[r]=__builtin_amdgcn_rcpf(wsf[32+crow(r,hi)]);
  bf16*Ow=O+(rowbase+q0+wid*QBLK)*DM+h*D;
  { bf16*stg=(bf16*)(shm+LDS_OST)+wid*2048;
    #pragma unroll
    for(int r=0;r<16;++r){const int orow=crow(r,hi);
      #pragma unroll
      for(int d0=0;d0<2;++d0)stg[orow*64+d0*32+r32]=__float2bfloat16(o[d0][r]*rli[r]);}
    asm volatile("s_waitcnt lgkmcnt(0)":::"memory");
    #pragma unroll
    for(int i=0;i<4;++i){const int row=i*8+(lane>>3),ch=lane&7; const u32x4 v=*(const u32x4*)(stg+row*64+ch*8); const u32x4 gg=ggv[i]; u32x4 w;
      #pragma unroll
      for(int c=0;c<4;++c){ const float lo=__uint_as_float(v[c]<<16)*__uint_as_float(gg[c]<<16), hh=__uint_as_float(v[c]&0xffff0000u)*__uint_as_float(gg[c]&0xffff0000u); w[c]=cvtpk_s(lo,hh); }
      ATTN_STORE16(Ow+(long)row*DM+ch*8,w);} }
  asm volatile("s_waitcnt lgkmcnt(0)\n\ts_barrier":::"memory");
  #undef DMA_K
  #undef DMA_V
  #undef CMASK
  #undef FKLD
  #undef START
  #undef RESC
  #undef ROT
}
constexpr int ATTN_LDS_BYTES=LDS_BYTES;
struct AttnTensors { const bf16* Q; const bf16* K; const bf16* V; const bf16* G; bf16* O; const u32x4* FBT; };
struct AttnUnit { int bh; int qb; };
struct StaticOrder {
  int vcu, G;
  __device__ __forceinline__ bool next(int i,AttnUnit&u)const{ u.bh=vcu+(i>>3)*G; if(u.bh>=BATCH*NHEAD)return false; u.qb=(i+(vcu&7))&7; return true; }
};
__device__ __forceinline__ void scan_bias_table(char*lds,const float*FG,const float*bfp,int bh,u32x4*tab){
  float*wtot=(float*)lds; const int b_=bh/NHEAD,h_=bh%NHEAD,t_=threadIdx.x,ln_=t_&63,wv_=t_>>6; const float bf_=bfp[h_]; float p_[4]; float run=0.f;
  #pragma unroll
  for(int i=0;i<4;++i){ const float xg=FG[((size_t)b_*SEQ+4*t_+i)*NHEAD+h_]+bf_; run+=(xg>=0.f?-log1pf(expf(-xg)):xg-log1pf(expf(xg))); p_[i]=run; }
  float inc=run;
  #pragma unroll
  for(int o=1;o<64;o<<=1){ const float tt=__shfl_up(inc,o); if(ln_>=o)inc+=tt; }
  __syncthreads();
  if(ln_==63)wtot[wv_]=inc;
  __syncthreads();
  float base_=inc-run; for(int w=0;w<wv_;++w)base_+=wtot[w];
  #pragma unroll
  for(int i=0;i<4;++i){ const float x=-1.4426950408889634f*(base_+p_[i]); const unsigned h=cvtpk_s(x,0.f)&0xffffu; const float r1=x-__uint_as_float(h<<16); const unsigned m=cvtpk_s(r1,0.f)&0xffffu;
    const float r2=r1-__uint_as_float(m<<16); const unsigned l=cvtpk_s(r2,0.f)&0xffffu; u32x4 w; w[0]=h|(m<<16); w[1]=l|(0x3F80u<<16); w[2]=0x3F803F80u; w[3]=0u; tab[(size_t)bh*SEQ+4*t_+i]=w; }
}
template<class Sched,int THRL=8> __device__ __forceinline__ void attn_phase(char*lds,const AttnTensors&T,const Sched&S){
  AttnUnit u; int cur=-1;
  for(int i=0;S.next(i,u);++i){
    if(u.bh!=cur){ cur=u.bh; u32x4*fb=(u32x4*)(lds+LDS_FB); const u32x4*src=T.FBT+(size_t)u.bh*SEQ;
      #pragma unroll
      for(int k=0;k<SEQ/(NW*64);++k)fb[threadIdx.x+k*NW*64]=src[threadIdx.x+k*NW*64];
      asm volatile("s_waitcnt vmcnt(0) lgkmcnt(0)\n\ts_barrier":::"memory"); }
    attn_unit<THRL>(u.bh/NHEAD,u.bh%NHEAD,u.qb,T.Q,T.K,T.V,T.G,T.O,lds);
  }
}
#undef SBAR
#undef WAIT_BAR
}
#define GAS __attribute__((address_space(1)))
#define LAS __attribute__((address_space(3)))
typedef unsigned short bf16;
typedef unsigned v4u __attribute__((ext_vector_type(4)));
typedef float f32x4 __attribute__((ext_vector_type(4)));
typedef short bf16x8 __attribute__((ext_vector_type(8)));
typedef GAS unsigned gu32;
typedef GAS unsigned long long gu64;
#define RLX_AGENT __ATOMIC_RELAXED, __HIP_MEMORY_SCOPE_AGENT
#define LDS_WAIT() asm volatile("s_waitcnt lgkmcnt(0)" ::: "memory")
#define VM_WAIT() asm volatile("s_waitcnt vmcnt(0)" ::: "memory")
__device__ __forceinline__ unsigned long long rt() { return __builtin_amdgcn_s_memrealtime(); }
__device__ __forceinline__ unsigned f2bf(float f) { unsigned u = __builtin_bit_cast(unsigned, f); return (u + 0x7fffu + ((u >> 16) & 1u)) >> 16; }
__device__ __forceinline__ unsigned pk2(float lo, float hi) { return f2bf(lo) | (f2bf(hi) << 16); }

#define XB_TMO      128
#define XB_XCNT(j)  (256  + 64 * (j))
#define XB_XSUB(j)  (1280 + 64 * (j))
#define XB_XGEN(j)  (2304 + 64 * (j))
#define XB_TOP      3328
#define XB_TOPGEN   3392
#define XCD_BAR_WORDS 3456
#define XB_SPIN_CAP (1u << 18)

__device__ __forceinline__ unsigned xb_ld(unsigned* p)              { return __hip_atomic_load(p, __ATOMIC_RELAXED, __HIP_MEMORY_SCOPE_AGENT); }
__device__ __forceinline__ unsigned xb_add(unsigned* p, unsigned v) { return __hip_atomic_fetch_add(p, v, __ATOMIC_RELAXED, __HIP_MEMORY_SCOPE_AGENT); }
__device__ __forceinline__ unsigned xb_xcc_id() { return (unsigned)__builtin_amdgcn_s_getreg((3 << 11) | 20) & 0xFu; }
#define XB_SPIN(cond, bar) do { unsigned _sp = 0; while (cond) { __builtin_amdgcn_s_sleep(1); \
    if ((++_sp & 255u) == 0u) { if (xb_ld(&(bar)[XB_TMO])) break; if (_sp > XB_SPIN_CAP) { atomicAdd(&(bar)[XB_TMO], 1u); break; } } } } while (0)

struct XcdBarrier {
    unsigned* bar; unsigned x;
    volatile LAS unsigned* st;
};

__device__ __forceinline__ XcdBarrier xcd_barrier_post(unsigned* bar, volatile LAS unsigned* st) {
    XcdBarrier b; b.bar = bar; b.x = xb_xcc_id(); b.st = st;
    if (threadIdx.x == 0) (void)xb_add(&bar[XB_XCNT(b.x)], 1u);
    return b;
}
__device__ __forceinline__ void xcd_barrier_complete(unsigned* bar, unsigned x, unsigned& nloc, unsigned& nx) {
    const unsigned G = gridDim.x * gridDim.y * gridDim.z;
    unsigned sum, cnt, mine, sp = 0u;
    for (;;) {
        sum = 0u; cnt = 0u; mine = 0u;
#pragma unroll
        for (unsigned j = 0; j < 16; ++j) { const unsigned c = xb_ld(&bar[XB_XCNT(j)]); sum += c; cnt += (c > 0u) ? 1u : 0u; mine = (j == x) ? c : mine; }
        if (sum == G) break;
        __builtin_amdgcn_s_sleep(1);
        if ((++sp & 255u) == 0u) { if (xb_ld(&bar[XB_TMO])) break; if (sp > XB_SPIN_CAP) { atomicAdd(&bar[XB_TMO], 1u); break; } }
    }
    nloc = mine > 0u ? mine : 1u; nx = cnt > 0u ? cnt : 1u;
}

__device__ __forceinline__ void xcd_barrier(const XcdBarrier& b) {
    asm volatile("s_waitcnt vmcnt(0)" ::: "memory");
    __syncthreads();
    if (threadIdx.x == 0) {
        unsigned* bar = b.bar;
        __builtin_amdgcn_s_waitcnt(0);
        unsigned nloc = b.st[0], nx = b.st[1];
        if (nloc == 0u) { xcd_barrier_complete(bar, b.x, nloc, nx); b.st[0] = nloc; b.st[1] = nx; }
        const unsigned old = xb_add(&bar[XB_XSUB(b.x)], 1u);
        const unsigned gen = old / nloc;
        if (old + 1u == (gen + 1u) * nloc) {
            __builtin_amdgcn_fence(__ATOMIC_RELEASE, "agent");
            asm volatile("s_waitcnt vmcnt(0)" ::: "memory");
            const unsigned og = xb_add(&bar[XB_TOP], 1u);
            const unsigned tg = og / nx;
            if (og + 1u == (tg + 1u) * nx) xb_add(&bar[XB_TOPGEN], 1u);
            else XB_SPIN(xb_ld(&bar[XB_TOPGEN]) == tg, bar);
            __builtin_amdgcn_fence(__ATOMIC_ACQUIRE, "agent");
            xb_add(&bar[XB_XGEN(b.x)], 1u);
            asm volatile("s_waitcnt vmcnt(0)" ::: "memory");
        } else {
            XB_SPIN(xb_ld(&bar[XB_XGEN(b.x)]) == gen, bar);
            __builtin_amdgcn_fence(__ATOMIC_ACQUIRE, "agent");
            asm volatile("s_waitcnt vmcnt(0)" ::: "memory");
        }
    }
    __syncthreads();
}

constexpr int NWAVES = 8;
constexpr int DM = 1024, BATCH = 16, SEQ = 2048, MROWS = BATCH * SEQ;
constexpr int A_FFN = 6144, A_HALF = 3072, A_GROUPS = 8, A_GD = 384, GCH = 128, CHK = 64;
constexpr int D_FF = 2816, NEXP = 8, D_EXP = 3584, NHEAD = 16, HD = 64;
constexpr int KVW_LD = 2 * DM + NHEAD;
constexpr float RMS_EPS = 1e-6f;
constexpr float W8_SCALE = 64.0f;
constexpr int W8_SCALE_E8M0 = 0x79797979;
enum { I_X = 0, I_A_NORM_G, I_A_W_IN, I_A_V_NORM_G, I_A_W_SP, I_A_B_SP, I_A_W_OUT, I_F_NORM_G, I_F_W_IN, I_F_W_OUT, I_KV_NORM_G, I_KV_W, I_KV_B_F, I_K_NORM_G,
       I_B_NORM_G, I_B_W_IN, I_Q_NORM_G, I_B_W_OUT, I_M_NORM_G, I_M_W_ROUTER, I_M_W_IN, I_M_W_OUT, N_IN };

constexpr size_t MiB = 1u << 20;
constexpr size_t WS_CTL = 0, CTL_ZERO_BYTES = 1 * MiB;
constexpr size_t WS_RSQ = 4 * MiB;
constexpr size_t WS_VPART = 286 * MiB;
constexpr size_t WS_FG = 2 * MiB;
constexpr size_t WS_GW = 6 * MiB;
constexpr size_t WS_TOKSLOT = 7 * MiB;
constexpr size_t WS_WA_IN = 8 * MiB, WS_WA_OUT = 20 * MiB, WS_WF_IN = 26 * MiB, WS_WF_OUT = 37 * MiB, WS_WKV = 43 * MiB, WS_WBIN = 47 * MiB, WS_WBOUT = 51 * MiB;
constexpr size_t WS_WM_IN = 53 * MiB, WS_WM_OUT = 165 * MiB;
constexpr size_t WS_XN = 222 * MiB, WS_XQ = 286 * MiB;
constexpr size_t WS_BIG = 350 * MiB;
constexpr int MAXSLOT = MROWS * 2 + NEXP * 256;
constexpr size_t WS_XG = 286 * MiB;
constexpr size_t WS_ACT = 418 * MiB;
constexpr size_t WS_Y = 8 * MiB;
constexpr size_t WS_ELIST = 880 * MiB, WS_EWL = 881 * MiB;
constexpr size_t WS_FBT = 700 * MiB;
constexpr int YP_ROWS = 16 * 256;
constexpr size_t WS_END = 883 * MiB;
constexpr int CW_BAR = 4096, CW_CNT = 64;

constexpr int RING_OFF = 0, RING_BYTES = 131072;
constexpr int LDSCTL_OFF = RING_BYTES, MISC_OFF = LDSCTL_OFF + 320;
constexpr int LDS_BYTES = 147456;

typedef short s16x4 __attribute__((ext_vector_type(4)));
__device__ __forceinline__ unsigned off_b(unsigned row, unsigned ch) { return 256u * row + 16u * (ch ^ (((row & 3u) << 2) | ((row >> 2) & 3u))); }
struct Frame {
    LAS unsigned char* lds; volatile LAS unsigned* MISC; gu32* ctl;
    int tid, lane, wave, vcu, G;
};
__device__ __forceinline__ float wave_sum(float v) {
#pragma unroll
    for (int o = 1; o < 64; o <<= 1) v += __shfl_xor(v, o);
    return v;
}
__device__ __forceinline__ void tr_load(float (&tmp)[32], const float* W, int ldw, int k0, int n0, int lane) {
#pragma unroll
    for (int i = 0; i < 32; ++i) { const int kk = 2 * i + (lane >> 5); tmp[i] = W[(size_t)(k0 + kk) * ldw + n0 + (lane & 31)]; }
}
template <class RowMap>
__device__ __forceinline__ void tr_store(float (&tmp)[32], int K, bf16* WT, LAS float* scr, int k0, int n0, int lane, const RowMap& rowmap, const float* gk, float f8scale = 0.f) {
    if (gk) {
#pragma unroll
        for (int i = 0; i < 32; ++i) tmp[i] *= gk[k0 + 2 * i + (lane >> 5)]; }
#pragma unroll
    for (int i = 0; i < 32; ++i) { const int kk = 2 * i + (lane >> 5); scr[kk * 33 + (lane & 31)] = tmp[i]; }
    LDS_WAIT(); asm volatile("" ::: "memory");
    const int c = lane & 7;
#pragma unroll
    for (int j = 0; j < 4; ++j) { const int n = (lane >> 3) + 8 * j; const LAS float* s = scr + (8 * c) * 33 + n;
        if (f8scale != 0.f) { unsigned lo = 0u, hi = 0u;
            lo = __builtin_amdgcn_cvt_pk_fp8_f32(s[0 * 33] * f8scale, s[1 * 33] * f8scale, lo, false); lo = __builtin_amdgcn_cvt_pk_fp8_f32(s[2 * 33] * f8scale, s[3 * 33] * f8scale, lo, true);
            hi = __builtin_amdgcn_cvt_pk_fp8_f32(s[4 * 33] * f8scale, s[5 * 33] * f8scale, hi, false); hi = __builtin_amdgcn_cvt_pk_fp8_f32(s[6 * 33] * f8scale, s[7 * 33] * f8scale, hi, true);
            *(GAS unsigned long long*)((GAS unsigned char*)WT + (size_t)rowmap(n0 + n) * K + k0 + 8 * c) = (unsigned long long)lo | ((unsigned long long)hi << 32); }
        else { v4u o; o.x = pk2(s[0 * 33], s[1 * 33]); o.y = pk2(s[2 * 33], s[3 * 33]); o.z = pk2(s[4 * 33], s[5 * 33]); o.w = pk2(s[6 * 33], s[7 * 33]);
            *(GAS v4u*)(WT + (size_t)rowmap(n0 + n) * K + k0 + 8 * c) = o; } }
    LDS_WAIT(); asm volatile("" ::: "memory");
}
struct MapId { __device__ __forceinline__ int operator()(int n) const { return n; } };
struct MapGlu { int half; __device__ __forceinline__ int operator()(int n) const { const int b = n >= half ? 1 : 0, x = n - b * half; return (x >> 7) * 256 + b * 128 + (x & 127); } };
struct MapGlu64 { int half; __device__ __forceinline__ int operator()(int n) const { const int b = n >= half ? 1 : 0, x = n - b * half, pn = x >> 6, xx = x & 63; return pn * 128 + (xx >> 4) * 32 + ((xx >> 2) & 3) * 8 + b * 4 + (xx & 3); } };
struct MapHead { __device__ __forceinline__ int operator()(int n) const { const int blk = n >> 10, hh = (n >> 6) & 15, d = n & 63; return (blk * 4 + (hh >> 2)) * 256 + (d >> 5) * 128 + (hh & 3) * 32 + (d & 31); } };
template <class RowMap>
__device__ __forceinline__ void tr_matrix(Frame& F, const float* W, int ldw, int K, int ncols, bf16* WT, const RowMap& rm, int& gwoff, const float* gk = nullptr, float f8scale = 0.f) {
    LAS float* scr = (LAS float*)(F.lds + RING_OFF + F.wave * 16384);
    const int NGW = F.G * NWAVES, nblk = ncols / 32, items = (K / 64) * nblk;
    int gw = F.vcu * NWAVES + F.wave - gwoff; if (gw < 0) gw += NGW;
    int it = gw; if (it < items) { float ta[32], tb[32]; tr_load(ta, W, ldw, 64 * (it / nblk), 32 * (it % nblk), F.lane);
        for (;;) { const int n1 = it + NGW; if (n1 < items) tr_load(tb, W, ldw, 64 * (n1 / nblk), 32 * (n1 % nblk), F.lane);
            tr_store(ta, K, WT, scr, 64 * (it / nblk), 32 * (it % nblk), F.lane, rm, gk, f8scale); if (n1 >= items) break;
            const int n2 = n1 + NGW; if (n2 < items) tr_load(ta, W, ldw, 64 * (n2 / nblk), 32 * (n2 % nblk), F.lane);
            tr_store(tb, K, WT, scr, 64 * (n1 / nblk), 32 * (n1 % nblk), F.lane, rm, gk, f8scale); if (n2 >= items) break;
            it = n2; } }
    gwoff = (gwoff + items) % NGW;
}
__device__ __forceinline__ void row_load(const float* xrow, int lane, f32x4 (&v)[4]) {
    const GAS f32x4* xr = (const GAS f32x4*)xrow + lane;
#pragma unroll
    for (int j = 0; j < 4; ++j) v[j] = xr[64 * j];
}
__device__ __forceinline__ void row_load(const bf16* xrow, int lane, f32x4 (&v)[4]) {
    const GAS unsigned long long* xr = (const GAS unsigned long long*)xrow + lane;
#pragma unroll
    for (int j = 0; j < 4; ++j) { const unsigned long long w = xr[64 * j]; const unsigned lo = (unsigned)w, hi = (unsigned)(w >> 32);
        v[j] = (f32x4){__uint_as_float(lo << 16), __uint_as_float(lo & 0xffff0000u), __uint_as_float(hi << 16), __uint_as_float(hi & 0xffff0000u)}; }
}
__device__ __forceinline__ float row_rstd(const f32x4 (&v)[4]) { float s = 0.f;
#pragma unroll
    for (int j = 0; j < 4; ++j) s += (v[j].x * v[j].x + v[j].y * v[j].y) + (v[j].z * v[j].z + v[j].w * v[j].w);
    return 1.0f / sqrtf(wave_sum(s) * (1.f / DM) + RMS_EPS);
}
#define ROW_LOOP_BEGIN(src) { f32x4 vn_[4]; if (gw < MROWS) row_load((src) + (size_t)gw * DM, F.lane, vn_); \
        for (int m = gw; m < MROWS; m += NGW) { f32x4 v[4]; _Pragma("unroll") for (int j_ = 0; j_ < 4; ++j_) v[j_] = vn_[j_]; \
            if (m + NGW < MROWS) row_load((src) + (size_t)(m + NGW) * DM, F.lane, vn_); const float r = row_rstd(v);
#define ROW_LOOP_END } }
__device__ __forceinline__ void rms_row_store(const f32x4 (&v)[4], float rstd, const float* g, bf16* orow, int lane, float extra = 1.0f) {
    const GAS f32x4* gr = (const GAS f32x4*)g + lane; GAS unsigned long long* o8 = (GAS unsigned long long*)orow + lane;
#pragma unroll
    for (int j = 0; j < 4; ++j) { const f32x4 gg = gr[64 * j]; const f32x4 y = (v[j] * rstd) * gg * extra;
        o8[64 * j] = (unsigned long long)pk2(y.x, y.y) | ((unsigned long long)pk2(y.z, y.w) << 32); }
}
template <int N> __device__ __forceinline__ float wave_tr_reduce(float (&v)[N], int lane) {
    static_assert(N == 16 || N == 8, "N");
#define TRR_STEP(M, NN) if (N >= NN) { const bool up = (lane & M) != 0; _Pragma("unroll") for (int i = 0; i < NN / 2; ++i) { const float keep = up ? v[i + NN / 2] : v[i], send = up ? v[i] : v[i + NN / 2]; v[i] = keep + __shfl_xor(send, M); } }
    TRR_STEP(8, 16) TRR_STEP(4, 8) TRR_STEP(2, 4) TRR_STEP(1, 2)
#undef TRR_STEP
    float t = v[0];
#pragma unroll
    for (int o = N; o < 64; o <<= 1) t += __shfl_xor(t, o);
    return t;
}
__device__ __forceinline__ float bflo(unsigned u) { return __uint_as_float(u << 16); }
__device__ __forceinline__ float bfhi(unsigned u) { return __uint_as_float(u & 0xffff0000u); }
__device__ __forceinline__ float log_sigmoid(float x) { return x >= 0.f ? -log1pf(expf(-x)) : x - log1pf(expf(x)); }

enum { PH_PRO = 0, PH_GEMM1, PH_SPATIAL, PH_GEMM2, PH_FFN_UP, PH_FFN_DOWN, PH_KVQ, PH_ATTN, PH_OPROJ, PH_ROUTER, PH_MOE_UP, PH_MOE_DOWN, PH_COMBINE, PH_END };
#ifndef MK_ONE_LAUNCH
#define MK_ONE_LAUNCH 1
#endif
#ifndef MK_PH_STOP
#define MK_PH_STOP PH_END
#endif

struct Args { const float* in[N_IN]; float* out; unsigned char* ws; int ph_lo, ph_hi, li, pad; };
__global__ void __launch_bounds__(NWAVES * 64, 2) yoco_fwd(Args args) {
    extern __shared__ __attribute__((aligned(16))) unsigned char lds[];
    Frame F;
    F.lds = (LAS unsigned char*)lds; F.MISC = (volatile LAS unsigned*)(F.lds + MISC_OFF);
    F.tid = threadIdx.x; F.lane = F.tid & 63; F.wave = __builtin_amdgcn_readfirstlane(F.tid >> 6);
    F.G = gridDim.x; { const int bx = blockIdx.x; F.vcu = (F.G % 8 == 0) ? (bx % 8) * (F.G / 8) + bx / 8 : bx; }
    unsigned char* ws = args.ws; F.ctl = (gu32*)(ws + WS_CTL);
    for (int u = F.tid; u < (LDS_BYTES - LDSCTL_OFF) / 4; u += NWAVES * 64) ((LAS unsigned*)(F.lds + LDSCTL_OFF))[u] = 0u;
    __syncthreads();
    XcdBarrier bar; bar.bar = (unsigned*)(F.ctl + CW_BAR) + args.li * XCD_BAR_WORDS; bar.x = 0; bar.st = nullptr;
    if (MK_ONE_LAUNCH) bar = xcd_barrier_post((unsigned*)(F.ctl + CW_BAR) + args.li * XCD_BAR_WORDS, F.MISC + 8);
#define GRID_BAR() do { if (MK_ONE_LAUNCH) xcd_barrier(bar); } while (0)
    const int lo = args.ph_lo, hi = args.ph_hi;
#ifndef MK_PHMASK
#define MK_PHMASK 0xffffffffu
#endif
#define IN(k) (((MK_PHMASK >> (k)) & 1u) && lo <= (k) && (k) < hi)
#define BOTH(k) (IN(k) && IN((k) + 1))
    const float* x = args.in[I_X]; float* H = args.out;
    bf16* WA_IN = (bf16*)(ws + WS_WA_IN); bf16* WA_OUT = (bf16*)(ws + WS_WA_OUT); bf16* WF_IN = (bf16*)(ws + WS_WF_IN); bf16* WF_OUT = (bf16*)(ws + WS_WF_OUT);
    bf16* WKV = (bf16*)(ws + WS_WKV); bf16* WBIN = (bf16*)(ws + WS_WBIN); bf16* WBOUT = (bf16*)(ws + WS_WBOUT); bf16* WM_IN = (bf16*)(ws + WS_WM_IN); bf16* WM_OUT = (bf16*)(ws + WS_WM_OUT);
    float* RX = (float*)(ws + 1 * MiB + 131072);
    bf16* WF16 = (bf16*)(ws + 1 * MiB);
    bf16* XN = (bf16*)(ws + WS_XN); bf16* XQ = (bf16*)(ws + WS_XQ); bf16* BIG = (bf16*)(ws + WS_BIG);
    float* RSQ_V = (float*)(ws + WS_VPART); float* RSQ_H1 = (float*)(ws + WS_RSQ); bf16* HB = XQ;
 float* FG = (float*)(ws + WS_FG); unsigned* IDL = (unsigned*)(ws + WS_GW + 512 * 1024);   float* GW = (float*)(ws + WS_GW); unsigned* TOKSLOT = (unsigned*)(ws + WS_TOKSLOT); unsigned* ELIST = (unsigned*)(ws + WS_ELIST); float* EWL = (float*)(ws + WS_EWL); unsigned* ERS = (unsigned*)(ws + WS_EWL + 1 * MiB);
    bf16* ACT = (bf16*)(ws + WS_ACT); bf16* YB = (bf16*)(ws + WS_Y); bf16* YP = (bf16*)(ws + WS_BIG);
    bf16* KB = BIG; bf16* VB = BIG + (size_t)MROWS * DM; bf16* QB = BIG + (size_t)2 * MROWS * DM; bf16* GB = BIG + (size_t)3 * MROWS * DM;
    const int gw = F.vcu * NWAVES + F.wave, NGW = F.G * NWAVES;

    if (IN(PH_PRO)) {
        int go = 0;
        tr_matrix(F, args.in[I_A_W_IN], A_FFN, DM, A_FFN, WA_IN, MapId{}, go, args.in[I_A_NORM_G]);
        tr_matrix(F, args.in[I_A_W_OUT], DM, A_HALF, DM, WA_OUT, MapId{}, go);
        tr_matrix(F, args.in[I_F_W_IN], 2 * D_FF, DM, 2 * D_FF, WF_IN, MapGlu{D_FF}, go, args.in[I_F_NORM_G]);
        tr_matrix(F, args.in[I_F_W_OUT], DM, D_FF, DM, WF_OUT, MapId{}, go);
        tr_matrix(F, args.in[I_KV_W], KVW_LD, DM, 2 * DM, WKV, MapHead{}, go, args.in[I_KV_NORM_G]);
        tr_matrix(F, args.in[I_B_W_IN], 2 * DM, DM, 2 * DM, WBIN, MapHead{}, go, args.in[I_B_NORM_G]);
        tr_matrix(F, args.in[I_B_W_OUT], DM, DM, DM, WBOUT, MapId{}, go);
        for (int e = 0; e < NEXP; ++e) {
            tr_matrix(F, args.in[I_M_W_IN] + (size_t)e * DM * 2 * D_EXP, 2 * D_EXP, DM, 2 * D_EXP, (bf16*)((unsigned char*)WM_IN + (size_t)e * 2 * D_EXP * DM), MapGlu{D_EXP}, go, args.in[I_M_NORM_G], W8_SCALE);
            tr_matrix(F, args.in[I_M_W_OUT] + (size_t)e * D_EXP * DM, DM, D_EXP, DM, (bf16*)((unsigned char*)WM_OUT + (size_t)e * DM * D_EXP), MapId{}, go, nullptr, W8_SCALE);
        }
        ROW_LOOP_BEGIN(x) { GAS unsigned long long* o8 = (GAS unsigned long long*)(XN + (size_t)m * DM) + F.lane;
#pragma unroll
            for (int j = 0; j < 4; ++j) o8[64 * j] = (unsigned long long)pk2(v[j].x, v[j].y) | ((unsigned long long)pk2(v[j].z, v[j].w) << 32);
            if (F.lane == 0) RX[m] = r; } ROW_LOOP_END
        for (int e = blockIdx.x * (NWAVES * 64) + F.tid; e < NHEAD * DM; e += F.G * NWAVES * 64) { const int h = e >> 10, k = e & 1023; WF16[e] = (bf16)f2bf(args.in[I_KV_W][(size_t)k * KVW_LD + 2 * DM + h] * args.in[I_KV_NORM_G][k]); }
        if (BOTH(PH_PRO)) GRID_BAR();
    }
    if (IN(PH_GEMM1)) {
        pg8::Gemm g{XN, WA_IN, MROWS, A_FFN, DM, DM, 0, nullptr, 0, nullptr, 0}; pg8::StaticOrder S; S.init(MROWS, A_FFN, F.G, (int)blockIdx.x);
        LAS float* RT = (LAS float*)(F.lds + LDSCTL_OFF + 4096);
        { pg8::Unit uu; __syncthreads();
          for (int i0 = 0; i0 < 12; i0 += 2) { const int i = i0 + (F.tid >> 8); if (!S.next(i, uu)) continue; RT[i * 256 + (F.tid & 255)] = RX[uu.pm * 256 + (F.tid & 255)]; }
          __syncthreads(); }
        pg8::EpiGeluSq E{BIG, A_FFN, RSQ_V, A_HALF / 256, RT};
        pg8::gemm_phase<pg8::EpiGeluSq, pg8::StaticOrder, true, true>(F.lds + RING_OFF, g, S, E);
        if (BOTH(PH_GEMM1)) GRID_BAR();
    }
    if (IN(PH_SPATIAL)) {
        int tid_ = threadIdx.x; asm volatile("" : "+v"(tid_));
        const int tid = tid_, lane = tid & 63, wid = __builtin_amdgcn_readfirstlane(tid >> 6), wr = wid >> 2, wc = wid & 3, L15 = lane & 15, G4 = lane >> 4, q_ = (lane & 15) >> 2, p_ = lane & 3;
        LAS unsigned char* VI = F.lds + RING_OFF; LAS unsigned char* WI = F.lds + RING_OFF + 98304; LAS float* RVS = (LAS float*)(F.lds + LDSCTL_OFF + 1024);
        const float* wsp = args.in[I_A_W_SP]; const float* bsp = args.in[I_A_B_SP]; const float* gvn = args.in[I_A_V_NORM_G];
        for (int u = F.vcu; u < (MROWS / GCH) * A_GROUPS; u += F.G) {
            const int cc = u / A_GROUPS, g = u % A_GROUPS; const size_t r0 = (size_t)cc * GCH;
            __syncthreads();
            if (tid < GCH) { const GAS f32x4* pp = (const GAS f32x4*)(RSQ_V + (r0 + tid) * 48); float t = 0.f;
#pragma unroll
                for (int k = 0; k < 12; ++k) { const f32x4 p = pp[k]; t += (p[0] + p[1]) + (p[2] + p[3]); }
                RVS[tid] = 1.0f / sqrtf(t * (1.f / A_HALF) + RMS_EPS); }
            __syncthreads();
            { const unsigned char* vbase = (const unsigned char*)(BIG + r0 * A_FFN + A_HALF + g * A_GD);
#pragma unroll
              for (int hb = 0; hb < 2; ++hb) { v4u vreg[6];
#pragma unroll
                  for (int k = 0; k < 6; ++k) { const unsigned q = tid + 512 * (6 * hb + k), row = q / 48u, c48 = q % 48u; vreg[k] = *(const GAS v4u*)(vbase + (row * A_FFN + c48 * 8u) * 2u); }
                  if (hb == 0) {
#pragma unroll
                      for (int k = 0; k < 4; ++k) { const unsigned q = tid + 512 * k, i = q >> 4, ch = q & 15; v4u o = (v4u){0u, 0u, 0u, 0u};
                          if ((ch >> 3) <= (i >> 6)) { const GAS f32x4* wp = (const GAS f32x4*)(wsp + (size_t)g * GCH * GCH + i * GCH + ch * 8); const LAS f32x4* rp = (const LAS f32x4*)(RVS + ch * 8); const f32x4 r0v = rp[0], r1v = rp[1];
                              const f32x4 w0 = wp[0] * r0v, w1 = wp[1] * r1v; o.x = pk2(w0.x, w0.y); o.y = pk2(w0.z, w0.w); o.z = pk2(w1.x, w1.y); o.w = pk2(w1.z, w1.w); }
                          *(LAS v4u*)(WI + off_b(i, ch)) = o; } }
#pragma unroll
                  for (int k = 0; k < 6; ++k) { const unsigned q = tid + 512 * (6 * hb + k), row = q / 48u, c48 = q % 48u; *(LAS v4u*)(VI + (c48 >> 4) * 32768u + off_b(row, c48 & 15u)) = vreg[k]; }
                  asm volatile("" ::: "memory"); } }
            __syncthreads();
            f32x4 acc[4][6];
#pragma unroll
            for (int m = 0; m < 4; ++m)
#pragma unroll
                for (int n = 0; n < 6; ++n) acc[m][n] = (f32x4){0.f, 0.f, 0.f, 0.f};
            const int nks = wr ? 4 : 2;
            const unsigned fW = ((L15 & 3u) << 2) | (L15 >> 2);
            const unsigned wbase = 256u * (wr * 64 + L15) + 16u * ((unsigned)G4 ^ (fW & 3u));
            const unsigned tb0 = 256u * (8 * G4 + q_) + 16u * ((unsigned)p_ ^ ((2u * G4) & 3u)), tb1 = 256u * (8 * G4 + 4 + q_) + 16u * ((unsigned)p_ ^ ((2u * G4 + 1u) & 3u));
            unsigned xc[3];
#pragma unroll
            for (int c32 = 0; c32 < 3; ++c32) { const unsigned col32 = wc * 96 + c32 * 32; xc[c32] = (col32 >> 7) * 32768u + 16u * (((col32 & 127u) >> 3) ^ ((unsigned)q_ << 2)); }
#pragma unroll 1
            for (int ks = 0; ks < nks; ++ks) {
                bf16x8 wf[4]; const LAS unsigned char* wp = WI + wbase + 16u * ((4u * ks) ^ (fW & 12u));
#pragma unroll
                for (int m = 0; m < 4; ++m) wf[m] = *(const LAS bf16x8*)(wp + m * 4096);
#pragma unroll
                for (int c32 = 0; c32 < 3; ++c32) { const LAS unsigned char* ib = VI + xc[c32] + 8192u * ks;
#pragma unroll
                    for (int nn = 0; nn < 2; ++nn) {
                        const s16x4 t0 = __builtin_bit_cast(s16x4, __builtin_amdgcn_ds_read_tr16_b64_v4i16((LAS s16x4*)(ib + tb0 + 8 * nn)));
                        const s16x4 t1 = __builtin_bit_cast(s16x4, __builtin_amdgcn_ds_read_tr16_b64_v4i16((LAS s16x4*)(ib + tb1 + 8 * nn)));
                        const bf16x8 vf = (bf16x8){t0[0], t0[1], t0[2], t0[3], t1[0], t1[1], t1[2], t1[3]};
#pragma unroll
                        for (int m = 0; m < 4; ++m) acc[m][2 * c32 + nn] = __builtin_amdgcn_mfma_f32_16x16x32_bf16(vf, wf[m], acc[m][2 * c32 + nn], 0, 0, 0); } }
            }
            f32x4 gvv[3][2];
#pragma unroll
            for (int c32 = 0; c32 < 3; ++c32) { const GAS f32x4* gp = (const GAS f32x4*)(gvn + g * A_GD + wc * 96 + c32 * 32 + 8 * G4); gvv[c32][0] = gp[0]; gvv[c32][1] = gp[1]; }
#pragma unroll
            for (int m = 0; m < 4; ++m) { const int i = wr * 64 + 16 * m + L15; const float bi = bsp[g * GCH + i]; bf16* rowp = BIG + (r0 + i) * A_FFN + g * A_GD + wc * 96 + 8 * G4;
#pragma unroll
                for (int c32 = 0; c32 < 3; ++c32) { const v4u uu = *(const GAS v4u*)(rowp + c32 * 32); const f32x4 a = acc[m][2 * c32] * gvv[c32][0] + bi, b = acc[m][2 * c32 + 1] * gvv[c32][1] + bi; v4u o;
                    o.x = pk2(bflo(uu.x) * a.x, bfhi(uu.x) * a.y); o.y = pk2(bflo(uu.y) * a.z, bfhi(uu.y) * a.w); o.z = pk2(bflo(uu.z) * b.x, bfhi(uu.z) * b.y); o.w = pk2(bflo(uu.w) * b.z, bfhi(uu.w) * b.w);
                    *(GAS v4u*)(rowp + c32 * 32) = o; } }
        }
        if (BOTH(PH_SPATIAL)) GRID_BAR();
    }
    if (IN(PH_GEMM2)) {
        pg8::Gemm g{BIG, WA_OUT, MROWS, DM, A_HALF, A_FFN, 0, nullptr, 0, nullptr, 0}; pg8::StaticOrder S; S.init(MROWS, DM, F.G, (int)blockIdx.x);
        pg8::EpiResBf<true> E{XN, HB, RSQ_H1, DM};
        pg8::gemm_phase<pg8::EpiResBf<true>, pg8::StaticOrder, true, true>(F.lds + RING_OFF, g, S, E);
        if (BOTH(PH_GEMM2)) GRID_BAR();
    }
    if (IN(PH_FFN_UP)) {
        pg8::Gemm g{HB, WF_IN, MROWS, 2 * D_FF, DM, DM, 0, nullptr, 0, nullptr, 0}; pg8::StaticOrder S; S.init(MROWS, 2 * D_FF, F.G, (int)blockIdx.x);
        LAS float* RT = (LAS float*)(F.lds + LDSCTL_OFF + 4096);
        { pg8::Unit uu; __syncthreads();
          for (int i0 = 0; i0 < 12; i0 += 2) { const int i = i0 + (F.tid >> 8); if (!S.next(i, uu)) continue; const int r = F.tid & 255; const GAS f32x4* pp = (const GAS f32x4*)(RSQ_H1 + (size_t)(uu.pm * 256 + r) * 16); float t = 0.f;
#pragma unroll
              for (int k = 0; k < 4; ++k) { const f32x4 p = pp[k]; t += (p[0] + p[1]) + (p[2] + p[3]); }
              RT[i * 256 + r] = 1.0f / sqrtf(t * (1.f / DM) + RMS_EPS); }
          __syncthreads(); }
        pg8::EpiSwiGLU E{BIG, D_FF, RT};
        pg8::gemm_phase<pg8::EpiSwiGLU, pg8::StaticOrder, true, true>(F.lds + RING_OFF, g, S, E);
        if (BOTH(PH_FFN_UP)) GRID_BAR();
    }
    if (IN(PH_FFN_DOWN)) {
        pg8::Gemm g{BIG, WF_OUT, MROWS, DM, D_FF, D_FF, 0, nullptr, 0, nullptr, 0}; pg8::StaticOrder S; S.init(MROWS, DM, F.G, (int)blockIdx.x);
        pg8::EpiResBf<true> E{HB, XN, RSQ_H1, DM};
        pg8::gemm_phase<pg8::EpiResBf<true>, pg8::StaticOrder, true, true>(F.lds + RING_OFF, g, S, E);
        if (BOTH(PH_FFN_DOWN)) GRID_BAR();
    }
    if (IN(PH_KVQ)) {
        LAS float* HG = (LAS float*)(F.lds + LDSCTL_OFF + 1024);
        LAS float* RT = (LAS float*)(F.lds + LDSCTL_OFF + 4096);
        pg8::StaticOrder S; S.init(MROWS, 4 * DM, F.G, (int)blockIdx.x);
        __syncthreads();
        if (F.tid < 64) HG[F.tid] = args.in[I_K_NORM_G][F.tid]; else if (F.tid < 128) HG[F.tid] = args.in[I_Q_NORM_G][F.tid - 64] * attn_body::C2;
        { pg8::Unit uu;
          for (int i0 = 0; i0 < 12; i0 += 2) { const int i = i0 + (F.tid >> 8); if (!S.next(i, uu)) continue; const int r = F.tid & 255; const GAS f32x4* pp = (const GAS f32x4*)(RSQ_H1 + (size_t)(uu.pm * 256 + r) * 16); float t = 0.f;
#pragma unroll
              for (int k = 0; k < 4; ++k) { const f32x4 p = pp[k]; t += (p[0] + p[1]) + (p[2] + p[3]); }
              RT[i * 256 + r] = 1.0f / sqrtf(t * (1.f / DM) + RMS_EPS); } }
        { const int L15 = F.lane & 15, KQ = F.lane >> 4; const size_t row0 = (size_t)F.vcu * 128 + F.wave * 16;
          if (row0 < MROWS) {
              const bf16* ap = XN + (row0 + L15) * DM + 8 * KQ; const bf16* bp = WF16 + (size_t)L15 * DM + 8 * KQ; f32x4 fa = (f32x4){0.f, 0.f, 0.f, 0.f};
#pragma unroll
              for (int jb = 0; jb < 4; ++jb) { bf16x8 af[8], bfr[8];
#pragma unroll
                  for (int j = 0; j < 8; ++j) { af[j] = *(const GAS bf16x8*)(ap + 32 * (8 * jb + j)); bfr[j] = *(const GAS bf16x8*)(bp + 32 * (8 * jb + j)); }
#pragma unroll
                  for (int j = 0; j < 8; ++j) fa = __builtin_amdgcn_mfma_f32_16x16x32_bf16(af[j], bfr[j], fa, 0, 0, 0); }
#pragma unroll
              for (int e = 0; e < 4; ++e) { const size_t row = row0 + 4 * KQ + e; const GAS f32x4* pp = (const GAS f32x4*)(RSQ_H1 + row * 16); float t = 0.f;
#pragma unroll
                  for (int k = 0; k < 4; ++k) { const f32x4 p = pp[k]; t += (p[0] + p[1]) + (p[2] + p[3]); }
                  FG[row * NHEAD + L15] = fa[e] * (1.0f / sqrtf(t * (1.f / DM) + RMS_EPS)); } } }
        __syncthreads();
        { pg8::Gemm g{XN, WKV, MROWS, 4 * DM, DM, DM, 0, nullptr, 0, nullptr, 0};
          pg8::EpiHead4 E{KB, (size_t)MROWS * DM, HG, RMS_EPS, RT};
          pg8::gemm_phase<pg8::EpiHead4, pg8::StaticOrder, true, true>(F.lds + RING_OFF, g, S, E); }
        if (BOTH(PH_KVQ)) GRID_BAR();
    }
    if (IN(PH_ATTN)) {
        __syncthreads();
        for (int bh = F.vcu; bh < BATCH * NHEAD; bh += F.G) attn_body::scan_bias_table((char*)lds + RING_OFF, FG, args.in[I_KV_B_F], bh, (attn_body::u32x4*)(ws + WS_FBT));
        asm volatile("s_waitcnt vmcnt(0)" ::: "memory"); __syncthreads();
        const attn_body::AttnTensors AT{(const attn_body::bf16*)QB, (const attn_body::bf16*)KB, (const attn_body::bf16*)VB, (const attn_body::bf16*)GB, (attn_body::bf16*)QB, (const attn_body::u32x4*)(ws + WS_FBT)};
        const attn_body::StaticOrder AS{F.vcu, F.G}; attn_body::attn_phase<attn_body::StaticOrder>((char*)lds + RING_OFF, AT, AS);
        if (BOTH(PH_ATTN)) GRID_BAR();
    }
    if (IN(PH_OPROJ)) {
        pg8::Gemm g{QB, WBOUT, MROWS, DM, DM, DM, 0, nullptr, 0, nullptr, 0}; pg8::StaticOrder S; S.init(MROWS, DM, F.G, (int)blockIdx.x);
        pg8::EpiResBf<true> E{XN, HB, nullptr, DM};
        pg8::gemm_phase<pg8::EpiResBf<true>, pg8::StaticOrder, true, true>(F.lds + RING_OFF, g, S, E);
        if (BOTH(PH_OPROJ)) GRID_BAR();
    }
    if (IN(PH_ROUTER)) {
        LAS float* Wr = (LAS float*)(F.lds + RING_OFF);
        LAS unsigned* CNTL = (LAS unsigned*)(F.lds + RING_OFF + 65536); LAS unsigned* RREC = CNTL + 64;
        if (F.tid < 16) CNTL[F.tid] = 0u;
        __syncthreads();
        for (int idx = F.tid; idx < DM * NEXP; idx += NWAVES * 64) { const int c = idx & 3, ln = (idx >> 2) & 63, q = (idx >> 8) & 1, kk = idx >> 9, k = 4 * ln + 256 * (kk >> 2) + (kk & 3);
            Wr[idx] = args.in[I_M_W_ROUTER][(size_t)k * NEXP + 4 * q + c]; }
        __syncthreads();
        ROW_LOOP_BEGIN(HB)
            { GAS unsigned* o8 = (GAS unsigned*)((GAS unsigned char*)XN + (size_t)m * DM) + F.lane;
#pragma unroll
              for (int j = 0; j < 4; ++j) { unsigned w = 0u; w = __builtin_amdgcn_cvt_pk_fp8_f32(v[j].x, v[j].y, w, false); w = __builtin_amdgcn_cvt_pk_fp8_f32(v[j].z, v[j].w, w, true); o8[64 * j] = w; } }
            float a[NEXP];
#pragma unroll
            for (int h = 0; h < NEXP; ++h) a[h] = 0.f;
            const GAS f32x4* gr = (const GAS f32x4*)args.in[I_M_NORM_G] + F.lane;
#pragma unroll
            for (int j = 0; j < 4; ++j) { const f32x4 s4 = (v[j] * r) * gr[64 * j];
#pragma unroll
                for (int e = 0; e < 4; ++e) { const float sk = s4[e];
#pragma unroll
                    for (int q = 0; q < 2; ++q) { const f32x4 w = *(const LAS f32x4*)(Wr + (((4 * j + e) * 2 + q) * 64 + F.lane) * 4); a[4 * q] += sk * w.x; a[4 * q + 1] += sk * w.y; a[4 * q + 2] += sk * w.z; a[4 * q + 3] += sk * w.w; } } }
            { const float mine = wave_tr_reduce<8>(a, F.lane);
#pragma unroll
              for (int h = 0; h < NEXP; ++h) a[h] = __shfl(mine, h); }
            int i1 = 0; float v1 = a[0];
#pragma unroll
            for (int h = 1; h < NEXP; ++h) if (a[h] > v1) { v1 = a[h]; i1 = h; }
            int i2 = -1; float v2 = -INFINITY;
#pragma unroll
            for (int h = 0; h < NEXP; ++h) if (h != i1 && a[h] > v2) { v2 = a[h]; i2 = h; }
            const float e2 = expf(v2 - v1), w1 = 1.0f / (1.0f + e2), w2 = e2 / (1.0f + e2);
            if (F.lane == 0) { const int k = (m - gw) / NGW; LAS unsigned* rec = RREC + (F.wave * 16 + k) * 8;
                const unsigned p1 = __hip_atomic_fetch_add(CNTL + i1, 1u, __ATOMIC_RELAXED, __HIP_MEMORY_SCOPE_WORKGROUP), p2 = __hip_atomic_fetch_add(CNTL + i2, 1u, __ATOMIC_RELAXED, __HIP_MEMORY_SCOPE_WORKGROUP);
                rec[0] = (unsigned)i1; rec[1] = p1; rec[2] = __float_as_uint(w1); rec[3] = (unsigned)i2; rec[4] = p2; rec[5] = __float_as_uint(w2); rec[6] = (unsigned)m; rec[7] = __float_as_uint(r); } ROW_LOOP_END
        __syncthreads();
        if (F.tid < NEXP) CNTL[8 + F.tid] = __hip_atomic_fetch_add(F.ctl + CW_CNT + F.tid, CNTL[F.tid], __ATOMIC_RELAXED, __HIP_MEMORY_SCOPE_AGENT);
        __syncthreads();
        if (F.lane < 16) { const int m = gw + F.lane * NGW; if (m < MROWS) { const LAS unsigned* rec = RREC + (F.wave * 16 + F.lane) * 8;
#pragma unroll
            for (int k = 0; k < 2; ++k) { const unsigned e = rec[3 * k], p = CNTL[8 + e] + rec[3 * k + 1]; ELIST[(size_t)e * MROWS + p] = rec[6] * 2u + (unsigned)k; EWL[(size_t)e * MROWS + p] = __uint_as_float(rec[3 * k + 2]); ERS[(size_t)e * MROWS + p] = rec[7]; } } }
        if (BOTH(PH_ROUTER)) GRID_BAR();
    }
    pg8::GroupedOrder GS; int ecnt[NEXP];
    if (hi > PH_ROUTER) { GS.ts[0] = 0;
#pragma unroll
        for (int e = 0; e < NEXP; ++e) { ecnt[e] = (int)__builtin_amdgcn_readfirstlane(__hip_atomic_load(F.ctl + CW_CNT + e, RLX_AGENT)); GS.cnt[e] = ecnt[e]; GS.ts[e + 1] = GS.ts[e] + (ecnt[e] + 255) / 256; } GS.cap = MROWS; }
    const int NT = GS.ts[NEXP];
    if (IN(PH_MOE_UP)) {
        for (int sl = gw * 64 + F.lane; sl < NT * 256; sl += NGW * 64) { const int tile = sl >> 8; const int e = GS.expert(tile);
            int cnt_e = GS.cnt[0], ts_e = 0;
#pragma unroll
            for (int k = 1; k < NEXP; ++k) { cnt_e = (e == k) ? GS.cnt[k] : cnt_e; ts_e = (e == k) ? GS.ts[k] : ts_e; }
            const int p = sl - ts_e * 256;
            IDL[sl] = 2u * (unsigned)sl;
            if (p < cnt_e) { const unsigned ent = ELIST[(size_t)e * MROWS + p]; GW[sl] = EWL[(size_t)e * MROWS + p]; TOKSLOT[ent] = (unsigned)sl; } else GW[sl] = 0.f; }
        pg8::Gemm g{XN, WM_IN, NT * 256, 2 * D_EXP, DM / 2, DM / 2, (size_t)2 * D_EXP * DM, ELIST, 0, ERS, W8_SCALE_E8M0}; GS.init(NT * 256, 2 * D_EXP, F.G, (int)blockIdx.x);
        pg8::EpiSwiGLU8q E{(unsigned char*)ACT, D_EXP};
        pg8::gemm_phase_f8q<pg8::EpiSwiGLU8q, pg8::GroupedOrder>(F.lds + RING_OFF, g, GS, E, (LAS unsigned*)(F.lds + LDSCTL_OFF + 2048));
        if (BOTH(PH_MOE_UP)) GRID_BAR();
    }
    const int DU = NT * 4, DLIM = (DU / F.G) * F.G, DTS = 2, DKP = D_EXP / DTS;
    if (IN(PH_MOE_DOWN)) {
        { pg8::DownMainQ DM_; (pg8::GroupedOrder&)DM_ = GS; DM_.init(NT * 256, DM, F.G, (int)blockIdx.x); DM_.v = F.vcu; DM_.lim = DLIM < DU ? DLIM : DU;
          pg8::Gemm g{ACT, WM_OUT, NT * 256, DM, D_EXP / 2, D_EXP / 2, (size_t)DM * D_EXP, IDL, 0, (const unsigned*)GW, W8_SCALE_E8M0};
          pg8::EpiY8q E{YB, DM, 0};
          pg8::gemm_phase_f8q<pg8::EpiY8q, pg8::DownMainQ>(F.lds + RING_OFF, g, DM_, E, (LAS unsigned*)(F.lds + LDSCTL_OFF + 2048)); }
        if (DU > DLIM) {
            pg8::DownTailQ DT_; (pg8::GroupedOrder&)DT_ = GS; DT_.init(NT * 256, DM, F.G, (int)blockIdx.x); DT_.v = F.vcu; DT_.lim = DLIM; DT_.S = DTS; DT_.ntask = (DU - DLIM) * DTS;
            pg8::Gemm g{ACT, WM_OUT, NT * 256, DM, DKP / 2, D_EXP / 2, (size_t)DM * D_EXP, IDL, D_EXP / 2, (const unsigned*)GW, W8_SCALE_E8M0};
            pg8::EpiY8q E{YP - (size_t)(DLIM / 4) * 256 * DM, DM, (size_t)YP_ROWS * DM};
            pg8::gemm_phase_f8q<pg8::EpiY8q, pg8::DownTailQ>(F.lds + RING_OFF, g, DT_, E, (LAS unsigned*)(F.lds + LDSCTL_OFF + 2048));
        }
        if (BOTH(PH_MOE_DOWN)) GRID_BAR();
    }
    if (IN(PH_COMBINE)) {
        const unsigned tail0 = (unsigned)(DLIM / 4) * 256u;
#define CB_YBASE(sl) ((((DU > DLIM) && (sl) >= tail0) ? YP + (size_t)((sl) - tail0) * DM : YB + (size_t)(sl) * DM))
#define CB_LOAD(hd, yd, mm, sa, sb) do { const GAS v4u* hp_ = (const GAS v4u*)(HB + (size_t)(mm) * DM) + F.lane; const GAS v4u* ya_ = (const GAS v4u*)CB_YBASE(sa) + F.lane; const GAS v4u* yb_ = (const GAS v4u*)CB_YBASE(sb) + F.lane; \
            _Pragma("unroll") for (int j = 0; j < 2; ++j) { hd[j] = hp_[64 * j]; yd[j] = ya_[64 * j]; yd[2 + j] = yb_[64 * j]; } } while (0)
        unsigned sa0 = 0, sa1 = 0, sb0 = 0, sb1 = 0; v4u hn[2]; v4u yn[4];
        if (gw < MROWS) { sa0 = TOKSLOT[2 * gw]; sa1 = TOKSLOT[2 * gw + 1]; if (gw + NGW < MROWS) { sb0 = TOKSLOT[2 * (gw + NGW)]; sb1 = TOKSLOT[2 * (gw + NGW) + 1]; } CB_LOAD(hn, yn, gw, sa0, sa1); }
        for (int m = gw; m < MROWS; m += NGW) {
            f32x4 h[4]; v4u y[4]; const unsigned s0 = sa0, s1 = sa1;
#pragma unroll
            for (int j = 0; j < 2; ++j) { const v4u a = hn[j]; h[2 * j] = (f32x4){bflo(a.x), bfhi(a.x), bflo(a.y), bfhi(a.y)}; h[2 * j + 1] = (f32x4){bflo(a.z), bfhi(a.z), bflo(a.w), bfhi(a.w)}; }
#pragma unroll
            for (int j = 0; j < 4; ++j) y[j] = yn[j];
            sa0 = sb0; sa1 = sb1;
            if (m + 2 * NGW < MROWS) { sb0 = TOKSLOT[2 * (m + 2 * NGW)]; sb1 = TOKSLOT[2 * (m + 2 * NGW) + 1]; }
            if (m + NGW < MROWS) CB_LOAD(hn, yn, m + NGW, sa0, sa1);
#pragma unroll
            for (int k = 0; k < 2; ++k) {
#pragma unroll
                for (int j = 0; j < 2; ++j) { const v4u a = y[2 * k + j];
                    h[2 * j].x += bflo(a.x); h[2 * j].y += bfhi(a.x); h[2 * j].z += bflo(a.y); h[2 * j].w += bfhi(a.y); h[2 * j + 1].x += bflo(a.z); h[2 * j + 1].y += bfhi(a.z); h[2 * j + 1].z += bflo(a.w); h[2 * j + 1].w += bfhi(a.w); }
                const unsigned sl = k ? s1 : s0;
                if ((DU > DLIM) && sl >= tail0) {
                    for (int p = 1; p < DTS; ++p) { const GAS v4u* yp = (const GAS v4u*)(YP + (size_t)(sl - tail0) * DM + (size_t)p * YP_ROWS * DM) + F.lane;
#pragma unroll
                        for (int j = 0; j < 2; ++j) { const v4u a = yp[64 * j];
                            h[2 * j].x += bflo(a.x); h[2 * j].y += bfhi(a.x); h[2 * j].z += bflo(a.y); h[2 * j].w += bfhi(a.y); h[2 * j + 1].x += bflo(a.z); h[2 * j + 1].y += bfhi(a.z); h[2 * j + 1].z += bflo(a.w); h[2 * j + 1].w += bfhi(a.w); } } } }
            GAS f32x4* hp = (GAS f32x4*)(H + (size_t)m * DM) + 2 * F.lane;
#pragma unroll
            for (int j = 0; j < 2; ++j) { hp[128 * j] = h[2 * j]; hp[128 * j + 1] = h[2 * j + 1]; } }
#undef CB_YBASE
#undef CB_LOAD
    }
#undef IN
#undef BOTH
}

extern "C" void kernel_launch(void* const* d_in, const int* in_sizes, int n_in, void* d_out, int out_size, void* d_ws, size_t ws_size, hipStream_t stream) {
    static int grid = 0;
    if (grid == 0) {
        if (n_in != N_IN || in_sizes[0] != MROWS * DM || out_size != MROWS * DM || ws_size < WS_END) { fprintf(stderr, "kernel_launch: unexpected shapes / workspace (n_in %d, in0 %d, out %d, ws %zu < %zu)\n", n_in, n_in > 0 ? in_sizes[0] : -1, out_size, ws_size, (size_t)WS_END); grid = -1; return; }
        int dev = 0, cus = 0, per_cu = 0;
        if (hipGetDevice(&dev) != hipSuccess || hipDeviceGetAttribute(&cus, hipDeviceAttributeMultiprocessorCount, dev) != hipSuccess) { grid = -1; return; }
        if (hipFuncSetAttribute((const void*)yoco_fwd, hipFuncAttributeMaxDynamicSharedMemorySize, LDS_BYTES) != hipSuccess) { fprintf(stderr, "kernel_launch: hipFuncSetAttribute failed\n"); grid = -1; return; }
        if (hipOccupancyMaxActiveBlocksPerMultiprocessor(&per_cu, (const void*)yoco_fwd, NWAVES * 64, LDS_BYTES) != hipSuccess || per_cu < 1) fprintf(stderr, "kernel_launch: occupancy query reports %d\n", per_cu);
        (void)hipGetLastError();
        if (cus != 256) { fprintf(stderr, "kernel_launch: built for a 256-CU device (got %d)\n", cus); grid = -1; return; }
        grid = cus;
    }
    if (grid < 0) return;
    if (hipMemsetAsync((char*)d_ws + WS_CTL, 0, CTL_ZERO_BYTES, stream) != hipSuccess) return;
    Args a{};
    for (int i = 0; i < N_IN; ++i) a.in[i] = (const float*)d_in[i];
    a.out = (float*)d_out; a.ws = (unsigned char*)d_ws;
#if MK_ONE_LAUNCH
    a.ph_lo = 0; a.ph_hi = MK_PH_STOP; a.li = 0;
    hipLaunchKernelGGL(yoco_fwd, dim3(grid), dim3(NWAVES * 64), LDS_BYTES, stream, a);
#else
    for (int p = 0; p < MK_PH_STOP; ++p) { a.ph_lo = p; a.ph_hi = p + 1; a.li = 0; hipLaunchKernelGGL(yoco_fwd, dim3(grid), dim3(NWAVES * 64), LDS_BYTES, stream, a); }
#endif
}
```

```cpp
#include <hip/hip_runtime.h>
#include <hip/hip_bf16.h>
#include <cstdio>
#include <cstdint>
#include <cmath>
namespace pg8 {
#define PG8_LAS __attribute__((address_space(3)))
typedef unsigned short bf16_t;
typedef short bf16x8 __attribute__((ext_vector_type(8)));
typedef float f32x4 __attribute__((ext_vector_type(4)));
typedef unsigned u32x4 __attribute__((ext_vector_type(4)));
constexpr int BM = 256, BK = 64, HALF = 128, HTB = HALF * BK * 2  , STAGE_BYTES = 8 * HTB, NXCD = 8, WGM = 8;

__host__ __device__ __forceinline__ int lds_byte(int r, int c) { const int st = (r >> 4) * 2 + (c >> 5), rr = r & 15, cc = c & 31, ob = rr * 64 + cc * 2; return st * 1024 + (ob ^ (((ob >> 9) & 1) << 5)); }
__host__ __device__ __forceinline__ void stage_rc(int b, int& R, int& C) { const int st = b / 1024, sb = b % 1024, swz = sb ^ (((sb >> 9) & 1) << 5); R = (st >> 1) * 16 + swz / 64; C = (st & 1) * 32 + (swz % 64) / 2; }
__host__ __device__ __forceinline__ int perm32(int rho) { const int n = rho >> 4, i = rho & 15; return 8 * (i >> 2) + 4 * n + (i & 3); }

struct Unit { int pm, pn, kp; };
struct Gemm { const bf16_t* A; const bf16_t* Bt; int M, N, K, lda; size_t bstride; const unsigned* rowlist; int ldb; const unsigned* wlist; int scale_b; };

struct StaticOrder {
    int nM, nN, nwg, G, c;
    __host__ __device__ __forceinline__ void init(int M, int N, int G_, int c_) { nM = M / BM; nN = N / BM; nwg = nM * nN; G = G_; c = c_; }
    __host__ __device__ __forceinline__ bool next(int i, Unit& u) const {
        const long L = (long)i * G + c; if (L >= nwg) return false;
        int wgid = (int)L; { const int q = nwg / NXCD, r = nwg % NXCD, xcd = wgid % NXCD, off = wgid / NXCD; wgid = (xcd < r ? xcd * (q + 1) : r * (q + 1) + (xcd - r) * q) + off; }
        const int nig = WGM * nN, gid = wgid / nig, fm = gid * WGM, gsz = (nM - fm) < WGM ? (nM - fm) : WGM;
        u.pm = fm + ((wgid % nig) % gsz); u.pn = (wgid % nig) / gsz; u.kp = 0; return true;
    }
    __device__ __forceinline__ void a_ready(const Unit&) const {}
    __device__ __forceinline__ void done(const Unit&) const {}
    __device__ __forceinline__ int expert(int) const { return 0; }
    __device__ __forceinline__ size_t kbytes(const Unit&, int) const { return 0; }
    __device__ __forceinline__ int listoff(int) const { return 0; }
    __device__ __forceinline__ int rows(int) const { return 256; }
};
struct GroupedOrder : StaticOrder {
    int ts[9], cnt[8], cap;
    __device__ __forceinline__ int listoff(int pm) const { const int e = expert(pm); int t0 = 0;
#pragma unroll
        for (int k = 1; k < 8; ++k) t0 = (e == k) ? ts[k] : t0;
        return e * cap + (pm - t0) * 256; }
    __device__ __forceinline__ int rows(int pm) const { const int e = expert(pm); int t0 = 0, c = cnt[0];
#pragma unroll
        for (int k = 1; k < 8; ++k) { t0 = (e == k) ? ts[k] : t0; c = (e == k) ? cnt[k] : c; }
        const int r = c - (pm - t0) * 256; return r < 0 ? 0 : (r > 256 ? 256 : r); }
    __device__ __forceinline__ int expert(int pm) const { int e = 0;
#pragma unroll
        for (int k = 1; k < 8; ++k) e += (pm >= ts[k]) ? 1 : 0;
        return e; }
};

__device__ __forceinline__ unsigned cvt_pk_bf16(float lo, float hi) { unsigned r; asm volatile("v_cvt_pk_bf16_f32 %0, %1, %2" : "=v"(r) : "v"(lo), "v"(hi)); return r; }
typedef float f32x2 __attribute__((ext_vector_type(2)));
__device__ __forceinline__ f32x2 gelu_pk(f32x2 v) {
    const f32x2 av = __builtin_elementwise_abs(v), d = av * 0.2316418882f + 1.0f;
    f32x2 t; t.x = __builtin_amdgcn_rcpf(d.x); t.y = __builtin_amdgcn_rcpf(d.y);
    f32x2 q = t * 0.5307027145f + (-0.7265760135f); q = q * t + 0.7107068705f; q = q * t + (-0.142248368f); q = q * t + 0.127414796f; q = q * t;
    const f32x2 s = (v * v) * (-0.72134752044f);
    f32x2 e; e.x = __builtin_amdgcn_exp2f(s.x); e.y = __builtin_amdgcn_exp2f(s.y);
    const f32x2 m = v * (q * e), r = v - m;
    f32x2 o; o.x = v.x < 0.f ? m.x : r.x; o.y = v.y < 0.f ? m.y : r.y; return o;
}
constexpr float GELU_K = 0.84932180f;
__device__ __forceinline__ void gelu_w_pk4(const f32x2 (&w)[4], f32x2 (&o)[4]) {
    constexpr float C[9] = {5.886622071e-01f, -5.522741079e-01f, 4.032063782e-01f, -2.406371087e-01f, 1.149394065e-01f, -4.112898186e-02f, 1.002788637e-02f, -1.450342475e-03f, 9.243155364e-05f};
    f32x2 y[4], p[4], e[4];
#pragma unroll
    for (int i = 0; i < 4; ++i) { y[i].x = __builtin_fabsf(w[i].x); y[i].y = __builtin_fabsf(w[i].y); }
#pragma unroll
    for (int i = 0; i < 4; ++i) p[i] = y[i] * C[8] + C[7];
#pragma unroll
    for (int c = 6; c >= 0; --c)
#pragma unroll
        for (int i = 0; i < 4; ++i) p[i] = p[i] * y[i] + C[c];
#pragma unroll
    for (int i = 0; i < 4; ++i) { const f32x2 s = w[i] * w[i]; e[i].x = __builtin_amdgcn_exp2f(-s.x); e[i].y = __builtin_amdgcn_exp2f(-s.y); }
#pragma unroll
    for (int i = 0; i < 4; ++i) { const f32x2 h = 0.588705011f - p[i] * e[i]; o[i] = w[i] * 0.588705011f + y[i] * h; }
}

template <int ACT  > struct EpiBf16 {
    static constexpr bool PERM = true, AFTER_DRAIN = false; static_assert(ACT == 0 || ACT == 1, "EpiBf16: ACT is 0 (none) or 1 (gelu_pk)");
    bf16_t* O; int ldc; const float* bias; int split_cols; size_t split_stride; float scale0;
    __device__ __forceinline__ void operator()(const f32x4 (&acc)[2][2][4][2], const Unit& u, int wr, int wc, int fr, int fq, int ui = 0, const PG8_LAS unsigned* tab = nullptr) const {
        const int row0 = u.pm * BM + wr * 64 + fr; int colt = u.pn * BM; bf16_t* base = O;
        float sc = 1.f; if (split_cols) { const int t = colt / split_cols; base += (size_t)t * split_stride; colt -= t * split_cols; if (t == 0) sc = scale0; }
        const int col0 = colt + wc * 32 + 8 * fq, bcol0 = u.pn * BM + wc * 32 + 8 * fq;
        f32x4 bv[2][2];
#pragma unroll
        for (int bj = 0; bj < 2; ++bj)
#pragma unroll
            for (int n = 0; n < 2; ++n) bv[bj][n] = bias ? *(const f32x4*)(bias + bcol0 + bj * HALF + 4 * n) : (f32x4){0.f, 0.f, 0.f, 0.f};
#pragma unroll
        for (int ai = 0; ai < 2; ++ai)
#pragma unroll
            for (int m = 0; m < 4; ++m) { bf16_t* rowp = base + (size_t)(row0 + ai * HALF + m * 16) * ldc + col0;
#pragma unroll
                for (int bj = 0; bj < 2; ++bj) { f32x4 v0 = acc[ai][bj][m][0] + bv[bj][0], v1 = acc[ai][bj][m][1] + bv[bj][1];
                    if (ACT == 1) { f32x2 a = gelu_pk((f32x2){v0[0], v0[1]}), b = gelu_pk((f32x2){v0[2], v0[3]}), c = gelu_pk((f32x2){v1[0], v1[1]}), d = gelu_pk((f32x2){v1[2], v1[3]});
                        v0 = (f32x4){a.x, a.y, b.x, b.y}; v1 = (f32x4){c.x, c.y, d.x, d.y}; }
                    v0 = v0 * sc; v1 = v1 * sc; u32x4 w; w.x = cvt_pk_bf16(v0[0], v0[1]); w.y = cvt_pk_bf16(v0[2], v0[3]); w.z = cvt_pk_bf16(v1[0], v1[1]); w.w = cvt_pk_bf16(v1[2], v1[3]);
                    *(u32x4*)(rowp + bj * HALF) = w; } }
    }
};


struct DownMain : GroupedOrder {
    int v, lim;
    __device__ __forceinline__ bool next(int i, Unit& u) const { const int L = i * G + v; if (L >= lim) return false; u.pm = L >> 2; u.pn = L & 3; u.kp = 0; return true; }
};
struct DownTail : GroupedOrder {
    int v, lim, ntask, S;
    __device__ __forceinline__ bool next(int i, Unit& u) const { const int t = i * G + v; if (t >= ntask) return false; const int L = lim + t / S; u.pm = L >> 2; u.pn = L & 3; u.kp = t % S; return true; }
    __device__ __forceinline__ size_t kbytes(const Unit& u, int K) const { return (size_t)u.kp * K * 2; }
};
struct DownMainQ : DownMain { __device__ __forceinline__ int listoff(int pm) const { return pm * 256; } __device__ __forceinline__ int rows(int) const { return 256; } };
struct DownTailQ : DownTail { __device__ __forceinline__ int listoff(int pm) const { return pm * 256; } __device__ __forceinline__ int rows(int) const { return 256; } };
struct DownMain8 : GroupedOrder {
    int v, lim;
    __device__ __forceinline__ bool next(int i, Unit& u) const { const int L = i * G + v; if (L >= lim) return false; u.pm = L >> 3; u.pn = L & 7; u.kp = 0; return true; }
    __device__ __forceinline__ int listoff(int pm) const { return pm * 256; }
    __device__ __forceinline__ int rows(int) const { return 256; }
};
struct DownTail8 : GroupedOrder {
    int v, lim, ntask, S;
    __device__ __forceinline__ bool next(int i, Unit& u) const { const int t = i * G + v; if (t >= ntask) return false; const int L = lim + t / S; u.pm = L >> 3; u.pn = L & 7; u.kp = t % S; return true; }
    __device__ __forceinline__ size_t kbytes(const Unit& u, int K) const { return (size_t)u.kp * K * 2; }
    __device__ __forceinline__ int listoff(int pm) const { return pm * 256; }
    __device__ __forceinline__ int rows(int) const { return 256; }
};
struct EpiF32Res {
    static constexpr bool PERM = false, AFTER_DRAIN = false;
    const float* base; float* out; int ldc; const float* gate; int gstride;
    __device__ __forceinline__ void operator()(const f32x4 (&acc)[2][2][4][2], const Unit& u, int wr, int wc, int fr, int fq, int ui = 0, const PG8_LAS unsigned* tab = nullptr) const {
        const int row0 = u.pm * BM + wr * 64 + fr, col0 = u.pn * BM + wc * 32 + 4 * fq;
#pragma unroll
        for (int ai = 0; ai < 2; ++ai) {
            f32x4 bs[4][2][2];
#pragma unroll
            for (int m = 0; m < 4; ++m) { const size_t off = (size_t)(row0 + ai * HALF + m * 16) * ldc + col0;
#pragma unroll
                for (int bj = 0; bj < 2; ++bj)
#pragma unroll
                    for (int n = 0; n < 2; ++n) bs[m][bj][n] = *(const f32x4*)(base + off + bj * HALF + n * 16); }
#pragma unroll
            for (int m = 0; m < 4; ++m) { const int row = row0 + ai * HALF + m * 16; const size_t off = (size_t)row * ldc + col0;
                const float gs = gate ? gate[(size_t)row * gstride] : 1.0f;
#pragma unroll
                for (int bj = 0; bj < 2; ++bj)
#pragma unroll
                    for (int n = 0; n < 2; ++n) *(f32x4*)(out + off + bj * HALF + n * 16) = bs[m][bj][n] + acc[ai][bj][m][n] * gs; }
            asm volatile("" ::: "memory"); }
    }
};
__device__ __forceinline__ float part16_rstd(const float* part, int row, int fq, float inv_n, float eps) {
    const f32x4 p = *(const f32x4*)(part + (size_t)row * 16 + 4 * fq); float t = (p[0] + p[1]) + (p[2] + p[3]); t += __shfl_xor(t, 16); t += __shfl_xor(t, 32); return 1.0f / sqrtf(t * inv_n + eps); }
template <bool BASE_BF16> struct EpiResBf {
    static constexpr bool PERM = true, AFTER_DRAIN = false;
    const void* base; bf16_t* hb; float* part; int ldc;
    __device__ __forceinline__ void operator()(const f32x4 (&acc)[2][2][4][2], const Unit& u, int wr, int wc, int fr, int fq, int ui = 0, const PG8_LAS unsigned* tab = nullptr) const {
        const int row0 = u.pm * BM + wr * 64 + fr, col0 = u.pn * BM + wc * 32 + 8 * fq;
#pragma unroll
        for (int ai = 0; ai < 2; ++ai) {
            f32x4 bs[4][2][2];
#pragma unroll
            for (int m = 0; m < 4; ++m) { const size_t off = (size_t)(row0 + ai * HALF + m * 16) * ldc + col0;
#pragma unroll
                for (int bj = 0; bj < 2; ++bj) {
                    if (BASE_BF16) { const u32x4 w = *(const u32x4*)((const bf16_t*)base + off + bj * HALF);
                        bs[m][bj][0] = (f32x4){__uint_as_float(w.x << 16), __uint_as_float(w.x & 0xffff0000u), __uint_as_float(w.y << 16), __uint_as_float(w.y & 0xffff0000u)};
                        bs[m][bj][1] = (f32x4){__uint_as_float(w.z << 16), __uint_as_float(w.z & 0xffff0000u), __uint_as_float(w.w << 16), __uint_as_float(w.w & 0xffff0000u)}; }
                    else { bs[m][bj][0] = *(const f32x4*)((const float*)base + off + bj * HALF); bs[m][bj][1] = *(const f32x4*)((const float*)base + off + bj * HALF + 4); } } }
#pragma unroll
            for (int m = 0; m < 4; ++m) { const int row = row0 + ai * HALF + m * 16; const size_t off = (size_t)row * ldc + col0; float ss = 0.f;
#pragma unroll
                for (int bj = 0; bj < 2; ++bj) { const f32x4 o0 = bs[m][bj][0] + acc[ai][bj][m][0], o1 = bs[m][bj][1] + acc[ai][bj][m][1];
                    ss += ((o0[0] * o0[0] + o0[1] * o0[1]) + (o0[2] * o0[2] + o0[3] * o0[3])) + ((o1[0] * o1[0] + o1[1] * o1[1]) + (o1[2] * o1[2] + o1[3] * o1[3]));
                    u32x4 w; w.x = cvt_pk_bf16(o0[0], o0[1]); w.y = cvt_pk_bf16(o0[2], o0[3]); w.z = cvt_pk_bf16(o1[0], o1[1]); w.w = cvt_pk_bf16(o1[2], o1[3]); *(u32x4*)(hb + off + bj * HALF) = w; }
                if (part) { ss += __shfl_xor(ss, 16); ss += __shfl_xor(ss, 32); if (fq == 0) part[(size_t)row * 16 + 4 * u.pn + wc] = ss; } }
            asm volatile("" ::: "memory"); }
    }
};
struct EpiGeluSq {
    static constexpr bool PERM = true, AFTER_DRAIN = false;
    bf16_t* O; int ldc; float* vpart; int pn_sq; const PG8_LAS float* rtab;
    __device__ __forceinline__ void operator()(const f32x4 (&acc)[2][2][4][2], const Unit& u, int wr, int wc, int fr, int fq, int ui = 0, const PG8_LAS unsigned* tab = nullptr) const {
        const int row0 = u.pm * BM + wr * 64 + fr, col0 = u.pn * BM + wc * 32 + 8 * fq; const bool sq = u.pn >= pn_sq;
#pragma unroll
        for (int ai = 0; ai < 2; ++ai)
#pragma unroll
            for (int m = 0; m < 4; ++m) { const int row = row0 + ai * HALF + m * 16; bf16_t* rowp = O + (size_t)row * ldc + col0; f32x2 ss2 = {0.f, 0.f}; const float rr = rtab[ui * 256 + (row - u.pm * BM)] * GELU_K;
#pragma unroll
                for (int bj = 0; bj < 2; ++bj) { const f32x4 v0 = acc[ai][bj][m][0] * rr, v1 = acc[ai][bj][m][1] * rr;
                    const f32x2 wi[4] = {(f32x2){v0[0], v0[1]}, (f32x2){v0[2], v0[3]}, (f32x2){v1[0], v1[1]}, (f32x2){v1[2], v1[3]}}; f32x2 go[4]; gelu_w_pk4(wi, go); const f32x2 a = go[0], b = go[1], c = go[2], d = go[3];
                    if (sq) { ss2 = a * a + ss2; ss2 = b * b + ss2; ss2 = c * c + ss2; ss2 = d * d + ss2; }
                    u32x4 w; w.x = cvt_pk_bf16(a.x, a.y); w.y = cvt_pk_bf16(b.x, b.y); w.z = cvt_pk_bf16(c.x, c.y); w.w = cvt_pk_bf16(d.x, d.y);
                    *(u32x4*)(rowp + bj * HALF) = w; }
                float ss = ss2.x + ss2.y;
                if (sq) { ss += __shfl_xor(ss, 16); ss += __shfl_xor(ss, 32); if (fq == 0) vpart[(size_t)row * 48 + 4 * (u.pn - pn_sq) + wc] = ss; } }
    }
};

struct EpiHead4 {
    static constexpr bool PERM = true, AFTER_DRAIN = false;
    bf16_t* T; size_t tstride; const PG8_LAS float* g; float eps; const PG8_LAS float* rtab;
    __device__ __forceinline__ void operator()(const f32x4 (&acc)[2][2][4][2], const Unit& u, int wr, int wc, int fr, int fq, int ui = 0, const PG8_LAS unsigned* tab = nullptr) const {
        const int row0 = u.pm * BM + wr * 64 + fr, kind = u.pn >> 2; const bool nrm = (kind & 1) == 0; const int col0 = ((u.pn & 3) * 4 + wc) * 64 + 8 * fq;
        bf16_t* base = T + (size_t)kind * tstride;
        f32x4 gg[2][2];
#pragma unroll
        for (int bj = 0; bj < 2; ++bj)
#pragma unroll
            for (int n = 0; n < 2; ++n) gg[bj][n] = *(const PG8_LAS f32x4*)(g + 32 * (kind & 2) + 32 * bj + 8 * fq + 4 * n);
#pragma unroll
        for (int ai = 0; ai < 2; ++ai)
#pragma unroll
            for (int m = 0; m < 4; ++m) { bf16_t* rowp = base + (size_t)(row0 + ai * HALF + m * 16) * 1024 + col0; const float rr = rtab[ui * 256 + ai * HALF + wr * 64 + m * 16 + fr];
                f32x4 v[2][2];
#pragma unroll
                for (int bj = 0; bj < 2; ++bj)
#pragma unroll
                    for (int n = 0; n < 2; ++n) v[bj][n] = acc[ai][bj][m][n] * rr;
                if (nrm) { float ss = 0.f;
#pragma unroll
                    for (int bj = 0; bj < 2; ++bj)
#pragma unroll
                        for (int n = 0; n < 2; ++n) ss += (v[bj][n][0] * v[bj][n][0] + v[bj][n][1] * v[bj][n][1]) + (v[bj][n][2] * v[bj][n][2] + v[bj][n][3] * v[bj][n][3]);
                    ss += __shfl_xor(ss, 16); ss += __shfl_xor(ss, 32);
                    const float rs = 1.0f / sqrtf(ss * (1.0f / 64.0f) + eps);
#pragma unroll
                    for (int bj = 0; bj < 2; ++bj)
#pragma unroll
                        for (int n = 0; n < 2; ++n) v[bj][n] = v[bj][n] * rs * gg[bj][n];
                } else if (kind == 3) {
#pragma unroll
                    for (int bj = 0; bj < 2; ++bj)
#pragma unroll
                        for (int n = 0; n < 2; ++n)
#pragma unroll
                            for (int e = 0; e < 4; ++e) v[bj][n][e] = __builtin_amdgcn_rcpf(1.0f + __builtin_amdgcn_exp2f(-1.4426950408889634f * v[bj][n][e]));
                }
                u32x4 w[2];
#pragma unroll
                for (int bj = 0; bj < 2; ++bj) { w[bj].x = cvt_pk_bf16(v[bj][0][0], v[bj][0][1]); w[bj].y = cvt_pk_bf16(v[bj][0][2], v[bj][0][3]); w[bj].z = cvt_pk_bf16(v[bj][1][0], v[bj][1][1]); w[bj].w = cvt_pk_bf16(v[bj][1][2], v[bj][1][3]); }
                const bool lo = fr < 8; u32x4 y;
#pragma unroll
                for (int e = 0; e < 4; ++e) y[e] = (unsigned)__builtin_amdgcn_update_dpp(0, (int)(lo ? w[1][e] : w[0][e]), 0x128, 0xf, 0xf, false);
                bf16_t* p1 = lo ? rowp : rowp - 8 * 1024 + 32; bf16_t* p2 = lo ? rowp + 8 * 1024 : rowp + 32;
                u32x4 d1, d2;
#pragma unroll
                for (int e = 0; e < 4; ++e) { d1[e] = lo ? w[0][e] : y[e]; d2[e] = lo ? y[e] : w[1][e]; }
                *(u32x4*)p1 = d1; *(u32x4*)p2 = d2; }
    }
};
struct EpiBf16RowScale {
    static constexpr bool PERM = true, AFTER_DRAIN = false;
    bf16_t* O; int ldc; const PG8_LAS float* rs; size_t kstride;
    __device__ __forceinline__ void operator()(const f32x4 (&acc)[2][2][4][2], const Unit& u, int wr, int wc, int fr, int fq, int ui = 0, const PG8_LAS unsigned* tab = nullptr) const {
        const int row0 = u.pm * BM + wr * 64 + fr, col0 = u.pn * BM + wc * 32 + 8 * fq;
#pragma unroll
        for (int ai = 0; ai < 2; ++ai)
#pragma unroll
            for (int m = 0; m < 4; ++m) { const int row = row0 + ai * HALF + m * 16; bf16_t* rowp = O + (size_t)u.kp * kstride + (size_t)row * ldc + col0; const float sc = rs[ui * 256 + (row - u.pm * BM)];
#pragma unroll
                for (int bj = 0; bj < 2; ++bj) { const f32x4 v0 = acc[ai][bj][m][0] * sc, v1 = acc[ai][bj][m][1] * sc;
                    u32x4 w; w.x = cvt_pk_bf16(v0[0], v0[1]); w.y = cvt_pk_bf16(v0[2], v0[3]); w.z = cvt_pk_bf16(v1[0], v1[1]); w.w = cvt_pk_bf16(v1[2], v1[3]);
                    *(u32x4*)(rowp + bj * HALF) = w; } }
    }
};
struct EpiSwiGLU {
    static constexpr bool PERM = true, AFTER_DRAIN = false;
    bf16_t* O; int ldc; const PG8_LAS float* rtab;
    static __device__ __forceinline__ float silu(float x) { return x * __builtin_amdgcn_rcpf(1.0f + __builtin_amdgcn_exp2f(-1.4426950408889634f * x)); }
    __device__ __forceinline__ void operator()(const f32x4 (&acc)[2][2][4][2], const Unit& u, int wr, int wc, int fr, int fq, int ui = 0, const PG8_LAS unsigned* tab = nullptr) const {
        const int row0 = u.pm * BM + wr * 64 + fr, col0 = u.pn * HALF + wc * 32 + 8 * fq;
#pragma unroll
        for (int ai = 0; ai < 2; ++ai)
#pragma unroll
            for (int m = 0; m < 4; ++m) { const int row = row0 + ai * HALF + m * 16; bf16_t* rowp = O + (size_t)row * ldc + col0;
                const float rs = rtab ? rtab[ui * 256 + (row - u.pm * BM)] : __uint_as_float(tab[256 + (row - u.pm * BM)]);
                const f32x4 a0 = acc[ai][0][m][0] * rs, a1 = acc[ai][0][m][1] * rs, b0 = acc[ai][1][m][0] * rs, b1 = acc[ai][1][m][1] * rs;
                const f32x4 t0 = a0 * (-1.4426950408889634f), t1 = a1 * (-1.4426950408889634f); f32x4 d0, d1;
#pragma unroll
                for (int e = 0; e < 4; ++e) { d0[e] = __builtin_amdgcn_exp2f(t0[e]); d1[e] = __builtin_amdgcn_exp2f(t1[e]); }
                d0 = d0 + 1.0f; d1 = d1 + 1.0f;
#pragma unroll
                for (int e = 0; e < 4; ++e) { d0[e] = __builtin_amdgcn_rcpf(d0[e]); d1[e] = __builtin_amdgcn_rcpf(d1[e]); }
                const f32x4 y0 = (a0 * b0) * d0, y1 = (a1 * b1) * d1;
                u32x4 w; w.x = cvt_pk_bf16(y0[0], y0[1]); w.y = cvt_pk_bf16(y0[2], y0[3]); w.z = cvt_pk_bf16(y1[0], y1[1]); w.w = cvt_pk_bf16(y1[2], y1[3]);
                *(u32x4*)rowp = w; }
    }
};
struct EpiSwiGLU8q {
    static constexpr bool PERM = true, AFTER_DRAIN = false;
    unsigned char* O; int ldc;
    __device__ __forceinline__ void operator()(const f32x4 (&acc)[2][2][4][2], const Unit& u, int wr, int wc, int fr, int fq, int ui = 0, const PG8_LAS unsigned* tab = nullptr) const {
        const int col0 = u.pn * HALF + wc * 32 + 8 * fq;
#pragma unroll
        for (int ai = 0; ai < 2; ++ai)
#pragma unroll
            for (int m = 0; m < 4; ++m) { const int r = ai * HALF + wr * 64 + m * 16 + fr; const float rs = __uint_as_float(tab[256 + r]);
                const f32x4 a0 = acc[ai][0][m][0] * rs, a1 = acc[ai][0][m][1] * rs, b0 = acc[ai][1][m][0] * rs, b1 = acc[ai][1][m][1] * rs;
                const f32x4 t0 = a0 * (-1.4426950408889634f), t1 = a1 * (-1.4426950408889634f); f32x4 d0, d1;
#pragma unroll
                for (int e = 0; e < 4; ++e) { d0[e] = __builtin_amdgcn_exp2f(t0[e]); d1[e] = __builtin_amdgcn_exp2f(t1[e]); }
                d0 = d0 + 1.0f; d1 = d1 + 1.0f;
#pragma unroll
                for (int e = 0; e < 4; ++e) { d0[e] = __builtin_amdgcn_rcpf(d0[e]); d1[e] = __builtin_amdgcn_rcpf(d1[e]); }
                const f32x4 y0 = (a0 * b0) * d0, y1 = (a1 * b1) * d1; unsigned w0 = 0u, w1 = 0u;
                w0 = __builtin_amdgcn_cvt_pk_fp8_f32(y0[0], y0[1], w0, false); w0 = __builtin_amdgcn_cvt_pk_fp8_f32(y0[2], y0[3], w0, true);
                w1 = __builtin_amdgcn_cvt_pk_fp8_f32(y1[0], y1[1], w1, false); w1 = __builtin_amdgcn_cvt_pk_fp8_f32(y1[2], y1[3], w1, true);
                uint2 w; w.x = w0; w.y = w1; *(uint2*)(O + (size_t)(u.pm * BM + r) * ldc + col0) = w; }
    }
};
struct EpiY8q {
    static constexpr bool PERM = true, AFTER_DRAIN = false;
    bf16_t* O; int ldc; size_t kstride;
    __device__ __forceinline__ void operator()(const f32x4 (&acc)[2][2][4][2], const Unit& u, int wr, int wc, int fr, int fq, int ui = 0, const PG8_LAS unsigned* tab = nullptr) const {
        const int col0 = u.pn * BM + wc * 32 + 8 * fq;
#pragma unroll
        for (int ai = 0; ai < 2; ++ai)
#pragma unroll
            for (int m = 0; m < 4; ++m) { const int r = ai * HALF + wr * 64 + m * 16 + fr; const float sc = __uint_as_float(tab[256 + r]); bf16_t* rowp = O + (size_t)u.kp * kstride + (size_t)(u.pm * BM + r) * ldc + col0;
#pragma unroll
                for (int bj = 0; bj < 2; ++bj) { const f32x4 v0 = acc[ai][bj][m][0] * sc, v1 = acc[ai][bj][m][1] * sc;
                    u32x4 w; w.x = cvt_pk_bf16(v0[0], v0[1]); w.y = cvt_pk_bf16(v0[2], v0[3]); w.z = cvt_pk_bf16(v1[0], v1[1]); w.w = cvt_pk_bf16(v1[2], v1[3]);
                    *(u32x4*)(rowp + bj * HALF) = w; } }
    }
};
template <class Epi, class Sched, bool ALIGN_EPI = false, bool SP2 = true, bool GATHER = false>
__device__ __forceinline__ void gemm_phase(PG8_LAS unsigned char* lds, const Gemm g, const Sched& S, const Epi& E, PG8_LAS unsigned* tt = nullptr) {
    static_assert(SP2, "only the two-MFMA-blocks-per-barrier-pair loop is kept in this file");
    int tid_ = threadIdx.x; asm volatile("" : "+v"(tid_));
    const int tid = tid_, wid = __builtin_amdgcn_readfirstlane(tid >> 6), lane = tid & 63, wr = wid >> 2, wc = wid & 3, fr = lane & 15, fq = lane >> 4;
    const int K = g.K, nt = K / BK, ldb = g.ldb ? g.ldb : K;
    unsigned c0[2], c1[2], n0[2], n1[2], voffB[2]; int rA[2]; unsigned cbA[2];
    const size_t kstep = (size_t)(BK * 2);
    const size_t hstepA = (size_t)HALF * g.lda * 2, hstep = (size_t)HALF * ldb * 2;
    const size_t tstepA = 2 * hstepA, tstep = 2 * hstep;
#pragma unroll
    for (int i = 0; i < 2; ++i) { int R, C; stage_rc(tid * 16 + i * 8192, R, C); const int Rb = Epi::PERM ? ((R & ~31) + perm32(R & 31)) : R; rA[i] = R; cbA[i] = (unsigned)C * 2u;
        c0[i] = (unsigned)(R * g.lda + C) * 2u; c1[i] = c0[i] + (unsigned)hstepA; n0[i] = c0[i]; n1[i] = c1[i]; voffB[i] = (unsigned)(Rb * ldb + C) * 2u; }
    const unsigned ldsw = (unsigned)wid * 1024u;
    const int aoff = lds_byte(wr * 64 + fr, fq * 8), boff = lds_byte(wc * 32 + fr, fq * 8);
#define PG8_SA(b, h) (((b) * 2 + (h)) * HTB)
#define PG8_SB(b, h) ((4 + (b) * 2 + (h)) * HTB)
#define PG8_STAGE(bufoff, gbase, voff) do { _Pragma("unroll") for (int _i = 0; _i < 2; ++_i) \
        __builtin_amdgcn_global_load_lds((const unsigned*)((const char*)(gbase) + (voff)[_i]), (PG8_LAS unsigned*)(lds + (bufoff) + ldsw + _i * 8192), 16, 0, 0); } while (0)
#define PG8_LDA(dst, b, h) do { _Pragma("unroll") for (int m = 0; m < 4; ++m) _Pragma("unroll") for (int k = 0; k < 2; ++k) dst[m][k] = *(const PG8_LAS bf16x8*)(lds + PG8_SA(b, h) + aoff + m * 2048 + k * 1024); } while (0)
#define PG8_LDB(dst, b, h) do { _Pragma("unroll") for (int n = 0; n < 2; ++n) _Pragma("unroll") for (int k = 0; k < 2; ++k) dst[n][k] = *(const PG8_LAS bf16x8*)(lds + PG8_SB(b, h) + boff + n * 2048 + k * 1024); } while (0)
#define PG8_MMA(ai, bj, At, Bt) do { __builtin_amdgcn_s_setprio(1); _Pragma("unroll") for (int m = 0; m < 4; ++m) _Pragma("unroll") for (int n = 0; n < 2; ++n) _Pragma("unroll") for (int k = 0; k < 2; ++k) \
        acc[ai][bj][m][n] = __builtin_amdgcn_mfma_f32_16x16x32_bf16(Bt[n][k], At[m][k], acc[ai][bj][m][n], 0, 0, 0); __builtin_amdgcn_s_setprio(0); } while (0)
#define PG8_WAIT_V(n) asm volatile("s_waitcnt vmcnt(" #n ")" ::: "memory")
#define PG8_WAIT_L(n) asm volatile("s_waitcnt lgkmcnt(" #n ")" ::: "memory")
#define PG8_BAR __builtin_amdgcn_s_barrier()
#define PG8_SCHED __builtin_amdgcn_sched_barrier(0)
#define PG8_GOFF(o0, o1, tab, nv) do { _Pragma("unroll") for (int _i = 0; _i < 2; ++_i) { const unsigned e0_ = (tab)[rA[_i]], e1_ = (tab)[HALF + rA[_i]]; \
        o0[_i] = ((rA[_i] < (nv)) ? (e0_ >> 1) : 0u) * (unsigned)(g.lda * 2) + cbA[_i]; o1[_i] = ((HALF + rA[_i] < (nv)) ? (e1_ >> 1) : 0u) * (unsigned)(g.lda * 2) + cbA[_i]; } } while (0)
    Unit cur, nxt; int ui = 0;
    if (!S.next(0, cur)) return;
    f32x4 acc[2][2][4][2];
#pragma unroll
    for (int a = 0; a < 2; ++a)
#pragma unroll
        for (int b = 0; b < 2; ++b)
#pragma unroll
            for (int m = 0; m < 4; ++m)
#pragma unroll
                for (int n = 0; n < 2; ++n) acc[a][b][m][n] = (f32x4){0.f, 0.f, 0.f, 0.f};
    bf16x8 At[4][2], B0[2][2], B1[2][2];
    int tbuf = 0, tnext = 1;
    if constexpr (GATHER) {
        { const int lo_ = S.listoff(cur.pm); if (tid < 256) tt[tid] = g.rowlist[lo_ + tid]; else tt[tid] = g.wlist[lo_ + tid - 256]; }
        asm volatile("s_waitcnt vmcnt(0) lgkmcnt(0)" ::: "memory"); PG8_BAR; asm volatile("" ::: "memory");
        PG8_GOFF(c0, c1, tt, S.rows(cur.pm));
    }
    const char* cA = (GATHER ? (const char*)g.A : (const char*)g.A + (size_t)cur.pm * tstepA) + S.kbytes(cur, K); const char* cB = (const char*)g.Bt + (size_t)S.expert(cur.pm) * g.bstride + (size_t)cur.pn * tstep + S.kbytes(cur, K);
    S.a_ready(cur);
    PG8_STAGE(PG8_SB(0, 0), cB, voffB); PG8_STAGE(PG8_SB(0, 1), cB + hstep, voffB); PG8_STAGE(PG8_SA(0, 0), cA, c0); PG8_STAGE(PG8_SA(0, 1), cA, c1);
    if (wr == 1) PG8_BAR;
    PG8_WAIT_V(2); PG8_BAR;
    PG8_STAGE(PG8_SB(1, 0), cB + kstep, voffB); PG8_STAGE(PG8_SA(1, 0), cA + kstep, c0); PG8_STAGE(PG8_SB(1, 1), cB + hstep + kstep, voffB);
    PG8_WAIT_V(6); PG8_BAR;
    for (;;) {
        const bool has_next = S.next(ui + 1, nxt);
        const char* nA = GATHER ? cA : (has_next ? (const char*)g.A + (size_t)nxt.pm * tstepA + S.kbytes(nxt, K) : cA); const char* nB = has_next ? (const char*)g.Bt + (size_t)S.expert(nxt.pm) * g.bstride + (size_t)nxt.pn * tstep + S.kbytes(nxt, K) : cB;
        if constexpr (GATHER) { if (has_next) {
            const unsigned* src_ = (wid < 4 ? g.rowlist : g.wlist) + S.listoff(nxt.pm) + (wid & 3) * 64 + lane;
            __builtin_amdgcn_global_load_lds(src_, (PG8_LAS unsigned*)(tt + tnext * 512 + wid * 64), 4, 0, 0); } }
        for (int t = 0; t < nt; t += 2) {
            const bool last = (t == nt - 2);
            if constexpr (GATHER) { if (last && has_next) PG8_GOFF(n0, n1, tt + tnext * 512, S.rows(nxt.pm)); }
            const char* a1 = cA + (size_t)(t + 1) * kstep;
            const char* a2 = last ? nA : cA + (size_t)(t + 2) * kstep; const char* b2 = last ? nB : cB + (size_t)(t + 2) * kstep;
            const char* a3 = a2 + kstep; const char* b3 = b2 + kstep;
            unsigned x0[2], x1[2];
#pragma unroll
            for (int i = 0; i < 2; ++i) { x0[i] = last ? n0[i] : c0[i]; x1[i] = last ? n1[i] : c1[i]; }
            if (last && has_next) S.a_ready(nxt);
            PG8_LDB(B0, 0, 0); PG8_LDB(B1, 0, 1); PG8_SCHED; PG8_LDA(At, 0, 0); PG8_STAGE(PG8_SA(1, 1), a1, c1);
            PG8_WAIT_V(8); PG8_WAIT_L(0); PG8_BAR; PG8_MMA(0, 0, At, B0); PG8_MMA(0, 1, At, B1); PG8_BAR; PG8_SCHED;
            PG8_LDA(At, 0, 1); PG8_STAGE(PG8_SB(0, 0), b2, voffB); PG8_STAGE(PG8_SB(0, 1), b2 + hstep, voffB); PG8_STAGE(PG8_SA(0, 0), a2, x0);
            PG8_WAIT_V(8); PG8_WAIT_L(0); PG8_BAR; PG8_MMA(1, 0, At, B0); PG8_MMA(1, 1, At, B1); PG8_BAR; PG8_SCHED;
            PG8_LDB(B0, 1, 0); PG8_LDB(B1, 1, 1); PG8_SCHED; PG8_LDA(At, 1, 0); PG8_STAGE(PG8_SA(0, 1), a2, x1);
            PG8_WAIT_V(8); PG8_WAIT_L(0); PG8_BAR; PG8_MMA(0, 0, At, B0); PG8_MMA(0, 1, At, B1); PG8_BAR; PG8_SCHED;
            PG8_LDA(At, 1, 1); PG8_STAGE(PG8_SB(1, 0), b3, voffB); PG8_STAGE(PG8_SB(1, 1), b3 + hstep, voffB); PG8_STAGE(PG8_SA(1, 0), a3, x0);
            PG8_WAIT_V(8); PG8_WAIT_L(0); PG8_BAR; PG8_MMA(1, 0, At, B0); PG8_MMA(1, 1, At, B1); PG8_BAR; PG8_SCHED;
        }
        if constexpr (ALIGN_EPI) { if (wr == 0) PG8_BAR; }
        if constexpr (!Epi::AFTER_DRAIN) { E(acc, cur, wr, wc, fr, fq, ui, GATHER ? tt + tbuf * 512 : nullptr); S.done(cur); }
        if (!has_next) break;
#pragma unroll
        for (int a = 0; a < 2; ++a)
#pragma unroll
            for (int b = 0; b < 2; ++b)
#pragma unroll
                for (int m = 0; m < 4; ++m)
#pragma unroll
                    for (int n = 0; n < 2; ++n) acc[a][b][m][n] = (f32x4){0.f, 0.f, 0.f, 0.f};
        cur = nxt; cA = nA; cB = nB; ++ui; tbuf = tnext; tnext = (tnext == 2) ? 0 : tnext + 1;
        if constexpr (GATHER) {
#pragma unroll
            for (int i = 0; i < 2; ++i) { c0[i] = n0[i]; c1[i] = n1[i]; } }
        if constexpr (ALIGN_EPI) { if (wr == 1) PG8_BAR; }
    }
    PG8_WAIT_V(0);
    if constexpr (!ALIGN_EPI) { if (wr == 0) PG8_BAR; }
    PG8_BAR;
    if constexpr (Epi::AFTER_DRAIN) { E.fused(acc, cur, wr, wc, fr, fq, lds, wid, lane); S.done(cur); }
#undef PG8_SA
#undef PG8_SB
#undef PG8_STAGE
#undef PG8_LDA
#undef PG8_LDB
#undef PG8_MMA
#undef PG8_WAIT_V
#undef PG8_WAIT_L
#undef PG8_BAR
#undef PG8_SCHED
#undef PG8_GOFF
}

template <class Epi, class Sched, bool ALIGN_EPI = true, bool SP2 = true, bool GATHER = true>
__device__ __forceinline__ void gemm_phase_f8q(PG8_LAS unsigned char* lds, const Gemm g, const Sched& S, const Epi& E, PG8_LAS unsigned* tt = nullptr) {
    static_assert(SP2, "only the two-MFMA-blocks-per-barrier-pair loop is kept in this file");
    typedef int v8i_t __attribute__((ext_vector_type(8))); typedef int v4i_t __attribute__((ext_vector_type(4)));
    int tid_ = threadIdx.x; asm volatile("" : "+v"(tid_));
    const int tid = tid_, wid = __builtin_amdgcn_readfirstlane(tid >> 6), lane = tid & 63, wr = wid >> 2, wc = wid & 3, fr = lane & 15, fq = lane >> 4;
    const int K = g.K, nt = K / BK, ldb = g.ldb ? g.ldb : K;
    unsigned c0[2], c1[2], n0[2], n1[2], voffB[2]; int rA[2]; unsigned cbA[2];
    const size_t kstep = (size_t)(BK * 2);
    const size_t hstepA = (size_t)HALF * g.lda * 2, hstep = (size_t)HALF * ldb * 2;
    const size_t tstepA = 2 * hstepA, tstep = 2 * hstep;
#pragma unroll
    for (int i = 0; i < 2; ++i) { const int R = (tid >> 3) + 64 * i, x = R & 15, C = (((tid & 7) ^ (((x >> 1) & 1) | (((x >> 3) & 1) << 2))) * 16); const int Rb = (R & ~31) + perm32(R & 31);
        rA[i] = R; cbA[i] = (unsigned)C; c0[i] = (unsigned)(R * g.lda) * 2u + (unsigned)C; c1[i] = c0[i] + (unsigned)hstepA; n0[i] = c0[i]; n1[i] = c1[i]; voffB[i] = (unsigned)(Rb * ldb) * 2u + (unsigned)C; }
    const unsigned ldsw = (unsigned)wid * 1024u;
    const int fsw = ((fr >> 1) & 1) | (((fr >> 3) & 1) << 2);
    const int aoffL = (wr * 64 + fr) * 128 + (((2 * fq) ^ fsw) * 16), aoffH = (wr * 64 + fr) * 128 + (((2 * fq + 1) ^ fsw) * 16);
    const int boffL = (wc * 32 + fr) * 128 + (((2 * fq) ^ fsw) * 16), boffH = (wc * 32 + fr) * 128 + (((2 * fq + 1) ^ fsw) * 16);
#define PG8_SA(b, h) (((b) * 2 + (h)) * HTB)
#define PG8_SB(b, h) ((4 + (b) * 2 + (h)) * HTB)
#define PG8_STAGE(bufoff, gbase, voff) do { _Pragma("unroll") for (int _i = 0; _i < 2; ++_i) \
        __builtin_amdgcn_global_load_lds((const unsigned*)((const char*)(gbase) + (voff)[_i]), (PG8_LAS unsigned*)(lds + (bufoff) + ldsw + _i * 8192), 16, 0, 0); } while (0)
#define PG8_LDA(dst, b, h) do { _Pragma("unroll") for (int m = 0; m < 4; ++m) { const v4i_t l_ = *(const PG8_LAS v4i_t*)(lds + PG8_SA(b, h) + aoffL + m * 2048), h_ = *(const PG8_LAS v4i_t*)(lds + PG8_SA(b, h) + aoffH + m * 2048); \
        dst[m] = (v8i_t){l_[0], l_[1], l_[2], l_[3], h_[0], h_[1], h_[2], h_[3]}; } } while (0)
#define PG8_LDB(dst, b, h) do { _Pragma("unroll") for (int n = 0; n < 2; ++n) { const v4i_t l_ = *(const PG8_LAS v4i_t*)(lds + PG8_SB(b, h) + boffL + n * 2048), h_ = *(const PG8_LAS v4i_t*)(lds + PG8_SB(b, h) + boffH + n * 2048); \
        dst[n] = (v8i_t){l_[0], l_[1], l_[2], l_[3], h_[0], h_[1], h_[2], h_[3]}; } } while (0)
#define PG8_MMA(ai, bj, At, Bt) do { __builtin_amdgcn_s_setprio(1); _Pragma("unroll") for (int m = 0; m < 4; ++m) _Pragma("unroll") for (int n = 0; n < 2; ++n) \
        asm volatile("v_mfma_scale_f32_16x16x128_f8f6f4 %0, %1, %2, %0, %3, %4 op_sel_hi:[0,0,0]" : "+v"(acc[ai][bj][m][n]) : "v"(Bt[n]), "v"(At[m]), "v"(sclB), "v"(sclA)); __builtin_amdgcn_s_setprio(0); } while (0)
#define PG8_WAIT_V(n) asm volatile("s_waitcnt vmcnt(" #n ")" ::: "memory")
#define PG8_WAIT_L(n) asm volatile("s_waitcnt lgkmcnt(" #n ")" ::: "memory")
#define PG8_BAR __builtin_amdgcn_s_barrier()
#define PG8_SCHED __builtin_amdgcn_sched_barrier(0)
#define PG8_GOFF(o0, o1, tab, nv) do { _Pragma("unroll") for (int _i = 0; _i < 2; ++_i) { const unsigned e0_ = (tab)[rA[_i]], e1_ = (tab)[HALF + rA[_i]]; \
        o0[_i] = ((rA[_i] < (nv)) ? (e0_ >> 1) : 0u) * (unsigned)(g.lda * 2) + cbA[_i]; o1[_i] = ((HALF + rA[_i] < (nv)) ? (e1_ >> 1) : 0u) * (unsigned)(g.lda * 2) + cbA[_i]; } } while (0)
    Unit cur, nxt; int ui = 0;
    if (!S.next(0, cur)) return;
    f32x4 acc[2][2][4][2];
#pragma unroll
    for (int a = 0; a < 2; ++a)
#pragma unroll
        for (int b = 0; b < 2; ++b)
#pragma unroll
            for (int m = 0; m < 4; ++m)
#pragma unroll
                for (int n = 0; n < 2; ++n) acc[a][b][m][n] = (f32x4){0.f, 0.f, 0.f, 0.f};
    const int sclB = g.scale_b, sclA = 0x7f7f7f7f;
    v8i_t At[4], B0[2], B1[2];
    int tbuf = 0, tnext = 1;
    if constexpr (GATHER) {
        { const int lo_ = S.listoff(cur.pm); if (tid < 256) tt[tid] = g.rowlist[lo_ + tid]; else tt[tid] = g.wlist[lo_ + tid - 256]; }
        asm volatile("s_waitcnt vmcnt(0) lgkmcnt(0)" ::: "memory"); PG8_BAR; asm volatile("" ::: "memory");
        PG8_GOFF(c0, c1, tt, S.rows(cur.pm));
    }
    const char* cA = (GATHER ? (const char*)g.A : (const char*)g.A + (size_t)cur.pm * tstepA) + S.kbytes(cur, K); const char* cB = (const char*)g.Bt + (size_t)S.expert(cur.pm) * g.bstride + (size_t)cur.pn * tstep + S.kbytes(cur, K);
    S.a_ready(cur);
    PG8_STAGE(PG8_SB(0, 0), cB, voffB); PG8_STAGE(PG8_SB(0, 1), cB + hstep, voffB); PG8_STAGE(PG8_SA(0, 0), cA, c0); PG8_STAGE(PG8_SA(0, 1), cA, c1);
    if (wr == 1) PG8_BAR;
    PG8_WAIT_V(2); PG8_BAR;
    PG8_STAGE(PG8_SB(1, 0), cB + kstep, voffB); PG8_STAGE(PG8_SA(1, 0), cA + kstep, c0); PG8_STAGE(PG8_SB(1, 1), cB + hstep + kstep, voffB);
    PG8_WAIT_V(6); PG8_BAR;
    for (;;) {
        const bool has_next = S.next(ui + 1, nxt);
        const char* nA = GATHER ? cA : (has_next ? (const char*)g.A + (size_t)nxt.pm * tstepA + S.kbytes(nxt, K) : cA); const char* nB = has_next ? (const char*)g.Bt + (size_t)S.expert(nxt.pm) * g.bstride + (size_t)nxt.pn * tstep + S.kbytes(nxt, K) : cB;
        if constexpr (GATHER) { if (has_next) {
            const unsigned* src_ = (wid < 4 ? g.rowlist : g.wlist) + S.listoff(nxt.pm) + (wid & 3) * 64 + lane;
            __builtin_amdgcn_global_load_lds(src_, (PG8_LAS unsigned*)(tt + tnext * 512 + wid * 64), 4, 0, 0); } }
        for (int t = 0; t < nt; t += 2) {
            const bool last = (t == nt - 2);
            if constexpr (GATHER) { if (last && has_next) PG8_GOFF(n0, n1, tt + tnext * 512, S.rows(nxt.pm)); }
            const char* a1 = cA + (size_t)(t + 1) * kstep;
            const char* a2 = last ? nA : cA + (size_t)(t + 2) * kstep; const char* b2 = last ? nB : cB + (size_t)(t + 2) * kstep;
            const char* a3 = a2 + kstep; const char* b3 = b2 + kstep;
            unsigned x0[2], x1[2];
#pragma unroll
            for (int i = 0; i < 2; ++i) { x0[i] = last ? n0[i] : c0[i]; x1[i] = last ? n1[i] : c1[i]; }
            if (last && has_next) S.a_ready(nxt);
            PG8_LDB(B0, 0, 0); PG8_LDB(B1, 0, 1); PG8_SCHED; PG8_LDA(At, 0, 0); PG8_STAGE(PG8_SA(1, 1), a1, c1);
            PG8_WAIT_V(8); PG8_WAIT_L(0); PG8_BAR; PG8_MMA(0, 0, At, B0); PG8_MMA(0, 1, At, B1); PG8_BAR; PG8_SCHED;
            PG8_LDA(At, 0, 1); PG8_STAGE(PG8_SB(0, 0), b2, voffB); PG8_STAGE(PG8_SB(0, 1), b2 + hstep, voffB); PG8_STAGE(PG8_SA(0, 0), a2, x0);
            PG8_WAIT_V(8); PG8_WAIT_L(0); PG8_BAR; PG8_MMA(1, 0, At, B0); PG8_MMA(1, 1, At, B1); PG8_BAR; PG8_SCHED;
            PG8_LDB(B0, 1, 0); PG8_LDB(B1, 1, 1); PG8_SCHED; PG8_LDA(At, 1, 0); PG8_STAGE(PG8_SA(0, 1), a2, x1);
            PG8_WAIT_V(8); PG8_WAIT_L(0); PG8_BAR; PG8_MMA(0, 0, At, B0); PG8_MMA(0, 1, At, B1); PG8_BAR; PG8_SCHED;
            PG8_LDA(At, 1, 1); PG8_STAGE(PG8_SB(1, 0), b3, voffB); PG8_STAGE(PG8_SB(1, 1), b3 + hstep, voffB); PG8_STAGE(PG8_SA(1, 0), a3, x0);
            PG8_WAIT_V(8); PG8_WAIT_L(0); PG8_BAR; PG8_MMA(1, 0, At, B0); PG8_MMA(1, 1, At, B1); PG8_BAR; PG8_SCHED;
        }
        if constexpr (ALIGN_EPI) { if (wr == 0) PG8_BAR; }
        asm volatile("s_nop 15\n\ts_nop 15" ::: "memory");
        if constexpr (!Epi::AFTER_DRAIN) { E(acc, cur, wr, wc, fr, fq, ui, GATHER ? tt + tbuf * 512 : nullptr); S.done(cur); }
        if (!has_next) break;
#pragma unroll
        for (int a = 0; a < 2; ++a)
#pragma unroll
            for (int b = 0; b < 2; ++b)
#pragma unroll
                for (int m = 0; m < 4; ++m)
#pragma unroll
                    for (int n = 0; n < 2; ++n) acc[a][b][m][n] = (f32x4){0.f, 0.f, 0.f, 0.f};
        cur = nxt; cA = nA; cB = nB; ++ui; tbuf = tnext; tnext = (tnext == 2) ? 0 : tnext + 1;
        if constexpr (GATHER) {
#pragma unroll
            for (int i = 0; i < 2; ++i) { c0[i] = n0[i]; c1[i] = n1[i]; } }
        if constexpr (ALIGN_EPI) { if (wr == 1) PG8_BAR; }
    }
    PG8_WAIT_V(0);
    if constexpr (!ALIGN_EPI) { if (wr == 0) PG8_BAR; }
    PG8_BAR;
    if constexpr (Epi::AFTER_DRAIN) { E.fused(acc, cur, wr, wc, fr, fq, lds, wid, lane); S.done(cur); }
#undef PG8_SA
#undef PG8_SB
#undef PG8_STAGE
#undef PG8_LDA
#undef PG8_LDB
#undef PG8_MMA
#undef PG8_WAIT_V
#undef PG8_WAIT_L
#undef PG8_BAR
#undef PG8_SCHED
#undef PG8_GOFF
}

struct EpiSwiGLU64 {
    unsigned char* O; int ldc;
    __device__ __forceinline__ void operator()(const f32x4 (&acc)[2][4][2], const Unit& u, int wr, int wc, int fr, int fq, const PG8_LAS unsigned* tab) const {
        const int col0 = u.pn * 64 + wc * 16 + 4 * fq;
#pragma unroll
        for (int ai = 0; ai < 2; ++ai)
#pragma unroll
            for (int m = 0; m < 4; ++m) { const int r = ai * HALF + wr * 64 + m * 16 + fr; const float rs = __uint_as_float(tab[256 + r]);
                const f32x4 a = acc[ai][m][0] * rs, b = acc[ai][m][1] * rs; const f32x4 t = a * (-1.4426950408889634f); f32x4 d;
#pragma unroll
                for (int e = 0; e < 4; ++e) d[e] = __builtin_amdgcn_exp2f(t[e]);
                d = d + 1.0f;
#pragma unroll
                for (int e = 0; e < 4; ++e) d[e] = __builtin_amdgcn_rcpf(d[e]);
                const f32x4 y = (a * b) * d; unsigned w = 0u; w = __builtin_amdgcn_cvt_pk_fp8_f32(y[0], y[1], w, false); w = __builtin_amdgcn_cvt_pk_fp8_f32(y[2], y[3], w, true);
                *(unsigned*)(O + (size_t)(u.pm * BM + r) * ldc + col0) = w; }
    }
};
struct EpiY64 {
    bf16_t* O; int ldc; size_t kstride;
    __device__ __forceinline__ void operator()(const f32x4 (&acc)[2][4][2], const Unit& u, int wr, int wc, int fr, int fq, const PG8_LAS unsigned* tab) const {
        const int col0 = u.pn * 128 + wc * 32 + 8 * fq;
#pragma unroll
        for (int ai = 0; ai < 2; ++ai)
#pragma unroll
            for (int m = 0; m < 4; ++m) { const int r = ai * HALF + wr * 64 + m * 16 + fr; const float gw = __uint_as_float(tab[256 + r]);
                const f32x4 a = acc[ai][m][0] * gw, b = acc[ai][m][1] * gw; u32x4 w; w.x = cvt_pk_bf16(a[0], a[1]); w.y = cvt_pk_bf16(a[2], a[3]); w.z = cvt_pk_bf16(b[0], b[1]); w.w = cvt_pk_bf16(b[2], b[3]);
                *(u32x4*)(O + (size_t)u.kp * kstride + (size_t)(u.pm * BM + r) * ldc + col0) = w; }
    }
};
template <class Epi, class Sched>
__device__ __forceinline__ void gemm_phase_f8n128(PG8_LAS unsigned char* lds, const Gemm g, const Sched& S, const Epi& E, PG8_LAS unsigned* tt) {
    typedef int v8i_t __attribute__((ext_vector_type(8))); typedef int v4i_t __attribute__((ext_vector_type(4)));
    int tid_ = threadIdx.x; asm volatile("" : "+v"(tid_));
    const int tid = tid_, wid = __builtin_amdgcn_readfirstlane(tid >> 6), lane = tid & 63, wr = wid >> 2, wc = wid & 3, fr = lane & 15, fq = lane >> 4;
    const int K = g.K, nt = K / BK, ldb = g.ldb ? g.ldb : K;
    unsigned c0[2], c1[2], n0[2], n1[2], voffB[2]; int rA[2]; unsigned cbA[2];
    const size_t kstep = (size_t)(BK * 2), tstepB = (size_t)HALF * ldb * 2;
#pragma unroll
    for (int i = 0; i < 2; ++i) { const int R = (tid >> 3) + 64 * i, x = R & 15, C = (((tid & 7) ^ (((x >> 1) & 1) | (((x >> 3) & 1) << 2))) * 16); const int Rb = (R & ~31) + perm32(R & 31);
        rA[i] = R; cbA[i] = (unsigned)C; c0[i] = c1[i] = n0[i] = n1[i] = 0u; voffB[i] = (unsigned)(Rb * ldb) * 2u + (unsigned)C; }
    const unsigned ldsw = (unsigned)wid * 1024u;
    const int fsw = ((fr >> 1) & 1) | (((fr >> 3) & 1) << 2);
    const int aoffL = (wr * 64 + fr) * 128 + (((2 * fq) ^ fsw) * 16), aoffH = (wr * 64 + fr) * 128 + (((2 * fq + 1) ^ fsw) * 16);
    const int boffL = (wc * 32 + fr) * 128 + (((2 * fq) ^ fsw) * 16), boffH = (wc * 32 + fr) * 128 + (((2 * fq + 1) ^ fsw) * 16);
#define F8_SA(b, h) (((b) * 3 + (h)) * HTB)
#define F8_SB(b) (((b) * 3 + 2) * HTB)
#define F8_STAGE1(bufoff, gbase, voff, i_) __builtin_amdgcn_global_load_lds((const unsigned*)((const char*)(gbase) + (voff)[i_]), (PG8_LAS unsigned*)(lds + (bufoff) + ldsw + (i_) * 8192), 16, 0, 0)
#define F8_STAGE(bufoff, gbase, voff) do { F8_STAGE1(bufoff, gbase, voff, 0); F8_STAGE1(bufoff, gbase, voff, 1); } while (0)
#define F8_LDA1(dst, b, h, m) do { const v4i_t l_ = *(const PG8_LAS v4i_t*)(lds + F8_SA(b, h) + aoffL + (m) * 2048), h_ = *(const PG8_LAS v4i_t*)(lds + F8_SA(b, h) + aoffH + (m) * 2048); \
        dst[m] = (v8i_t){l_[0], l_[1], l_[2], l_[3], h_[0], h_[1], h_[2], h_[3]}; } while (0)
#define F8_LDB1(dst, b, n) do { const v4i_t l_ = *(const PG8_LAS v4i_t*)(lds + F8_SB(b) + boffL + (n) * 2048), h_ = *(const PG8_LAS v4i_t*)(lds + F8_SB(b) + boffH + (n) * 2048); \
        dst[n] = (v8i_t){l_[0], l_[1], l_[2], l_[3], h_[0], h_[1], h_[2], h_[3]}; } while (0)
#define F8_LDA(dst, b, h) do { F8_LDA1(dst, b, h, 0); F8_LDA1(dst, b, h, 1); F8_LDA1(dst, b, h, 2); F8_LDA1(dst, b, h, 3); } while (0)
#define F8_LDB(dst, b) do { F8_LDB1(dst, b, 0); F8_LDB1(dst, b, 1); } while (0)
#define F8_MMA1(ai, m, At, Bf) do { _Pragma("unroll") for (int n = 0; n < 2; ++n) \
        acc[ai][m][n] = __builtin_amdgcn_mfma_scale_f32_16x16x128_f8f6f4(Bf[n], At[m], acc[ai][m][n], 0, 0, 0, g.scale_b, 0, 0x7f7f7f7f); } while (0)
#define F8_WAIT_V(n) asm volatile("s_waitcnt vmcnt(" #n ")" ::: "memory")
#define F8_WAIT_L(n) asm volatile("s_waitcnt lgkmcnt(" #n ")" ::: "memory")
#define F8_BAR __builtin_amdgcn_s_barrier()
#define F8_SCHED __builtin_amdgcn_sched_barrier(0)
#define F8_GOFF(o0, o1, tab, nv) do { _Pragma("unroll") for (int _i = 0; _i < 2; ++_i) { const unsigned e0_ = (tab)[rA[_i]], e1_ = (tab)[HALF + rA[_i]]; \
        o0[_i] = ((rA[_i] < (nv)) ? (e0_ >> 1) : 0u) * (unsigned)(g.lda * 2) + cbA[_i]; o1[_i] = ((HALF + rA[_i] < (nv)) ? (e1_ >> 1) : 0u) * (unsigned)(g.lda * 2) + cbA[_i]; } } while (0)
    Unit cur, nxt; int ui = 0;
    if (!S.next(0, cur)) return;
    f32x4 acc[2][4][2];
#pragma unroll
    for (int a = 0; a < 2; ++a)
#pragma unroll
        for (int m = 0; m < 4; ++m)
#pragma unroll
            for (int n = 0; n < 2; ++n) acc[a][m][n] = (f32x4){0.f, 0.f, 0.f, 0.f};
    v8i_t AtA[4], AtB[4], BfA[2], BfB[2];
    int tbuf = 0, tnext = 1;
    { const int lo_ = S.listoff(cur.pm); if (tid < 256) tt[tid] = g.rowlist[lo_ + tid]; else tt[tid] = g.wlist[lo_ + tid - 256]; }
    asm volatile("s_waitcnt vmcnt(0) lgkmcnt(0)" ::: "memory"); F8_BAR; asm volatile("" ::: "memory");
    F8_GOFF(c0, c1, tt, S.rows(cur.pm));
    const char* cA = (const char*)g.A + S.kbytes(cur, K); const char* cB = (const char*)g.Bt + (size_t)S.expert(cur.pm) * g.bstride + (size_t)cur.pn * tstepB + S.kbytes(cur, K);
    F8_STAGE(F8_SB(0), cB, voffB); F8_STAGE(F8_SA(0, 0), cA, c0); F8_STAGE(F8_SA(0, 1), cA, c1);
    F8_STAGE(F8_SB(1), cB + kstep, voffB); F8_STAGE(F8_SA(1, 0), cA + kstep, c0); F8_STAGE(F8_SA(1, 1), cA + kstep, c1);
    F8_WAIT_V(8); F8_BAR;
    F8_LDB(BfA, 0); F8_LDA(AtA, 0, 0);
    for (;;) {
        const bool has_next = S.next(ui + 1, nxt);
        const char* nA = has_next ? (const char*)g.A + S.kbytes(nxt, K) : cA; const char* nB = has_next ? (const char*)g.Bt + (size_t)S.expert(nxt.pm) * g.bstride + (size_t)nxt.pn * tstepB + S.kbytes(nxt, K) : cB;
        if (has_next) { const unsigned* src_ = (wid < 4 ? g.rowlist : g.wlist) + S.listoff(nxt.pm) + (wid & 3) * 64 + lane;
            __builtin_amdgcn_global_load_lds(src_, (PG8_LAS unsigned*)(tt + tnext * 512 + wid * 64), 4, 0, 0); }
#pragma unroll 1
        for (int t = 0; t < nt; t += 2) {
            const bool last = (t == nt - 2);
            if (last && has_next) F8_GOFF(n0, n1, tt + tnext * 512, S.rows(nxt.pm));
            const char* a2 = last ? nA : cA + (size_t)(t + 2) * kstep; const char* b2 = last ? nB : cB + (size_t)(t + 2) * kstep;
            const char* a3 = a2 + kstep; const char* b3 = b2 + kstep;
            unsigned x0[2], x1[2];
#pragma unroll
            for (int i = 0; i < 2; ++i) { x0[i] = (last && has_next) ? n0[i] : c0[i]; x1[i] = (last && has_next) ? n1[i] : c1[i]; }
#define F8_TOP F8_WAIT_V(6); F8_WAIT_L(0); F8_BAR; F8_SCHED
#define F8_SP1(b, Bf, bp, ap, xo) F8_TOP; \
            F8_MMA1(0, 0, AtA, Bf); F8_SCHED; F8_STAGE1(F8_SB(b), bp, voffB, 0); F8_LDA1(AtB, b, 1, 0); F8_SCHED; F8_MMA1(0, 1, AtA, Bf); F8_SCHED; F8_STAGE1(F8_SB(b), bp, voffB, 1); F8_LDA1(AtB, b, 1, 1); F8_SCHED; \
            F8_MMA1(0, 2, AtA, Bf); F8_SCHED; F8_STAGE1(F8_SA(b, 0), ap, xo, 0); F8_LDA1(AtB, b, 1, 2); F8_SCHED; F8_MMA1(0, 3, AtA, Bf); F8_SCHED; F8_STAGE1(F8_SA(b, 0), ap, xo, 1); F8_LDA1(AtB, b, 1, 3); F8_SCHED
#define F8_SP2(b, Bf, Bn, ap, xo) F8_TOP; \
            F8_MMA1(1, 0, AtB, Bf); F8_SCHED; F8_STAGE1(F8_SA(b, 1), ap, xo, 0); F8_LDB1(Bn, (b) ^ 1, 0); F8_LDA1(AtA, (b) ^ 1, 0, 0); F8_SCHED; F8_MMA1(1, 1, AtB, Bf); F8_SCHED; F8_STAGE1(F8_SA(b, 1), ap, xo, 1); F8_LDB1(Bn, (b) ^ 1, 1); F8_LDA1(AtA, (b) ^ 1, 0, 1); F8_SCHED; \
            F8_MMA1(1, 2, AtB, Bf); F8_SCHED; F8_LDA1(AtA, (b) ^ 1, 0, 2); F8_SCHED; F8_MMA1(1, 3, AtB, Bf); F8_SCHED; F8_LDA1(AtA, (b) ^ 1, 0, 3); F8_SCHED
            F8_SP1(0, BfA, b2, a2, x0); F8_SP2(0, BfA, BfB, a2, x1);
            F8_SP1(1, BfB, b3, a3, x0); F8_SP2(1, BfB, BfA, a3, x1);
#undef F8_TOP
#undef F8_SP1
#undef F8_SP2
        }
        F8_WAIT_L(0);
        E(acc, cur, wr, wc, fr, fq, tt + tbuf * 512);
        if (!has_next) break;
#pragma unroll
        for (int a = 0; a < 2; ++a)
#pragma unroll
            for (int m = 0; m < 4; ++m)
#pragma unroll
                for (int n = 0; n < 2; ++n) acc[a][m][n] = (f32x4){0.f, 0.f, 0.f, 0.f};
        cur = nxt; cA = nA; cB = nB; ++ui; tbuf = tnext; tnext = (tnext == 2) ? 0 : tnext + 1;
#pragma unroll
        for (int i = 0; i < 2; ++i) { c0[i] = n0[i]; c1[i] = n1[i]; }
    }
    F8_WAIT_V(0);
    F8_BAR;
#undef F8_SA
#undef F8_SB
#undef F8_STAGE1
#undef F8_STAGE
#undef F8_LDA1
#undef F8_LDB1
#undef F8_LDA
#undef F8_LDB
#undef F8_MMA1
#undef F8_WAIT_V
#undef F8_WAIT_L
#undef F8_BAR
#undef F8_SCHED
#undef F8_GOFF
}
}
namespace attn_body {
using bf16=__hip_bfloat16;
using bf16x8=__attribute__((ext_vector_type(8)))short;
using s16x4=__attribute__((ext_vector_type(4)))short;
using f32x16=__attribute__((ext_vector_type(16)))float;
using u32x4=__attribute__((ext_vector_type(4)))unsigned;
using f32x4v=__attribute__((ext_vector_type(4)))float;
constexpr int BATCH=16,NHEAD=16,SEQ=2048,D=64,DM=NHEAD*D;
constexpr int NW=8,QBLK=32,QB=QBLK*NW,KVBLK=64,NQB=SEQ/QB;
constexpr int ATTN_PITCH=DM, ATTN_UNIT_ROWS=QB;
__device__ __forceinline__ int crow(int r,int hi){return (r&3)+8*(r>>2)+4*hi;}
#define SBAR() __builtin_amdgcn_sched_barrier(0)
__device__ __forceinline__ void cmask(f32x16&p0,f32x16&p1,int jb,int qrel,int hi){
  const float NEG=-INFINITY; int kb=64*jb+4*hi;
  #pragma unroll
  for(int r=0;r<16;++r){int kv=kb+(r&3)+8*(r>>2); if(kv>qrel)p0[r]=NEG; if(kv+32>qrel)p1[r]=NEG;}
}

constexpr int NSLOT=3, SLOTB=8192;
constexpr int LDS_K=0, LDS_V=NSLOT*SLOTB, LDS_WS=2*NSLOT*SLOTB, LDS_OST=LDS_WS+NW*64*4, LDS_FB=LDS_OST+NW*4096, LDS_BYTES=LDS_FB+SEQ*16;
constexpr float C2=0.125f*1.4426950408889634f;
__device__ __forceinline__ void glds16(const void*gsrc,unsigned lds_dst){unsigned keep;
  asm volatile("s_mov_b32 %0, m0\n\ts_mov_b32 m0, %2\n\ts_nop 0\n\tglobal_load_lds_dwordx4 %1, off\n\ts_mov_b32 m0, %0":"=&s"(keep):"v"(gsrc),"s"(lds_dst):"memory");}
__device__ __forceinline__ float max3f(float a,float b,float c){float r;asm("v_max3_f32 %0, %1, %2, %3":"=v"(r):"v"(a),"v"(b),"v"(c));return r;}
__device__ __forceinline__ float max2f(float a,float b){float r;asm("v_max_f32_e32 %0, %1, %2":"=v"(r):"v"(a),"v"(b));return r;}
__device__ __forceinline__ float fadd_s(float a,float b){float r;asm("v_add_f32_e32 %0, %1, %2":"=v"(r):"v"(a),"v"(b));return r;}
__device__ __forceinline__ float fsub_s(float a,float b){float r;asm("v_sub_f32_e32 %0, %1, %2":"=v"(r):"v"(a),"v"(b));return r;}
typedef float f32x2_t __attribute__((ext_vector_type(2))); typedef __bf16 bf16x2_t __attribute__((ext_vector_type(2)));
__device__ __forceinline__ unsigned cvtpk_s(float lo,float hi){f32x2_t v={lo,hi};bf16x2_t b=__builtin_convertvector(v,bf16x2_t);return __builtin_bit_cast(unsigned,b);}
#define WAIT_BAR(N) asm volatile("s_waitcnt vmcnt(" #N ") lgkmcnt(0)\n\ts_barrier":::"memory")

__device__ __forceinline__ bf16x8 mk_qbias(float mhat,int hi){
  const float x=-mhat; const unsigned h=cvtpk_s(x,0.f)&0xffffu; const float r1=x-__uint_as_float(h<<16); const unsigned m=cvtpk_s(r1,0.f)&0xffffu; const float r2=r1-__uint_as_float(m<<16); const unsigned l=cvtpk_s(r2,0.f)&0xffffu;
  u32x4 w; w[0]=0x3F803F80u; w[1]=0x3F80u|(h<<16); w[2]=m|(l<<16); w[3]=0u; if(hi){w[0]=0u;w[1]=0u;w[2]=0u;} return __builtin_bit_cast(bf16x8,w);
}
__device__ __forceinline__ void qkt(f32x16&p0,f32x16&p1,const char*Kslot,const bf16x8*qr,bf16x8 fk0,bf16x8 fk1,bf16x8 qbias,int r32,int hi){
  const char*kb=Kslot+hi*1024+r32*16;
  p0=__builtin_amdgcn_mfma_f32_32x32x16_bf16(fk0,qbias,f32x16{},0,0,0);p1=__builtin_amdgcn_mfma_f32_32x32x16_bf16(fk1,qbias,f32x16{},0,0,0);
  #pragma unroll
  for(int d0=0;d0<4;++d0){
    const bf16x8 b0=*reinterpret_cast<const bf16x8*>(kb+d0*2048);
    const bf16x8 b1=*reinterpret_cast<const bf16x8*>(kb+d0*2048+512);
    p0=__builtin_amdgcn_mfma_f32_32x32x16_bf16(b0,qr[d0],p0,0,0,0);p1=__builtin_amdgcn_mfma_f32_32x32x16_bf16(b1,qr[d0],p1,0,0,0);}
}
typedef __attribute__((address_space(3))) const char* lds_cptr;
typedef short v4i16_t __attribute__((ext_vector_type(4)));
__device__ __forceinline__ void kload8(bf16x8*kf,lds_cptr kp){
  kf[0]=*(const __attribute__((address_space(3))) bf16x8*)(kp);      kf[1]=*(const __attribute__((address_space(3))) bf16x8*)(kp+512);
  kf[2]=*(const __attribute__((address_space(3))) bf16x8*)(kp+2048); kf[3]=*(const __attribute__((address_space(3))) bf16x8*)(kp+2560);
  kf[4]=*(const __attribute__((address_space(3))) bf16x8*)(kp+4096); kf[5]=*(const __attribute__((address_space(3))) bf16x8*)(kp+4608);
  kf[6]=*(const __attribute__((address_space(3))) bf16x8*)(kp+6144); kf[7]=*(const __attribute__((address_space(3))) bf16x8*)(kp+6656);
}
__device__ __forceinline__ void kload2(bf16x8*kf,lds_cptr kp,int j){ kf[2*j]=*(const __attribute__((address_space(3))) bf16x8*)(kp+j*2048); kf[2*j+1]=*(const __attribute__((address_space(3))) bf16x8*)(kp+j*2048+512); }
__device__ __forceinline__ s16x4 vtr(lds_cptr p){ return __builtin_bit_cast(s16x4,__builtin_amdgcn_ds_read_tr16_b64_v4i16((__attribute__((address_space(3))) v4i16_t*)p)); }
__device__ __forceinline__ float rowmax(const f32x16&p0,const f32x16&p1){
  float a=max3f(p0[0],p0[1],p1[0]),b=max3f(p0[2],p0[3],p1[1]);a=max3f(a,p1[2],p1[3]);
  #pragma unroll
  for(int r=4;r<16;r+=4){a=max3f(a,p0[r],p0[r+1]);b=max3f(b,p0[r+2],p0[r+3]);a=max3f(a,p1[r],p1[r+1]);b=max3f(b,p1[r+2],p1[r+3]);}
  const float m=max2f(a,b);
  auto rr=__builtin_amdgcn_permlane32_swap(__float_as_uint(m),__float_as_uint(m),false,false);
  return max2f(__uint_as_float(rr[0]),__uint_as_float(rr[1]));
}
__device__ __forceinline__ void pv(f32x16*o,int vb,bf16x8 pa0,bf16x8 pa1,bf16x8 pa2,bf16x8 pa3){
  #pragma unroll
  for(int d0=0;d0<2;++d0){s16x4 lo[4],hi[4];
    #pragma unroll
    for(int ks=0;ks<4;++ks){
      asm volatile("ds_read_b64_tr_b16 %0,%1 offset:%c2":"=&v"(lo[ks]):"v"(vb),"i"(d0*4096+ks*1024):"memory");
      asm volatile("ds_read_b64_tr_b16 %0,%1 offset:%c2":"=&v"(hi[ks]):"v"(vb),"i"(d0*4096+ks*1024+512):"memory");}
    asm volatile("s_waitcnt lgkmcnt(0)":::"memory");SBAR();
    #define PK(k) (bf16x8){lo[k][0],lo[k][1],lo[k][2],lo[k][3],hi[k][0],hi[k][1],hi[k][2],hi[k][3]}
    o[d0]=__builtin_amdgcn_mfma_f32_32x32x16_bf16(pa0,PK(0),o[d0],0,0,0);
    o[d0]=__builtin_amdgcn_mfma_f32_32x32x16_bf16(pa1,PK(1),o[d0],0,0,0);
    o[d0]=__builtin_amdgcn_mfma_f32_32x32x16_bf16(pa2,PK(2),o[d0],0,0,0);
    o[d0]=__builtin_amdgcn_mfma_f32_32x32x16_bf16(pa3,PK(3),o[d0],0,0,0);
    #undef PK
  }
}

#ifndef ATTN_STORE16
#define ATTN_STORE16(p,v) (*(u32x4*)(p)=(v))
#endif
template<int THRL> __device__ __forceinline__ void attn_unit(int b,int h,int qb,const bf16*Q,const bf16*__restrict__ K,const bf16*__restrict__ V,const bf16*__restrict__ G,bf16*O,char*shm){
  int tid_=threadIdx.x; asm volatile("":"+v"(tid_)); const int tid=tid_,lane=tid&63,r32=lane&31,hi=lane>>5; const int wid=__builtin_amdgcn_readfirstlane(tid>>6);
  const long rowbase=(long)b*SEQ; const int q0=qb*QB;
  const bf16*Qw=Q+(rowbase+q0+wid*QBLK)*DM+h*D;
  const bf16*Kh=K+rowbase*DM+h*D,*Vh=V+rowbase*DM+h*D;
  const unsigned lds0=(unsigned)(uintptr_t)shm;
  float*wsf=(float*)(shm+LDS_WS)+wid*64;
  const bf16*ksrc=Kh+(long)lane*DM+wid*8;
  const bf16*vsrc=Vh+(long)(16*(wid&3)+(lane>>2))*DM+(wid>>2)*32+(lane&3)*8;
  const unsigned kdst=lds0+LDS_K+wid*1024, vdst=lds0+LDS_V+wid*1024;
  #define DMA_K(t,slot) glds16(ksrc+(long)(t)*KVBLK*DM,(unsigned)__builtin_amdgcn_readfirstlane(kdst+(slot)))
  #define DMA_V(t,slot) glds16(vsrc+(long)(t)*KVBLK*DM,(unsigned)__builtin_amdgcn_readfirstlane(vdst+(slot)))
  const int vb0=(int)(lds0+LDS_V)+((lane>>4)&1)*32+(lane&3)*8+(4*hi+((lane&15)>>2))*64;
  const char*Kbase=shm+LDS_K; bf16x8 kf[8];
  const lds_cptr shm3=(lds_cptr)shm; const lds_cptr kp0=shm3+LDS_K+hi*1024+r32*16; const lds_cptr vp0=shm3+LDS_V+((lane>>4)&1)*32+(lane&3)*8+(4*hi+((lane&15)>>2))*64;
  const int NT=(q0+QB)/KVBLK;
  DMA_K(0,0);DMA_V(0,0);DMA_K(1,SLOTB);
  bf16x8 qr[4];
  #pragma unroll
  for(int d0=0;d0<4;++d0)qr[d0]=*reinterpret_cast<const bf16x8*>(&Qw[(long)r32*DM+d0*16+hi*8]);
  float mhat; { const u32x4 eq=*(const __attribute__((address_space(3))) u32x4*)(shm3+LDS_FB+(q0+wid*QBLK+r32)*16); mhat=__uint_as_float(eq[0]<<16)+__uint_as_float(eq[0]&0xffff0000u)+__uint_as_float(eq[1]<<16); }
  float l_reg=0.f;f32x16 o[2];o[0]=f32x16{};o[1]=f32x16{};bf16x8 qbias=mk_qbias(mhat,hi);asm volatile("":"+v"(qbias));
  const int qrel=wid*QBLK+r32;
  #define CMASK(P0,P1,t) do{int jb_=(t)-(NT-4); if(jb_>=0)cmask(P0,P1,jb_,qrel,hi);}while(0)
  const lds_cptr fbt=shm3+LDS_FB+r32*16;
  #define FKLD(t,blk) (*(const __attribute__((address_space(3))) bf16x8*)(fbt+((t)*64+(blk)*32)*16))
  bool resc=false;
  #define START(P0,P1) do{ const float rm=rowmax(P0,P1); resc=false; \
    { const float dl=rm; mhat=fadd_s(mhat,dl); \
      _Pragma("unroll") for(int r=0;r<16;++r){P0[r]=fsub_s(P0[r],dl);P1[r]=fsub_s(P1[r],dl);} \
      qbias=mk_qbias(mhat,hi); asm volatile("":"+v"(qbias)); } \
    _Pragma("unroll") for(int r=0;r<16;++r)P0[r]=__builtin_amdgcn_exp2f(P0[r]); }while(0)
  #define RESC() do{ if(resc){ asm volatile("s_waitcnt lgkmcnt(0)":::"memory"); \
      _Pragma("unroll") for(int d_=0;d_<2;++d_) _Pragma("unroll") for(int r=0;r<16;++r)o[d_][r]*=wsf[crow(r,hi)]; } }while(0)
  f32x16 pA0,pA1,pB0,pB1;
  int sl_prev=0,sl_cur=0,sl_next=SLOTB;
  #define ROT() do{sl_prev=sl_cur;sl_cur=sl_next;sl_next=(sl_next==(NSLOT-1)*SLOTB)?0:sl_next+SLOTB;}while(0)
  DMA_K(2,2*SLOTB);
  WAIT_BAR(3);
  qkt(pA0,pA1,Kbase,qr,FKLD(0,0),FKLD(0,1),qbias,r32,hi);asm volatile("s_nop 15\n\ts_nop 7":"+v"(pA0),"+v"(pA1));CMASK(pA0,pA1,0);
  START(pA0,pA1);
  _Pragma("unroll") for(int r=0;r<16;++r)pA1[r]=__builtin_amdgcn_exp2f(pA1[r]);
  WAIT_BAR(0);
  DMA_K(3,0);DMA_V(1,SLOTB);
  ROT();
  kload8(kf,kp0+sl_cur);
  WAIT_BAR(2);
  s16x4 vlo[8],vhi[8]; u32x4 pw0,pw1,pw2,pw3;
  #define PKW(P,B) cvtpk_s(P[B],P[B+1])
  #define PAF(k) __builtin_bit_cast(bf16x8,pw##k)
  #define VFR(i) (bf16x8){vlo[i][0],vlo[i][1],vlo[i][2],vlo[i][3],vhi[i][0],vhi[i][1],vhi[i][2],vhi[i][3]}
  #define PIN(x) asm volatile("":"+v"(x))
  #define MX3(a,b,c) __builtin_fmaxf(__builtin_fmaxf((a),(b)),(c))
  #define GAPA(MF,A0,A1,A2,A3,W0,W1,PW) do{ MF; sacc+=A0; sacc+=A1; sacc+=A2; sacc+=A3; PIN(sacc); W0; W1; PIN(PW); SBAR(); }while(0)
  #define EX(v) __builtin_amdgcn_exp2f(v)
  #define GAPB(MF,X,B) do{ MF; X[B]=EX(X[B]); X[B+1]=EX(X[B+1]); X[B+2]=EX(X[B+2]); X[B+3]=EX(X[B+3]); PIN(X); SBAR(); }while(0)
  #define VRD(i) do{ vlo[i]=vtr(vp_+(((i)>>2)*4096+((i)&3)*1024)); vhi[i]=vtr(vp_+(((i)>>2)*4096+((i)&3)*1024+512)); }while(0)
  #define KRD(G,j) do{ if(G){ kload2(kf,kp0+sl_next,j); SBAR(); } }while(0)
  #define STEP(C0,C1,P0,P1,t,GK,GV,GL) do{ SBAR(); \
    const lds_cptr vp_=vp0+sl_prev; const bf16x8 fk0_=FKLD(t,0), fk1_=FKLD(t,1); \
    VRD(0); SBAR(); float sacc=(P0[0]+P0[1]); \
    GAPA(C0=__builtin_amdgcn_mfma_f32_32x32x16_bf16(kf[0],qr[0],f32x16{},0,0,0), P0[2],P0[3],P0[4],P0[5],     pw0[0]=PKW(P0,0), pw0[1]=PKW(P0,2), pw0); \
    VRD(4); SBAR(); GAPA(C1=__builtin_amdgcn_mfma_f32_32x32x16_bf16(kf[1],qr[0],f32x16{},0,0,0), P0[6],P0[7],P0[8],P0[9],     pw0[2]=PKW(P0,4), pw0[3]=PKW(P0,6), pw0); \
    VRD(1); SBAR(); GAPA(C0=__builtin_amdgcn_mfma_f32_32x32x16_bf16(kf[2],qr[1],C0,0,0,0),   P0[10],P0[11],P0[12],P0[13], pw1[0]=PKW(P0,8), pw1[1]=PKW(P0,10), pw1); \
    VRD(5); SBAR(); GAPA(C1=__builtin_amdgcn_mfma_f32_32x32x16_bf16(kf[3],qr[1],C1,0,0,0),   P0[14],P0[15],P1[0],P1[1],   pw1[2]=PKW(P0,12),pw1[3]=PKW(P0,14), pw1); \
    VRD(2); SBAR(); GAPA(C0=__builtin_amdgcn_mfma_f32_32x32x16_bf16(kf[4],qr[2],C0,0,0,0),   P1[2],P1[3],P1[4],P1[5],     pw2[0]=PKW(P1,0), pw2[1]=PKW(P1,2), pw2); \
    VRD(6); SBAR(); GAPA(C1=__builtin_amdgcn_mfma_f32_32x32x16_bf16(kf[5],qr[2],C1,0,0,0),   P1[6],P1[7],P1[8],P1[9],     pw2[2]=PKW(P1,4), pw2[3]=PKW(P1,6), pw2); \
    VRD(3); SBAR(); GAPA(C0=__builtin_amdgcn_mfma_f32_32x32x16_bf16(kf[6],qr[3],C0,0,0,0),   P1[10],P1[11],P1[12],P1[13], pw3[0]=PKW(P1,8), pw3[1]=PKW(P1,10), pw3); \
    VRD(7); SBAR(); GAPA(C1=__builtin_amdgcn_mfma_f32_32x32x16_bf16(kf[7],qr[3],C1,0,0,0),   P1[14],P1[15],0.f,0.f,       pw3[2]=PKW(P1,12),pw3[3]=PKW(P1,14), pw3); \
    C0=__builtin_amdgcn_mfma_f32_32x32x16_bf16(fk0_,qbias,C0,0,0,0); C1=__builtin_amdgcn_mfma_f32_32x32x16_bf16(fk1_,qbias,C1,0,0,0); \
    l_reg+=sacc; \
    if(GK){DMA_K((t)+3,sl_cur);} if(GV){DMA_V((t)+1,sl_next);} \
    CMASK(C0,C1,t); \
    { float a=MX3(C0[0],C0[1],C1[0]),b=MX3(C0[2],C0[3],C1[1]); a=MX3(a,C1[2],C1[3]); \
      _Pragma("unroll") for(int r=4;r<16;r+=4){a=MX3(a,C0[r],C0[r+1]);b=MX3(b,C0[r+2],C0[r+3]);a=MX3(a,C1[r],C1[r+1]);b=MX3(b,C1[r+2],C1[r+3]);} \
      float rm=__builtin_fmaxf(a,b); { auto rr=__builtin_amdgcn_permlane32_swap(__float_as_uint(rm),__float_as_uint(rm),false,false); rm=__builtin_fmaxf(__uint_as_float(rr[0]),__uint_as_float(rr[1])); } \
      resc=false; \
      if(__builtin_expect(__any(rm>(float)THRL),0)){ const float dl=__builtin_fmaxf(rm,0.f); mhat+=dl; \
        _Pragma("unroll") for(int r=0;r<16;++r){C0[r]-=dl;C1[r]-=dl;} \
        qbias=mk_qbias(mhat,hi); asm volatile("":"+v"(qbias)); \
        const float f=__builtin_amdgcn_exp2f(-dl); l_reg*=f; if(hi==0)wsf[r32]=f; resc=true; } } \
    SBAR(); \
    GAPB(o[0]=__builtin_amdgcn_mfma_f32_32x32x16_bf16(PAF(0),VFR(0),o[0],0,0,0), C0,0); \
    GAPB(o[1]=__builtin_amdgcn_mfma_f32_32x32x16_bf16(PAF(0),VFR(4),o[1],0,0,0), C0,4); \
    KRD(GL,0); GAPB(o[0]=__builtin_amdgcn_mfma_f32_32x32x16_bf16(PAF(1),VFR(1),o[0],0,0,0), C0,8); \
    KRD(GL,1); GAPB(o[1]=__builtin_amdgcn_mfma_f32_32x32x16_bf16(PAF(1),VFR(5),o[1],0,0,0), C0,12); \
    KRD(GL,2); GAPB(o[0]=__builtin_amdgcn_mfma_f32_32x32x16_bf16(PAF(2),VFR(2),o[0],0,0,0), C1,0); \
    KRD(GL,3); GAPB(o[1]=__builtin_amdgcn_mfma_f32_32x32x16_bf16(PAF(2),VFR(6),o[1],0,0,0), C1,4); \
    GAPB(o[0]=__builtin_amdgcn_mfma_f32_32x32x16_bf16(PAF(3),VFR(3),o[0],0,0,0), C1,8); \
    GAPB(o[1]=__builtin_amdgcn_mfma_f32_32x32x16_bf16(PAF(3),VFR(7),o[1],0,0,0), C1,12); \
    }while(0)
  int t=1;
  #undef CMASK
  #define CMASK(P0,P1,t) do{}while(0)
  for(;t+5<NT;t+=2){
    STEP(pB0,pB1,pA0,pA1,t,true,true,true);     WAIT_BAR(2); RESC(); ROT();
    STEP(pA0,pA1,pB0,pB1,t+1,true,true,true);   WAIT_BAR(2); RESC(); ROT();
  }
  #undef CMASK
  #define CMASK(P0,P1,t) do{int jb_=(t)-(NT-4); if(jb_>=0)cmask(P0,P1,jb_,qrel,hi);}while(0)
  #define ENDW(tt) do{ if((tt)+3<NT){WAIT_BAR(2);} else if((tt)+2<NT){WAIT_BAR(1);} else {WAIT_BAR(0);} }while(0)
  for(;t+1<NT;t+=2){
    STEP(pB0,pB1,pA0,pA1,t,(t+3<NT),(t+1<NT),(t+1<NT));       ENDW(t);   RESC(); ROT();
    STEP(pA0,pA1,pB0,pB1,t+1,(t+4<NT),(t+2<NT),(t+2<NT));     ENDW(t+1); RESC(); ROT();
  }
  STEP(pB0,pB1,pA0,pA1,NT-1,false,false,false); RESC();
  u32x4 ggv[4];
  { const bf16*Gw_=G+(rowbase+q0+wid*QBLK)*DM+h*D;
    #pragma unroll
    for(int i=0;i<4;++i)ggv[i]=*(const u32x4*)(Gw_+(long)(i*8+(lane>>3))*DM+(lane&7)*8); }
  { float sacc=pB0[0]+pB0[1]; _Pragma("unroll") for(int r=2;r<16;++r)sacc+=pB0[r]; _Pragma("unroll") for(int r=0;r<16;++r)sacc+=pB1[r]; l_reg+=sacc;
    pw0=(u32x4){PKW(pB0,0),PKW(pB0,2),PKW(pB0,4),PKW(pB0,6)};pw1=(u32x4){PKW(pB0,8),PKW(pB0,10),PKW(pB0,12),PKW(pB0,14)};pw2=(u32x4){PKW(pB1,0),PKW(pB1,2),PKW(pB1,4),PKW(pB1,6)};pw3=(u32x4){PKW(pB1,8),PKW(pB1,10),PKW(pB1,12),PKW(pB1,14)};
    SBAR(); pv(o,vb0+sl_cur,PAF(0),PAF(1),PAF(2),PAF(3)); }
  #undef PKW
  #undef PAF
  #undef VFR
  #undef PIN
  #undef MX3
  #undef GAPA
  #undef GAPB
  #undef EX
  #undef VRD
  #undef KRD
  #undef STEP
  #undef ENDW
  {auto rr=__builtin_amdgcn_permlane32_swap(__float_as_uint(l_reg),__float_as_uint(l_reg),false,false);l_reg=__uint_as_float(rr[0])+__uint_as_float(rr[1]);}
  if(hi==0)wsf[32+r32]=l_reg;asm volatile("s_waitcnt lgkmcnt(0)":::"memory");
  float rli[16];
  #pragma unroll
  for(int r=0;r<16;++r)rli[r]=__builtin_amdgcn_rcpf(wsf[32+crow(r,hi)]);
  bf16*Ow=O+(rowbase+q0+wid*QBLK)*DM+h*D;
  { bf16*stg=(bf16*)(shm+LDS_OST)+wid*2048;
    #pragma unroll
    for(int r=0;r<16;++r){const int orow=crow(r,hi);
      #pragma unroll
      for(int d0=0;d0<2;++d0)stg[orow*64+d0*32+r32]=__float2bfloat16(o[d0][r]*rli[r]);}
    asm volatile("s_waitcnt lgkmcnt(0)":::"memory");
    #pragma unroll
    for(int i=0;i<4;++i){const int row=i*8+(lane>>3),ch=lane&7; const u32x4 v=*(const u32x4*)(stg+row*64+ch*8); const u32x4 gg=ggv[i]; u32x4 w;
      #pragma unroll
      for(int c=0;c<4;++c){ const float lo=__uint_as_float(v[c]<<16)*__uint_as_float(gg[c]<<16), hh=__uint_as_float(v[c]&0xffff0000u)*__uint_as_float(gg[c]&0xffff0000u); w[c]=cvtpk_s(lo,hh); }
      ATTN_STORE16(Ow+(long)row*DM+ch*8,w);} }
  asm volatile("s_waitcnt lgkmcnt(0)\n\ts_barrier":::"memory");
  #undef DMA_K
  #undef DMA_V
  #undef CMASK
  #undef FKLD
  #undef START
  #undef RESC
  #undef ROT
}
constexpr int ATTN_LDS_BYTES=LDS_BYTES;
struct AttnTensors { const bf16* Q; const bf16* K; const bf16* V; const bf16* G; bf16* O; const u32x4* FBT; };
struct AttnUnit { int bh; int qb; };
struct StaticOrder {
  int vcu, G;
  __device__ __forceinline__ bool next(int i,AttnUnit&u)const{ u.bh=vcu+(i>>3)*G; if(u.bh>=BATCH*NHEAD)return false; u.qb=(i+(vcu&7))&7; return true; }
};
__device__ __forceinline__ void scan_bias_table(char*lds,const float*FG,const float*bfp,int bh,u32x4*tab){
  float*wtot=(float*)lds; const int b_=bh/NHEAD,h_=bh%NHEAD,t_=threadIdx.x,ln_=t_&63,wv_=t_>>6; const float bf_=bfp[h_]; float p_[4]; float run=0.f;
  #pragma unroll
  for(int i=0;i<4;++i){ const float xg=FG[((size_t)b_*SEQ+4*t_+i)*NHEAD+h_]+bf_; run+=(xg>=0.f?-log1pf(expf(-xg)):xg-log1pf(expf(xg))); p_[i]=run; }
  float inc=run;
  #pragma unroll
  for(int o=1;o<64;o<<=1){ const float tt=__shfl_up(inc,o); if(ln_>=o)inc+=tt; }
  __syncthreads();
  if(ln_==63)wtot[wv_]=inc;
  __syncthreads();
  float base_=inc-run; for(int w=0;w<wv_;++w)base_+=wtot[w];
  #pragma unroll
  for(int i=0;i<4;++i){ const float x=-1.4426950408889634f*(base_+p_[i]); const unsigned h=cvtpk_s(x,0.f)&0xffffu; const float r1=x-__uint_as_float(h<<16); const unsigned m=cvtpk_s(r1,0.f)&0xffffu;
    const float r2=r1-__uint_as_float(m<<16); const unsigned l=cvtpk_s(r2,0.f)&0xffffu; u32x4 w; w[0]=h|(m<<16); w[1]=l|(0x3F80u<<16); w[2]=0x3F803F80u; w[3]=0u; tab[(size_t)bh*SEQ+4*t_+i]=w; }
}
template<class Sched,int THRL=8> __device__ __forceinline__ void attn_phase(char*lds,const AttnTensors&T,const Sched&S){
  AttnUnit u; int cur=-1;
  for(int i=0;S.next(i,u);++i){
    if(u.bh!=cur){ cur=u.bh; u32x4*fb=(u32x4*)(lds+LDS_FB); const u32x4*src=T.FBT+(size_t)u.bh*SEQ;
      #pragma unroll
      for(int k=0;k<SEQ/(NW*64);++k)fb[threadIdx.x+k*NW*64]=src[threadIdx.x+k*NW*64];
      asm volatile("s_waitcnt vmcnt(0) lgkmcnt(0)\n\ts_barrier":::"memory"); }
    attn_unit<THRL>(u.bh/NHEAD,u.bh%NHEAD,u.qb,T.Q,T.K,T.V,T.G,T.O,lds);
  }
}
#undef SBAR
#undef WAIT_BAR
}
#define GAS __attribute__((address_space(1)))
#define LAS __attribute__((address_space(3)))
typedef unsigned short bf16;
typedef unsigned v4u __attribute__((ext_vector_type(4)));
typedef float f32x4 __attribute__((ext_vector_type(4)));
typedef short bf16x8 __attribute__((ext_vector_type(8)));
typedef GAS unsigned gu32;
typedef GAS unsigned long long gu64;
#define RLX_AGENT __ATOMIC_RELAXED, __HIP_MEMORY_SCOPE_AGENT
#define LDS_WAIT() asm volatile("s_waitcnt lgkmcnt(0)" ::: "memory")
#define VM_WAIT() asm volatile("s_waitcnt vmcnt(0)" ::: "memory")
__device__ __forceinline__ unsigned long long rt() { return __builtin_amdgcn_s_memrealtime(); }
__device__ __forceinline__ unsigned f2bf(float f) { unsigned u = __builtin_bit_cast(unsigned, f); return (u + 0x7fffu + ((u >> 16) & 1u)) >> 16; }
__device__ __forceinline__ unsigned pk2(float lo, float hi) { return f2bf(lo) | (f2bf(hi) << 16); }

#define XB_TMO      128
#define XB_XCNT(j)  (256  + 64 * (j))
#define XB_XSUB(j)  (1280 + 64 * (j))
#define XB_XGEN(j)  (2304 + 64 * (j))
#define XB_TOP      3328
#define XB_TOPGEN   3392
#define XCD_BAR_WORDS 3456
#define XB_SPIN_CAP (1u << 18)

__device__ __forceinline__ unsigned xb_ld(unsigned* p)              { return __hip_atomic_load(p, __ATOMIC_RELAXED, __HIP_MEMORY_SCOPE_AGENT); }
__device__ __forceinline__ unsigned xb_add(unsigned* p, unsigned v) { return __hip_atomic_fetch_add(p, v, __ATOMIC_RELAXED, __HIP_MEMORY_SCOPE_AGENT); }
__device__ __forceinline__ unsigned xb_xcc_id() { return (unsigned)__builtin_amdgcn_s_getreg((3 << 11) | 20) & 0xFu; }
#define XB_SPIN(cond, bar) do { unsigned _sp = 0; while (cond) { __builtin_amdgcn_s_sleep(1); \
    if ((++_sp & 255u) == 0u) { if (xb_ld(&(bar)[XB_TMO])) break; if (_sp > XB_SPIN_CAP) { atomicAdd(&(bar)[XB_TMO], 1u); break; } } } } while (0)

struct XcdBarrier {
    unsigned* bar; unsigned x;
    volatile LAS unsigned* st;
};

__device__ __forceinline__ XcdBarrier xcd_barrier_post(unsigned* bar, volatile LAS unsigned* st) {
    XcdBarrier b; b.bar = bar; b.x = xb_xcc_id(); b.st = st;
    if (threadIdx.x == 0) (void)xb_add(&bar[XB_XCNT(b.x)], 1u);
    return b;
}
__device__ __forceinline__ void xcd_barrier_complete(unsigned* bar, unsigned x, unsigned& nloc, unsigned& nx) {
    const unsigned G = gridDim.x * gridDim.y * gridDim.z;
    unsigned sum, cnt, mine, sp = 0u;
    for (;;) {
        sum = 0u; cnt = 0u; mine = 0u;
#pragma unroll
        for (unsigned j = 0; j < 16; ++j) { const unsigned c = xb_ld(&bar[XB_XCNT(j)]); sum += c; cnt += (c > 0u) ? 1u : 0u; mine = (j == x) ? c : mine; }
        if (sum == G) break;
        __builtin_amdgcn_s_sleep(1);
        if ((++sp & 255u) == 0u) { if (xb_ld(&bar[XB_TMO])) break; if (sp > XB_SPIN_CAP) { atomicAdd(&bar[XB_TMO], 1u); break; } }
    }
    nloc = mine > 0u ? mine : 1u; nx = cnt > 0u ? cnt : 1u;
}

__device__ __forceinline__ void xcd_barrier(const XcdBarrier& b) {
    asm volatile("s_waitcnt vmcnt(0)" ::: "memory");
    __syncthreads();
    if (threadIdx.x == 0) {
        unsigned* bar = b.bar;
        __builtin_amdgcn_s_waitcnt(0);
        unsigned nloc = b.st[0], nx = b.st[1];
        if (nloc == 0u) { xcd_barrier_complete(bar, b.x, nloc, nx); b.st[0] = nloc; b.st[1] = nx; }
        const unsigned old = xb_add(&bar[XB_XSUB(b.x)], 1u);
        const unsigned gen = old / nloc;
        if (old + 1u == (gen + 1u) * nloc) {
            __builtin_amdgcn_fence(__ATOMIC_RELEASE, "agent");
            asm volatile("s_waitcnt vmcnt(0)" ::: "memory");
            const unsigned og = xb_add(&bar[XB_TOP], 1u);
            const unsigned tg = og / nx;
            if (og + 1u == (tg + 1u) * nx) xb_add(&bar[XB_TOPGEN], 1u);
            else XB_SPIN(xb_ld(&bar[XB_TOPGEN]) == tg, bar);
            __builtin_amdgcn_fence(__ATOMIC_ACQUIRE, "agent");
            xb_add(&bar[XB_XGEN(b.x)], 1u);
            asm volatile("s_waitcnt vmcnt(0)" ::: "memory");
        } else {
            XB_SPIN(xb_ld(&bar[XB_XGEN(b.x)]) == gen, bar);
            __builtin_amdgcn_fence(__ATOMIC_ACQUIRE, "agent");
            asm volatile("s_waitcnt vmcnt(0)" ::: "memory");
        }
    }
    __syncthreads();
}

constexpr int NWAVES = 8;
constexpr int DM = 1024, BATCH = 16, SEQ = 2048, MROWS = BATCH * SEQ;
constexpr int A_FFN = 6144, A_HALF = 3072, A_GROUPS = 8, A_GD = 384, GCH = 128, CHK = 64;
constexpr int D_FF = 2816, NEXP = 8, D_EXP = 3584, NHEAD = 16, HD = 64;
constexpr int KVW_LD = 2 * DM + NHEAD;
constexpr float RMS_EPS = 1e-6f;
constexpr float W8_SCALE = 64.0f;
constexpr int W8_SCALE_E8M0 = 0x79797979;
enum { I_X = 0, I_A_NORM_G, I_A_W_IN, I_A_V_NORM_G, I_A_W_SP, I_A_B_SP, I_A_W_OUT, I_F_NORM_G, I_F_W_IN, I_F_W_OUT, I_KV_NORM_G, I_KV_W, I_KV_B_F, I_K_NORM_G,
       I_B_NORM_G, I_B_W_IN, I_Q_NORM_G, I_B_W_OUT, I_M_NORM_G, I_M_W_ROUTER, I_M_W_IN, I_M_W_OUT, N_IN };

constexpr size_t MiB = 1u << 20;
constexpr size_t WS_CTL = 0, CTL_ZERO_BYTES = 1 * MiB;
constexpr size_t WS_RSQ = 4 * MiB;
constexpr size_t WS_VPART = 286 * MiB;
constexpr size_t WS_FG = 2 * MiB;
constexpr size_t WS_GW = 6 * MiB;
constexpr size_t WS_TOKSLOT = 7 * MiB;
constexpr size_t WS_WA_IN = 8 * MiB, WS_WA_OUT = 20 * MiB, WS_WF_IN = 26 * MiB, WS_WF_OUT = 37 * MiB, WS_WKV = 43 * MiB, WS_WBIN = 47 * MiB, WS_WBOUT = 51 * MiB;
constexpr size_t WS_WM_IN = 53 * MiB, WS_WM_OUT = 165 * MiB;
constexpr size_t WS_XN = 222 * MiB, WS_XQ = 286 * MiB;
constexpr size_t WS_BIG = 350 * MiB;
constexpr int MAXSLOT = MROWS * 2 + NEXP * 256;
constexpr size_t WS_XG = 286 * MiB;
constexpr size_t WS_ACT = 418 * MiB;
constexpr size_t WS_Y = 8 * MiB;
constexpr size_t WS_ELIST = 880 * MiB, WS_EWL = 881 * MiB;
constexpr size_t WS_FBT = 700 * MiB;
constexpr int YP_ROWS = 16 * 256;
constexpr size_t WS_END = 883 * MiB;
constexpr int CW_BAR = 4096, CW_CNT = 64;

constexpr int RING_OFF = 0, RING_BYTES = 131072;
constexpr int LDSCTL_OFF = RING_BYTES, MISC_OFF = LDSCTL_OFF + 320;
constexpr int LDS_BYTES = 147456;

typedef short s16x4 __attribute__((ext_vector_type(4)));
__device__ __forceinline__ unsigned off_b(unsigned row, unsigned ch) { return 256u * row + 16u * (ch ^ (((row & 3u) << 2) | ((row >> 2) & 3u))); }
struct Frame {
    LAS unsigned char* lds; volatile LAS unsigned* MISC; gu32* ctl;
    int tid, lane, wave, vcu, G;
};
__device__ __forceinline__ float wave_sum(float v) {
#pragma unroll
    for (int o = 1; o < 64; o <<= 1) v += __shfl_xor(v, o);
    return v;
}
__device__ __forceinline__ void tr_load(float (&tmp)[32], const float* W, int ldw, int k0, int n0, int lane) {
#pragma unroll
    for (int i = 0; i < 32; ++i) { const int kk = 2 * i + (lane >> 5); tmp[i] = W[(size_t)(k0 + kk) * ldw + n0 + (lane & 31)]; }
}
template <class RowMap>
__device__ __forceinline__ void tr_store(float (&tmp)[32], int K, bf16* WT, LAS float* scr, int k0, int n0, int lane, const RowMap& rowmap, const float* gk, float f8scale = 0.f) {
    if (gk) {
#pragma unroll
        for (int i = 0; i < 32; ++i) tmp[i] *= gk[k0 + 2 * i + (lane >> 5)]; }
#pragma unroll
    for (int i = 0; i < 32; ++i) { const int kk = 2 * i + (lane >> 5); scr[kk * 33 + (lane & 31)] = tmp[i]; }
    LDS_WAIT(); asm volatile("" ::: "memory");
    const int c = lane & 7;
#pragma unroll
    for (int j = 0; j < 4; ++j) { const int n = (lane >> 3) + 8 * j; const LAS float* s = scr + (8 * c) * 33 + n;
        if (f8scale != 0.f) { unsigned lo = 0u, hi = 0u;
            lo = __builtin_amdgcn_cvt_pk_fp8_f32(s[0 * 33] * f8scale, s[1 * 33] * f8scale, lo, false); lo = __builtin_amdgcn_cvt_pk_fp8_f32(s[2 * 33] * f8scale, s[3 * 33] * f8scale, lo, true);
            hi = __builtin_amdgcn_cvt_pk_fp8_f32(s[4 * 33] * f8scale, s[5 * 33] * f8scale, hi, false); hi = __builtin_amdgcn_cvt_pk_fp8_f32(s[6 * 33] * f8scale, s[7 * 33] * f8scale, hi, true);
            *(GAS unsigned long long*)((GAS unsigned char*)WT + (size_t)rowmap(n0 + n) * K + k0 + 8 * c) = (unsigned long long)lo | ((unsigned long long)hi << 32); }
        else { v4u o; o.x = pk2(s[0 * 33], s[1 * 33]); o.y = pk2(s[2 * 33], s[3 * 33]); o.z = pk2(s[4 * 33], s[5 * 33]); o.w = pk2(s[6 * 33], s[7 * 33]);
            *(GAS v4u*)(WT + (size_t)rowmap(n0 + n) * K + k0 + 8 * c) = o; } }
    LDS_WAIT(); asm volatile("" ::: "memory");
}
struct MapId { __device__ __forceinline__ int operator()(int n) const { return n; } };
struct MapGlu { int half; __device__ __forceinline__ int operator()(int n) const { const int b = n >= half ? 1 : 0, x = n - b * half; return (x >> 7) * 256 + b * 128 + (x & 127); } };
struct MapGlu64 { int half; __device__ __forceinline__ int operator()(int n) const { const int b = n >= half ? 1 : 0, x = n - b * half, pn = x >> 6, xx = x & 63; return pn * 128 + (xx >> 4) * 32 + ((xx >> 2) & 3) * 8 + b * 4 + (xx & 3); } };
struct MapHead { __device__ __forceinline__ int operator()(int n) const { const int blk = n >> 10, hh = (n >> 6) & 15, d = n & 63; return (blk * 4 + (hh >> 2)) * 256 + (d >> 5) * 128 + (hh & 3) * 32 + (d & 31); } };
template <class RowMap>
__device__ __forceinline__ void tr_matrix(Frame& F, const float* W, int ldw, int K, int ncols, bf16* WT, const RowMap& rm, int& gwoff, const float* gk = nullptr, float f8scale = 0.f) {
    LAS float* scr = (LAS float*)(F.lds + RING_OFF + F.wave * 16384);
    const int NGW = F.G * NWAVES, nblk = ncols / 32, items = (K / 64) * nblk;
    int gw = F.vcu * NWAVES + F.wave - gwoff; if (gw < 0) gw += NGW;
    int it = gw; if (it < items) { float ta[32], tb[32]; tr_load(ta, W, ldw, 64 * (it / nblk), 32 * (it % nblk), F.lane);
        for (;;) { const int n1 = it + NGW; if (n1 < items) tr_load(tb, W, ldw, 64 * (n1 / nblk), 32 * (n1 % nblk), F.lane);
            tr_store(ta, K, WT, scr, 64 * (it / nblk), 32 * (it % nblk), F.lane, rm, gk, f8scale); if (n1 >= items) break;
            const int n2 = n1 + NGW; if (n2 < items) tr_load(ta, W, ldw, 64 * (n2 / nblk), 32 * (n2 % nblk), F.lane);
            tr_store(tb, K, WT, scr, 64 * (n1 / nblk), 32 * (n1 % nblk), F.lane, rm, gk, f8scale); if (n2 >= items) break;
            it = n2; } }
    gwoff = (gwoff + items) % NGW;
}
__device__ __forceinline__ void row_load(const float* xrow, int lane, f32x4 (&v)[4]) {
    const GAS f32x4* xr = (const GAS f32x4*)xrow + lane;
#pragma unroll
    for (int j = 0; j < 4; ++j) v[j] = xr[64 * j];
}
__device__ __forceinline__ void row_load(const bf16* xrow, int lane, f32x4 (&v)[4]) {
    const GAS unsigned long long* xr = (const GAS unsigned long long*)xrow + lane;
#pragma unroll
    for (int j = 0; j < 4; ++j) { const unsigned long long w = xr[64 * j]; const unsigned lo = (unsigned)w, hi = (unsigned)(w >> 32);
        v[j] = (f32x4){__uint_as_float(lo << 16), __uint_as_float(lo & 0xffff0000u), __uint_as_float(hi << 16), __uint_as_float(hi & 0xffff0000u)}; }
}
__device__ __forceinline__ float row_rstd(const f32x4 (&v)[4]) { float s = 0.f;
#pragma unroll
    for (int j = 0; j < 4; ++j) s += (v[j].x * v[j].x + v[j].y * v[j].y) + (v[j].z * v[j].z + v[j].w * v[j].w);
    return 1.0f / sqrtf(wave_sum(s) * (1.f / DM) + RMS_EPS);
}
#define ROW_LOOP_BEGIN(src) { f32x4 vn_[4]; if (gw < MROWS) row_load((src) + (size_t)gw * DM, F.lane, vn_); \
        for (int m = gw; m < MROWS; m += NGW) { f32x4 v[4]; _Pragma("unroll") for (int j_ = 0; j_ < 4; ++j_) v[j_] = vn_[j_]; \
            if (m + NGW < MROWS) row_load((src) + (size_t)(m + NGW) * DM, F.lane, vn_); const float r = row_rstd(v);
#define ROW_LOOP_END } }
__device__ __forceinline__ void rms_row_store(const f32x4 (&v)[4], float rstd, const float* g, bf16* orow, int lane, float extra = 1.0f) {
    const GAS f32x4* gr = (const GAS f32x4*)g + lane; GAS unsigned long long* o8 = (GAS unsigned long long*)orow + lane;
#pragma unroll
    for (int j = 0; j < 4; ++j) { const f32x4 gg = gr[64 * j]; const f32x4 y = (v[j] * rstd) * gg * extra;
        o8[64 * j] = (unsigned long long)pk2(y.x, y.y) | ((unsigned long long)pk2(y.z, y.w) << 32); }
}
template <int N> __device__ __forceinline__ float wave_tr_reduce(float (&v)[N], int lane) {
    static_assert(N == 16 || N == 8, "N");
#define TRR_STEP(M, NN) if (N >= NN) { const bool up = (lane & M) != 0; _Pragma("unroll") for (int i = 0; i < NN / 2; ++i) { const float keep = up ? v[i + NN / 2] : v[i], send = up ? v[i] : v[i + NN / 2]; v[i] = keep + __shfl_xor(send, M); } }
    TRR_STEP(8, 16) TRR_STEP(4, 8) TRR_STEP(2, 4) TRR_STEP(1, 2)
#undef TRR_STEP
    float t = v[0];
#pragma unroll
    for (int o = N; o < 64; o <<= 1) t += __shfl_xor(t, o);
    return t;
}
__device__ __forceinline__ float bflo(unsigned u) { return __uint_as_float(u << 16); }
__device__ __forceinline__ float bfhi(unsigned u) { return __uint_as_float(u & 0xffff0000u); }
__device__ __forceinline__ float log_sigmoid(float x) { return x >= 0.f ? -log1pf(expf(-x)) : x - log1pf(expf(x)); }

enum { PH_PRO = 0, PH_GEMM1, PH_SPATIAL, PH_GEMM2, PH_FFN_UP, PH_FFN_DOWN, PH_KVQ, PH_ATTN, PH_OPROJ, PH_ROUTER, PH_MOE_UP, PH_MOE_DOWN, PH_COMBINE, PH_END };
#ifndef MK_ONE_LAUNCH
#define MK_ONE_LAUNCH 1
#endif
#ifndef MK_PH_STOP
#define MK_PH_STOP PH_END
#endif

struct Args { const float* in[N_IN]; float* out; unsigned char* ws; int ph_lo, ph_hi, li, pad; };
__global__ void __launch_bounds__(NWAVES * 64, 2) yoco_fwd(Args args) {
    extern __shared__ __attribute__((aligned(16))) unsigned char lds[];
    Frame F;
    F.lds = (LAS unsigned char*)lds; F.MISC = (volatile LAS unsigned*)(F.lds + MISC_OFF);
    F.tid = threadIdx.x; F.lane = F.tid & 63; F.wave = __builtin_amdgcn_readfirstlane(F.tid >> 6);
    F.G = gridDim.x; { const int bx = blockIdx.x; F.vcu = (F.G % 8 == 0) ? (bx % 8) * (F.G / 8) + bx / 8 : bx; }
    unsigned char* ws = args.ws; F.ctl = (gu32*)(ws + WS_CTL);
    for (int u = F.tid; u < (LDS_BYTES - LDSCTL_OFF) / 4; u += NWAVES * 64) ((LAS unsigned*)(F.lds + LDSCTL_OFF))[u] = 0u;
    __syncthreads();
    XcdBarrier bar; bar.bar = (unsigned*)(F.ctl + CW_BAR) + args.li * XCD_BAR_WORDS; bar.x = 0; bar.st = nullptr;
    if (MK_ONE_LAUNCH) bar = xcd_barrier_post((unsigned*)(F.ctl + CW_BAR) + args.li * XCD_BAR_WORDS, F.MISC + 8);
#define GRID_BAR() do { if (MK_ONE_LAUNCH) xcd_barrier(bar); } while (0)
    const int lo = args.ph_lo, hi = args.ph_hi;
#ifndef MK_PHMASK
#define MK_PHMASK 0xffffffffu
#endif
#define IN(k) (((MK_PHMASK >> (k)) & 1u) && lo <= (k) && (k) < hi)
#define BOTH(k) (IN(k) && IN((k) + 1))
    const float* x = args.in[I_X]; float* H = args.out;
    bf16* WA_IN = (bf16*)(ws + WS_WA_IN); bf16* WA_OUT = (bf16*)(ws + WS_WA_OUT); bf16* WF_IN = (bf16*)(ws + WS_WF_IN); bf16* WF_OUT = (bf16*)(ws + WS_WF_OUT);
    bf16* WKV = (bf16*)(ws + WS_WKV); bf16* WBIN = (bf16*)(ws + WS_WBIN); bf16* WBOUT = (bf16*)(ws + WS_WBOUT); bf16* WM_IN = (bf16*)(ws + WS_WM_IN); bf16* WM_OUT = (bf16*)(ws + WS_WM_OUT);
    float* RX = (float*)(ws + 1 * MiB + 131072);
    bf16* WF16 = (bf16*)(ws + 1 * MiB);
    bf16* XN = (bf16*)(ws + WS_XN); bf16* XQ = (bf16*)(ws + WS_XQ); bf16* BIG = (bf16*)(ws + WS_BIG);
    float* RSQ_V = (float*)(ws + WS_VPART); float* RSQ_H1 = (float*)(ws + WS_RSQ); bf16* HB = XQ;
 float* FG = (float*)(ws + WS_FG); unsigned* IDL = (unsigned*)(ws + WS_GW + 512 * 1024);   float* GW = (float*)(ws + WS_GW); unsigned* TOKSLOT = (unsigned*)(ws + WS_TOKSLOT); unsigned* ELIST = (unsigned*)(ws + WS_ELIST); float* EWL = (float*)(ws + WS_EWL); unsigned* ERS = (unsigned*)(ws + WS_EWL + 1 * MiB);
    bf16* ACT = (bf16*)(ws + WS_ACT); bf16* YB = (bf16*)(ws + WS_Y); bf16* YP = (bf16*)(ws + WS_BIG);
    bf16* KB = BIG; bf16* VB = BIG + (size_t)MROWS * DM; bf16* QB = BIG + (size_t)2 * MROWS * DM; bf16* GB = BIG + (size_t)3 * MROWS * DM;
    const int gw = F.vcu * NWAVES + F.wave, NGW = F.G * NWAVES;

    if (IN(PH_PRO)) {
        int go = 0;
        tr_matrix(F, args.in[I_A_W_IN], A_FFN, DM, A_FFN, WA_IN, MapId{}, go, args.in[I_A_NORM_G]);
        tr_matrix(F, args.in[I_A_W_OUT], DM, A_HALF, DM, WA_OUT, MapId{}, go);
        tr_matrix(F, args.in[I_F_W_IN], 2 * D_FF, DM, 2 * D_FF, WF_IN, MapGlu{D_FF}, go, args.in[I_F_NORM_G]);
        tr_matrix(F, args.in[I_F_W_OUT], DM, D_FF, DM, WF_OUT, MapId{}, go);
        tr_matrix(F, args.in[I_KV_W], KVW_LD, DM, 2 * DM, WKV, MapHead{}, go, args.in[I_KV_NORM_G]);
        tr_matrix(F, args.in[I_B_W_IN], 2 * DM, DM, 2 * DM, WBIN, MapHead{}, go, args.in[I_B_NORM_G]);
        tr_matrix(F, args.in[I_B_W_OUT], DM, DM, DM, WBOUT, MapId{}, go);
        for (int e = 0; e < NEXP; ++e) {
            tr_matrix(F, args.in[I_M_W_IN] + (size_t)e * DM * 2 * D_EXP, 2 * D_EXP, DM, 2 * D_EXP, (bf16*)((unsigned char*)WM_IN + (size_t)e * 2 * D_EXP * DM), MapGlu{D_EXP}, go, args.in[I_M_NORM_G], W8_SCALE);
            tr_matrix(F, args.in[I_M_W_OUT] + (size_t)e * D_EXP * DM, DM, D_EXP, DM, (bf16*)((unsigned char*)WM_OUT + (size_t)e * DM * D_EXP), MapId{}, go, nullptr, W8_SCALE);
        }
        ROW_LOOP_BEGIN(x) { GAS unsigned long long* o8 = (GAS unsigned long long*)(XN + (size_t)m * DM) + F.lane;
#pragma unroll
            for (int j = 0; j < 4; ++j) o8[64 * j] = (unsigned long long)pk2(v[j].x, v[j].y) | ((unsigned long long)pk2(v[j].z, v[j].w) << 32);
            if (F.lane == 0) RX[m] = r; } ROW_LOOP_END
        for (int e = blockIdx.x * (NWAVES * 64) + F.tid; e < NHEAD * DM; e += F.G * NWAVES * 64) { const int h = e >> 10, k = e & 1023; WF16[e] = (bf16)f2bf(args.in[I_KV_W][(size_t)k * KVW_LD + 2 * DM + h] * args.in[I_KV_NORM_G][k]); }
        if (BOTH(PH_PRO)) GRID_BAR();
    }
    if (IN(PH_GEMM1)) {
        pg8::Gemm g{XN, WA_IN, MROWS, A_FFN, DM, DM, 0, nullptr, 0, nullptr, 0}; pg8::StaticOrder S; S.init(MROWS, A_FFN, F.G, (int)blockIdx.x);
        LAS float* RT = (LAS float*)(F.lds + LDSCTL_OFF + 4096);
        { pg8::Unit uu; __syncthreads();
          for (int i0 = 0; i0 < 12; i0 += 2) { const int i = i0 + (F.tid >> 8); if (!S.next(i, uu)) continue; RT[i * 256 + (F.tid & 255)] = RX[uu.pm * 256 + (F.tid & 255)]; }
          __syncthreads(); }
        pg8::EpiGeluSq E{BIG, A_FFN, RSQ_V, A_HALF / 256, RT};
        pg8::gemm_phase<pg8::EpiGeluSq, pg8::StaticOrder, true, true>(F.lds + RING_OFF, g, S, E);
        if (BOTH(PH_GEMM1)) GRID_BAR();
    }
    if (IN(PH_SPATIAL)) {
        int tid_ = threadIdx.x; asm volatile("" : "+v"(tid_));
        const int tid = tid_, lane = tid & 63, wid = __builtin_amdgcn_readfirstlane(tid >> 6), wr = wid >> 2, wc = wid & 3, L15 = lane & 15, G4 = lane >> 4, q_ = (lane & 15) >> 2, p_ = lane & 3;
        LAS unsigned char* VI = F.lds + RING_OFF; LAS unsigned char* WI = F.lds + RING_OFF + 98304; LAS float* RVS = (LAS float*)(F.lds + LDSCTL_OFF + 1024);
        const float* wsp = args.in[I_A_W_SP]; const float* bsp = args.in[I_A_B_SP]; const float* gvn = args.in[I_A_V_NORM_G];
        for (int u = F.vcu; u < (MROWS / GCH) * A_GROUPS; u += F.G) {
            const int cc = u / A_GROUPS, g = u % A_GROUPS; const size_t r0 = (size_t)cc * GCH;
            __syncthreads();
            if (tid < GCH) { const GAS f32x4* pp = (const GAS f32x4*)(RSQ_V + (r0 + tid) * 48); float t = 0.f;
#pragma unroll
                for (int k = 0; k < 12; ++k) { const f32x4 p = pp[k]; t += (p[0] + p[1]) + (p[2] + p[3]); }
                RVS[tid] = 1.0f / sqrtf(t * (1.f / A_HALF) + RMS_EPS); }
            __syncthreads();
            { const unsigned char* vbase = (const unsigned char*)(BIG + r0 * A_FFN + A_HALF + g * A_GD);
#pragma unroll
              for (int hb = 0; hb < 2; ++hb) { v4u vreg[6];
#pragma unroll
                  for (int k = 0; k < 6; ++k) { const unsigned q = tid + 512 * (6 * hb + k), row = q / 48u, c48 = q % 48u; vreg[k] = *(const GAS v4u*)(vbase + (row * A_FFN + c48 * 8u) * 2u); }
                  if (hb == 0) {
#pragma unroll
                      for (int k = 0; k < 4; ++k) { const unsigned q = tid + 512 * k, i = q >> 4, ch = q & 15; v4u o = (v4u){0u, 0u, 0u, 0u};
                          if ((ch >> 3) <= (i >> 6)) { const GAS f32x4* wp = (const GAS f32x4*)(wsp + (size_t)g * GCH * GCH + i * GCH + ch * 8); const LAS f32x4* rp = (const LAS f32x4*)(RVS + ch * 8); const f32x4 r0v = rp[0], r1v = rp[1];
                              const f32x4 w0 = wp[0] * r0v, w1 = wp[1] * r1v; o.x = pk2(w0.x, w0.y); o.y = pk2(w0.z, w0.w); o.z = pk2(w1.x, w1.y); o.w = pk2(w1.z, w1.w); }
                          *(LAS v4u*)(WI + off_b(i, ch)) = o; } }
#pragma unroll
                  for (int k = 0; k < 6; ++k) { const unsigned q = tid + 512 * (6 * hb + k), row = q / 48u, c48 = q % 48u; *(LAS v4u*)(VI + (c48 >> 4) * 32768u + off_b(row, c48 & 15u)) = vreg[k]; }
                  asm volatile("" ::: "memory"); } }
            __syncthreads();
            f32x4 acc[4][6];
#pragma unroll
            for (int m = 0; m < 4; ++m)
#pragma unroll
                for (int n = 0; n < 6; ++n) acc[m][n] = (f32x4){0.f, 0.f, 0.f, 0.f};
            const int nks = wr ? 4 : 2;
            const unsigned fW = ((L15 & 3u) << 2) | (L15 >> 2);
            const unsigned wbase = 256u * (wr * 64 + L15) + 16u * ((unsigned)G4 ^ (fW & 3u));
            const unsigned tb0 = 256u * (8 * G4 + q_) + 16u * ((unsigned)p_ ^ ((2u * G4) & 3u)), tb1 = 256u * (8 * G4 + 4 + q_) + 16u * ((unsigned)p_ ^ ((2u * G4 + 1u) & 3u));
            unsigned xc[3];
#pragma unroll
            for (int c32 = 0; c32 < 3; ++c32) { const unsigned col32 = wc * 96 + c32 * 32; xc[c32] = (col32 >> 7) * 32768u + 16u * (((col32 & 127u) >> 3) ^ ((unsigned)q_ << 2)); }
#pragma unroll 1
            for (int ks = 0; ks < nks; ++ks) {
                bf16x8 wf[4]; const LAS unsigned char* wp = WI + wbase + 16u * ((4u * ks) ^ (fW & 12u));
#pragma unroll
                for (int m = 0; m < 4; ++m) wf[m] = *(const LAS bf16x8*)(wp + m * 4096);
#pragma unroll
                for (int c32 = 0; c32 < 3; ++c32) { const LAS unsigned char* ib = VI + xc[c32] + 8192u * ks;
#pragma unroll
                    for (int nn = 0; nn < 2; ++nn) {
                        const s16x4 t0 = __builtin_bit_cast(s16x4, __builtin_amdgcn_ds_read_tr16_b64_v4i16((LAS s16x4*)(ib + tb0 + 8 * nn)));
                        const s16x4 t1 = __builtin_bit_cast(s16x4, __builtin_amdgcn_ds_read_tr16_b64_v4i16((LAS s16x4*)(ib + tb1 + 8 * nn)));
                        const bf16x8 vf = (bf16x8){t0[0], t0[1], t0[2], t0[3], t1[0], t1[1], t1[2], t1[3]};
#pragma unroll
                        for (int m = 0; m < 4; ++m) acc[m][2 * c32 + nn] = __builtin_amdgcn_mfma_f32_16x16x32_bf16(vf, wf[m], acc[m][2 * c32 + nn], 0, 0, 0); } }
            }
            f32x4 gvv[3][2];
#pragma unroll
            for (int c32 = 0; c32 < 3; ++c32) { const GAS f32x4* gp = (const GAS f32x4*)(gvn + g * A_GD + wc * 96 + c32 * 32 + 8 * G4); gvv[c32][0] = gp[0]; gvv[c32][1] = gp[1]; }
#pragma unroll
            for (int m = 0; m < 4; ++m) { const int i = wr * 64 + 16 * m + L15; const float bi = bsp[g * GCH + i]; bf16* rowp = BIG + (r0 + i) * A_FFN + g * A_GD + wc * 96 + 8 * G4;
#pragma unroll
                for (int c32 = 0; c32 < 3; ++c32) { const v4u uu = *(const GAS v4u*)(rowp + c32 * 32); const f32x4 a = acc[m][2 * c32] * gvv[c32][0] + bi, b = acc[m][2 * c32 + 1] * gvv[c32][1] + bi; v4u o;
                    o.x = pk2(bflo(uu.x) * a.x, bfhi(uu.x) * a.y); o.y = pk2(bflo(uu.y) * a.z, bfhi(uu.y) * a.w); o.z = pk2(bflo(uu.z) * b.x, bfhi(uu.z) * b.y); o.w = pk2(bflo(uu.w) * b.z, bfhi(uu.w) * b.w);
                    *(GAS v4u*)(rowp + c32 * 32) = o; } }
        }
        if (BOTH(PH_SPATIAL)) GRID_BAR();
    }
    if (IN(PH_GEMM2)) {
        pg8::Gemm g{BIG, WA_OUT, MROWS, DM, A_HALF, A_FFN, 0, nullptr, 0, nullptr, 0}; pg8::StaticOrder S; S.init(MROWS, DM, F.G, (int)blockIdx.x);
        pg8::EpiResBf<true> E{XN, HB, RSQ_H1, DM};
        pg8::gemm_phase<pg8::EpiResBf<true>, pg8::StaticOrder, true, true>(F.lds + RING_OFF, g, S, E);
        if (BOTH(PH_GEMM2)) GRID_BAR();
    }
    if (IN(PH_FFN_UP)) {
        pg8::Gemm g{HB, WF_IN, MROWS, 2 * D_FF, DM, DM, 0, nullptr, 0, nullptr, 0}; pg8::StaticOrder S; S.init(MROWS, 2 * D_FF, F.G, (int)blockIdx.x);
        LAS float* RT = (LAS float*)(F.lds + LDSCTL_OFF + 4096);
        { pg8::Unit uu; __syncthreads();
          for (int i0 = 0; i0 < 12; i0 += 2) { const int i = i0 + (F.tid >> 8); if (!S.next(i, uu)) continue; const int r = F.tid & 255; const GAS f32x4* pp = (const GAS f32x4*)(RSQ_H1 + (size_t)(uu.pm * 256 + r) * 16); float t = 0.f;
#pragma unroll
              for (int k = 0; k < 4; ++k) { const f32x4 p = pp[k]; t += (p[0] + p[1]) + (p[2] + p[3]); }
              RT[i * 256 + r] = 1.0f / sqrtf(t * (1.f / DM) + RMS_EPS); }
          __syncthreads(); }
        pg8::EpiSwiGLU E{BIG, D_FF, RT};
        pg8::gemm_phase<pg8::EpiSwiGLU, pg8::StaticOrder, true, true>(F.lds + RING_OFF, g, S, E);
        if (BOTH(PH_FFN_UP)) GRID_BAR();
    }
    if (IN(PH_FFN_DOWN)) {
        pg8::Gemm g{BIG, WF_OUT, MROWS, DM, D_FF, D_FF, 0, nullptr, 0, nullptr, 0}; pg8::StaticOrder S; S.init(MROWS, DM, F.G, (int)blockIdx.x);
        pg8::EpiResBf<true> E{HB, XN, RSQ_H1, DM};
        pg8::gemm_phase<pg8::EpiResBf<true>, pg8::StaticOrder, true, true>(F.lds + RING_OFF, g, S, E);
        if (BOTH(PH_FFN_DOWN)) GRID_BAR();
    }
    if (IN(PH_KVQ)) {
        LAS float* HG = (LAS float*)(F.lds + LDSCTL_OFF + 1024);
        LAS float* RT = (LAS float*)(F.lds + LDSCTL_OFF + 4096);
        pg8::StaticOrder S; S.init(MROWS, 4 * DM, F.G, (int)blockIdx.x);
        __syncthreads();
        if (F.tid < 64) HG[F.tid] = args.in[I_K_NORM_G][F.tid]; else if (F.tid < 128) HG[F.tid] = args.in[I_Q_NORM_G][F.tid - 64] * attn_body::C2;
        { pg8::Unit uu;
          for (int i0 = 0; i0 < 12; i0 += 2) { const int i = i0 + (F.tid >> 8); if (!S.next(i, uu)) continue; const int r = F.tid & 255; const GAS f32x4* pp = (const GAS f32x4*)(RSQ_H1 + (size_t)(uu.pm * 256 + r) * 16); float t = 0.f;
#pragma unroll
              for (int k = 0; k < 4; ++k) { const f32x4 p = pp[k]; t += (p[0] + p[1]) + (p[2] + p[3]); }
              RT[i * 256 + r] = 1.0f / sqrtf(t * (1.f / DM) + RMS_EPS); } }
        { const int L15 = F.lane & 15, KQ = F.lane >> 4; const size_t row0 = (size_t)F.vcu * 128 + F.wave * 16;
          if (row0 < MROWS) {
              const bf16* ap = XN + (row0 + L15) * DM + 8 * KQ; const bf16* bp = WF16 + (size_t)L15 * DM + 8 * KQ; f32x4 fa = (f32x4){0.f, 0.f, 0.f, 0.f};
#pragma unroll
              for (int jb = 0; jb < 4; ++jb) { bf16x8 af[8], bfr[8];
#pragma unroll
                  for (int j = 0; j < 8; ++j) { af[j] = *(const GAS bf16x8*)(ap + 32 * (8 * jb + j)); bfr[j] = *(const GAS bf16x8*)(bp + 32 * (8 * jb + j)); }
#pragma unroll
                  for (int j = 0; j < 8; ++j) fa = __builtin_amdgcn_mfma_f32_16x16x32_bf16(af[j], bfr[j], fa, 0, 0, 0); }
#pragma unroll
              for (int e = 0; e < 4; ++e) { const size_t row = row0 + 4 * KQ + e; const GAS f32x4* pp = (const GAS f32x4*)(RSQ_H1 + row * 16); float t = 0.f;
#pragma unroll
                  for (int k = 0; k < 4; ++k) { const f32x4 p = pp[k]; t += (p[0] + p[1]) + (p[2] + p[3]); }
                  FG[row * NHEAD + L15] = fa[e] * (1.0f / sqrtf(t * (1.f / DM) + RMS_EPS)); } } }
        __syncthreads();
        { pg8::Gemm g{XN, WKV, MROWS, 4 * DM, DM, DM, 0, nullptr, 0, nullptr, 0};
          pg8::EpiHead4 E{KB, (size_t)MROWS * DM, HG, RMS_EPS, RT};
          pg8::gemm_phase<pg8::EpiHead4, pg8::StaticOrder, true, true>(F.lds + RING_OFF, g, S, E); }
        if (BOTH(PH_KVQ)) GRID_BAR();
    }
    if (IN(PH_ATTN)) {
        __syncthreads();
        for (int bh = F.vcu; bh < BATCH * NHEAD; bh += F.G) attn_body::scan_bias_table((char*)lds + RING_OFF, FG, args.in[I_KV_B_F], bh, (attn_body::u32x4*)(ws + WS_FBT));
        asm volatile("s_waitcnt vmcnt(0)" ::: "memory"); __syncthreads();
        const attn_body::AttnTensors AT{(const attn_body::bf16*)QB, (const attn_body::bf16*)KB, (const attn_body::bf16*)VB, (const attn_body::bf16*)GB, (attn_body::bf16*)QB, (const attn_body::u32x4*)(ws + WS_FBT)};
        const attn_body::StaticOrder AS{F.vcu, F.G}; attn_body::attn_phase<attn_body::StaticOrder>((char*)lds + RING_OFF, AT, AS);
        if (BOTH(PH_ATTN)) GRID_BAR();
    }
    if (IN(PH_OPROJ)) {
        pg8::Gemm g{QB, WBOUT, MROWS, DM, DM, DM, 0, nullptr, 0, nullptr, 0}; pg8::StaticOrder S; S.init(MROWS, DM, F.G, (int)blockIdx.x);
        pg8::EpiResBf<true> E{XN, HB, nullptr, DM};
        pg8::gemm_phase<pg8::EpiResBf<true>, pg8::StaticOrder, true, true>(F.lds + RING_OFF, g, S, E);
        if (BOTH(PH_OPROJ)) GRID_BAR();
    }
    if (IN(PH_ROUTER)) {
        LAS float* Wr = (LAS float*)(F.lds + RING_OFF);
        LAS unsigned* CNTL = (LAS unsigned*)(F.lds + RING_OFF + 65536); LAS unsigned* RREC = CNTL + 64;
        if (F.tid < 16) CNTL[F.tid] = 0u;
        __syncthreads();
        for (int idx = F.tid; idx < DM * NEXP; idx += NWAVES * 64) { const int c = idx & 3, ln = (idx >> 2) & 63, q = (idx >> 8) & 1, kk = idx >> 9, k = 4 * ln + 256 * (kk >> 2) + (kk & 3);
            Wr[idx] = args.in[I_M_W_ROUTER][(size_t)k * NEXP + 4 * q + c]; }
        __syncthreads();
        ROW_LOOP_BEGIN(HB)
            { GAS unsigned* o8 = (GAS unsigned*)((GAS unsigned char*)XN + (size_t)m * DM) + F.lane;
#pragma unroll
              for (int j = 0; j < 4; ++j) { unsigned w = 0u; w = __builtin_amdgcn_cvt_pk_fp8_f32(v[j].x, v[j].y, w, false); w = __builtin_amdgcn_cvt_pk_fp8_f32(v[j].z, v[j].w, w, true); o8[64 * j] = w; } }
            float a[NEXP];
#pragma unroll
            for (int h = 0; h < NEXP; ++h) a[h] = 0.f;
            const GAS f32x4* gr = (const GAS f32x4*)args.in[I_M_NORM_G] + F.lane;
#pragma unroll
            for (int j = 0; j < 4; ++j) { const f32x4 s4 = (v[j] * r) * gr[64 * j];
#pragma unroll
                for (int e = 0; e < 4; ++e) { const float sk = s4[e];
#pragma unroll
                    for (int q = 0; q < 2; ++q) { const f32x4 w = *(const LAS f32x4*)(Wr + (((4 * j + e) * 2 + q) * 64 + F.lane) * 4); a[4 * q] += sk * w.x; a[4 * q + 1] += sk * w.y; a[4 * q + 2] += sk * w.z; a[4 * q + 3] += sk * w.w; } } }
            { const float mine = wave_tr_reduce<8>(a, F.lane);
#pragma unroll
              for (int h = 0; h < NEXP; ++h) a[h] = __shfl(mine, h); }
            int i1 = 0; float v1 = a[0];
#pragma unroll
            for (int h = 1; h < NEXP; ++h) if (a[h] > v1) { v1 = a[h]; i1 = h; }
            int i2 = -1; float v2 = -INFINITY;
#pragma unroll
            for (int h = 0; h < NEXP; ++h) if (h != i1 && a[h] > v2) { v2 = a[h]; i2 = h; }
            const float e2 = expf(v2 - v1), w1 = 1.0f / (1.0f + e2), w2 = e2 / (1.0f + e2);
            if (F.lane == 0) { const int k = (m - gw) / NGW; LAS unsigned* rec = RREC + (F.wave * 16 + k) * 8;
                const unsigned p1 = __hip_atomic_fetch_add(CNTL + i1, 1u, __ATOMIC_RELAXED, __HIP_MEMORY_SCOPE_WORKGROUP), p2 = __hip_atomic_fetch_add(CNTL + i2, 1u, __ATOMIC_RELAXED, __HIP_MEMORY_SCOPE_WORKGROUP);
                rec[0] = (unsigned)i1; rec[1] = p1; rec[2] = __float_as_uint(w1); rec[3] = (unsigned)i2; rec[4] = p2; rec[5] = __float_as_uint(w2); rec[6] = (unsigned)m; rec[7] = __float_as_uint(r); } ROW_LOOP_END
        __syncthreads();
        if (F.tid < NEXP) CNTL[8 + F.tid] = __hip_atomic_fetch_add(F.ctl + CW_CNT + F.tid, CNTL[F.tid], __ATOMIC_RELAXED, __HIP_MEMORY_SCOPE_AGENT);
        __syncthreads();
        if (F.lane < 16) { const int m = gw + F.lane * NGW; if (m < MROWS) { const LAS unsigned* rec = RREC + (F.wave * 16 + F.lane) * 8;
#pragma unroll
            for (int k = 0; k < 2; ++k) { const unsigned e = rec[3 * k], p = CNTL[8 + e] + rec[3 * k + 1]; ELIST[(size_t)e * MROWS + p] = rec[6] * 2u + (unsigned)k; EWL[(size_t)e * MROWS + p] = __uint_as_float(rec[3 * k + 2]); ERS[(size_t)e * MROWS + p] = rec[7]; } } }
        if (BOTH(PH_ROUTER)) GRID_BAR();
    }
    pg8::GroupedOrder GS; int ecnt[NEXP];
    if (hi > PH_ROUTER) { GS.ts[0] = 0;
#pragma unroll
        for (int e = 0; e < NEXP; ++e) { ecnt[e] = (int)__builtin_amdgcn_readfirstlane(__hip_atomic_load(F.ctl + CW_CNT + e, RLX_AGENT)); GS.cnt[e] = ecnt[e]; GS.ts[e + 1] = GS.ts[e] + (ecnt[e] + 255) / 256; } GS.cap = MROWS; }
    const int NT = GS.ts[NEXP];
    if (IN(PH_MOE_UP)) {
        for (int sl = gw * 64 + F.lane; sl < NT * 256; sl += NGW * 64) { const int tile = sl >> 8; const int e = GS.expert(tile);
            int cnt_e = GS.cnt[0], ts_e = 0;
#pragma unroll
            for (int k = 1; k < NEXP; ++k) { cnt_e = (e == k) ? GS.cnt[k] : cnt_e; ts_e = (e == k) ? GS.ts[k] : ts_e; }
            const int p = sl - ts_e * 256;
            IDL[sl] = 2u * (unsigned)sl;
            if (p < cnt_e) { const unsigned ent = ELIST[(size_t)e * MROWS + p]; GW[sl] = EWL[(size_t)e * MROWS + p]; TOKSLOT[ent] = (unsigned)sl; } else GW[sl] = 0.f; }
        pg8::Gemm g{XN, WM_IN, NT * 256, 2 * D_EXP, DM / 2, DM / 2, (size_t)2 * D_EXP * DM, ELIST, 0, ERS, W8_SCALE_E8M0}; GS.init(NT * 256, 2 * D_EXP, F.G, (int)blockIdx.x);
        pg8::EpiSwiGLU8q E{(unsigned char*)ACT, D_EXP};
        pg8::gemm_phase_f8q<pg8::EpiSwiGLU8q, pg8::GroupedOrder>(F.lds + RING_OFF, g, GS, E, (LAS unsigned*)(F.lds + LDSCTL_OFF + 2048));
        if (BOTH(PH_MOE_UP)) GRID_BAR();
    }
    const int DU = NT * 4, DLIM = (DU / F.G) * F.G, DTS = 2, DKP = D_EXP / DTS;
    if (IN(PH_MOE_DOWN)) {
        { pg8::DownMainQ DM_; (pg8::GroupedOrder&)DM_ = GS; DM_.init(NT * 256, DM, F.G, (int)blockIdx.x); DM_.v = F.vcu; DM_.lim = DLIM < DU ? DLIM : DU;
          pg8::Gemm g{ACT, WM_OUT, NT * 256, DM, D_EXP / 2, D_EXP / 2, (size_t)DM * D_EXP, IDL, 0, (const unsigned*)GW, W8_SCALE_E8M0};
          pg8::EpiY8q E{YB, DM, 0};
          pg8::gemm_phase_f8q<pg8::EpiY8q, pg8::DownMainQ>(F.lds + RING_OFF, g, DM_, E, (LAS unsigned*)(F.lds + LDSCTL_OFF + 2048)); }
        if (DU > DLIM) {
            pg8::DownTailQ DT_; (pg8::GroupedOrder&)DT_ = GS; DT_.init(NT * 256, DM, F.G, (int)blockIdx.x); DT_.v = F.vcu; DT_.lim = DLIM; DT_.S = DTS; DT_.ntask = (DU - DLIM) * DTS;
            pg8::Gemm g{ACT, WM_OUT, NT * 256, DM, DKP / 2, D_EXP / 2, (size_t)DM * D_EXP, IDL, D_EXP / 2, (const unsigned*)GW, W8_SCALE_E8M0};
            pg8::EpiY8q E{YP - (size_t)(DLIM / 4) * 256 * DM, DM, (size_t)YP_ROWS * DM};
            pg8::gemm_phase_f8q<pg8::EpiY8q, pg8::DownTailQ>(F.lds + RING_OFF, g, DT_, E, (LAS unsigned*)(F.lds + LDSCTL_OFF + 2048));
        }
        if (BOTH(PH_MOE_DOWN)) GRID_BAR();
    }
    if (IN(PH_COMBINE)) {
        const unsigned tail0 = (unsigned)(DLIM / 4) * 256u;
#define CB_YBASE(sl) ((((DU > DLIM) && (sl) >= tail0) ? YP + (size_t)((sl) - tail0) * DM : YB + (size_t)(sl) * DM))
#define CB_LOAD(hd, yd, mm, sa, sb) do { const GAS v4u* hp_ = (const GAS v4u*)(HB + (size_t)(mm) * DM) + F.lane; const GAS v4u* ya_ = (const GAS v4u*)CB_YBASE(sa) + F.lane; const GAS v4u* yb_ = (const GAS v4u*)CB_YBASE(sb) + F.lane; \
            _Pragma("unroll") for (int j = 0; j < 2; ++j) { hd[j] = hp_[64 * j]; yd[j] = ya_[64 * j]; yd[2 + j] = yb_[64 * j]; } } while (0)
        unsigned sa0 = 0, sa1 = 0, sb0 = 0, sb1 = 0; v4u hn[2]; v4u yn[4];
        if (gw < MROWS) { sa0 = TOKSLOT[2 * gw]; sa1 = TOKSLOT[2 * gw + 1]; if (gw + NGW < MROWS) { sb0 = TOKSLOT[2 * (gw + NGW)]; sb1 = TOKSLOT[2 * (gw + NGW) + 1]; } CB_LOAD(hn, yn, gw, sa0, sa1); }
        for (int m = gw; m < MROWS; m += NGW) {
            f32x4 h[4]; v4u y[4]; const unsigned s0 = sa0, s1 = sa1;
#pragma unroll
            for (int j = 0; j < 2; ++j) { const v4u a = hn[j]; h[2 * j] = (f32x4){bflo(a.x), bfhi(a.x), bflo(a.y), bfhi(a.y)}; h[2 * j + 1] = (f32x4){bflo(a.z), bfhi(a.z), bflo(a.w), bfhi(a.w)}; }
#pragma unroll
            for (int j = 0; j < 4; ++j) y[j] = yn[j];
            sa0 = sb0; sa1 = sb1;
            if (m + 2 * NGW < MROWS) { sb0 = TOKSLOT[2 * (m + 2 * NGW)]; sb1 = TOKSLOT[2 * (m + 2 * NGW) + 1]; }
            if (m + NGW < MROWS) CB_LOAD(hn, yn, m + NGW, sa0, sa1);
#pragma unroll
            for (int k = 0; k < 2; ++k) {
#pragma unroll
                for (int j = 0; j < 2; ++j) { const v4u a = y[2 * k + j];
                    h[2 * j].x += bflo(a.x); h[2 * j].y += bfhi(a.x); h[2 * j].z += bflo(a.y); h[2 * j].w += bfhi(a.y); h[2 * j + 1].x += bflo(a.z); h[2 * j + 1].y += bfhi(a.z); h[2 * j + 1].z += bflo(a.w); h[2 * j + 1].w += bfhi(a.w); }
                const unsigned sl = k ? s1 : s0;
                if ((DU > DLIM) && sl >= tail0) {
                    for (int p = 1; p < DTS; ++p) { const GAS v4u* yp = (const GAS v4u*)(YP + (size_t)(sl - tail0) * DM + (size_t)p * YP_ROWS * DM) + F.lane;
#pragma unroll
                        for (int j = 0; j < 2; ++j) { const v4u a = yp[64 * j];
                            h[2 * j].x += bflo(a.x); h[2 * j].y += bfhi(a.x); h[2 * j].z += bflo(a.y); h[2 * j].w += bfhi(a.y); h[2 * j + 1].x += bflo(a.z); h[2 * j + 1].y += bfhi(a.z); h[2 * j + 1].z += bflo(a.w); h[2 * j + 1].w += bfhi(a.w); } } } }
            GAS f32x4* hp = (GAS f32x4*)(H + (size_t)m * DM) + 2 * F.lane;
#pragma unroll
            for (int j = 0; j < 2; ++j) { hp[128 * j] = h[2 * j]; hp[128 * j + 1] = h[2 * j + 1]; } }
#undef CB_YBASE
#undef CB_LOAD
    }
#undef IN
#undef BOTH
}

extern "C" void kernel_launch(void* const* d_in, const int* in_sizes, int n_in, void* d_out, int out_size, void* d_ws, size_t ws_size, hipStream_t stream) {
    static int grid = 0;
    if (grid == 0) {
        if (n_in != N_IN || in_sizes[0] != MROWS * DM || out_size != MROWS * DM || ws_size < WS_END) { fprintf(stderr, "kernel_launch: unexpected shapes / workspace (n_in %d, in0 %d, out %d, ws %zu < %zu)\n", n_in, n_in > 0 ? in_sizes[0] : -1, out_size, ws_size, (size_t)WS_END); grid = -1; return; }
        int dev = 0, cus = 0, per_cu = 0;
        if (hipGetDevice(&dev) != hipSuccess || hipDeviceGetAttribute(&cus, hipDeviceAttributeMultiprocessorCount, dev) != hipSuccess) { grid = -1; return; }
        if (hipFuncSetAttribute((const void*)yoco_fwd, hipFuncAttributeMaxDynamicSharedMemorySize, LDS_BYTES) != hipSuccess) { fprintf(stderr, "kernel_launch: hipFuncSetAttribute failed\n"); grid = -1; return; }
        if (hipOccupancyMaxActiveBlocksPerMultiprocessor(&per_cu, (const void*)yoco_fwd, NWAVES * 64, LDS_BYTES) != hipSuccess || per_cu < 1) fprintf(stderr, "kernel_launch: occupancy query reports %d\n", per_cu);
        (void)hipGetLastError();
        if (cus != 256) { fprintf(stderr, "kernel_launch: built for a 256-CU device (got %d)\n", cus); grid = -1; return; }
        grid = cus;
    }
    if (grid < 0) return;
    if (hipMemsetAsync((char*)d_ws + WS_CTL, 0, CTL_ZERO_BYTES, stream) != hipSuccess) return;
    Args a{};
    for (int i = 0; i < N_IN; ++i) a.in[i] = (const float*)d_in[i];
    a.out = (float*)d_out; a.ws = (unsigned char*)d_ws;
#if MK_ONE_LAUNCH
    a.ph_lo = 0; a.ph_hi = MK_PH_STOP; a.li = 0;
    hipLaunchKernelGGL(yoco_fwd, dim3(grid), dim3(NWAVES * 64), LDS_BYTES, stream, a);
#else
    for (int p = 0; p < MK_PH_STOP; ++p) { a.ph_lo = p; a.ph_hi = p + 1; a.li = 0; hipLaunchKernelGGL(yoco_fwd, dim3(grid), dim3(NWAVES * 64), LDS_BYTES, stream, a); }
#endif
}
```

```cpp
#include <hip/hip_runtime.h>
#include <hip/hip_bf16.h>
#include <cstdio>
#include <cstdint>
#include <cmath>
namespace pg8 {
#define PG8_LAS __attribute__((address_space(3)))
typedef unsigned short bf16_t;
typedef short bf16x8 __attribute__((ext_vector_type(8)));
typedef float f32x4 __attribute__((ext_vector_type(4)));
typedef unsigned u32x4 __attribute__((ext_vector_type(4)));
constexpr int BM = 256, BK = 64, HALF = 128, HTB = HALF * BK * 2  , STAGE_BYTES = 8 * HTB, NXCD = 8, WGM = 8;

__host__ __device__ __forceinline__ int lds_byte(int r, int c) { const int st = (r >> 4) * 2 + (c >> 5), rr = r & 15, cc = c & 31, ob = rr * 64 + cc * 2; return st * 1024 + (ob ^ (((ob >> 9) & 1) << 5)); }
__host__ __device__ __forceinline__ void stage_rc(int b, int& R, int& C) { const int st = b / 1024, sb = b % 1024, swz = sb ^ (((sb >> 9) & 1) << 5); R = (st >> 1) * 16 + swz / 64; C = (st & 1) * 32 + (swz % 64) / 2; }
__host__ __device__ __forceinline__ int perm32(int rho) { const int n = rho >> 4, i = rho & 15; return 8 * (i >> 2) + 4 * n + (i & 3); }

struct Unit { int pm, pn, kp; };
struct Gemm { const bf16_t* A; const bf16_t* Bt; int M, N, K, lda; size_t bstride; const unsigned* rowlist; int ldb; const unsigned* wlist; int scale_b; };

struct StaticOrder {
    int nM, nN, nwg, G, c;
    __host__ __device__ __forceinline__ void init(int M, int N, int G_, int c_) { nM = M / BM; nN = N / BM; nwg = nM * nN; G = G_; c = c_; }
    __host__ __device__ __forceinline__ bool next(int i, Unit& u) const {
        const long L = (long)i * G + c; if (L >= nwg) return false;
        int wgid = (int)L; { const int q = nwg / NXCD, r = nwg % NXCD, xcd = wgid % NXCD, off = wgid / NXCD; wgid = (xcd < r ? xcd * (q + 1) : r * (q + 1) + (xcd - r) * q) + off; }
        const int nig = WGM * nN, gid = wgid / nig, fm = gid * WGM, gsz = (nM - fm) < WGM ? (nM - fm) : WGM;
        u.pm = fm + ((wgid % nig) % gsz); u.pn = (wgid % nig) / gsz; u.kp = 0; return true;
    }
    __device__ __forceinline__ void a_ready(const Unit&) const {}
    __device__ __forceinline__ void done(const Unit&) const {}
    __device__ __forceinline__ int expert(int) const { return 0; }
    __device__ __forceinline__ size_t kbytes(const Unit&, int) const { return 0; }
    __device__ __forceinline__ int listoff(int) const { return 0; }
    __device__ __forceinline__ int rows(int) const { return 256; }
};
struct GroupedOrder : StaticOrder {
    int ts[9], cnt[8], cap;
    __device__ __forceinline__ int listoff(int pm) const { const int e = expert(pm); int t0 = 0;
#pragma unroll
        for (int k = 1; k < 8; ++k) t0 = (e == k) ? ts[k] : t0;
        return e * cap + (pm - t0) * 256; }
    __device__ __forceinline__ int rows(int pm) const { const int e = expert(pm); int t0 = 0, c = cnt[0];
#pragma unroll
        for (int k = 1; k < 8; ++k) { t0 = (e == k) ? ts[k] : t0; c = (e == k) ? cnt[k] : c; }
        const int r = c - (pm - t0) * 256; return r < 0 ? 0 : (r > 256 ? 256 : r); }
    __device__ __forceinline__ int expert(int pm) const { int e = 0;
#pragma unroll
        for (int k = 1; k < 8; ++k) e += (pm >= ts[k]) ? 1 : 0;
        return e; }
};

__device__ __forceinline__ unsigned cvt_pk_bf16(float lo, float hi) { unsigned r; asm volatile("v_cvt_pk_bf16_f32 %0, %1, %2" : "=v"(r) : "v"(lo), "v"(hi)); return r; }
typedef float f32x2 __attribute__((ext_vector_type(2)));
__device__ __forceinline__ f32x2 gelu_pk(f32x2 v) {
    const f32x2 av = __builtin_elementwise_abs(v), d = av * 0.2316418882f + 1.0f;
    f32x2 t; t.x = __builtin_amdgcn_rcpf(d.x); t.y = __builtin_amdgcn_rcpf(d.y);
    f32x2 q = t * 0.5307027145f + (-0.7265760135f); q = q * t + 0.7107068705f; q = q * t + (-0.142248368f); q = q * t + 0.127414796f; q = q * t;
    const f32x2 s = (v * v) * (-0.72134752044f);
    f32x2 e; e.x = __builtin_amdgcn_exp2f(s.x); e.y = __builtin_amdgcn_exp2f(s.y);
    const f32x2 m = v * (q * e), r = v - m;
    f32x2 o; o.x = v.x < 0.f ? m.x : r.x; o.y = v.y < 0.f ? m.y : r.y; return o;
}
constexpr float GELU_K = 0.84932180f;
__device__ __forceinline__ void gelu_w_pk4(const f32x2 (&w)[4], f32x2 (&o)[4]) {
    constexpr float C[9] = {5.886622071e-01f, -5.522741079e-01f, 4.032063782e-01f, -2.406371087e-01f, 1.149394065e-01f, -4.112898186e-02f, 1.002788637e-02f, -1.450342475e-03f, 9.243155364e-05f};
    f32x2 y[4], p[4], e[4];
#pragma unroll
    for (int i = 0; i < 4; ++i) { y[i].x = __builtin_fabsf(w[i].x); y[i].y = __builtin_fabsf(w[i].y); }
#pragma unroll
    for (int i = 0; i < 4; ++i) p[i] = y[i] * C[8] + C[7];
#pragma unroll
    for (int c = 6; c >= 0; --c)
#pragma unroll
        for (int i = 0; i < 4; ++i) p[i] = p[i] * y[i] + C[c];
#pragma unroll
    for (int i = 0; i < 4; ++i) { const f32x2 s = w[i] * w[i]; e[i].x = __builtin_amdgcn_exp2f(-s.x); e[i].y = __builtin_amdgcn_exp2f(-s.y); }
#pragma unroll
    for (int i = 0; i < 4; ++i) { const f32x2 h = 0.588705011f - p[i] * e[i]; o[i] = w[i] * 0.588705011f + y[i] * h; }
}

template <int ACT  > struct EpiBf16 {
    static constexpr bool PERM = true, AFTER_DRAIN = false; static_assert(ACT == 0 || ACT == 1, "EpiBf16: ACT is 0 (none) or 1 (gelu_pk)");
    bf16_t* O; int ldc; const float* bias; int split_cols; size_t split_stride; float scale0;
    __device__ __forceinline__ void operator()(const f32x4 (&acc)[2][2][4][2], const Unit& u, int wr, int wc, int fr, int fq, int ui = 0, const PG8_LAS unsigned* tab = nullptr) const {
        const int row0 = u.pm * BM + wr * 64 + fr; int colt = u.pn * BM; bf16_t* base = O;
        float sc = 1.f; if (split_cols) { const int t = colt / split_cols; base += (size_t)t * split_stride; colt -= t * split_cols; if (t == 0) sc = scale0; }
        const int col0 = colt + wc * 32 + 8 * fq, bcol0 = u.pn * BM + wc * 32 + 8 * fq;
        f32x4 bv[2][2];
#pragma unroll
        for (int bj = 0; bj < 2; ++bj)
#pragma unroll
            for (int n = 0; n < 2; ++n) bv[bj][n] = bias ? *(const f32x4*)(bias + bcol0 + bj * HALF + 4 * n) : (f32x4){0.f, 0.f, 0.f, 0.f};
#pragma unroll
        for (int ai = 0; ai < 2; ++ai)
#pragma unroll
            for (int m = 0; m < 4; ++m) { bf16_t* rowp = base + (size_t)(row0 + ai * HALF + m * 16) * ldc + col0;
#pragma unroll
                for (int bj = 0; bj < 2; ++bj) { f32x4 v0 = acc[ai][bj][m][0] + bv[bj][0], v1 = acc[ai][bj][m][1] + bv[bj][1];
                    if (ACT == 1) { f32x2 a = gelu_pk((f32x2){v0[0], v0[1]}), b = gelu_pk((f32x2){v0[2], v0[3]}), c = gelu_pk((f32x2){v1[0], v1[1]}), d = gelu_pk((f32x2){v1[2], v1[3]});
                        v0 = (f32x4){a.x, a.y, b.x, b.y}; v1 = (f32x4){c.x, c.y, d.x, d.y}; }
                    v0 = v0 * sc; v1 = v1 * sc; u32x4 w; w.x = cvt_pk_bf16(v0[0], v0[1]); w.y = cvt_pk_bf16(v0[2], v0[3]); w.z = cvt_pk_bf16(v1[0], v1[1]); w.w = cvt_pk_bf16(v1[2], v1[3]);
                    *(u32x4*)(rowp + bj * HALF) = w; } }
    }
};


struct DownMain : GroupedOrder {
    int v, lim;
    __device__ __forceinline__ bool next(int i, Unit& u) const { const int L = i * G + v; if (L >= lim) return false; u.pm = L >> 2; u.pn = L & 3; u.kp = 0; return true; }
};
struct DownTail : GroupedOrder {
    int v, lim, ntask, S;
    __device__ __forceinline__ bool next(int i, Unit& u) const { const int t = i * G + v; if (t >= ntask) return false; const int L = lim + t / S; u.pm = L >> 2; u.pn = L & 3; u.kp = t % S; return true; }
    __device__ __forceinline__ size_t kbytes(const Unit& u, int K) const { return (size_t)u.kp * K * 2; }
};
struct DownMainQ : DownMain { __device__ __forceinline__ int listoff(int pm) const { return pm * 256; } __device__ __forceinline__ int rows(int) const { return 256; } };
struct DownTailQ : DownTail { __device__ __forceinline__ int listoff(int pm) const { return pm * 256; } __device__ __forceinline__ int rows(int) const { return 256; } };
struct DownMain8 : GroupedOrder {
    int v, lim;
    __device__ __forceinline__ bool next(int i, Unit& u) const { const int L = i * G + v; if (L >= lim) return false; u.pm = L >> 3; u.pn = L & 7; u.kp = 0; return true; }
    __device__ __forceinline__ int listoff(int pm) const { return pm * 256; }
    __device__ __forceinline__ int rows(int) const { return 256; }
};
struct DownTail8 : GroupedOrder {
    int v, lim, ntask, S;
    __device__ __forceinline__ bool next(int i, Unit& u) const { const int t = i * G + v; if (t >= ntask) return false; const int L = lim + t / S; u.pm = L >> 3; u.pn = L & 7; u.kp = t % S; return true; }
    __device__ __forceinline__ size_t kbytes(const Unit& u, int K) const { return (size_t)u.kp * K * 2; }
    __device__ __forceinline__ int listoff(int pm) const { return pm * 256; }
    __device__ __forceinline__ int rows(int) const { return 256; }
};
struct EpiF32Res {
    static constexpr bool PERM = false, AFTER_DRAIN = false;
    const float* base; float* out; int ldc; const float* gate; int gstride;
    __device__ __forceinline__ void operator()(const f32x4 (&acc)[2][2][4][2], const Unit& u, int wr, int wc, int fr, int fq, int ui = 0, const PG8_LAS unsigned* tab = nullptr) const {
        const int row0 = u.pm * BM + wr * 64 + fr, col0 = u.pn * BM + wc * 32 + 4 * fq;
#pragma unroll
        for (int ai = 0; ai < 2; ++ai) {
            f32x4 bs[4][2][2];
#pragma unroll
            for (int m = 0; m < 4; ++m) { const size_t off = (size_t)(row0 + ai * HALF + m * 16) * ldc + col0;
#pragma unroll
                for (int bj = 0; bj < 2; ++bj)
#pragma unroll
                    for (int n = 0; n < 2; ++n) bs[m][bj][n] = *(const f32x4*)(base + off + bj * HALF + n * 16); }
#pragma unroll
            for (int m = 0; m < 4; ++m) { const int row = row0 + ai * HALF + m * 16; const size_t off = (size_t)row * ldc + col0;
                const float gs = gate ? gate[(size_t)row * gstride] : 1.0f;
#pragma unroll
                for (int bj = 0; bj < 2; ++bj)
#pragma unroll
                    for (int n = 0; n < 2; ++n) *(f32x4*)(out + off + bj * HALF + n * 16) = bs[m][bj][n] + acc[ai][bj][m][n] * gs; }
            asm volatile("" ::: "memory"); }
    }
};
__device__ __forceinline__ float part16_rstd(const float* part, int row, int fq, float inv_n, float eps) {
    const f32x4 p = *(const f32x4*)(part + (size_t)row * 16 + 4 * fq); float t = (p[0] + p[1]) + (p[2] + p[3]); t += __shfl_xor(t, 16); t += __shfl_xor(t, 32); return 1.0f / sqrtf(t * inv_n + eps); }
template <bool BASE_BF16> struct EpiResBf {
    static constexpr bool PERM = true, AFTER_DRAIN = false;
    const void* base; bf16_t* hb; float* part; int ldc;
    __device__ __forceinline__ void operator()(const f32x4 (&acc)[2][2][4][2], const Unit& u, int wr, int wc, int fr, int fq, int ui = 0, const PG8_LAS unsigned* tab = nullptr) const {
        const int row0 = u.pm * BM + wr * 64 + fr, col0 = u.pn * BM + wc * 32 + 8 * fq;
#pragma unroll
        for (int ai = 0; ai < 2; ++ai) {
            f32x4 bs[4][2][2];
#pragma unroll
            for (int m = 0; m < 4; ++m) { const size_t off = (size_t)(row0 + ai * HALF + m * 16) * ldc + col0;
#pragma unroll
                for (int bj = 0; bj < 2; ++bj) {
                    if (BASE_BF16) { const u32x4 w = *(const u32x4*)((const bf16_t*)base + off + bj * HALF);
                        bs[m][bj][0] = (f32x4){__uint_as_float(w.x << 16), __uint_as_float(w.x & 0xffff0000u), __uint_as_float(w.y << 16), __uint_as_float(w.y & 0xffff0000u)};
                        bs[m][bj][1] = (f32x4){__uint_as_float(w.z << 16), __uint_as_float(w.z & 0xffff0000u), __uint_as_float(w.w << 16), __uint_as_float(w.w & 0xffff0000u)}; }
                    else { bs[m][bj][0] = *(const f32x4*)((const float*)base + off + bj * HALF); bs[m][bj][1] = *(const f32x4*)((const float*)base + off + bj * HALF + 4); } } }
#pragma unroll
            for (int m = 0; m < 4; ++m) { const int row = row0 + ai * HALF + m * 16; const size_t off = (size_t)row * ldc + col0; float ss = 0.f;
#pragma unroll
                for (int bj = 0; bj < 2; ++bj) { const f32x4 o0 = bs[m][bj][0] + acc[ai][bj][m][0], o1 = bs[m][bj][1] + acc[ai][bj][m][1];
                    ss += ((o0[0] * o0[0] + o0[1] * o0[1]) + (o0[2] * o0[2] + o0[3] * o0[3])) + ((o1[0] * o1[0] + o1[1] * o1[1]) + (o1[2] * o1[2] + o1[3] * o1[3]));
                    u32x4 w; w.x = cvt_pk_bf16(o0[0], o0[1]); w.y = cvt_pk_bf16(o0[2], o0[3]); w.z = cvt_pk_bf16(o1[0], o1[1]); w.w = cvt_pk_bf16(o1[2], o1[3]); *(u32x4*)(hb + off + bj * HALF) = w; }
                if (part) { ss += __shfl_xor(ss, 16); ss += __shfl_xor(ss, 32); if (fq == 0) part[(size_t)row * 16 + 4 * u.pn + wc] = ss; } }
            asm volatile("" ::: "memory"); }
    }
};
struct EpiGeluSq {
    static constexpr bool PERM = true, AFTER_DRAIN = false;
    bf16_t* O; int ldc; float* vpart; int pn_sq; const PG8_LAS float* rtab;
    __device__ __forceinline__ void operator()(const f32x4 (&acc)[2][2][4][2], const Unit& u, int wr, int wc, int fr, int fq, int ui = 0, const PG8_LAS unsigned* tab = nullptr) const {
        const int row0 = u.pm * BM + wr * 64 + fr, col0 = u.pn * BM + wc * 32 + 8 * fq; const bool sq = u.pn >= pn_sq;
#pragma unroll
        for (int ai = 0; ai < 2; ++ai)
#pragma unroll
            for (int m = 0; m < 4; ++m) { const int row = row0 + ai * HALF + m * 16; bf16_t* rowp = O + (size_t)row * ldc + col0; f32x2 ss2 = {0.f, 0.f}; const float rr = rtab[ui * 256 + (row - u.pm * BM)] * GELU_K;
#pragma unroll
                for (int bj = 0; bj < 2; ++bj) { const f32x4 v0 = acc[ai][bj][m][0] * rr, v1 = acc[ai][bj][m][1] * rr;
                    const f32x2 wi[4] = {(f32x2){v0[0], v0[1]}, (f32x2){v0[2], v0[3]}, (f32x2){v1[0], v1[1]}, (f32x2){v1[2], v1[3]}}; f32x2 go[4]; gelu_w_pk4(wi, go); const f32x2 a = go[0], b = go[1], c = go[2], d = go[3];
                    if (sq) { ss2 = a * a + ss2; ss2 = b * b + ss2; ss2 = c * c + ss2; ss2 = d * d + ss2; }
                    u32x4 w; w.x = cvt_pk_bf16(a.x, a.y); w.y = cvt_pk_bf16(b.x, b.y); w.z = cvt_pk_bf16(c.x, c.y); w.w = cvt_pk_bf16(d.x, d.y);
                    *(u32x4*)(rowp + bj * HALF) = w; }
                float ss = ss2.x + ss2.y;
                if (sq) { ss += __shfl_xor(ss, 16); ss += __shfl_xor(ss, 32); if (fq == 0) vpart[(size_t)row * 48 + 4 * (u.pn - pn_sq) + wc] = ss; } }
    }
};

struct EpiHead4 {
    static constexpr bool PERM = true, AFTER_DRAIN = false;
    bf16_t* T; size_t tstride; const PG8_LAS float* g; float eps; const PG8_LAS float* rtab;
    __device__ __forceinline__ void operator()(const f32x4 (&acc)[2][2][4][2], const Unit& u, int wr, int wc, int fr, int fq, int ui = 0, const PG8_LAS unsigned* tab = nullptr) const {
        const int row0 = u.pm * BM + wr * 64 + fr, kind = u.pn >> 2; const bool nrm = (kind & 1) == 0; const int col0 = ((u.pn & 3) * 4 + wc) * 64 + 8 * fq;
        bf16_t* base = T + (size_t)kind * tstride;
        f32x4 gg[2][2];
#pragma unroll
        for (int bj = 0; bj < 2; ++bj)
#pragma unroll
            for (int n = 0; n < 2; ++n) gg[bj][n] = *(const PG8_LAS f32x4*)(g + 32 * (kind & 2) + 32 * bj + 8 * fq + 4 * n);
#pragma unroll
        for (int ai = 0; ai < 2; ++ai)
#pragma unroll
            for (int m = 0; m < 4; ++m) { bf16_t* rowp = base + (size_t)(row0 + ai * HALF + m * 16) * 1024 + col0; const float rr = rtab[ui * 256 + ai * HALF + wr * 64 + m * 16 + fr];
                f32x4 v[2][2];
#pragma unroll
                for (int bj = 0; bj < 2; ++bj)
#pragma unroll
                    for (int n = 0; n < 2; ++n) v[bj][n] = acc[ai][bj][m][n] * rr;
                if (nrm) { float ss = 0.f;
#pragma unroll
                    for (int bj = 0; bj < 2; ++bj)
#pragma unroll
                        for (int n = 0; n < 2; ++n) ss += (v[bj][n][0] * v[bj][n][0] + v[bj][n][1] * v[bj][n][1]) + (v[bj][n][2] * v[bj][n][2] + v[bj][n][3] * v[bj][n][3]);
                    ss += __shfl_xor(ss, 16); ss += __shfl_xor(ss, 32);
                    const float rs = 1.0f / sqrtf(ss * (1.0f / 64.0f) + eps);
#pragma unroll
                    for (int bj = 0; bj < 2; ++bj)
#pragma unroll
                        for (int n = 0; n < 2; ++n) v[bj][n] = v[bj][n] * rs * gg[bj][n];
                } else if (kind == 3) {
#pragma unroll
                    for (int bj = 0; bj < 2; ++bj)
#pragma unroll
                        for (int n = 0; n < 2; ++n)
#pragma unroll
                            for (int e = 0; e < 4; ++e) v[bj][n][e] = __builtin_amdgcn_rcpf(1.0f + __builtin_amdgcn_exp2f(-1.4426950408889634f * v[bj][n][e]));
                }
#pragma unroll
                for (int bj = 0; bj < 2; ++bj) { u32x4 w; w.x = cvt_pk_bf16(v[bj][0][0], v[bj][0][1]); w.y = cvt_pk_bf16(v[bj][0][2], v[bj][0][3]); w.z = cvt_pk_bf16(v[bj][1][0], v[bj][1][1]); w.w = cvt_pk_bf16(v[bj][1][2], v[bj][1][3]);
                    *(u32x4*)(rowp + 32 * bj) = w; } }
    }
};
struct EpiBf16RowScale {
    static constexpr bool PERM = true, AFTER_DRAIN = false;
    bf16_t* O; int ldc; const PG8_LAS float* rs; size_t kstride;
    __device__ __forceinline__ void operator()(const f32x4 (&acc)[2][2][4][2], const Unit& u, int wr, int wc, int fr, int fq, int ui = 0, const PG8_LAS unsigned* tab = nullptr) const {
        const int row0 = u.pm * BM + wr * 64 + fr, col0 = u.pn * BM + wc * 32 + 8 * fq;
#pragma unroll
        for (int ai = 0; ai < 2; ++ai)
#pragma unroll
            for (int m = 0; m < 4; ++m) { const int row = row0 + ai * HALF + m * 16; bf16_t* rowp = O + (size_t)u.kp * kstride + (size_t)row * ldc + col0; const float sc = rs[ui * 256 + (row - u.pm * BM)];
#pragma unroll
                for (int bj = 0; bj < 2; ++bj) { const f32x4 v0 = acc[ai][bj][m][0] * sc, v1 = acc[ai][bj][m][1] * sc;
                    u32x4 w; w.x = cvt_pk_bf16(v0[0], v0[1]); w.y = cvt_pk_bf16(v0[2], v0[3]); w.z = cvt_pk_bf16(v1[0], v1[1]); w.w = cvt_pk_bf16(v1[2], v1[3]);
                    *(u32x4*)(rowp + bj * HALF) = w; } }
    }
};
struct EpiSwiGLU {
    static constexpr bool PERM = true, AFTER_DRAIN = false;
    bf16_t* O; int ldc; const PG8_LAS float* rtab;
    static __device__ __forceinline__ float silu(float x) { return x * __builtin_amdgcn_rcpf(1.0f + __builtin_amdgcn_exp2f(-1.4426950408889634f * x)); }
    __device__ __forceinline__ void operator()(const f32x4 (&acc)[2][2][4][2], const Unit& u, int wr, int wc, int fr, int fq, int ui = 0, const PG8_LAS unsigned* tab = nullptr) const {
        const int row0 = u.pm * BM + wr * 64 + fr, col0 = u.pn * HALF + wc * 32 + 8 * fq;
#pragma unroll
        for (int ai = 0; ai < 2; ++ai)
#pragma unroll
            for (int m = 0; m < 4; ++m) { const int row = row0 + ai * HALF + m * 16; bf16_t* rowp = O + (size_t)row * ldc + col0;
                const float rs = rtab ? rtab[ui * 256 + (row - u.pm * BM)] : __uint_as_float(tab[256 + (row - u.pm * BM)]);
                const f32x4 a0 = acc[ai][0][m][0] * rs, a1 = acc[ai][0][m][1] * rs, b0 = acc[ai][1][m][0] * rs, b1 = acc[ai][1][m][1] * rs;
                const f32x4 t0 = a0 * (-1.4426950408889634f), t1 = a1 * (-1.4426950408889634f); f32x4 d0, d1;
#pragma unroll
                for (int e = 0; e < 4; ++e) { d0[e] = __builtin_amdgcn_exp2f(t0[e]); d1[e] = __builtin_amdgcn_exp2f(t1[e]); }
                d0 = d0 + 1.0f; d1 = d1 + 1.0f;
#pragma unroll
                for (int e = 0; e < 4; ++e) { d0[e] = __builtin_amdgcn_rcpf(d0[e]); d1[e] = __builtin_amdgcn_rcpf(d1[e]); }
                const f32x4 y0 = (a0 * b0) * d0, y1 = (a1 * b1) * d1;
                u32x4 w; w.x = cvt_pk_bf16(y0[0], y0[1]); w.y = cvt_pk_bf16(y0[2], y0[3]); w.z = cvt_pk_bf16(y1[0], y1[1]); w.w = cvt_pk_bf16(y1[2], y1[3]);
                *(u32x4*)rowp = w; }
    }
};
struct EpiSwiGLU8q {
    static constexpr bool PERM = true, AFTER_DRAIN = false;
    unsigned char* O; int ldc;
    __device__ __forceinline__ void operator()(const f32x4 (&acc)[2][2][4][2], const Unit& u, int wr, int wc, int fr, int fq, int ui = 0, const PG8_LAS unsigned* tab = nullptr) const {
        const int col0 = u.pn * HALF + wc * 32 + 8 * fq;
#pragma unroll
        for (int ai = 0; ai < 2; ++ai)
#pragma unroll
            for (int m = 0; m < 4; ++m) { const int r = ai * HALF + wr * 64 + m * 16 + fr; const float rs = __uint_as_float(tab[256 + r]);
                const f32x4 a0 = acc[ai][0][m][0] * rs, a1 = acc[ai][0][m][1] * rs, b0 = acc[ai][1][m][0] * rs, b1 = acc[ai][1][m][1] * rs;
                const f32x4 t0 = a0 * (-1.4426950408889634f), t1 = a1 * (-1.4426950408889634f); f32x4 d0, d1;
#pragma unroll
                for (int e = 0; e < 4; ++e) { d0[e] = __builtin_amdgcn_exp2f(t0[e]); d1[e] = __builtin_amdgcn_exp2f(t1[e]); }
                d0 = d0 + 1.0f; d1 = d1 + 1.0f;
#pragma unroll
                for (int e = 0; e < 4; ++e) { d0[e] = __builtin_amdgcn_rcpf(d0[e]); d1[e] = __builtin_amdgcn_rcpf(d1[e]); }
                const f32x4 y0 = (a0 * b0) * d0, y1 = (a1 * b1) * d1; unsigned w0 = 0u, w1 = 0u;
                w0 = __builtin_amdgcn_cvt_pk_fp8_f32(y0[0], y0[1], w0, false); w0 = __builtin_amdgcn_cvt_pk_fp8_f32(y0[2], y0[3], w0, true);
                w1 = __builtin_amdgcn_cvt_pk_fp8_f32(y1[0], y1[1], w1, false); w1 = __builtin_amdgcn_cvt_pk_fp8_f32(y1[2], y1[3], w1, true);
                uint2 w; w.x = w0; w.y = w1; *(uint2*)(O + (size_t)(u.pm * BM + r) * ldc + col0) = w; }
    }
};
struct EpiY8q {
    static constexpr bool PERM = true, AFTER_DRAIN = false;
    bf16_t* O; int ldc; size_t kstride;
    __device__ __forceinline__ void operator()(const f32x4 (&acc)[2][2][4][2], const Unit& u, int wr, int wc, int fr, int fq, int ui = 0, const PG8_LAS unsigned* tab = nullptr) const {
        const int col0 = u.pn * BM + wc * 32 + 8 * fq;
#pragma unroll
        for (int ai = 0; ai < 2; ++ai)
#pragma unroll
            for (int m = 0; m < 4; ++m) { const int r = ai * HALF + wr * 64 + m * 16 + fr; const float sc = __uint_as_float(tab[256 + r]); bf16_t* rowp = O + (size_t)u.kp * kstride + (size_t)(u.pm * BM + r) * ldc + col0;
#pragma unroll
                for (int bj = 0; bj < 2; ++bj) { const f32x4 v0 = acc[ai][bj][m][0] * sc, v1 = acc[ai][bj][m][1] * sc;
                    u32x4 w; w.x = cvt_pk_bf16(v0[0], v0[1]); w.y = cvt_pk_bf16(v0[2], v0[3]); w.z = cvt_pk_bf16(v1[0], v1[1]); w.w = cvt_pk_bf16(v1[2], v1[3]);
                    *(u32x4*)(rowp + bj * HALF) = w; } }
    }
};
constexpr float Y8_SCALE = 16.0f, Y8_INV = 0.0625f;
struct EpiY8q8 {
    static constexpr bool PERM = true, AFTER_DRAIN = false;
    unsigned char* O; int ldc;
    __device__ __forceinline__ void operator()(const f32x4 (&acc)[2][2][4][2], const Unit& u, int wr, int wc, int fr, int fq, int ui = 0, const PG8_LAS unsigned* tab = nullptr) const {
        typedef unsigned u32x2_ __attribute__((ext_vector_type(2)));
        const int col0 = u.pn * BM + wc * 32 + 8 * fq;
#pragma unroll
        for (int ai = 0; ai < 2; ++ai)
#pragma unroll
            for (int m = 0; m < 4; ++m) { const int r = ai * HALF + wr * 64 + m * 16 + fr; const float sc = __uint_as_float(tab[256 + r]) * Y8_SCALE; unsigned char* rowp = O + (size_t)(u.pm * BM + r) * ldc + col0;
#pragma unroll
                for (int bj = 0; bj < 2; ++bj) { const f32x4 v0 = acc[ai][bj][m][0] * sc, v1 = acc[ai][bj][m][1] * sc; unsigned w0 = 0u, w1 = 0u;
                    w0 = __builtin_amdgcn_cvt_pk_fp8_f32(v0[0], v0[1], w0, false); w0 = __builtin_amdgcn_cvt_pk_fp8_f32(v0[2], v0[3], w0, true);
                    w1 = __builtin_amdgcn_cvt_pk_fp8_f32(v1[0], v1[1], w1, false); w1 = __builtin_amdgcn_cvt_pk_fp8_f32(v1[2], v1[3], w1, true);
                    u32x2_ w; w.x = w0; w.y = w1; *(u32x2_*)(rowp + bj * HALF) = w; } }
    }
};
template <class Epi, class Sched, bool ALIGN_EPI = false, bool SP2 = true, bool GATHER = false>
__device__ __forceinline__ void gemm_phase(PG8_LAS unsigned char* lds, const Gemm g, const Sched& S, const Epi& E, PG8_LAS unsigned* tt = nullptr) {
    static_assert(SP2, "only the two-MFMA-blocks-per-barrier-pair loop is kept in this file");
    int tid_ = threadIdx.x; asm volatile("" : "+v"(tid_));
    const int tid = tid_, wid = __builtin_amdgcn_readfirstlane(tid >> 6), lane = tid & 63, wr = wid >> 2, wc = wid & 3, fr = lane & 15, fq = lane >> 4;
    const int K = g.K, nt = K / BK, ldb = g.ldb ? g.ldb : K;
    unsigned c0[2], c1[2], n0[2], n1[2], voffB[2]; int rA[2]; unsigned cbA[2];
    const size_t kstep = (size_t)(BK * 2);
    const size_t hstepA = (size_t)HALF * g.lda * 2, hstep = (size_t)HALF * ldb * 2;
    const size_t tstepA = 2 * hstepA, tstep = 2 * hstep;
#pragma unroll
    for (int i = 0; i < 2; ++i) { int R, C; stage_rc(tid * 16 + i * 8192, R, C); const int Rb = Epi::PERM ? ((R & ~31) + perm32(R & 31)) : R; rA[i] = R; cbA[i] = (unsigned)C * 2u;
        c0[i] = (unsigned)(R * g.lda + C) * 2u; c1[i] = c0[i] + (unsigned)hstepA; n0[i] = c0[i]; n1[i] = c1[i]; voffB[i] = (unsigned)(Rb * ldb + C) * 2u; }
    const unsigned ldsw = (unsigned)wid * 1024u;
    const int aoff = lds_byte(wr * 64 + fr, fq * 8), boff = lds_byte(wc * 32 + fr, fq * 8);
#define PG8_SA(b, h) (((b) * 2 + (h)) * HTB)
#define PG8_SB(b, h) ((4 + (b) * 2 + (h)) * HTB)
#define PG8_STAGE(bufoff, gbase, voff) do { _Pragma("unroll") for (int _i = 0; _i < 2; ++_i) \
        __builtin_amdgcn_global_load_lds((const unsigned*)((const char*)(gbase) + (voff)[_i]), (PG8_LAS unsigned*)(lds + (bufoff) + ldsw + _i * 8192), 16, 0, 0); } while (0)
#define PG8_LDA(dst, b, h) do { _Pragma("unroll") for (int m = 0; m < 4; ++m) _Pragma("unroll") for (int k = 0; k < 2; ++k) dst[m][k] = *(const PG8_LAS bf16x8*)(lds + PG8_SA(b, h) + aoff + m * 2048 + k * 1024); } while (0)
#define PG8_LDB(dst, b, h) do { _Pragma("unroll") for (int n = 0; n < 2; ++n) _Pragma("unroll") for (int k = 0; k < 2; ++k) dst[n][k] = *(const PG8_LAS bf16x8*)(lds + PG8_SB(b, h) + boff + n * 2048 + k * 1024); } while (0)
#define PG8_MMA(ai, bj, At, Bt) do { __builtin_amdgcn_s_setprio(1); _Pragma("unroll") for (int m = 0; m < 4; ++m) _Pragma("unroll") for (int n = 0; n < 2; ++n) _Pragma("unroll") for (int k = 0; k < 2; ++k) \
        acc[ai][bj][m][n] = __builtin_amdgcn_mfma_f32_16x16x32_bf16(Bt[n][k], At[m][k], acc[ai][bj][m][n], 0, 0, 0); __builtin_amdgcn_s_setprio(0); } while (0)
#define PG8_WAIT_V(n) asm volatile("s_waitcnt vmcnt(" #n ")" ::: "memory")
#define PG8_WAIT_L(n) asm volatile("s_waitcnt lgkmcnt(" #n ")" ::: "memory")
#define PG8_BAR __builtin_amdgcn_s_barrier()
#define PG8_SCHED __builtin_amdgcn_sched_barrier(0)
#define PG8_GOFF(o0, o1, tab, nv) do { _Pragma("unroll") for (int _i = 0; _i < 2; ++_i) { const unsigned e0_ = (tab)[rA[_i]], e1_ = (tab)[HALF + rA[_i]]; \
        o0[_i] = ((rA[_i] < (nv)) ? (e0_ >> 1) : 0u) * (unsigned)(g.lda * 2) + cbA[_i]; o1[_i] = ((HALF + rA[_i] < (nv)) ? (e1_ >> 1) : 0u) * (unsigned)(g.lda * 2) + cbA[_i]; } } while (0)
    Unit cur, nxt; int ui = 0;
    if (!S.next(0, cur)) return;
    f32x4 acc[2][2][4][2];
#pragma unroll
    for (int a = 0; a < 2; ++a)
#pragma unroll
        for (int b = 0; b < 2; ++b)
#pragma unroll
            for (int m = 0; m < 4; ++m)
#pragma unroll
                for (int n = 0; n < 2; ++n) acc[a][b][m][n] = (f32x4){0.f, 0.f, 0.f, 0.f};
    bf16x8 At[4][2], B0[2][2], B1[2][2];
    int tbuf = 0, tnext = 1;
    if constexpr (GATHER) {
        { const int lo_ = S.listoff(cur.pm); if (tid < 256) tt[tid] = g.rowlist[lo_ + tid]; else tt[tid] = g.wlist[lo_ + tid - 256]; }
        asm volatile("s_waitcnt vmcnt(0) lgkmcnt(0)" ::: "memory"); PG8_BAR; asm volatile("" ::: "memory");
        PG8_GOFF(c0, c1, tt, S.rows(cur.pm));
    }
    const char* cA = (GATHER ? (const char*)g.A : (const char*)g.A + (size_t)cur.pm * tstepA) + S.kbytes(cur, K); const char* cB = (const char*)g.Bt + (size_t)S.expert(cur.pm) * g.bstride + (size_t)cur.pn * tstep + S.kbytes(cur, K);
    S.a_ready(cur);
    PG8_STAGE(PG8_SB(0, 0), cB, voffB); PG8_STAGE(PG8_SB(0, 1), cB + hstep, voffB); PG8_STAGE(PG8_SA(0, 0), cA, c0); PG8_STAGE(PG8_SA(0, 1), cA, c1);
    if (wr == 1) PG8_BAR;
    PG8_WAIT_V(2); PG8_BAR;
    PG8_STAGE(PG8_SB(1, 0), cB + kstep, voffB); PG8_STAGE(PG8_SA(1, 0), cA + kstep, c0); PG8_STAGE(PG8_SB(1, 1), cB + hstep + kstep, voffB);
    PG8_WAIT_V(6); PG8_BAR;
    for (;;) {
        const bool has_next = S.next(ui + 1, nxt);
        const char* nA = GATHER ? cA : (has_next ? (const char*)g.A + (size_t)nxt.pm * tstepA + S.kbytes(nxt, K) : cA); const char* nB = has_next ? (const char*)g.Bt + (size_t)S.expert(nxt.pm) * g.bstride + (size_t)nxt.pn * tstep + S.kbytes(nxt, K) : cB;
        if constexpr (GATHER) { if (has_next) {
            const unsigned* src_ = (wid < 4 ? g.rowlist : g.wlist) + S.listoff(nxt.pm) + (wid & 3) * 64 + lane;
            __builtin_amdgcn_global_load_lds(src_, (PG8_LAS unsigned*)(tt + tnext * 512 + wid * 64), 4, 0, 0); } }
        for (int t = 0; t < nt; t += 2) {
            const bool last = (t == nt - 2);
            if constexpr (GATHER) { if (last && has_next) PG8_GOFF(n0, n1, tt + tnext * 512, S.rows(nxt.pm)); }
            const char* a1 = cA + (size_t)(t + 1) * kstep;
            const char* a2 = last ? nA : cA + (size_t)(t + 2) * kstep; const char* b2 = last ? nB : cB + (size_t)(t + 2) * kstep;
            const char* a3 = a2 + kstep; const char* b3 = b2 + kstep;
            unsigned x0[2], x1[2];
#pragma unroll
            for (int i = 0; i < 2; ++i) { x0[i] = last ? n0[i] : c0[i]; x1[i] = last ? n1[i] : c1[i]; }
            if (last && has_next) S.a_ready(nxt);
            PG8_LDB(B0, 0, 0); PG8_LDB(B1, 0, 1); PG8_SCHED; PG8_LDA(At, 0, 0); PG8_STAGE(PG8_SA(1, 1), a1, c1);
            PG8_WAIT_V(8); PG8_WAIT_L(0); PG8_BAR; PG8_MMA(0, 0, At, B0); PG8_MMA(0, 1, At, B1); PG8_BAR; PG8_SCHED;
            PG8_LDA(At, 0, 1); PG8_STAGE(PG8_SB(0, 0), b2, voffB); PG8_STAGE(PG8_SB(0, 1), b2 + hstep, voffB); PG8_STAGE(PG8_SA(0, 0), a2, x0);
            PG8_WAIT_V(8); PG8_WAIT_L(0); PG8_BAR; PG8_MMA(1, 0, At, B0); PG8_MMA(1, 1, At, B1); PG8_BAR; PG8_SCHED;
            PG8_LDB(B0, 1, 0); PG8_LDB(B1, 1, 1); PG8_SCHED; PG8_LDA(At, 1, 0); PG8_STAGE(PG8_SA(0, 1), a2, x1);
            PG8_WAIT_V(8); PG8_WAIT_L(0); PG8_BAR; PG8_MMA(0, 0, At, B0); PG8_MMA(0, 1, At, B1); PG8_BAR; PG8_SCHED;
            PG8_LDA(At, 1, 1); PG8_STAGE(PG8_SB(1, 0), b3, voffB); PG8_STAGE(PG8_SB(1, 1), b3 + hstep, voffB); PG8_STAGE(PG8_SA(1, 0), a3, x0);
            PG8_WAIT_V(8); PG8_WAIT_L(0); PG8_BAR; PG8_MMA(1, 0, At, B0); PG8_MMA(1, 1, At, B1); PG8_BAR; PG8_SCHED;
        }
        if constexpr (ALIGN_EPI) { if (wr == 0) PG8_BAR; }
        if constexpr (!Epi::AFTER_DRAIN) { E(acc, cur, wr, wc, fr, fq, ui, GATHER ? tt + tbuf * 512 : nullptr); S.done(cur); }
        if (!has_next) break;
#pragma unroll
        for (int a = 0; a < 2; ++a)
#pragma unroll
            for (int b = 0; b < 2; ++b)
#pragma unroll
                for (int m = 0; m < 4; ++m)
#pragma unroll
                    for (int n = 0; n < 2; ++n) acc[a][b][m][n] = (f32x4){0.f, 0.f, 0.f, 0.f};
        cur = nxt; cA = nA; cB = nB; ++ui; tbuf = tnext; tnext = (tnext == 2) ? 0 : tnext + 1;
        if constexpr (GATHER) {
#pragma unroll
            for (int i = 0; i < 2; ++i) { c0[i] = n0[i]; c1[i] = n1[i]; } }
        if constexpr (ALIGN_EPI) { if (wr == 1) PG8_BAR; }
    }
    PG8_WAIT_V(0);
    if constexpr (!ALIGN_EPI) { if (wr == 0) PG8_BAR; }
    PG8_BAR;
    if constexpr (Epi::AFTER_DRAIN) { E.fused(acc, cur, wr, wc, fr, fq, lds, wid, lane); S.done(cur); }
#undef PG8_SA
#undef PG8_SB
#undef PG8_STAGE
#undef PG8_LDA
#undef PG8_LDB
#undef PG8_MMA
#undef PG8_WAIT_V
#undef PG8_WAIT_L
#undef PG8_BAR
#undef PG8_SCHED
#undef PG8_GOFF
}

template <class Epi, class Sched, bool ALIGN_EPI = true, bool SP2 = true, bool GATHER = true>
__device__ __forceinline__ void gemm_phase_f8q(PG8_LAS unsigned char* lds, const Gemm g, const Sched& S, const Epi& E, PG8_LAS unsigned* tt = nullptr) {
    static_assert(SP2, "only the two-MFMA-blocks-per-barrier-pair loop is kept in this file");
    typedef int v8i_t __attribute__((ext_vector_type(8))); typedef int v4i_t __attribute__((ext_vector_type(4)));
    int tid_ = threadIdx.x; asm volatile("" : "+v"(tid_));
    const int tid = tid_, wid = __builtin_amdgcn_readfirstlane(tid >> 6), lane = tid & 63, wr = wid >> 2, wc = wid & 3, fr = lane & 15, fq = lane >> 4;
    const int K = g.K, nt = K / BK, ldb = g.ldb ? g.ldb : K;
    unsigned c0[2], c1[2], n0[2], n1[2], voffB[2]; int rA[2]; unsigned cbA[2];
    const size_t kstep = (size_t)(BK * 2);
    const size_t hstepA = (size_t)HALF * g.lda * 2, hstep = (size_t)HALF * ldb * 2;
    const size_t tstepA = 2 * hstepA, tstep = 2 * hstep;
#pragma unroll
    for (int i = 0; i < 2; ++i) { const int R = (tid >> 3) + 64 * i, x = R & 15, C = (((tid & 7) ^ (((x >> 1) & 1) | (((x >> 3) & 1) << 2))) * 16); const int Rb = (R & ~31) + perm32(R & 31);
        rA[i] = R; cbA[i] = (unsigned)C; c0[i] = (unsigned)(R * g.lda) * 2u + (unsigned)C; c1[i] = c0[i] + (unsigned)hstepA; n0[i] = c0[i]; n1[i] = c1[i]; voffB[i] = (unsigned)(Rb * ldb) * 2u + (unsigned)C; }
    const unsigned ldsw = (unsigned)wid * 1024u;
    const int fsw = ((fr >> 1) & 1) | (((fr >> 3) & 1) << 2);
    const int aoffL = (wr * 64 + fr) * 128 + (((2 * fq) ^ fsw) * 16), aoffH = (wr * 64 + fr) * 128 + (((2 * fq + 1) ^ fsw) * 16);
    const int boffL = (wc * 32 + fr) * 128 + (((2 * fq) ^ fsw) * 16), boffH = (wc * 32 + fr) * 128 + (((2 * fq + 1) ^ fsw) * 16);
#define PG8_SA(b, h) (((b) * 2 + (h)) * HTB)
#define PG8_SB(b, h) ((4 + (b) * 2 + (h)) * HTB)
#define PG8_STAGE(bufoff, gbase, voff) do { _Pragma("unroll") for (int _i = 0; _i < 2; ++_i) \
        __builtin_amdgcn_global_load_lds((const unsigned*)((const char*)(gbase) + (voff)[_i]), (PG8_LAS unsigned*)(lds + (bufoff) + ldsw + _i * 8192), 16, 0, 0); } while (0)
#define PG8_LDA(dst, b, h) do { _Pragma("unroll") for (int m = 0; m < 4; ++m) { const v4i_t l_ = *(const PG8_LAS v4i_t*)(lds + PG8_SA(b, h) + aoffL + m * 2048), h_ = *(const PG8_LAS v4i_t*)(lds + PG8_SA(b, h) + aoffH + m * 2048); \
        dst[m] = (v8i_t){l_[0], l_[1], l_[2], l_[3], h_[0], h_[1], h_[2], h_[3]}; } } while (0)
#define PG8_LDB(dst, b, h) do { _Pragma("unroll") for (int n = 0; n < 2; ++n) { const v4i_t l_ = *(const PG8_LAS v4i_t*)(lds + PG8_SB(b, h) + boffL + n * 2048), h_ = *(const PG8_LAS v4i_t*)(lds + PG8_SB(b, h) + boffH + n * 2048); \
        dst[n] = (v8i_t){l_[0], l_[1], l_[2], l_[3], h_[0], h_[1], h_[2], h_[3]}; } } while (0)
#define PG8_MMA(ai, bj, At, Bt) do { __builtin_amdgcn_s_setprio(1); _Pragma("unroll") for (int m = 0; m < 4; ++m) _Pragma("unroll") for (int n = 0; n < 2; ++n) \
        asm volatile("v_mfma_scale_f32_16x16x128_f8f6f4 %0, %1, %2, %0, %3, %4 op_sel_hi:[0,0,0]" : "+v"(acc[ai][bj][m][n]) : "v"(Bt[n]), "v"(At[m]), "v"(sclB), "v"(sclA)); __builtin_amdgcn_s_setprio(0); } while (0)
#define PG8_WAIT_V(n) asm volatile("s_waitcnt vmcnt(" #n ")" ::: "memory")
#define PG8_WAIT_L(n) asm volatile("s_waitcnt lgkmcnt(" #n ")" ::: "memory")
#define PG8_BAR __builtin_amdgcn_s_barrier()
#define PG8_SCHED __builtin_amdgcn_sched_barrier(0)
#define PG8_GOFF(o0, o1, tab, nv) do { _Pragma("unroll") for (int _i = 0; _i < 2; ++_i) { const unsigned e0_ = (tab)[rA[_i]], e1_ = (tab)[HALF + rA[_i]]; \
        o0[_i] = ((rA[_i] < (nv)) ? (e0_ >> 1) : 0u) * (unsigned)(g.lda * 2) + cbA[_i]; o1[_i] = ((HALF + rA[_i] < (nv)) ? (e1_ >> 1) : 0u) * (unsigned)(g.lda * 2) + cbA[_i]; } } while (0)
    Unit cur, nxt; int ui = 0;
    if (!S.next(0, cur)) return;
    f32x4 acc[2][2][4][2];
#pragma unroll
    for (int a = 0; a < 2; ++a)
#pragma unroll
        for (int b = 0; b < 2; ++b)
#pragma unroll
            for (int m = 0; m < 4; ++m)
#pragma unroll
                for (int n = 0; n < 2; ++n) acc[a][b][m][n] = (f32x4){0.f, 0.f, 0.f, 0.f};
    const int sclB = g.scale_b, sclA = 0x7f7f7f7f;
    v8i_t At[4], B0[2], B1[2];
    int tbuf = 0, tnext = 1;
    if constexpr (GATHER) {
        { const int lo_ = S.listoff(cur.pm); if (tid < 256) tt[tid] = g.rowlist[lo_ + tid]; else tt[tid] = g.wlist[lo_ + tid - 256]; }
        asm volatile("s_waitcnt vmcnt(0) lgkmcnt(0)" ::: "memory"); PG8_BAR; asm volatile("" ::: "memory");
        PG8_GOFF(c0, c1, tt, S.rows(cur.pm));
    }
    const char* cA = (GATHER ? (const char*)g.A : (const char*)g.A + (size_t)cur.pm * tstepA) + S.kbytes(cur, K); const char* cB = (const char*)g.Bt + (size_t)S.expert(cur.pm) * g.bstride + (size_t)cur.pn * tstep + S.kbytes(cur, K);
    S.a_ready(cur);
    PG8_STAGE(PG8_SB(0, 0), cB, voffB); PG8_STAGE(PG8_SB(0, 1), cB + hstep, voffB); PG8_STAGE(PG8_SA(0, 0), cA, c0); PG8_STAGE(PG8_SA(0, 1), cA, c1);
    if (wr == 1) PG8_BAR;
    PG8_WAIT_V(2); PG8_BAR;
    PG8_STAGE(PG8_SB(1, 0), cB + kstep, voffB); PG8_STAGE(PG8_SA(1, 0), cA + kstep, c0); PG8_STAGE(PG8_SB(1, 1), cB + hstep + kstep, voffB);
    PG8_WAIT_V(6); PG8_BAR;
    for (;;) {
        const bool has_next = S.next(ui + 1, nxt);
        const char* nA = GATHER ? cA : (has_next ? (const char*)g.A + (size_t)nxt.pm * tstepA + S.kbytes(nxt, K) : cA); const char* nB = has_next ? (const char*)g.Bt + (size_t)S.expert(nxt.pm) * g.bstride + (size_t)nxt.pn * tstep + S.kbytes(nxt, K) : cB;
        if constexpr (GATHER) { if (has_next) {
            const unsigned* src_ = (wid < 4 ? g.rowlist : g.wlist) + S.listoff(nxt.pm) + (wid & 3) * 64 + lane;
            __builtin_amdgcn_global_load_lds(src_, (PG8_LAS unsigned*)(tt + tnext * 512 + wid * 64), 4, 0, 0); } }
        for (int t = 0; t < nt; t += 2) {
            const bool last = (t == nt - 2);
            if constexpr (GATHER) { if (last && has_next) PG8_GOFF(n0, n1, tt + tnext * 512, S.rows(nxt.pm)); }
            const char* a1 = cA + (size_t)(t + 1) * kstep;
            const char* a2 = last ? nA : cA + (size_t)(t + 2) * kstep; const char* b2 = last ? nB : cB + (size_t)(t + 2) * kstep;
            const char* a3 = a2 + kstep; const char* b3 = b2 + kstep;
            unsigned x0[2], x1[2];
#pragma unroll
            for (int i = 0; i < 2; ++i) { x0[i] = last ? n0[i] : c0[i]; x1[i] = last ? n1[i] : c1[i]; }
            if (last && has_next) S.a_ready(nxt);
            PG8_LDB(B0, 0, 0); PG8_LDB(B1, 0, 1); PG8_SCHED; PG8_LDA(At, 0, 0); PG8_STAGE(PG8_SA(1, 1), a1, c1);
            PG8_WAIT_V(8); PG8_WAIT_L(0); PG8_BAR; PG8_MMA(0, 0, At, B0); PG8_MMA(0, 1, At, B1); PG8_BAR; PG8_SCHED;
            PG8_LDA(At, 0, 1); PG8_STAGE(PG8_SB(0, 0), b2, voffB); PG8_STAGE(PG8_SB(0, 1), b2 + hstep, voffB); PG8_STAGE(PG8_SA(0, 0), a2, x0);
            PG8_WAIT_V(8); PG8_WAIT_L(0); PG8_BAR; PG8_MMA(1, 0, At, B0); PG8_MMA(1, 1, At, B1); PG8_BAR; PG8_SCHED;
            PG8_LDB(B0, 1, 0); PG8_LDB(B1, 1, 1); PG8_SCHED; PG8_LDA(At, 1, 0); PG8_STAGE(PG8_SA(0, 1), a2, x1);
            PG8_WAIT_V(8); PG8_WAIT_L(0); PG8_BAR; PG8_MMA(0, 0, At, B0); PG8_MMA(0, 1, At, B1); PG8_BAR; PG8_SCHED;
            PG8_LDA(At, 1, 1); PG8_STAGE(PG8_SB(1, 0), b3, voffB); PG8_STAGE(PG8_SB(1, 1), b3 + hstep, voffB); PG8_STAGE(PG8_SA(1, 0), a3, x0);
            PG8_WAIT_V(8); PG8_WAIT_L(0); PG8_BAR; PG8_MMA(1, 0, At, B0); PG8_MMA(1, 1, At, B1); PG8_BAR; PG8_SCHED;
        }
        if constexpr (ALIGN_EPI) { if (wr == 0) PG8_BAR; }
        asm volatile("s_nop 15\n\ts_nop 15" ::: "memory");
        if constexpr (!Epi::AFTER_DRAIN) { E(acc, cur, wr, wc, fr, fq, ui, GATHER ? tt + tbuf * 512 : nullptr); S.done(cur); }
        if (!has_next) break;
#pragma unroll
        for (int a = 0; a < 2; ++a)
#pragma unroll
            for (int b = 0; b < 2; ++b)
#pragma unroll
                for (int m = 0; m < 4; ++m)
#pragma unroll
                    for (int n = 0; n < 2; ++n) acc[a][b][m][n] = (f32x4){0.f, 0.f, 0.f, 0.f};
        cur = nxt; cA = nA; cB = nB; ++ui; tbuf = tnext; tnext = (tnext == 2) ? 0 : tnext + 1;
        if constexpr (GATHER) {
#pragma unroll
            for (int i = 0; i < 2; ++i) { c0[i] = n0[i]; c1[i] = n1[i]; } }
        if constexpr (ALIGN_EPI) { if (wr == 1) PG8_BAR; }
    }
    PG8_WAIT_V(0);
    if constexpr (!ALIGN_EPI) { if (wr == 0) PG8_BAR; }
    PG8_BAR;
    if constexpr (Epi::AFTER_DRAIN) { E.fused(acc, cur, wr, wc, fr, fq, lds, wid, lane); S.done(cur); }
#undef PG8_SA
#undef PG8_SB
#undef PG8_STAGE
#undef PG8_LDA
#undef PG8_LDB
#undef PG8_MMA
#undef PG8_WAIT_V
#undef PG8_WAIT_L
#undef PG8_BAR
#undef PG8_SCHED
#undef PG8_GOFF
}

struct EpiSwiGLU64 {
    unsigned char* O; int ldc;
    __device__ __forceinline__ void operator()(const f32x4 (&acc)[2][4][2], const Unit& u, int wr, int wc, int fr, int fq, const PG8_LAS unsigned* tab) const {
        const int col0 = u.pn * 64 + wc * 16 + 4 * fq;
#pragma unroll
        for (int ai = 0; ai < 2; ++ai)
#pragma unroll
            for (int m = 0; m < 4; ++m) { const int r = ai * HALF + wr * 64 + m * 16 + fr; const float rs = __uint_as_float(tab[256 + r]);
                const f32x4 a = acc[ai][m][0] * rs, b = acc[ai][m][1] * rs; const f32x4 t = a * (-1.4426950408889634f); f32x4 d;
#pragma unroll
                for (int e = 0; e < 4; ++e) d[e] = __builtin_amdgcn_exp2f(t[e]);
                d = d + 1.0f;
#pragma unroll
                for (int e = 0; e < 4; ++e) d[e] = __builtin_amdgcn_rcpf(d[e]);
                const f32x4 y = (a * b) * d; unsigned w = 0u; w = __builtin_amdgcn_cvt_pk_fp8_f32(y[0], y[1], w, false); w = __builtin_amdgcn_cvt_pk_fp8_f32(y[2], y[3], w, true);
                *(unsigned*)(O + (size_t)(u.pm * BM + r) * ldc + col0) = w; }
    }
};
struct EpiY64 {
    bf16_t* O; int ldc; size_t kstride;
    __device__ __forceinline__ void operator()(const f32x4 (&acc)[2][4][2], const Unit& u, int wr, int wc, int fr, int fq, const PG8_LAS unsigned* tab) const {
        const int col0 = u.pn * 128 + wc * 32 + 8 * fq;
#pragma unroll
        for (int ai = 0; ai < 2; ++ai)
#pragma unroll
            for (int m = 0; m < 4; ++m) { const int r = ai * HALF + wr * 64 + m * 16 + fr; const float gw = __uint_as_float(tab[256 + r]);
                const f32x4 a = acc[ai][m][0] * gw, b = acc[ai][m][1] * gw; u32x4 w; w.x = cvt_pk_bf16(a[0], a[1]); w.y = cvt_pk_bf16(a[2], a[3]); w.z = cvt_pk_bf16(b[0], b[1]); w.w = cvt_pk_bf16(b[2], b[3]);
                *(u32x4*)(O + (size_t)u.kp * kstride + (size_t)(u.pm * BM + r) * ldc + col0) = w; }
    }
};
template <class Epi, class Sched>
__device__ __forceinline__ void gemm_phase_f8n128(PG8_LAS unsigned char* lds, const Gemm g, const Sched& S, const Epi& E, PG8_LAS unsigned* tt) {
    typedef int v8i_t __attribute__((ext_vector_type(8))); typedef int v4i_t __attribute__((ext_vector_type(4)));
    int tid_ = threadIdx.x; asm volatile("" : "+v"(tid_));
    const int tid = tid_, wid = __builtin_amdgcn_readfirstlane(tid >> 6), lane = tid & 63, wr = wid >> 2, wc = wid & 3, fr = lane & 15, fq = lane >> 4;
    const int K = g.K, nt = K / BK, ldb = g.ldb ? g.ldb : K;
    unsigned c0[2], c1[2], n0[2], n1[2], voffB[2]; int rA[2]; unsigned cbA[2];
    const size_t kstep = (size_t)(BK * 2), tstepB = (size_t)HALF * ldb * 2;
#pragma unroll
    for (int i = 0; i < 2; ++i) { const int R = (tid >> 3) + 64 * i, x = R & 15, C = (((tid & 7) ^ (((x >> 1) & 1) | (((x >> 3) & 1) << 2))) * 16); const int Rb = (R & ~31) + perm32(R & 31);
        rA[i] = R; cbA[i] = (unsigned)C; c0[i] = c1[i] = n0[i] = n1[i] = 0u; voffB[i] = (unsigned)(Rb * ldb) * 2u + (unsigned)C; }
    const unsigned ldsw = (unsigned)wid * 1024u;
    const int fsw = ((fr >> 1) & 1) | (((fr >> 3) & 1) << 2);
    const int aoffL = (wr * 64 + fr) * 128 + (((2 * fq) ^ fsw) * 16), aoffH = (wr * 64 + fr) * 128 + (((2 * fq + 1) ^ fsw) * 16);
    const int boffL = (wc * 32 + fr) * 128 + (((2 * fq) ^ fsw) * 16), boffH = (wc * 32 + fr) * 128 + (((2 * fq + 1) ^ fsw) * 16);
#define F8_SA(b, h) (((b) * 3 + (h)) * HTB)
#define F8_SB(b) (((b) * 3 + 2) * HTB)
#define F8_STAGE1(bufoff, gbase, voff, i_) __builtin_amdgcn_global_load_lds((const unsigned*)((const char*)(gbase) + (voff)[i_]), (PG8_LAS unsigned*)(lds + (bufoff) + ldsw + (i_) * 8192), 16, 0, 0)
#define F8_STAGE(bufoff, gbase, voff) do { F8_STAGE1(bufoff, gbase, voff, 0); F8_STAGE1(bufoff, gbase, voff, 1); } while (0)
#define F8_LDA1(dst, b, h, m) do { const v4i_t l_ = *(const PG8_LAS v4i_t*)(lds + F8_SA(b, h) + aoffL + (m) * 2048), h_ = *(const PG8_LAS v4i_t*)(lds + F8_SA(b, h) + aoffH + (m) * 2048); \
        dst[m] = (v8i_t){l_[0], l_[1], l_[2], l_[3], h_[0], h_[1], h_[2], h_[3]}; } while (0)
#define F8_LDB1(dst, b, n) do { const v4i_t l_ = *(const PG8_LAS v4i_t*)(lds + F8_SB(b) + boffL + (n) * 2048), h_ = *(const PG8_LAS v4i_t*)(lds + F8_SB(b) + boffH + (n) * 2048); \
        dst[n] = (v8i_t){l_[0], l_[1], l_[2], l_[3], h_[0], h_[1], h_[2], h_[3]}; } while (0)
#define F8_LDA(dst, b, h) do { F8_LDA1(dst, b, h, 0); F8_LDA1(dst, b, h, 1); F8_LDA1(dst, b, h, 2); F8_LDA1(dst, b, h, 3); } while (0)
#define F8_LDB(dst, b) do { F8_LDB1(dst, b, 0); F8_LDB1(dst, b, 1); } while (0)
#define F8_MMA1(ai, m, At, Bf) do { _Pragma("unroll") for (int n = 0; n < 2; ++n) \
        acc[ai][m][n] = __builtin_amdgcn_mfma_scale_f32_16x16x128_f8f6f4(Bf[n], At[m], acc[ai][m][n], 0, 0, 0, g.scale_b, 0, 0x7f7f7f7f); } while (0)
#define F8_WAIT_V(n) asm volatile("s_waitcnt vmcnt(" #n ")" ::: "memory")
#define F8_WAIT_L(n) asm volatile("s_waitcnt lgkmcnt(" #n ")" ::: "memory")
#define F8_BAR __builtin_amdgcn_s_barrier()
#define F8_SCHED __builtin_amdgcn_sched_barrier(0)
#define F8_GOFF(o0, o1, tab, nv) do { _Pragma("unroll") for (int _i = 0; _i < 2; ++_i) { const unsigned e0_ = (tab)[rA[_i]], e1_ = (tab)[HALF + rA[_i]]; \
        o0[_i] = ((rA[_i] < (nv)) ? (e0_ >> 1) : 0u) * (unsigned)(g.lda * 2) + cbA[_i]; o1[_i] = ((HALF + rA[_i] < (nv)) ? (e1_ >> 1) : 0u) * (unsigned)(g.lda * 2) + cbA[_i]; } } while (0)
    Unit cur, nxt; int ui = 0;
    if (!S.next(0, cur)) return;
    f32x4 acc[2][4][2];
#pragma unroll
    for (int a = 0; a < 2; ++a)
#pragma unroll
        for (int m = 0; m < 4; ++m)
#pragma unroll
            for (int n = 0; n < 2; ++n) acc[a][m][n] = (f32x4){0.f, 0.f, 0.f, 0.f};
    v8i_t AtA[4], AtB[4], BfA[2], BfB[2];
    int tbuf = 0, tnext = 1;
    { const int lo_ = S.listoff(cur.pm); if (tid < 256) tt[tid] = g.rowlist[lo_ + tid]; else tt[tid] = g.wlist[lo_ + tid - 256]; }
    asm volatile("s_waitcnt vmcnt(0) lgkmcnt(0)" ::: "memory"); F8_BAR; asm volatile("" ::: "memory");
    F8_GOFF(c0, c1, tt, S.rows(cur.pm));
    const char* cA = (const char*)g.A + S.kbytes(cur, K); const char* cB = (const char*)g.Bt + (size_t)S.expert(cur.pm) * g.bstride + (size_t)cur.pn * tstepB + S.kbytes(cur, K);
    F8_STAGE(F8_SB(0), cB, voffB); F8_STAGE(F8_SA(0, 0), cA, c0); F8_STAGE(F8_SA(0, 1), cA, c1);
    F8_STAGE(F8_SB(1), cB + kstep, voffB); F8_STAGE(F8_SA(1, 0), cA + kstep, c0); F8_STAGE(F8_SA(1, 1), cA + kstep, c1);
    F8_WAIT_V(8); F8_BAR;
    F8_LDB(BfA, 0); F8_LDA(AtA, 0, 0);
    for (;;) {
        const bool has_next = S.next(ui + 1, nxt);
        const char* nA = has_next ? (const char*)g.A + S.kbytes(nxt, K) : cA; const char* nB = has_next ? (const char*)g.Bt + (size_t)S.expert(nxt.pm) * g.bstride + (size_t)nxt.pn * tstepB + S.kbytes(nxt, K) : cB;
        if (has_next) { const unsigned* src_ = (wid < 4 ? g.rowlist : g.wlist) + S.listoff(nxt.pm) + (wid & 3) * 64 + lane;
            __builtin_amdgcn_global_load_lds(src_, (PG8_LAS unsigned*)(tt + tnext * 512 + wid * 64), 4, 0, 0); }
#pragma unroll 1
        for (int t = 0; t < nt; t += 2) {
            const bool last = (t == nt - 2);
            if (last && has_next) F8_GOFF(n0, n1, tt + tnext * 512, S.rows(nxt.pm));
            const char* a2 = last ? nA : cA + (size_t)(t + 2) * kstep; const char* b2 = last ? nB : cB + (size_t)(t + 2) * kstep;
            const char* a3 = a2 + kstep; const char* b3 = b2 + kstep;
            unsigned x0[2], x1[2];
#pragma unroll
            for (int i = 0; i < 2; ++i) { x0[i] = (last && has_next) ? n0[i] : c0[i]; x1[i] = (last && has_next) ? n1[i] : c1[i]; }
#define F8_TOP F8_WAIT_V(6); F8_WAIT_L(0); F8_BAR; F8_SCHED
#define F8_SP1(b, Bf, bp, ap, xo) F8_TOP; \
            F8_MMA1(0, 0, AtA, Bf); F8_SCHED; F8_STAGE1(F8_SB(b), bp, voffB, 0); F8_LDA1(AtB, b, 1, 0); F8_SCHED; F8_MMA1(0, 1, AtA, Bf); F8_SCHED; F8_STAGE1(F8_SB(b), bp, voffB, 1); F8_LDA1(AtB, b, 1, 1); F8_SCHED; \
            F8_MMA1(0, 2, AtA, Bf); F8_SCHED; F8_STAGE1(F8_SA(b, 0), ap, xo, 0); F8_LDA1(AtB, b, 1, 2); F8_SCHED; F8_MMA1(0, 3, AtA, Bf); F8_SCHED; F8_STAGE1(F8_SA(b, 0), ap, xo, 1); F8_LDA1(AtB, b, 1, 3); F8_SCHED
#define F8_SP2(b, Bf, Bn, ap, xo) F8_TOP; \
            F8_MMA1(1, 0, AtB, Bf); F8_SCHED; F8_STAGE1(F8_SA(b, 1), ap, xo, 0); F8_LDB1(Bn, (b) ^ 1, 0); F8_LDA1(AtA, (b) ^ 1, 0, 0); F8_SCHED; F8_MMA1(1, 1, AtB, Bf); F8_SCHED; F8_STAGE1(F8_SA(b, 1), ap, xo, 1); F8_LDB1(Bn, (b) ^ 1, 1); F8_LDA1(AtA, (b) ^ 1, 0, 1); F8_SCHED; \
            F8_MMA1(1, 2, AtB, Bf); F8_SCHED; F8_LDA1(AtA, (b) ^ 1, 0, 2); F8_SCHED; F8_MMA1(1, 3, AtB, Bf); F8_SCHED; F8_LDA1(AtA, (b) ^ 1, 0, 3); F8_SCHED
            F8_SP1(0, BfA, b2, a2, x0); F8_SP2(0, BfA, BfB, a2, x1);
            F8_SP1(1, BfB, b3, a3, x0); F8_SP2(1, BfB, BfA, a3, x1);
#undef F8_TOP
#undef F8_SP1
#undef F8_SP2
        }
        F8_WAIT_L(0);
        E(acc, cur, wr, wc, fr, fq, tt + tbuf * 512);
        if (!has_next) break;
#pragma unroll
        for (int a = 0; a < 2; ++a)
#pragma unroll
            for (int m = 0; m < 4; ++m)
#pragma unroll
                for (int n = 0; n < 2; ++n) acc[a][m][n] = (f32x4){0.f, 0.f, 0.f, 0.f};
        cur = nxt; cA = nA; cB = nB; ++ui; tbuf = tnext; tnext = (tnext == 2) ? 0 : tnext + 1;
#pragma unroll
        for (int i = 0; i < 2; ++i) { c0[i] = n0[i]; c1[i] = n1[i]; }
    }
    F8_WAIT_V(0);
    F8_BAR;
#undef F8_SA
#undef F8_SB
#undef F8_STAGE1
#undef F8_STAGE
#undef F8_LDA1
#undef F8_LDB1
#undef F8_LDA
#undef F8_LDB
#undef F8_MMA1
#undef F8_WAIT_V
#undef F8_WAIT_L
#undef F8_BAR
#undef F8_SCHED
#undef F8_GOFF
}
}
namespace attn_body {
using bf16=__hip_bfloat16;
using bf16x8=__attribute__((ext_vector_type(8)))short;
using s16x4=__attribute__((ext_vector_type(4)))short;
using f32x16=__attribute__((ext_vector_type(16)))float;
using u32x4=__attribute__((ext_vector_type(4)))unsigned;
using f32x4v=__attribute__((ext_vector_type(4)))float;
constexpr int BATCH=16,NHEAD=16,SEQ=2048,D=64,DM=NHEAD*D;
constexpr int NW=8,QBLK=32,QB=QBLK*NW,KVBLK=64,NQB=SEQ/QB;
constexpr int ATTN_PITCH=DM, ATTN_UNIT_ROWS=QB;
__device__ __forceinline__ int crow(int r,int hi){return (r&3)+8*(r>>2)+4*hi;}
#define SBAR() __builtin_amdgcn_sched_barrier(0)
__device__ __forceinline__ void cmask(f32x16&p0,f32x16&p1,int jb,int qrel,int hi){
  const float NEG=-INFINITY; int kb=64*jb+4*hi;
  #pragma unroll
  for(int r=0;r<16;++r){int kv=kb+(r&3)+8*(r>>2); if(kv>qrel)p0[r]=NEG; if(kv+32>qrel)p1[r]=NEG;}
}

constexpr int NSLOT=3, SLOTB=8192;
constexpr int LDS_K=0, LDS_V=NSLOT*SLOTB, LDS_WS=2*NSLOT*SLOTB, LDS_OST=LDS_WS+NW*64*4, LDS_FB=LDS_OST+NW*4096, LDS_BYTES=LDS_FB+SEQ*16;
constexpr float C2=0.125f*1.4426950408889634f;
__device__ __forceinline__ void glds16(const void*gsrc,unsigned lds_dst){unsigned keep;
  asm volatile("s_mov_b32 %0, m0\n\ts_mov_b32 m0, %2\n\ts_nop 0\n\tglobal_load_lds_dwordx4 %1, off\n\ts_mov_b32 m0, %0":"=&s"(keep):"v"(gsrc),"s"(lds_dst):"memory");}
__device__ __forceinline__ float max3f(float a,float b,float c){float r;asm("v_max3_f32 %0, %1, %2, %3":"=v"(r):"v"(a),"v"(b),"v"(c));return r;}
__device__ __forceinline__ float max2f(float a,float b){float r;asm("v_max_f32_e32 %0, %1, %2":"=v"(r):"v"(a),"v"(b));return r;}
__device__ __forceinline__ float fadd_s(float a,float b){float r;asm("v_add_f32_e32 %0, %1, %2":"=v"(r):"v"(a),"v"(b));return r;}
__device__ __forceinline__ float fsub_s(float a,float b){float r;asm("v_sub_f32_e32 %0, %1, %2":"=v"(r):"v"(a),"v"(b));return r;}
typedef float f32x2_t __attribute__((ext_vector_type(2))); typedef __bf16 bf16x2_t __attribute__((ext_vector_type(2)));
__device__ __forceinline__ unsigned cvtpk_s(float lo,float hi){f32x2_t v={lo,hi};bf16x2_t b=__builtin_convertvector(v,bf16x2_t);return __builtin_bit_cast(unsigned,b);}
#define WAIT_BAR(N) asm volatile("s_waitcnt vmcnt(" #N ") lgkmcnt(0)\n\ts_barrier":::"memory")

__device__ __forceinline__ bf16x8 mk_qbias(float mhat,int hi){
  const float x=-mhat; const unsigned h=cvtpk_s(x,0.f)&0xffffu; const float r1=x-__uint_as_float(h<<16); const unsigned m=cvtpk_s(r1,0.f)&0xffffu; const float r2=r1-__uint_as_float(m<<16); const unsigned l=cvtpk_s(r2,0.f)&0xffffu;
  u32x4 w; w[0]=0x3F803F80u; w[1]=0x3F80u|(h<<16); w[2]=m|(l<<16); w[3]=0u; if(hi){w[0]=0u;w[1]=0u;w[2]=0u;} return __builtin_bit_cast(bf16x8,w);
}
__device__ __forceinline__ void qkt(f32x16&p0,f32x16&p1,const char*Kslot,const bf16x8*qr,bf16x8 fk0,bf16x8 fk1,bf16x8 qbias,int r32,int hi){
  const char*kb=Kslot+hi*1024+r32*16;
  p0=__builtin_amdgcn_mfma_f32_32x32x16_bf16(fk0,qbias,f32x16{},0,0,0);p1=__builtin_amdgcn_mfma_f32_32x32x16_bf16(fk1,qbias,f32x16{},0,0,0);
  #pragma unroll
  for(int d0=0;d0<4;++d0){
    const bf16x8 b0=*reinterpret_cast<const bf16x8*>(kb+d0*2048);
    const bf16x8 b1=*reinterpret_cast<const bf16x8*>(kb+d0*2048+512);
    p0=__builtin_amdgcn_mfma_f32_32x32x16_bf16(b0,qr[d0],p0,0,0,0);p1=__builtin_amdgcn_mfma_f32_32x32x16_bf16(b1,qr[d0],p1,0,0,0);}
}
typedef __attribute__((address_space(3))) const char* lds_cptr;
typedef short v4i16_t __attribute__((ext_vector_type(4)));
__device__ __forceinline__ void kload8(bf16x8*kf,lds_cptr kp){
  kf[0]=*(const __attribute__((address_space(3))) bf16x8*)(kp);      kf[1]=*(const __attribute__((address_space(3))) bf16x8*)(kp+512);
  kf[2]=*(const __attribute__((address_space(3))) bf16x8*)(kp+2048); kf[3]=*(const __attribute__((address_space(3))) bf16x8*)(kp+2560);
  kf[4]=*(const __attribute__((address_space(3))) bf16x8*)(kp+4096); kf[5]=*(const __attribute__((address_space(3))) bf16x8*)(kp+4608);
  kf[6]=*(const __attribute__((address_space(3))) bf16x8*)(kp+6144); kf[7]=*(const __attribute__((address_space(3))) bf16x8*)(kp+6656);
}
__device__ __forceinline__ void kload2(bf16x8*kf,lds_cptr kp,int j){ kf[2*j]=*(const __attribute__((address_space(3))) bf16x8*)(kp+j*2048); kf[2*j+1]=*(const __attribute__((address_space(3))) bf16x8*)(kp+j*2048+512); }
__device__ __forceinline__ s16x4 vtr(lds_cptr p){ return __builtin_bit_cast(s16x4,__builtin_amdgcn_ds_read_tr16_b64_v4i16((__attribute__((address_space(3))) v4i16_t*)p)); }
__device__ __forceinline__ float rowmax(const f32x16&p0,const f32x16&p1){
  float a=max3f(p0[0],p0[1],p1[0]),b=max3f(p0[2],p0[3],p1[1]);a=max3f(a,p1[2],p1[3]);
  #pragma unroll
  for(int r=4;r<16;r+=4){a=max3f(a,p0[r],p0[r+1]);b=max3f(b,p0[r+2],p0[r+3]);a=max3f(a,p1[r],p1[r+1]);b=max3f(b,p1[r+2],p1[r+3]);}
  const float m=max2f(a,b);
  auto rr=__builtin_amdgcn_permlane32_swap(__float_as_uint(m),__float_as_uint(m),false,false);
  return max2f(__uint_as_float(rr[0]),__uint_as_float(rr[1]));
}
__device__ __forceinline__ void pv(f32x16*o,int vb,bf16x8 pa0,bf16x8 pa1,bf16x8 pa2,bf16x8 pa3){
  #pragma unroll
  for(int d0=0;d0<2;++d0){s16x4 lo[4],hi[4];
    #pragma unroll
    for(int ks=0;ks<4;++ks){
      asm volatile("ds_read_b64_tr_b16 %0,%1 offset:%c2":"=&v"(lo[ks]):"v"(vb),"i"(d0*4096+ks*1024):"memory");
      asm volatile("ds_read_b64_tr_b16 %0,%1 offset:%c2":"=&v"(hi[ks]):"v"(vb),"i"(d0*4096+ks*1024+512):"memory");}
    asm volatile("s_waitcnt lgkmcnt(0)":::"memory");SBAR();
    #define PK(k) (bf16x8){lo[k][0],lo[k][1],lo[k][2],lo[k][3],hi[k][0],hi[k][1],hi[k][2],hi[k][3]}
    o[d0]=__builtin_amdgcn_mfma_f32_32x32x16_bf16(pa0,PK(0),o[d0],0,0,0);
    o[d0]=__builtin_amdgcn_mfma_f32_32x32x16_bf16(pa1,PK(1),o[d0],0,0,0);
    o[d0]=__builtin_amdgcn_mfma_f32_32x32x16_bf16(pa2,PK(2),o[d0],0,0,0);
    o[d0]=__builtin_amdgcn_mfma_f32_32x32x16_bf16(pa3,PK(3),o[d0],0,0,0);
    #undef PK
  }
}

#ifndef ATTN_STORE16
#define ATTN_STORE16(p,v) (*(u32x4*)(p)=(v))
#endif
template<int THRL> __device__ __forceinline__ void attn_unit(int b,int h,int qb,const bf16*Q,const bf16*__restrict__ K,const bf16*__restrict__ V,const bf16*__restrict__ G,bf16*O,char*shm){
  int tid_=threadIdx.x; asm volatile("":"+v"(tid_)); const int tid=tid_,lane=tid&63,r32=lane&31,hi=lane>>5; const int wid=__builtin_amdgcn_readfirstlane(tid>>6);
  const long rowbase=(long)b*SEQ; const int q0=qb*QB;
  const bf16*Qw=Q+(rowbase+q0+wid*QBLK)*DM+h*D;
  const bf16*Kh=K+rowbase*DM+h*D,*Vh=V+rowbase*DM+h*D;
  const unsigned lds0=(unsigned)(uintptr_t)shm;
  float*wsf=(float*)(shm+LDS_WS)+wid*64;
  const bf16*ksrc=Kh+(long)lane*DM+wid*8;
  const bf16*vsrc=Vh+(long)(16*(wid&3)+(lane>>2))*DM+(wid>>2)*32+(lane&3)*8;
  const unsigned kdst=lds0+LDS_K+wid*1024, vdst=lds0+LDS_V+wid*1024;
  #define DMA_K(t,slot) glds16(ksrc+(long)(t)*KVBLK*DM,(unsigned)__builtin_amdgcn_readfirstlane(kdst+(slot)))
  #define DMA_V(t,slot) glds16(vsrc+(long)(t)*KVBLK*DM,(unsigned)__builtin_amdgcn_readfirstlane(vdst+(slot)))
  const int vb0=(int)(lds0+LDS_V)+((lane>>4)&1)*32+(lane&3)*8+(4*hi+((lane&15)>>2))*64;
  const char*Kbase=shm+LDS_K; bf16x8 kf[8];
  const lds_cptr shm3=(lds_cptr)shm; const lds_cptr kp0=shm3+LDS_K+hi*1024+r32*16; const lds_cptr vp0=shm3+LDS_V+((lane>>4)&1)*32+(lane&3)*8+(4*hi+((lane&15)>>2))*64;
  const int NT=(q0+QB)/KVBLK;
  DMA_K(0,0);DMA_V(0,0);DMA_K(1,SLOTB);
  bf16x8 qr[4];
  #pragma unroll
  for(int d0=0;d0<4;++d0)qr[d0]=*reinterpret_cast<const bf16x8*>(&Qw[(long)r32*DM+d0*16+hi*8]);
  float mhat; { const u32x4 eq=*(const __attribute__((address_space(3))) u32x4*)(shm3+LDS_FB+(q0+wid*QBLK+r32)*16); mhat=__uint_as_float(eq[0]<<16)+__uint_as_float(eq[0]&0xffff0000u)+__uint_as_float(eq[1]<<16); }
  float l_reg=0.f;f32x16 o[2];o[0]=f32x16{};o[1]=f32x16{};bf16x8 qbias=mk_qbias(mhat,hi);asm volatile("":"+v"(qbias));
  const int qrel=wid*QBLK+r32;
  #define CMASK(P0,P1,t) do{int jb_=(t)-(NT-4); if(jb_>=0)cmask(P0,P1,jb_,qrel,hi);}while(0)
  const lds_cptr fbt=shm3+LDS_FB+r32*16;
  #define FKLD(t,blk) (*(const __attribute__((address_space(3))) bf16x8*)(fbt+((t)*64+(blk)*32)*16))
  bool resc=false;
  #define START(P0,P1) do{ const float rm=rowmax(P0,P1); resc=false; \
    { const float dl=rm; mhat=fadd_s(mhat,dl); \
      _Pragma("unroll") for(int r=0;r<16;++r){P0[r]=fsub_s(P0[r],dl);P1[r]=fsub_s(P1[r],dl);} \
      qbias=mk_qbias(mhat,hi); asm volatile("":"+v"(qbias)); } \
    _Pragma("unroll") for(int r=0;r<16;++r)P0[r]=__builtin_amdgcn_exp2f(P0[r]); }while(0)
  #define RESC() do{ if(resc){ asm volatile("s_waitcnt lgkmcnt(0)":::"memory"); \
      _Pragma("unroll") for(int d_=0;d_<2;++d_) _Pragma("unroll") for(int r=0;r<16;++r)o[d_][r]*=wsf[crow(r,hi)]; } }while(0)
  f32x16 pA0,pA1,pB0,pB1;
  int sl_prev=0,sl_cur=0,sl_next=SLOTB;
  #define ROT() do{sl_prev=sl_cur;sl_cur=sl_next;sl_next=(sl_next==(NSLOT-1)*SLOTB)?0:sl_next+SLOTB;}while(0)
  DMA_K(2,2*SLOTB);
  WAIT_BAR(3);
  qkt(pA0,pA1,Kbase,qr,FKLD(0,0),FKLD(0,1),qbias,r32,hi);asm volatile("s_nop 15\n\ts_nop 7":"+v"(pA0),"+v"(pA1));CMASK(pA0,pA1,0);
  START(pA0,pA1);
  _Pragma("unroll") for(int r=0;r<16;++r)pA1[r]=__builtin_amdgcn_exp2f(pA1[r]);
  WAIT_BAR(0);
  DMA_K(3,0);DMA_V(1,SLOTB);
  ROT();
  kload8(kf,kp0+sl_cur);
  WAIT_BAR(2);
  s16x4 vlo[8],vhi[8]; u32x4 pw0,pw1,pw2,pw3;
  #define PKW(P,B) cvtpk_s(P[B],P[B+1])
  #define PAF(k) __builtin_bit_cast(bf16x8,pw##k)
  #define VFR(i) (bf16x8){vlo[i][0],vlo[i][1],vlo[i][2],vlo[i][3],vhi[i][0],vhi[i][1],vhi[i][2],vhi[i][3]}
  #define PIN(x) asm volatile("":"+v"(x))
  #define MX3(a,b,c) __builtin_fmaxf(__builtin_fmaxf((a),(b)),(c))
  #define GAPA(MF,A0,A1,A2,A3,W0,W1,PW) do{ MF; sacc+=A0; sacc+=A1; sacc+=A2; sacc+=A3; PIN(sacc); W0; W1; PIN(PW); SBAR(); }while(0)
  #define EX(v) __builtin_amdgcn_exp2f(v)
  #define GAPB(MF,X,B) do{ MF; X[B]=EX(X[B]); X[B+1]=EX(X[B+1]); X[B+2]=EX(X[B+2]); X[B+3]=EX(X[B+3]); PIN(X); SBAR(); }while(0)
  #define VRD(i) do{ vlo[i]=vtr(vp_+(((i)>>2)*4096+((i)&3)*1024)); vhi[i]=vtr(vp_+(((i)>>2)*4096+((i)&3)*1024+512)); }while(0)
  #define KRD(G,j) do{ if(G){ kload2(kf,kp0+sl_next,j); SBAR(); } }while(0)
  #define STEP(C0,C1,P0,P1,t,GK,GV,GL) do{ SBAR(); \
    const lds_cptr vp_=vp0+sl_prev; const bf16x8 fk0_=FKLD(t,0), fk1_=FKLD(t,1); \
    VRD(0); SBAR(); float sacc=(P0[0]+P0[1]); \
    GAPA(C0=__builtin_amdgcn_mfma_f32_32x32x16_bf16(kf[0],qr[0],f32x16{},0,0,0), P0[2],P0[3],P0[4],P0[5],     pw0[0]=PKW(P0,0), pw0[1]=PKW(P0,2), pw0); \
    VRD(4); SBAR(); GAPA(C1=__builtin_amdgcn_mfma_f32_32x32x16_bf16(kf[1],qr[0],f32x16{},0,0,0), P0[6],P0[7],P0[8],P0[9],     pw0[2]=PKW(P0,4), pw0[3]=PKW(P0,6), pw0); \
    VRD(1); SBAR(); GAPA(C0=__builtin_amdgcn_mfma_f32_32x32x16_bf16(kf[2],qr[1],C0,0,0,0),   P0[10],P0[11],P0[12],P0[13], pw1[0]=PKW(P0,8), pw1[1]=PKW(P0,10), pw1); \
    VRD(5); SBAR(); GAPA(C1=__builtin_amdgcn_mfma_f32_32x32x16_bf16(kf[3],qr[1],C1,0,0,0),   P0[14],P0[15],P1[0],P1[1],   pw1[2]=PKW(P0,12),pw1[3]=PKW(P0,14), pw1); \
    VRD(2); SBAR(); GAPA(C0=__builtin_amdgcn_mfma_f32_32x32x16_bf16(kf[4],qr[2],C0,0,0,0),   P1[2],P1[3],P1[4],P1[5],     pw2[0]=PKW(P1,0), pw2[1]=PKW(P1,2), pw2); \
    VRD(6); SBAR(); GAPA(C1=__builtin_amdgcn_mfma_f32_32x32x16_bf16(kf[5],qr[2],C1,0,0,0),   P1[6],P1[7],P1[8],P1[9],     pw2[2]=PKW(P1,4), pw2[3]=PKW(P1,6), pw2); \
    VRD(3); SBAR(); GAPA(C0=__builtin_amdgcn_mfma_f32_32x32x16_bf16(kf[6],qr[3],C0,0,0,0),   P1[10],P1[11],P1[12],P1[13], pw3[0]=PKW(P1,8), pw3[1]=PKW(P1,10), pw3); \
    VRD(7); SBAR(); GAPA(C1=__builtin_amdgcn_mfma_f32_32x32x16_bf16(kf[7],qr[3],C1,0,0,0),   P1[14],P1[15],0.f,0.f,       pw3[2]=PKW(P1,12),pw3[3]=PKW(P1,14), pw3); \
    C0=__builtin_amdgcn_mfma_f32_32x32x16_bf16(fk0_,qbias,C0,0,0,0); C1=__builtin_amdgcn_mfma_f32_32x32x16_bf16(fk1_,qbias,C1,0,0,0); \
    l_reg+=sacc; \
    if(GK){DMA_K((t)+3,sl_cur);} if(GV){DMA_V((t)+1,sl_next);} \
    CMASK(C0,C1,t); \
    { float a=MX3(C0[0],C0[1],C1[0]),b=MX3(C0[2],C0[3],C1[1]); a=MX3(a,C1[2],C1[3]); \
      _Pragma("unroll") for(int r=4;r<16;r+=4){a=MX3(a,C0[r],C0[r+1]);b=MX3(b,C0[r+2],C0[r+3]);a=MX3(a,C1[r],C1[r+1]);b=MX3(b,C1[r+2],C1[r+3]);} \
      float rm=__builtin_fmaxf(a,b); { auto rr=__builtin_amdgcn_permlane32_swap(__float_as_uint(rm),__float_as_uint(rm),false,false); rm=__builtin_fmaxf(__uint_as_float(rr[0]),__uint_as_float(rr[1])); } \
      resc=false; \
      if(__builtin_expect(__any(rm>(float)THRL),0)){ const float dl=__builtin_fmaxf(rm,0.f); mhat+=dl; \
        _Pragma("unroll") for(int r=0;r<16;++r){C0[r]-=dl;C1[r]-=dl;} \
        qbias=mk_qbias(mhat,hi); asm volatile("":"+v"(qbias)); \
        const float f=__builtin_amdgcn_exp2f(-dl); l_reg*=f; if(hi==0)wsf[r32]=f; resc=true; } } \
    SBAR(); \
    GAPB(o[0]=__builtin_amdgcn_mfma_f32_32x32x16_bf16(PAF(0),VFR(0),o[0],0,0,0), C0,0); \
    GAPB(o[1]=__builtin_amdgcn_mfma_f32_32x32x16_bf16(PAF(0),VFR(4),o[1],0,0,0), C0,4); \
    KRD(GL,0); GAPB(o[0]=__builtin_amdgcn_mfma_f32_32x32x16_bf16(PAF(1),VFR(1),o[0],0,0,0), C0,8); \
    KRD(GL,1); GAPB(o[1]=__builtin_amdgcn_mfma_f32_32x32x16_bf16(PAF(1),VFR(5),o[1],0,0,0), C0,12); \
    KRD(GL,2); GAPB(o[0]=__builtin_amdgcn_mfma_f32_32x32x16_bf16(PAF(2),VFR(2),o[0],0,0,0), C1,0); \
    KRD(GL,3); GAPB(o[1]=__builtin_amdgcn_mfma_f32_32x32x16_bf16(PAF(2),VFR(6),o[1],0,0,0), C1,4); \
    GAPB(o[0]=__builtin_amdgcn_mfma_f32_32x32x16_bf16(PAF(3),VFR(3),o[0],0,0,0), C1,8); \
    GAPB(o[1]=__builtin_amdgcn_mfma_f32_32x32x16_bf16(PAF(3),VFR(7),o[1],0,0,0), C1,12); \
    }while(0)
  int t=1;
  #undef CMASK
  #define CMASK(P0,P1,t) do{}while(0)
  for(;t+5<NT;t+=2){
    STEP(pB0,pB1,pA0,pA1,t,true,true,true);     WAIT_BAR(2); RESC(); ROT();
    STEP(pA0,pA1,pB0,pB1,t+1,true,true,true);   WAIT_BAR(2); RESC(); ROT();
  }
  #undef CMASK
  #define CMASK(P0,P1,t) do{int jb_=(t)-(NT-4); if(jb_>=0)cmask(P0,P1,jb_,qrel,hi);}while(0)
  #define ENDW(tt) do{ if((tt)+3<NT){WAIT_BAR(2);} else if((tt)+2<NT){WAIT_BAR(1);} else {WAIT_BAR(0);} }while(0)
  for(;t+1<NT;t+=2){
    STEP(pB0,pB1,pA0,pA1,t,(t+3<NT),(t+1<NT),(t+1<NT));       ENDW(t);   RESC(); ROT();
    STEP(pA0,pA1,pB0,pB1,t+1,(t+4<NT),(t+2<NT),(t+2<NT));     ENDW(t+1); RESC(); ROT();
  }
  STEP(pB0,pB1,pA0,pA1,NT-1,false,false,false); RESC();
  u32x4 ggv[4];
  { const bf16*Gw_=G+(rowbase+q0+wid*QBLK)*DM+h*D;
    #pragma unroll
    for(int i=0;i<4;++i)ggv[i]=*(const u32x4*)(Gw_+(long)(i*8+(lane>>3))*DM+(lane&7)*8); }
  { float sacc=pB0[0]+pB0[1]; _Pragma("unroll") for(int r=2;r<16;++r)sacc+=pB0[r]; _Pragma("unroll") for(int r=0;r<16;++r)sacc+=pB1[r]; l_reg+=sacc;
    pw0=(u32x4){PKW(pB0,0),PKW(pB0,2),PKW(pB0,4),PKW(pB0,6)};pw1=(u32x4){PKW(pB0,8),PKW(pB0,10),PKW(pB0,12),PKW(pB0,14)};pw2=(u32x4){PKW(pB1,0),PKW(pB1,2),PKW(pB1,4),PKW(pB1,6)};pw3=(u32x4){PKW(pB1,8),PKW(pB1,10),PKW(pB1,12),PKW(pB1,14)};
    SBAR(); pv(o,vb0+sl_cur,PAF(0),PAF(1),PAF(2),PAF(3)); }
  #undef PKW
  #undef PAF
  #undef VFR
  #undef PIN
  #undef MX3
  #undef GAPA
  #undef GAPB
  #undef EX
  #undef VRD
  #undef KRD
  #undef STEP
  #undef ENDW
  {auto rr=__builtin_amdgcn_permlane32_swap(__float_as_uint(l_reg),__float_as_uint(l_reg),false,false);l_reg=__uint_as_float(rr[0])+__uint_as_float(rr[1]);}
  if(hi==0)wsf[32+r32]=l_reg;asm volatile("s_waitcnt lgkmcnt(0)":::"memory");
  float rli[16];
  #pragma unroll
  for(int r=0;r<16;++r)rli[r]=__builtin_amdgcn_rcpf(wsf[32+crow(r,hi)]);
  bf16*Ow=O+(rowbase+q0+wid*QBLK)*DM+h*D;
  { bf16*stg=(bf16*)(shm+LDS_OST)+wid*2048;
    #pragma unroll
    for(int r=0;r<16;++r){const int orow=crow(r,hi);
      #pragma unroll
      for(int d0=0;d0<2;++d0)stg[orow*64+d0*32+r32]=__float2bfloat16(o[d0][r]*rli[r]);}
    asm volatile("s_waitcnt lgkmcnt(0)":::"memory");
    #pragma unroll
    for(int i=0;i<4;++i){const int row=i*8+(lane>>3),ch=lane&7; const u32x4 v=*(const u32x4*)(stg+row*64+ch*8); const u32x4 gg=ggv[i]; u32x4 w;
      #pragma unroll
      for(int c=0;c<4;++c){ const float lo=__uint_as_float(v[c]<<16)*__uint_as_float(gg[c]<<16), hh=__uint_as_float(v[c]&0xffff0000u)*__uint_as_float(gg[c]&0xffff0000u); w[c]=cvtpk_s(lo,hh); }
      ATTN_STORE16(Ow+(long)row*DM+ch*8,w);} }
  asm volatile("s_waitcnt lgkmcnt(0)\n\ts_barrier":::"memory");
  #undef DMA_K
  #undef DMA_V
  #undef CMASK
  #undef FKLD
  #undef START
  #undef RESC
  #undef ROT
}
constexpr int ATTN_LDS_BYTES=LDS_BYTES;
struct AttnTensors { const bf16* Q; const bf16* K; const bf16* V; const bf16* G; bf16* O; const u32x4* FBT; };
struct AttnUnit { int bh; int qb; };
struct StaticOrder {
  int vcu, G;
  __device__ __forceinline__ bool next(int i,AttnUnit&u)const{ u.bh=vcu+(i>>3)*G; if(u.bh>=BATCH*NHEAD)return false; u.qb=(i+(vcu&7))&7; return true; }
};
__device__ __forceinline__ void scan_bias_table(char*lds,const float*FG,const float*bfp,int bh,u32x4*tab){
  float*wtot=(float*)lds; const int b_=bh/NHEAD,h_=bh%NHEAD,t_=threadIdx.x,ln_=t_&63,wv_=t_>>6; const float bf_=bfp[h_]; float p_[4]; float run=0.f;
  #pragma unroll
  for(int i=0;i<4;++i){ const float xg=FG[((size_t)b_*SEQ+4*t_+i)*NHEAD+h_]+bf_; run+=(xg>=0.f?-log1pf(expf(-xg)):xg-log1pf(expf(xg))); p_[i]=run; }
  float inc=run;
  #pragma unroll
  for(int o=1;o<64;o<<=1){ const float tt=__shfl_up(inc,o); if(ln_>=o)inc+=tt; }
  __syncthreads();
  if(ln_==63)wtot[wv_]=inc;
  __syncthreads();
  float base_=inc-run; for(int w=0;w<wv_;++w)base_+=wtot[w];
  #pragma unroll
  for(int i=0;i<4;++i){ const float x=-1.4426950408889634f*(base_+p_[i]); const unsigned h=cvtpk_s(x,0.f)&0xffffu; const float r1=x-__uint_as_float(h<<16); const unsigned m=cvtpk_s(r1,0.f)&0xffffu;
    const float r2=r1-__uint_as_float(m<<16); const unsigned l=cvtpk_s(r2,0.f)&0xffffu; u32x4 w; w[0]=h|(m<<16); w[1]=l|(0x3F80u<<16); w[2]=0x3F803F80u; w[3]=0u; tab[(size_t)bh*SEQ+4*t_+i]=w; }
}
template<class Sched,int THRL=8> __device__ __forceinline__ void attn_phase(char*lds,const AttnTensors&T,const Sched&S){
  AttnUnit u; int cur=-1;
  for(int i=0;S.next(i,u);++i){
    if(u.bh!=cur){ cur=u.bh; u32x4*fb=(u32x4*)(lds+LDS_FB); const u32x4*src=T.FBT+(size_t)u.bh*SEQ;
      #pragma unroll
      for(int k=0;k<SEQ/(NW*64);++k)fb[threadIdx.x+k*NW*64]=src[threadIdx.x+k*NW*64];
      asm volatile("s_waitcnt vmcnt(0) lgkmcnt(0)\n\ts_barrier":::"memory"); }
    attn_unit<THRL>(u.bh/NHEAD,u.bh%NHEAD,u.qb,T.Q,T.K,T.V,T.G,T.O,lds);
  }
}
#undef SBAR
#undef WAIT_BAR
}
#define GAS __attribute__((address_space(1)))
#define LAS __attribute__((address_space(3)))
typedef unsigned short bf16;
typedef unsigned v4u __attribute__((ext_vector_type(4)));
typedef float f32x4 __attribute__((ext_vector_type(4)));
typedef short bf16x8 __attribute__((ext_vector_type(8)));
typedef GAS unsigned gu32;
typedef GAS unsigned long long gu64;
#define RLX_AGENT __ATOMIC_RELAXED, __HIP_MEMORY_SCOPE_AGENT
#define LDS_WAIT() asm volatile("s_waitcnt lgkmcnt(0)" ::: "memory")
#define VM_WAIT() asm volatile("s_waitcnt vmcnt(0)" ::: "memory")
__device__ __forceinline__ unsigned long long rt() { return __builtin_amdgcn_s_memrealtime(); }
__device__ __forceinline__ unsigned f2bf(float f) { unsigned u = __builtin_bit_cast(unsigned, f); return (u + 0x7fffu + ((u >> 16) & 1u)) >> 16; }
__device__ __forceinline__ unsigned pk2(float lo, float hi) { return f2bf(lo) | (f2bf(hi) << 16); }

#define XB_TMO      128
#define XB_XCNT(j)  (256  + 64 * (j))
#define XB_XSUB(j)  (1280 + 64 * (j))
#define XB_XGEN(j)  (2304 + 64 * (j))
#define XB_TOP      3328
#define XB_TOPGEN   3392
#define XCD_BAR_WORDS 3456
#define XB_SPIN_CAP (1u << 18)

__device__ __forceinline__ unsigned xb_ld(unsigned* p)              { return __hip_atomic_load(p, __ATOMIC_RELAXED, __HIP_MEMORY_SCOPE_AGENT); }
__device__ __forceinline__ unsigned xb_add(unsigned* p, unsigned v) { return __hip_atomic_fetch_add(p, v, __ATOMIC_RELAXED, __HIP_MEMORY_SCOPE_AGENT); }
__device__ __forceinline__ unsigned xb_xcc_id() { return (unsigned)__builtin_amdgcn_s_getreg((3 << 11) | 20) & 0xFu; }
#define XB_SPIN(cond, bar) do { unsigned _sp = 0; while (cond) { __builtin_amdgcn_s_sleep(1); \
    if ((++_sp & 255u) == 0u) { if (xb_ld(&(bar)[XB_TMO])) break; if (_sp > XB_SPIN_CAP) { atomicAdd(&(bar)[XB_TMO], 1u); break; } } } } while (0)

struct XcdBarrier {
    unsigned* bar; unsigned x;
    volatile LAS unsigned* st;
};

__device__ __forceinline__ XcdBarrier xcd_barrier_post(unsigned* bar, volatile LAS unsigned* st) {
    XcdBarrier b; b.bar = bar; b.x = xb_xcc_id(); b.st = st;
    if (threadIdx.x == 0) (void)xb_add(&bar[XB_XCNT(b.x)], 1u);
    return b;
}
__device__ __forceinline__ void xcd_barrier_complete(unsigned* bar, unsigned x, unsigned& nloc, unsigned& nx) {
    const unsigned G = gridDim.x * gridDim.y * gridDim.z;
    unsigned sum, cnt, mine, sp = 0u;
    for (;;) {
        sum = 0u; cnt = 0u; mine = 0u;
#pragma unroll
        for (unsigned j = 0; j < 16; ++j) { const unsigned c = xb_ld(&bar[XB_XCNT(j)]); sum += c; cnt += (c > 0u) ? 1u : 0u; mine = (j == x) ? c : mine; }
        if (sum == G) break;
        __builtin_amdgcn_s_sleep(1);
        if ((++sp & 255u) == 0u) { if (xb_ld(&bar[XB_TMO])) break; if (sp > XB_SPIN_CAP) { atomicAdd(&bar[XB_TMO], 1u); break; } }
    }
    nloc = mine > 0u ? mine : 1u; nx = cnt > 0u ? cnt : 1u;
}

__device__ __forceinline__ void xcd_barrier(const XcdBarrier& b) {
    asm volatile("s_waitcnt vmcnt(0)" ::: "memory");
    __syncthreads();
    if (threadIdx.x == 0) {
        unsigned* bar = b.bar;
        __builtin_amdgcn_s_waitcnt(0);
        unsigned nloc = b.st[0], nx = b.st[1];
        if (nloc == 0u) { xcd_barrier_complete(bar, b.x, nloc, nx); b.st[0] = nloc; b.st[1] = nx; }
        const unsigned old = xb_add(&bar[XB_XSUB(b.x)], 1u);
        const unsigned gen = old / nloc;
        if (old + 1u == (gen + 1u) * nloc) {
            __builtin_amdgcn_fence(__ATOMIC_RELEASE, "agent");
            asm volatile("s_waitcnt vmcnt(0)" ::: "memory");
            const unsigned og = xb_add(&bar[XB_TOP], 1u);
            const unsigned tg = og / nx;
            if (og + 1u == (tg + 1u) * nx) xb_add(&bar[XB_TOPGEN], 1u);
            else XB_SPIN(xb_ld(&bar[XB_TOPGEN]) == tg, bar);
            __builtin_amdgcn_fence(__ATOMIC_ACQUIRE, "agent");
            xb_add(&bar[XB_XGEN(b.x)], 1u);
            asm volatile("s_waitcnt vmcnt(0)" ::: "memory");
        } else {
            XB_SPIN(xb_ld(&bar[XB_XGEN(b.x)]) == gen, bar);
            __builtin_amdgcn_fence(__ATOMIC_ACQUIRE, "agent");
            asm volatile("s_waitcnt vmcnt(0)" ::: "memory");
        }
    }
    __syncthreads();
}

constexpr int NWAVES = 8;
constexpr int DM = 1024, BATCH = 16, SEQ = 2048, MROWS = BATCH * SEQ;
constexpr int A_FFN = 6144, A_HALF = 3072, A_GROUPS = 8, A_GD = 384, GCH = 128, CHK = 64;
constexpr int D_FF = 2816, NEXP = 8, D_EXP = 3584, NHEAD = 16, HD = 64;
constexpr int KVW_LD = 2 * DM + NHEAD;
constexpr float RMS_EPS = 1e-6f;
constexpr float W8_SCALE = 64.0f;
constexpr int W8_SCALE_E8M0 = 0x79797979;
enum { I_X = 0, I_A_NORM_G, I_A_W_IN, I_A_V_NORM_G, I_A_W_SP, I_A_B_SP, I_A_W_OUT, I_F_NORM_G, I_F_W_IN, I_F_W_OUT, I_KV_NORM_G, I_KV_W, I_KV_B_F, I_K_NORM_G,
       I_B_NORM_G, I_B_W_IN, I_Q_NORM_G, I_B_W_OUT, I_M_NORM_G, I_M_W_ROUTER, I_M_W_IN, I_M_W_OUT, N_IN };

constexpr size_t MiB = 1u << 20;
constexpr size_t WS_CTL = 0, CTL_ZERO_BYTES = 1 * MiB;
constexpr size_t WS_RSQ = 4 * MiB;
constexpr size_t WS_VPART = 286 * MiB;
constexpr size_t WS_FG = 2 * MiB;
constexpr size_t WS_GW = 6 * MiB;
constexpr size_t WS_TOKSLOT = 7 * MiB;
constexpr size_t WS_WA_IN = 8 * MiB, WS_WA_OUT = 20 * MiB, WS_WF_IN = 26 * MiB, WS_WF_OUT = 37 * MiB, WS_WKV = 43 * MiB, WS_WBIN = 47 * MiB, WS_WBOUT = 51 * MiB;
constexpr size_t WS_WM_IN = 53 * MiB, WS_WM_OUT = 165 * MiB;
constexpr size_t WS_XN = 222 * MiB, WS_XQ = 286 * MiB;
constexpr size_t WS_BIG = 350 * MiB;
constexpr int MAXSLOT = MROWS * 2 + NEXP * 256;
constexpr size_t WS_XG = 286 * MiB;
constexpr size_t WS_ACT = 418 * MiB;
constexpr size_t WS_Y = 8 * MiB;
constexpr size_t WS_ELIST = 880 * MiB, WS_EWL = 881 * MiB;
constexpr size_t WS_FBT = 700 * MiB;
constexpr int YP_ROWS = 16 * 256;
constexpr size_t WS_END = 883 * MiB;
constexpr int CW_BAR = 4096, CW_CNT = 64;

constexpr int RING_OFF = 0, RING_BYTES = 131072;
constexpr int LDSCTL_OFF = RING_BYTES, MISC_OFF = LDSCTL_OFF + 320;
constexpr int LDS_BYTES = 147456;

typedef short s16x4 __attribute__((ext_vector_type(4)));
__device__ __forceinline__ unsigned off_b(unsigned row, unsigned ch) { return 256u * row + 16u * (ch ^ (((row & 3u) << 2) | ((row >> 2) & 3u))); }
struct Frame {
    LAS unsigned char* lds; volatile LAS unsigned* MISC; gu32* ctl;
    int tid, lane, wave, vcu, G;
};
__device__ __forceinline__ float wave_sum(float v) {
#pragma unroll
    for (int o = 1; o < 64; o <<= 1) v += __shfl_xor(v, o);
    return v;
}
__device__ __forceinline__ void tr_load(float (&tmp)[32], const float* W, int ldw, int k0, int n0, int lane) {
#pragma unroll
    for (int i = 0; i < 32; ++i) { const int kk = 2 * i + (lane >> 5); tmp[i] = W[(size_t)(k0 + kk) * ldw + n0 + (lane & 31)]; }
}
template <class RowMap>
__device__ __forceinline__ void tr_store(float (&tmp)[32], int K, bf16* WT, LAS float* scr, int k0, int n0, int lane, const RowMap& rowmap, const float* gk, float f8scale = 0.f) {
    if (gk) {
#pragma unroll
        for (int i = 0; i < 32; ++i) tmp[i] *= gk[k0 + 2 * i + (lane >> 5)]; }
#pragma unroll
    for (int i = 0; i < 32; ++i) { const int kk = 2 * i + (lane >> 5); scr[kk * 33 + (lane & 31)] = tmp[i]; }
    LDS_WAIT(); asm volatile("" ::: "memory");
    const int c = lane & 7;
#pragma unroll
    for (int j = 0; j < 4; ++j) { const int n = (lane >> 3) + 8 * j; const LAS float* s = scr + (8 * c) * 33 + n;
        if (f8scale != 0.f) { unsigned lo = 0u, hi = 0u;
            lo = __builtin_amdgcn_cvt_pk_fp8_f32(s[0 * 33] * f8scale, s[1 * 33] * f8scale, lo, false); lo = __builtin_amdgcn_cvt_pk_fp8_f32(s[2 * 33] * f8scale, s[3 * 33] * f8scale, lo, true);
            hi = __builtin_amdgcn_cvt_pk_fp8_f32(s[4 * 33] * f8scale, s[5 * 33] * f8scale, hi, false); hi = __builtin_amdgcn_cvt_pk_fp8_f32(s[6 * 33] * f8scale, s[7 * 33] * f8scale, hi, true);
            *(GAS unsigned long long*)((GAS unsigned char*)WT + (size_t)rowmap(n0 + n) * K + k0 + 8 * c) = (unsigned long long)lo | ((unsigned long long)hi << 32); }
        else { v4u o; o.x = pk2(s[0 * 33], s[1 * 33]); o.y = pk2(s[2 * 33], s[3 * 33]); o.z = pk2(s[4 * 33], s[5 * 33]); o.w = pk2(s[6 * 33], s[7 * 33]);
            *(GAS v4u*)(WT + (size_t)rowmap(n0 + n) * K + k0 + 8 * c) = o; } }
    LDS_WAIT(); asm volatile("" ::: "memory");
}
struct MapId { __device__ __forceinline__ int operator()(int n) const { return n; } };
struct MapGlu { int half; __device__ __forceinline__ int operator()(int n) const { const int b = n >= half ? 1 : 0, x = n - b * half; return (x >> 7) * 256 + b * 128 + (x & 127); } };
struct MapGlu64 { int half; __device__ __forceinline__ int operator()(int n) const { const int b = n >= half ? 1 : 0, x = n - b * half, pn = x >> 6, xx = x & 63; return pn * 128 + (xx >> 4) * 32 + ((xx >> 2) & 3) * 8 + b * 4 + (xx & 3); } };
struct MapHead { __device__ __forceinline__ int operator()(int n) const { const int blk = n >> 10, hh = (n >> 6) & 15, d = n & 63; return (blk * 4 + (hh >> 2)) * 256 + (d >> 5) * 128 + (hh & 3) * 32 + (d & 31); } };
template <class RowMap>
__device__ __forceinline__ void tr_matrix(Frame& F, const float* W, int ldw, int K, int ncols, bf16* WT, const RowMap& rm, int& gwoff, const float* gk = nullptr, float f8scale = 0.f) {
    LAS float* scr = (LAS float*)(F.lds + RING_OFF + F.wave * 16384);
    const int NGW = F.G * NWAVES, nblk = ncols / 32, items = (K / 64) * nblk;
    int gw = F.vcu * NWAVES + F.wave - gwoff; if (gw < 0) gw += NGW;
    int it = gw; if (it < items) { float ta[32], tb[32]; tr_load(ta, W, ldw, 64 * (it / nblk), 32 * (it % nblk), F.lane);
        for (;;) { const int n1 = it + NGW; if (n1 < items) tr_load(tb, W, ldw, 64 * (n1 / nblk), 32 * (n1 % nblk), F.lane);
            tr_store(ta, K, WT, scr, 64 * (it / nblk), 32 * (it % nblk), F.lane, rm, gk, f8scale); if (n1 >= items) break;
            const int n2 = n1 + NGW; if (n2 < items) tr_load(ta, W, ldw, 64 * (n2 / nblk), 32 * (n2 % nblk), F.lane);
            tr_store(tb, K, WT, scr, 64 * (n1 / nblk), 32 * (n1 % nblk), F.lane, rm, gk, f8scale); if (n2 >= items) break;
            it = n2; } }
    gwoff = (gwoff + items) % NGW;
}
__device__ __forceinline__ void row_load(const float* xrow, int lane, f32x4 (&v)[4]) {
    const GAS f32x4* xr = (const GAS f32x4*)xrow + lane;
#pragma unroll
    for (int j = 0; j < 4; ++j) v[j] = xr[64 * j];
}
__device__ __forceinline__ void row_load(const bf16* xrow, int lane, f32x4 (&v)[4]) {
    const GAS unsigned long long* xr = (const GAS unsigned long long*)xrow + lane;
#pragma unroll
    for (int j = 0; j < 4; ++j) { const unsigned long long w = xr[64 * j]; const unsigned lo = (unsigned)w, hi = (unsigned)(w >> 32);
        v[j] = (f32x4){__uint_as_float(lo << 16), __uint_as_float(lo & 0xffff0000u), __uint_as_float(hi << 16), __uint_as_float(hi & 0xffff0000u)}; }
}
__device__ __forceinline__ float row_rstd(const f32x4 (&v)[4]) { float s = 0.f;
#pragma unroll
    for (int j = 0; j < 4; ++j) s += (v[j].x * v[j].x + v[j].y * v[j].y) + (v[j].z * v[j].z + v[j].w * v[j].w);
    return 1.0f / sqrtf(wave_sum(s) * (1.f / DM) + RMS_EPS);
}
#define ROW_LOOP_BEGIN(src) { f32x4 vn_[4]; if (gw < MROWS) row_load((src) + (size_t)gw * DM, F.lane, vn_); \
        for (int m = gw; m < MROWS; m += NGW) { f32x4 v[4]; _Pragma("unroll") for (int j_ = 0; j_ < 4; ++j_) v[j_] = vn_[j_]; \
            if (m + NGW < MROWS) row_load((src) + (size_t)(m + NGW) * DM, F.lane, vn_); const float r = row_rstd(v);
#define ROW_LOOP_END } }
__device__ __forceinline__ void rms_row_store(const f32x4 (&v)[4], float rstd, const float* g, bf16* orow, int lane, float extra = 1.0f) {
    const GAS f32x4* gr = (const GAS f32x4*)g + lane; GAS unsigned long long* o8 = (GAS unsigned long long*)orow + lane;
#pragma unroll
    for (int j = 0; j < 4; ++j) { const f32x4 gg = gr[64 * j]; const f32x4 y = (v[j] * rstd) * gg * extra;
        o8[64 * j] = (unsigned long long)pk2(y.x, y.y) | ((unsigned long long)pk2(y.z, y.w) << 32); }
}
template <int N> __device__ __forceinline__ float wave_tr_reduce(float (&v)[N], int lane) {
    static_assert(N == 16 || N == 8, "N");
#define TRR_STEP(M, NN) if (N >= NN) { const bool up = (lane & M) != 0; _Pragma("unroll") for (int i = 0; i < NN / 2; ++i) { const float keep = up ? v[i + NN / 2] : v[i], send = up ? v[i] : v[i + NN / 2]; v[i] = keep + __shfl_xor(send, M); } }
    TRR_STEP(8, 16) TRR_STEP(4, 8) TRR_STEP(2, 4) TRR_STEP(1, 2)
#undef TRR_STEP
    float t = v[0];
#pragma unroll
    for (int o = N; o < 64; o <<= 1) t += __shfl_xor(t, o);
    return t;
}
__device__ __forceinline__ float bflo(unsigned u) { return __uint_as_float(u << 16); }
__device__ __forceinline__ float bfhi(unsigned u) { return __uint_as_float(u & 0xffff0000u); }
__device__ __forceinline__ float log_sigmoid(float x) { return x >= 0.f ? -log1pf(expf(-x)) : x - log1pf(expf(x)); }

enum { PH_PRO = 0, PH_GEMM1, PH_SPATIAL, PH_GEMM2, PH_FFN_UP, PH_FFN_DOWN, PH_KVQ, PH_ATTN, PH_OPROJ, PH_ROUTER, PH_MOE_UP, PH_MOE_DOWN, PH_COMBINE, PH_END };
#ifndef MK_ONE_LAUNCH
#define MK_ONE_LAUNCH 1
#endif
#ifndef MK_PH_STOP
#define MK_PH_STOP PH_END
#endif

struct Args { const float* in[N_IN]; float* out; unsigned char* ws; int ph_lo, ph_hi, li, pad; };
__global__ void __launch_bounds__(NWAVES * 64, 2) yoco_fwd(Args args) {
    extern __shared__ __attribute__((aligned(16))) unsigned char lds[];
    Frame F;
    F.lds = (LAS unsigned char*)lds; F.MISC = (volatile LAS unsigned*)(F.lds + MISC_OFF);
    F.tid = threadIdx.x; F.lane = F.tid & 63; F.wave = __builtin_amdgcn_readfirstlane(F.tid >> 6);
    F.G = gridDim.x; { const int bx = blockIdx.x; F.vcu = (F.G % 8 == 0) ? (bx % 8) * (F.G / 8) + bx / 8 : bx; }
    unsigned char* ws = args.ws; F.ctl = (gu32*)(ws + WS_CTL);
    for (int u = F.tid; u < (LDS_BYTES - LDSCTL_OFF) / 4; u += NWAVES * 64) ((LAS unsigned*)(F.lds + LDSCTL_OFF))[u] = 0u;
    __syncthreads();
    XcdBarrier bar; bar.bar = (unsigned*)(F.ctl + CW_BAR) + args.li * XCD_BAR_WORDS; bar.x = 0; bar.st = nullptr;
    if (MK_ONE_LAUNCH) bar = xcd_barrier_post((unsigned*)(F.ctl + CW_BAR) + args.li * XCD_BAR_WORDS, F.MISC + 8);
#define GRID_BAR() do { if (MK_ONE_LAUNCH) xcd_barrier(bar); } while (0)
    const int lo = args.ph_lo, hi = args.ph_hi;
#ifndef MK_PHMASK
#define MK_PHMASK 0xffffffffu
#endif
#define IN(k) (((MK_PHMASK >> (k)) & 1u) && lo <= (k) && (k) < hi)
#define BOTH(k) (IN(k) && IN((k) + 1))
    const float* x = args.in[I_X]; float* H = args.out;
    bf16* WA_IN = (bf16*)(ws + WS_WA_IN); bf16* WA_OUT = (bf16*)(ws + WS_WA_OUT); bf16* WF_IN = (bf16*)(ws + WS_WF_IN); bf16* WF_OUT = (bf16*)(ws + WS_WF_OUT);
    bf16* WKV = (bf16*)(ws + WS_WKV); bf16* WBIN = (bf16*)(ws + WS_WBIN); bf16* WBOUT = (bf16*)(ws + WS_WBOUT); bf16* WM_IN = (bf16*)(ws + WS_WM_IN); bf16* WM_OUT = (bf16*)(ws + WS_WM_OUT);
    float* RX = (float*)(ws + 1 * MiB + 131072);
    bf16* WF16 = (bf16*)(ws + 1 * MiB);
    bf16* XN = (bf16*)(ws + WS_XN); bf16* XQ = (bf16*)(ws + WS_XQ); bf16* BIG = (bf16*)(ws + WS_BIG);
    float* RSQ_V = (float*)(ws + WS_VPART); float* RSQ_H1 = (float*)(ws + WS_RSQ); bf16* HB = XQ;
 float* FG = (float*)(ws + WS_FG); unsigned* IDL = (unsigned*)(ws + WS_GW + 512 * 1024);   float* GW = (float*)(ws + WS_GW); unsigned* TOKSLOT = (unsigned*)(ws + WS_TOKSLOT); unsigned* ELIST = (unsigned*)(ws + WS_ELIST); float* EWL = (float*)(ws + WS_EWL); unsigned* ERS = (unsigned*)(ws + WS_EWL + 1 * MiB);
    bf16* ACT = (bf16*)(ws + WS_ACT); bf16* YB = (bf16*)(ws + WS_Y); bf16* YP = (bf16*)(ws + WS_BIG);
    bf16* KB = BIG; bf16* VB = BIG + (size_t)MROWS * DM; bf16* QB = BIG + (size_t)2 * MROWS * DM; bf16* GB = BIG + (size_t)3 * MROWS * DM;
    const int gw = F.vcu * NWAVES + F.wave, NGW = F.G * NWAVES;

    if (IN(PH_PRO)) {
        int go = 0;
        tr_matrix(F, args.in[I_A_W_IN], A_FFN, DM, A_FFN, WA_IN, MapId{}, go, args.in[I_A_NORM_G]);
        tr_matrix(F, args.in[I_A_W_OUT], DM, A_HALF, DM, WA_OUT, MapId{}, go);
        tr_matrix(F, args.in[I_F_W_IN], 2 * D_FF, DM, 2 * D_FF, WF_IN, MapGlu{D_FF}, go, args.in[I_F_NORM_G]);
        tr_matrix(F, args.in[I_F_W_OUT], DM, D_FF, DM, WF_OUT, MapId{}, go);
        tr_matrix(F, args.in[I_KV_W], KVW_LD, DM, 2 * DM, WKV, MapHead{}, go, args.in[I_KV_NORM_G]);
        tr_matrix(F, args.in[I_B_W_IN], 2 * DM, DM, 2 * DM, WBIN, MapHead{}, go, args.in[I_B_NORM_G]);
        tr_matrix(F, args.in[I_B_W_OUT], DM, DM, DM, WBOUT, MapId{}, go);
        for (int e = 0; e < NEXP; ++e) {
            tr_matrix(F, args.in[I_M_W_IN] + (size_t)e * DM * 2 * D_EXP, 2 * D_EXP, DM, 2 * D_EXP, (bf16*)((unsigned char*)WM_IN + (size_t)e * 2 * D_EXP * DM), MapGlu{D_EXP}, go, args.in[I_M_NORM_G], W8_SCALE);
            tr_matrix(F, args.in[I_M_W_OUT] + (size_t)e * D_EXP * DM, DM, D_EXP, DM, (bf16*)((unsigned char*)WM_OUT + (size_t)e * DM * D_EXP), MapId{}, go, nullptr, W8_SCALE);
        }
        ROW_LOOP_BEGIN(x) { GAS unsigned long long* o8 = (GAS unsigned long long*)(XN + (size_t)m * DM) + F.lane;
#pragma unroll
            for (int j = 0; j < 4; ++j) o8[64 * j] = (unsigned long long)pk2(v[j].x, v[j].y) | ((unsigned long long)pk2(v[j].z, v[j].w) << 32);
            if (F.lane == 0) RX[m] = r; } ROW_LOOP_END
        for (int e = blockIdx.x * (NWAVES * 64) + F.tid; e < NHEAD * DM; e += F.G * NWAVES * 64) { const int h = e >> 10, k = e & 1023; WF16[e] = (bf16)f2bf(args.in[I_KV_W][(size_t)k * KVW_LD + 2 * DM + h] * args.in[I_KV_NORM_G][k]); }
        if (BOTH(PH_PRO)) GRID_BAR();
    }
    if (IN(PH_GEMM1)) {
        pg8::Gemm g{XN, WA_IN, MROWS, A_FFN, DM, DM, 0, nullptr, 0, nullptr, 0}; pg8::StaticOrder S; S.init(MROWS, A_FFN, F.G, (int)blockIdx.x);
        LAS float* RT = (LAS float*)(F.lds + LDSCTL_OFF + 4096);
        { pg8::Unit uu; __syncthreads();
          for (int i0 = 0; i0 < 12; i0 += 2) { const int i = i0 + (F.tid >> 8); if (!S.next(i, uu)) continue; RT[i * 256 + (F.tid & 255)] = RX[uu.pm * 256 + (F.tid & 255)]; }
          __syncthreads(); }
        pg8::EpiGeluSq E{BIG, A_FFN, RSQ_V, A_HALF / 256, RT};
        pg8::gemm_phase<pg8::EpiGeluSq, pg8::StaticOrder, true, true>(F.lds + RING_OFF, g, S, E);
        if (BOTH(PH_GEMM1)) GRID_BAR();
    }
    if (IN(PH_SPATIAL)) {
        int tid_ = threadIdx.x; asm volatile("" : "+v"(tid_));
        const int tid = tid_, lane = tid & 63, wid = __builtin_amdgcn_readfirstlane(tid >> 6), wr = wid >> 2, wc = wid & 3, L15 = lane & 15, G4 = lane >> 4, q_ = (lane & 15) >> 2, p_ = lane & 3;
        LAS unsigned char* VI = F.lds + RING_OFF; LAS unsigned char* WI = F.lds + RING_OFF + 98304; LAS float* RVS = (LAS float*)(F.lds + LDSCTL_OFF + 1024);
        const float* wsp = args.in[I_A_W_SP]; const float* bsp = args.in[I_A_B_SP]; const float* gvn = args.in[I_A_V_NORM_G];
        for (int u = F.vcu; u < (MROWS / GCH) * A_GROUPS; u += F.G) {
            const int cc = u / A_GROUPS, g = u % A_GROUPS; const size_t r0 = (size_t)cc * GCH;
            __syncthreads();
            if (tid < GCH) { const GAS f32x4* pp = (const GAS f32x4*)(RSQ_V + (r0 + tid) * 48); float t = 0.f;
#pragma unroll
                for (int k = 0; k < 12; ++k) { const f32x4 p = pp[k]; t += (p[0] + p[1]) + (p[2] + p[3]); }
                RVS[tid] = 1.0f / sqrtf(t * (1.f / A_HALF) + RMS_EPS); }
            __syncthreads();
            { const unsigned char* vbase = (const unsigned char*)(BIG + r0 * A_FFN + A_HALF + g * A_GD);
#pragma unroll
              for (int hb = 0; hb < 2; ++hb) { v4u vreg[6];
#pragma unroll
                  for (int k = 0; k < 6; ++k) { const unsigned q = tid + 512 * (6 * hb + k), row = q / 48u, c48 = q % 48u; vreg[k] = *(const GAS v4u*)(vbase + (row * A_FFN + c48 * 8u) * 2u); }
                  if (hb == 0) {
#pragma unroll
                      for (int k = 0; k < 4; ++k) { const unsigned q = tid + 512 * k, i = q >> 4, ch = q & 15; v4u o = (v4u){0u, 0u, 0u, 0u};
                          if ((ch >> 3) <= (i >> 6)) { const GAS f32x4* wp = (const GAS f32x4*)(wsp + (size_t)g * GCH * GCH + i * GCH + ch * 8); const LAS f32x4* rp = (const LAS f32x4*)(RVS + ch * 8); const f32x4 r0v = rp[0], r1v = rp[1];
                              const f32x4 w0 = wp[0] * r0v, w1 = wp[1] * r1v; o.x = pk2(w0.x, w0.y); o.y = pk2(w0.z, w0.w); o.z = pk2(w1.x, w1.y); o.w = pk2(w1.z, w1.w); }
                          *(LAS v4u*)(WI + off_b(i, ch)) = o; } }
#pragma unroll
                  for (int k = 0; k < 6; ++k) { const unsigned q = tid + 512 * (6 * hb + k), row = q / 48u, c48 = q % 48u; *(LAS v4u*)(VI + (c48 >> 4) * 32768u + off_b(row, c48 & 15u)) = vreg[k]; }
                  asm volatile("" ::: "memory"); } }
            __syncthreads();
            f32x4 acc[4][6];
#pragma unroll
            for (int m = 0; m < 4; ++m)
#pragma unroll
                for (int n = 0; n < 6; ++n) acc[m][n] = (f32x4){0.f, 0.f, 0.f, 0.f};
            const int nks = wr ? 4 : 2;
            const unsigned fW = ((L15 & 3u) << 2) | (L15 >> 2);
            const unsigned wbase = 256u * (wr * 64 + L15) + 16u * ((unsigned)G4 ^ (fW & 3u));
            const unsigned tb0 = 256u * (8 * G4 + q_) + 16u * ((unsigned)p_ ^ ((2u * G4) & 3u)), tb1 = 256u * (8 * G4 + 4 + q_) + 16u * ((unsigned)p_ ^ ((2u * G4 + 1u) & 3u));
            unsigned xc[3];
#pragma unroll
            for (int c32 = 0; c32 < 3; ++c32) { const unsigned col32 = wc * 96 + c32 * 32; xc[c32] = (col32 >> 7) * 32768u + 16u * (((col32 & 127u) >> 3) ^ ((unsigned)q_ << 2)); }
#pragma unroll 1
            for (int ks = 0; ks < nks; ++ks) {
                bf16x8 wf[4]; const LAS unsigned char* wp = WI + wbase + 16u * ((4u * ks) ^ (fW & 12u));
#pragma unroll
                for (int m = 0; m < 4; ++m) wf[m] = *(const LAS bf16x8*)(wp + m * 4096);
#pragma unroll
                for (int c32 = 0; c32 < 3; ++c32) { const LAS unsigned char* ib = VI + xc[c32] + 8192u * ks;
#pragma unroll
                    for (int nn = 0; nn < 2; ++nn) {
                        const s16x4 t0 = __builtin_bit_cast(s16x4, __builtin_amdgcn_ds_read_tr16_b64_v4i16((LAS s16x4*)(ib + tb0 + 8 * nn)));
                        const s16x4 t1 = __builtin_bit_cast(s16x4, __builtin_amdgcn_ds_read_tr16_b64_v4i16((LAS s16x4*)(ib + tb1 + 8 * nn)));
                        const bf16x8 vf = (bf16x8){t0[0], t0[1], t0[2], t0[3], t1[0], t1[1], t1[2], t1[3]};
#pragma unroll
                        for (int m = 0; m < 4; ++m) acc[m][2 * c32 + nn] = __builtin_amdgcn_mfma_f32_16x16x32_bf16(vf, wf[m], acc[m][2 * c32 + nn], 0, 0, 0); } }
            }
            f32x4 gvv[3][2];
#pragma unroll
            for (int c32 = 0; c32 < 3; ++c32) { const GAS f32x4* gp = (const GAS f32x4*)(gvn + g * A_GD + wc * 96 + c32 * 32 + 8 * G4); gvv[c32][0] = gp[0]; gvv[c32][1] = gp[1]; }
#pragma unroll
            for (int m = 0; m < 4; ++m) { const int i = wr * 64 + 16 * m + L15; const float bi = bsp[g * GCH + i]; bf16* rowp = BIG + (r0 + i) * A_FFN + g * A_GD + wc * 96 + 8 * G4;
#pragma unroll
                for (int c32 = 0; c32 < 3; ++c32) { const v4u uu = *(const GAS v4u*)(rowp + c32 * 32); const f32x4 a = acc[m][2 * c32] * gvv[c32][0] + bi, b = acc[m][2 * c32 + 1] * gvv[c32][1] + bi; v4u o;
                    o.x = pk2(bflo(uu.x) * a.x, bfhi(uu.x) * a.y); o.y = pk2(bflo(uu.y) * a.z, bfhi(uu.y) * a.w); o.z = pk2(bflo(uu.z) * b.x, bfhi(uu.z) * b.y); o.w = pk2(bflo(uu.w) * b.z, bfhi(uu.w) * b.w);
                    *(GAS v4u*)(rowp + c32 * 32) = o; } }
        }
        if (BOTH(PH_SPATIAL)) GRID_BAR();
    }
    if (IN(PH_GEMM2)) {
        pg8::Gemm g{BIG, WA_OUT, MROWS, DM, A_HALF, A_FFN, 0, nullptr, 0, nullptr, 0}; pg8::StaticOrder S; S.init(MROWS, DM, F.G, (int)blockIdx.x);
        pg8::EpiResBf<true> E{XN, HB, RSQ_H1, DM};
        pg8::gemm_phase<pg8::EpiResBf<true>, pg8::StaticOrder, true, true>(F.lds + RING_OFF, g, S, E);
        if (BOTH(PH_GEMM2)) GRID_BAR();
    }
    if (IN(PH_FFN_UP)) {
        pg8::Gemm g{HB, WF_IN, MROWS, 2 * D_FF, DM, DM, 0, nullptr, 0, nullptr, 0}; pg8::StaticOrder S; S.init(MROWS, 2 * D_FF, F.G, (int)blockIdx.x);
        LAS float* RT = (LAS float*)(F.lds + LDSCTL_OFF + 4096);
        { pg8::Unit uu; __syncthreads();
          for (int i0 = 0; i0 < 12; i0 += 2) { const int i = i0 + (F.tid >> 8); if (!S.next(i, uu)) continue; const int r = F.tid & 255; const GAS f32x4* pp = (const GAS f32x4*)(RSQ_H1 + (size_t)(uu.pm * 256 + r) * 16); float t = 0.f;
#pragma unroll
              for (int k = 0; k < 4; ++k) { const f32x4 p = pp[k]; t += (p[0] + p[1]) + (p[2] + p[3]); }
              RT[i * 256 + r] = 1.0f / sqrtf(t * (1.f / DM) + RMS_EPS); }
          __syncthreads(); }
        pg8::EpiSwiGLU E{BIG, D_FF, RT};
        pg8::gemm_phase<pg8::EpiSwiGLU, pg8::StaticOrder, true, true>(F.lds + RING_OFF, g, S, E);
        if (BOTH(PH_FFN_UP)) GRID_BAR();
    }
    if (IN(PH_FFN_DOWN)) {
        pg8::Gemm g{BIG, WF_OUT, MROWS, DM, D_FF, D_FF, 0, nullptr, 0, nullptr, 0}; pg8::StaticOrder S; S.init(MROWS, DM, F.G, (int)blockIdx.x);
        pg8::EpiResBf<true> E{HB, XN, RSQ_H1, DM};
        pg8::gemm_phase<pg8::EpiResBf<true>, pg8::StaticOrder, true, true>(F.lds + RING_OFF, g, S, E);
        if (BOTH(PH_FFN_DOWN)) GRID_BAR();
    }
    if (IN(PH_KVQ)) {
        LAS float* HG = (LAS float*)(F.lds + LDSCTL_OFF + 1024);
        LAS float* RT = (LAS float*)(F.lds + LDSCTL_OFF + 4096);
        pg8::StaticOrder S; S.init(MROWS, 4 * DM, F.G, (int)blockIdx.x);
        __syncthreads();
        if (F.tid < 64) HG[F.tid] = args.in[I_K_NORM_G][F.tid]; else if (F.tid < 128) HG[F.tid] = args.in[I_Q_NORM_G][F.tid - 64] * attn_body::C2;
        { pg8::Unit uu;
          for (int i0 = 0; i0 < 12; i0 += 2) { const int i = i0 + (F.tid >> 8); if (!S.next(i, uu)) continue; const int r = F.tid & 255; const GAS f32x4* pp = (const GAS f32x4*)(RSQ_H1 + (size_t)(uu.pm * 256 + r) * 16); float t = 0.f;
#pragma unroll
              for (int k = 0; k < 4; ++k) { const f32x4 p = pp[k]; t += (p[0] + p[1]) + (p[2] + p[3]); }
              RT[i * 256 + r] = 1.0f / sqrtf(t * (1.f / DM) + RMS_EPS); } }
        { const int L15 = F.lane & 15, KQ = F.lane >> 4; const size_t row0 = (size_t)F.vcu * 128 + F.wave * 16;
          if (row0 < MROWS) {
              const bf16* ap = XN + (row0 + L15) * DM + 8 * KQ; const bf16* bp = WF16 + (size_t)L15 * DM + 8 * KQ; f32x4 fa = (f32x4){0.f, 0.f, 0.f, 0.f};
#pragma unroll
              for (int jb = 0; jb < 4; ++jb) { bf16x8 af[8], bfr[8];
#pragma unroll
                  for (int j = 0; j < 8; ++j) { af[j] = *(const GAS bf16x8*)(ap + 32 * (8 * jb + j)); bfr[j] = *(const GAS bf16x8*)(bp + 32 * (8 * jb + j)); }
#pragma unroll
                  for (int j = 0; j < 8; ++j) fa = __builtin_amdgcn_mfma_f32_16x16x32_bf16(af[j], bfr[j], fa, 0, 0, 0); }
#pragma unroll
              for (int e = 0; e < 4; ++e) { const size_t row = row0 + 4 * KQ + e; const GAS f32x4* pp = (const GAS f32x4*)(RSQ_H1 + row * 16); float t = 0.f;
#pragma unroll
                  for (int k = 0; k < 4; ++k) { const f32x4 p = pp[k]; t += (p[0] + p[1]) + (p[2] + p[3]); }
                  FG[row * NHEAD + L15] = fa[e] * (1.0f / sqrtf(t * (1.f / DM) + RMS_EPS)); } } }
        __syncthreads();
        { pg8::Gemm g{XN, WKV, MROWS, 4 * DM, DM, DM, 0, nullptr, 0, nullptr, 0};
          pg8::EpiHead4 E{KB, (size_t)MROWS * DM, HG, RMS_EPS, RT};
          pg8::gemm_phase<pg8::EpiHead4, pg8::StaticOrder, true, true>(F.lds + RING_OFF, g, S, E); }
        if (BOTH(PH_KVQ)) GRID_BAR();
    }
    if (IN(PH_ATTN)) {
        __syncthreads();
        for (int bh = F.vcu; bh < BATCH * NHEAD; bh += F.G) attn_body::scan_bias_table((char*)lds + RING_OFF, FG, args.in[I_KV_B_F], bh, (attn_body::u32x4*)(ws + WS_FBT));
        asm volatile("s_waitcnt vmcnt(0)" ::: "memory"); __syncthreads();
        const attn_body::AttnTensors AT{(const attn_body::bf16*)QB, (const attn_body::bf16*)KB, (const attn_body::bf16*)VB, (const attn_body::bf16*)GB, (attn_body::bf16*)QB, (const attn_body::u32x4*)(ws + WS_FBT)};
        const attn_body::StaticOrder AS{F.vcu, F.G}; attn_body::attn_phase<attn_body::StaticOrder>((char*)lds + RING_OFF, AT, AS);
        if (BOTH(PH_ATTN)) GRID_BAR();
    }
    if (IN(PH_OPROJ)) {
        pg8::Gemm g{QB, WBOUT, MROWS, DM, DM, DM, 0, nullptr, 0, nullptr, 0}; pg8::StaticOrder S; S.init(MROWS, DM, F.G, (int)blockIdx.x);
        pg8::EpiResBf<true> E{XN, HB, nullptr, DM};
        pg8::gemm_phase<pg8::EpiResBf<true>, pg8::StaticOrder, true, true>(F.lds + RING_OFF, g, S, E);
        if (BOTH(PH_OPROJ)) GRID_BAR();
    }
    if (IN(PH_ROUTER)) {
        LAS float* Wr = (LAS float*)(F.lds + RING_OFF);
        LAS unsigned* CNTL = (LAS unsigned*)(F.lds + RING_OFF + 65536); LAS unsigned* RREC = CNTL + 64;
        if (F.tid < 16) CNTL[F.tid] = 0u;
        __syncthreads();
        for (int idx = F.tid; idx < DM * NEXP; idx += NWAVES * 64) { const int c = idx & 3, ln = (idx >> 2) & 63, q = (idx >> 8) & 1, kk = idx >> 9, k = 4 * ln + 256 * (kk >> 2) + (kk & 3);
            Wr[idx] = args.in[I_M_W_ROUTER][(size_t)k * NEXP + 4 * q + c]; }
        __syncthreads();
        ROW_LOOP_BEGIN(HB)
            { GAS unsigned* o8 = (GAS unsigned*)((GAS unsigned char*)XN + (size_t)m * DM) + F.lane;
#pragma unroll
              for (int j = 0; j < 4; ++j) { unsigned w = 0u; w = __builtin_amdgcn_cvt_pk_fp8_f32(v[j].x, v[j].y, w, false); w = __builtin_amdgcn_cvt_pk_fp8_f32(v[j].z, v[j].w, w, true); o8[64 * j] = w; } }
            float a[NEXP];
#pragma unroll
            for (int h = 0; h < NEXP; ++h) a[h] = 0.f;
            const GAS f32x4* gr = (const GAS f32x4*)args.in[I_M_NORM_G] + F.lane;
#pragma unroll
            for (int j = 0; j < 4; ++j) { const f32x4 s4 = (v[j] * r) * gr[64 * j];
#pragma unroll
                for (int e = 0; e < 4; ++e) { const float sk = s4[e];
#pragma unroll
                    for (int q = 0; q < 2; ++q) { const f32x4 w = *(const LAS f32x4*)(Wr + (((4 * j + e) * 2 + q) * 64 + F.lane) * 4); a[4 * q] += sk * w.x; a[4 * q + 1] += sk * w.y; a[4 * q + 2] += sk * w.z; a[4 * q + 3] += sk * w.w; } } }
            { const float mine = wave_tr_reduce<8>(a, F.lane);
#pragma unroll
              for (int h = 0; h < NEXP; ++h) a[h] = __shfl(mine, h); }
            int i1 = 0; float v1 = a[0];
#pragma unroll
            for (int h = 1; h < NEXP; ++h) if (a[h] > v1) { v1 = a[h]; i1 = h; }
            int i2 = -1; float v2 = -INFINITY;
#pragma unroll
            for (int h = 0; h < NEXP; ++h) if (h != i1 && a[h] > v2) { v2 = a[h]; i2 = h; }
            const float e2 = expf(v2 - v1), w1 = 1.0f / (1.0f + e2), w2 = e2 / (1.0f + e2);
            if (F.lane == 0) { const int k = (m - gw) / NGW; LAS unsigned* rec = RREC + (F.wave * 16 + k) * 8;
                const unsigned p1 = __hip_atomic_fetch_add(CNTL + i1, 1u, __ATOMIC_RELAXED, __HIP_MEMORY_SCOPE_WORKGROUP), p2 = __hip_atomic_fetch_add(CNTL + i2, 1u, __ATOMIC_RELAXED, __HIP_MEMORY_SCOPE_WORKGROUP);
                rec[0] = (unsigned)i1; rec[1] = p1; rec[2] = __float_as_uint(w1); rec[3] = (unsigned)i2; rec[4] = p2; rec[5] = __float_as_uint(w2); rec[6] = (unsigned)m; rec[7] = __float_as_uint(r); } ROW_LOOP_END
        __syncthreads();
        if (F.tid < NEXP) CNTL[8 + F.tid] = __hip_atomic_fetch_add(F.ctl + CW_CNT + F.tid, CNTL[F.tid], __ATOMIC_RELAXED, __HIP_MEMORY_SCOPE_AGENT);
        __syncthreads();
        if (F.lane < 16) { const int m = gw + F.lane * NGW; if (m < MROWS) { const LAS unsigned* rec = RREC + (F.wave * 16 + F.lane) * 8;
#pragma unroll
            for (int k = 0; k < 2; ++k) { const unsigned e = rec[3 * k], p = CNTL[8 + e] + rec[3 * k + 1]; ELIST[(size_t)e * MROWS + p] = rec[6] * 2u + (unsigned)k; EWL[(size_t)e * MROWS + p] = __uint_as_float(rec[3 * k + 2]); ERS[(size_t)e * MROWS + p] = rec[7]; } } }
        if (BOTH(PH_ROUTER)) GRID_BAR();
    }
    pg8::GroupedOrder GS; int ecnt[NEXP];
    if (hi > PH_ROUTER) { GS.ts[0] = 0;
#pragma unroll
        for (int e = 0; e < NEXP; ++e) { ecnt[e] = (int)__builtin_amdgcn_readfirstlane(__hip_atomic_load(F.ctl + CW_CNT + e, RLX_AGENT)); GS.cnt[e] = ecnt[e]; GS.ts[e + 1] = GS.ts[e] + (ecnt[e] + 255) / 256; } GS.cap = MROWS; }
    const int NT = GS.ts[NEXP];
    if (IN(PH_MOE_UP)) {
        for (int sl = gw * 64 + F.lane; sl < NT * 256; sl += NGW * 64) { const int tile = sl >> 8; const int e = GS.expert(tile);
            int cnt_e = GS.cnt[0], ts_e = 0;
#pragma unroll
            for (int k = 1; k < NEXP; ++k) { cnt_e = (e == k) ? GS.cnt[k] : cnt_e; ts_e = (e == k) ? GS.ts[k] : ts_e; }
            const int p = sl - ts_e * 256;
            IDL[sl] = 2u * (unsigned)sl;
            if (p < cnt_e) { const unsigned ent = ELIST[(size_t)e * MROWS + p]; GW[sl] = EWL[(size_t)e * MROWS + p]; TOKSLOT[ent] = (unsigned)sl; } else GW[sl] = 0.f; }
        pg8::Gemm g{XN, WM_IN, NT * 256, 2 * D_EXP, DM / 2, DM / 2, (size_t)2 * D_EXP * DM, ELIST, 0, ERS, W8_SCALE_E8M0}; GS.init(NT * 256, 2 * D_EXP, F.G, (int)blockIdx.x);
        pg8::EpiSwiGLU8q E{(unsigned char*)ACT, D_EXP};
        pg8::gemm_phase_f8q<pg8::EpiSwiGLU8q, pg8::GroupedOrder>(F.lds + RING_OFF, g, GS, E, (LAS unsigned*)(F.lds + LDSCTL_OFF + 2048));
        if (BOTH(PH_MOE_UP)) GRID_BAR();
    }
    const int DU = NT * 4, DLIM = (DU / F.G) * F.G, DTS = 2, DKP = D_EXP / DTS;
    if (IN(PH_MOE_DOWN)) {
        { pg8::DownMainQ DM_; (pg8::GroupedOrder&)DM_ = GS; DM_.init(NT * 256, DM, F.G, (int)blockIdx.x); DM_.v = F.vcu; DM_.lim = DLIM < DU ? DLIM : DU;
          pg8::Gemm g{ACT, WM_OUT, NT * 256, DM, D_EXP / 2, D_EXP / 2, (size_t)DM * D_EXP, IDL, 0, (const unsigned*)GW, W8_SCALE_E8M0};
          pg8::EpiY8q8 E{(unsigned char*)YB, DM};
          pg8::gemm_phase_f8q<pg8::EpiY8q8, pg8::DownMainQ>(F.lds + RING_OFF, g, DM_, E, (LAS unsigned*)(F.lds + LDSCTL_OFF + 2048)); }
        if (DU > DLIM) {
            pg8::DownTailQ DT_; (pg8::GroupedOrder&)DT_ = GS; DT_.init(NT * 256, DM, F.G, (int)blockIdx.x); DT_.v = F.vcu; DT_.lim = DLIM; DT_.S = DTS; DT_.ntask = (DU - DLIM) * DTS;
            pg8::Gemm g{ACT, WM_OUT, NT * 256, DM, DKP / 2, D_EXP / 2, (size_t)DM * D_EXP, IDL, D_EXP / 2, (const unsigned*)GW, W8_SCALE_E8M0};
            pg8::EpiY8q E{YP - (size_t)(DLIM / 4) * 256 * DM, DM, (size_t)YP_ROWS * DM};
            pg8::gemm_phase_f8q<pg8::EpiY8q, pg8::DownTailQ>(F.lds + RING_OFF, g, DT_, E, (LAS unsigned*)(F.lds + LDSCTL_OFF + 2048));
        }
        if (BOTH(PH_MOE_DOWN)) GRID_BAR();
    }
    if (IN(PH_COMBINE)) {
        const unsigned tail0 = (unsigned)(DLIM / 4) * 256u;
        const GAS unsigned char* Y8 = (const GAS unsigned char*)YB;
#define CB_LOAD(hd, yd, mm, sa, sb) do { const GAS v4u* hp_ = (const GAS v4u*)(HB + (size_t)(mm) * DM) + 2 * F.lane; hd[0] = hp_[0]; hd[1] = hp_[1]; \
            yd[0] = ((const GAS v4u*)(Y8 + (size_t)(sa) * DM))[F.lane]; yd[1] = ((const GAS v4u*)(Y8 + (size_t)(sb) * DM))[F.lane]; } while (0)
        unsigned sa0 = 0, sa1 = 0, sb0 = 0, sb1 = 0; v4u hn[2]; v4u yn[2];
        if (gw < MROWS) { sa0 = TOKSLOT[2 * gw]; sa1 = TOKSLOT[2 * gw + 1]; if (gw + NGW < MROWS) { sb0 = TOKSLOT[2 * (gw + NGW)]; sb1 = TOKSLOT[2 * (gw + NGW) + 1]; } CB_LOAD(hn, yn, gw, sa0, sa1); }
        for (int m = gw; m < MROWS; m += NGW) {
            f32x4 h[4]; v4u y[2]; const unsigned s0 = sa0, s1 = sa1;
#pragma unroll
            for (int j = 0; j < 2; ++j) { const v4u a = hn[j]; h[2 * j] = (f32x4){bflo(a.x), bfhi(a.x), bflo(a.y), bfhi(a.y)}; h[2 * j + 1] = (f32x4){bflo(a.z), bfhi(a.z), bflo(a.w), bfhi(a.w)}; }
            y[0] = yn[0]; y[1] = yn[1];
            sa0 = sb0; sa1 = sb1;
            if (m + 2 * NGW < MROWS) { sb0 = TOKSLOT[2 * (m + 2 * NGW)]; sb1 = TOKSLOT[2 * (m + 2 * NGW) + 1]; }
            if (m + NGW < MROWS) CB_LOAD(hn, yn, m + NGW, sa0, sa1);
#pragma unroll
            for (int k = 0; k < 2; ++k) {
                const unsigned sl = k ? s1 : s0;
                if ((DU > DLIM) && sl >= tail0) {
                    for (int p = 0; p < DTS; ++p) { const GAS v4u* yp = (const GAS v4u*)(YP + (size_t)(sl - tail0) * DM + (size_t)p * YP_ROWS * DM) + 2 * F.lane;
#pragma unroll
                        for (int j = 0; j < 2; ++j) { const v4u a = yp[j];
                            h[2 * j].x += bflo(a.x); h[2 * j].y += bfhi(a.x); h[2 * j].z += bflo(a.y); h[2 * j].w += bfhi(a.y); h[2 * j + 1].x += bflo(a.z); h[2 * j + 1].y += bfhi(a.z); h[2 * j + 1].z += bflo(a.w); h[2 * j + 1].w += bfhi(a.w); } }
                } else { const v4u a = y[k];
#pragma unroll
                    for (int j = 0; j < 4; ++j) { const auto lo2 = __builtin_amdgcn_cvt_pk_f32_fp8((int)a[j], false), hi2 = __builtin_amdgcn_cvt_pk_f32_fp8((int)a[j], true);
                        h[j].x += lo2[0] * pg8::Y8_INV; h[j].y += lo2[1] * pg8::Y8_INV; h[j].z += hi2[0] * pg8::Y8_INV; h[j].w += hi2[1] * pg8::Y8_INV; } } }
            GAS f32x4* hp = (GAS f32x4*)(H + (size_t)m * DM) + 4 * F.lane;
#pragma unroll
            for (int j = 0; j < 4; ++j) hp[j] = h[j]; }
#undef CB_LOAD
    }
#undef IN
#undef BOTH
}

extern "C" void kernel_launch(void* const* d_in, const int* in_sizes, int n_in, void* d_out, int out_size, void* d_ws, size_t ws_size, hipStream_t stream) {
    static int grid = 0;
    if (grid == 0) {
        if (n_in != N_IN || in_sizes[0] != MROWS * DM || out_size != MROWS * DM || ws_size < WS_END) { fprintf(stderr, "kernel_launch: unexpected shapes / workspace (n_in %d, in0 %d, out %d, ws %zu < %zu)\n", n_in, n_in > 0 ? in_sizes[0] : -1, out_size, ws_size, (size_t)WS_END); grid = -1; return; }
        int dev = 0, cus = 0, per_cu = 0;
        if (hipGetDevice(&dev) != hipSuccess || hipDeviceGetAttribute(&cus, hipDeviceAttributeMultiprocessorCount, dev) != hipSuccess) { grid = -1; return; }
        if (hipFuncSetAttribute((const void*)yoco_fwd, hipFuncAttributeMaxDynamicSharedMemorySize, LDS_BYTES) != hipSuccess) { fprintf(stderr, "kernel_launch: hipFuncSetAttribute failed\n"); grid = -1; return; }
        if (hipOccupancyMaxActiveBlocksPerMultiprocessor(&per_cu, (const void*)yoco_fwd, NWAVES * 64, LDS_BYTES) != hipSuccess || per_cu < 1) fprintf(stderr, "kernel_launch: occupancy query reports %d\n", per_cu);
        (void)hipGetLastError();
        if (cus != 256) { fprintf(stderr, "kernel_launch: built for a 256-CU device (got %d)\n", cus); grid = -1; return; }
        grid = cus;
    }
    if (grid < 0) return;
    if (hipMemsetAsync((char*)d_ws + WS_CTL, 0, CTL_ZERO_BYTES, stream) != hipSuccess) return;
    Args a{};
    for (int i = 0; i < N_IN; ++i) a.in[i] = (const float*)d_in[i];
    a.out = (float*)d_out; a.ws = (unsigned char*)d_ws;
#if MK_ONE_LAUNCH
    a.ph_lo = 0; a.ph_hi = MK_PH_STOP; a.li = 0;
    hipLaunchKernelGGL(yoco_fwd, dim3(grid), dim3(NWAVES * 64), LDS_BYTES, stream, a);
#else
    for (int p = 0; p < MK_PH_STOP; ++p) { a.ph_lo = p; a.ph_hi = p + 1; a.li = 0; hipLaunchKernelGGL(yoco_fwd, dim3(grid), dim3(NWAVES * 64), LDS_BYTES, stream, a); }
#endif
}
```

```cpp
#include <hip/hip_runtime.h>
#include <hip/hip_bf16.h>
#include <cstdio>
#include <cstdint>
#include <cmath>
namespace pg8 {
#define PG8_LAS __attribute__((address_space(3)))
typedef unsigned short bf16_t;
typedef short bf16x8 __attribute__((ext_vector_type(8)));
typedef float f32x4 __attribute__((ext_vector_type(4)));
typedef unsigned u32x4 __attribute__((ext_vector_type(4)));
constexpr int BM = 256, BK = 64, HALF = 128, HTB = HALF * BK * 2  , STAGE_BYTES = 8 * HTB, NXCD = 8, WGM = 8;

__host__ __device__ __forceinline__ int lds_byte(int r, int c) { const int st = (r >> 4) * 2 + (c >> 5), rr = r & 15, cc = c & 31, ob = rr * 64 + cc * 2; return st * 1024 + (ob ^ (((ob >> 9) & 1) << 5)); }
__host__ __device__ __forceinline__ void stage_rc(int b, int& R, int& C) { const int st = b / 1024, sb = b % 1024, swz = sb ^ (((sb >> 9) & 1) << 5); R = (st >> 1) * 16 + swz / 64; C = (st & 1) * 32 + (swz % 64) / 2; }
__host__ __device__ __forceinline__ int perm32(int rho) { const int n = rho >> 4, i = rho & 15; return 8 * (i >> 2) + 4 * n + (i & 3); }

struct Unit { int pm, pn, kp; };
struct Gemm { const bf16_t* A; const bf16_t* Bt; int M, N, K, lda; size_t bstride; const unsigned* rowlist; int ldb; const unsigned* wlist; int scale_b; };

struct StaticOrder {
    int nM, nN, nwg, G, c;
    __host__ __device__ __forceinline__ void init(int M, int N, int G_, int c_) { nM = M / BM; nN = N / BM; nwg = nM * nN; G = G_; c = c_; }
    __host__ __device__ __forceinline__ bool next(int i, Unit& u) const {
        const long L = (long)i * G + c; if (L >= nwg) return false;
        int wgid = (int)L; { const int q = nwg / NXCD, r = nwg % NXCD, xcd = wgid % NXCD, off = wgid / NXCD; wgid = (xcd < r ? xcd * (q + 1) : r * (q + 1) + (xcd - r) * q) + off; }
        const int nig = WGM * nN, gid = wgid / nig, fm = gid * WGM, gsz = (nM - fm) < WGM ? (nM - fm) : WGM;
        u.pm = fm + ((wgid % nig) % gsz); u.pn = (wgid % nig) / gsz; u.kp = 0; return true;
    }
    __device__ __forceinline__ void a_ready(const Unit&) const {}
    __device__ __forceinline__ void done(const Unit&) const {}
    __device__ __forceinline__ int expert(int) const { return 0; }
    __device__ __forceinline__ size_t kbytes(const Unit&, int) const { return 0; }
    __device__ __forceinline__ int listoff(int) const { return 0; }
    __device__ __forceinline__ int rows(int) const { return 256; }
};
struct GroupedOrder : StaticOrder {
    int ts[9], cnt[8], cap;
    __device__ __forceinline__ int listoff(int pm) const { const int e = expert(pm); int t0 = 0;
#pragma unroll
        for (int k = 1; k < 8; ++k) t0 = (e == k) ? ts[k] : t0;
        return e * cap + (pm - t0) * 256; }
    __device__ __forceinline__ int rows(int pm) const { const int e = expert(pm); int t0 = 0, c = cnt[0];
#pragma unroll
        for (int k = 1; k < 8; ++k) { t0 = (e == k) ? ts[k] : t0; c = (e == k) ? cnt[k] : c; }
        const int r = c - (pm - t0) * 256; return r < 0 ? 0 : (r > 256 ? 256 : r); }
    __device__ __forceinline__ int expert(int pm) const { int e = 0;
#pragma unroll
        for (int k = 1; k < 8; ++k) e += (pm >= ts[k]) ? 1 : 0;
        return e; }
};

__device__ __forceinline__ unsigned cvt_pk_bf16(float lo, float hi) { unsigned r; asm volatile("v_cvt_pk_bf16_f32 %0, %1, %2" : "=v"(r) : "v"(lo), "v"(hi)); return r; }
typedef float f32x2 __attribute__((ext_vector_type(2)));
__device__ __forceinline__ f32x2 gelu_pk(f32x2 v) {
    const f32x2 av = __builtin_elementwise_abs(v), d = av * 0.2316418882f + 1.0f;
    f32x2 t; t.x = __builtin_amdgcn_rcpf(d.x); t.y = __builtin_amdgcn_rcpf(d.y);
    f32x2 q = t * 0.5307027145f + (-0.7265760135f); q = q * t + 0.7107068705f; q = q * t + (-0.142248368f); q = q * t + 0.127414796f; q = q * t;
    const f32x2 s = (v * v) * (-0.72134752044f);
    f32x2 e; e.x = __builtin_amdgcn_exp2f(s.x); e.y = __builtin_amdgcn_exp2f(s.y);
    const f32x2 m = v * (q * e), r = v - m;
    f32x2 o; o.x = v.x < 0.f ? m.x : r.x; o.y = v.y < 0.f ? m.y : r.y; return o;
}
constexpr float GELU_K = 0.84932180f;
__device__ __forceinline__ void gelu_w_pk4(const f32x2 (&w)[4], f32x2 (&o)[4]) {
    constexpr float C[9] = {5.886622071e-01f, -5.522741079e-01f, 4.032063782e-01f, -2.406371087e-01f, 1.149394065e-01f, -4.112898186e-02f, 1.002788637e-02f, -1.450342475e-03f, 9.243155364e-05f};
    f32x2 y[4], p[4], e[4];
#pragma unroll
    for (int i = 0; i < 4; ++i) { y[i].x = __builtin_fabsf(w[i].x); y[i].y = __builtin_fabsf(w[i].y); }
#pragma unroll
    for (int i = 0; i < 4; ++i) p[i] = y[i] * C[8] + C[7];
#pragma unroll
    for (int c = 6; c >= 0; --c)
#pragma unroll
        for (int i = 0; i < 4; ++i) p[i] = p[i] * y[i] + C[c];
#pragma unroll
    for (int i = 0; i < 4; ++i) { const f32x2 s = w[i] * w[i]; e[i].x = __builtin_amdgcn_exp2f(-s.x); e[i].y = __builtin_amdgcn_exp2f(-s.y); }
#pragma unroll
    for (int i = 0; i < 4; ++i) { const f32x2 h = 0.588705011f - p[i] * e[i]; o[i] = w[i] * 0.588705011f + y[i] * h; }
}

template <int ACT  > struct EpiBf16 {
    static constexpr bool PERM = true, AFTER_DRAIN = false; static_assert(ACT == 0 || ACT == 1, "EpiBf16: ACT is 0 (none) or 1 (gelu_pk)");
    bf16_t* O; int ldc; const float* bias; int split_cols; size_t split_stride; float scale0;
    __device__ __forceinline__ void operator()(const f32x4 (&acc)[2][2][4][2], const Unit& u, int wr, int wc, int fr, int fq, int ui = 0, const PG8_LAS unsigned* tab = nullptr) const {
        const int row0 = u.pm * BM + wr * 64 + fr; int colt = u.pn * BM; bf16_t* base = O;
        float sc = 1.f; if (split_cols) { const int t = colt / split_cols; base += (size_t)t * split_stride; colt -= t * split_cols; if (t == 0) sc = scale0; }
        const int col0 = colt + wc * 32 + 8 * fq, bcol0 = u.pn * BM + wc * 32 + 8 * fq;
        f32x4 bv[2][2];
#pragma unroll
        for (int bj = 0; bj < 2; ++bj)
#pragma unroll
            for (int n = 0; n < 2; ++n) bv[bj][n] = bias ? *(const f32x4*)(bias + bcol0 + bj * HALF + 4 * n) : (f32x4){0.f, 0.f, 0.f, 0.f};
#pragma unroll
        for (int ai = 0; ai < 2; ++ai)
#pragma unroll
            for (int m = 0; m < 4; ++m) { bf16_t* rowp = base + (size_t)(row0 + ai * HALF + m * 16) * ldc + col0;
#pragma unroll
                for (int bj = 0; bj < 2; ++bj) { f32x4 v0 = acc[ai][bj][m][0] + bv[bj][0], v1 = acc[ai][bj][m][1] + bv[bj][1];
                    if (ACT == 1) { f32x2 a = gelu_pk((f32x2){v0[0], v0[1]}), b = gelu_pk((f32x2){v0[2], v0[3]}), c = gelu_pk((f32x2){v1[0], v1[1]}), d = gelu_pk((f32x2){v1[2], v1[3]});
                        v0 = (f32x4){a.x, a.y, b.x, b.y}; v1 = (f32x4){c.x, c.y, d.x, d.y}; }
                    v0 = v0 * sc; v1 = v1 * sc; u32x4 w; w.x = cvt_pk_bf16(v0[0], v0[1]); w.y = cvt_pk_bf16(v0[2], v0[3]); w.z = cvt_pk_bf16(v1[0], v1[1]); w.w = cvt_pk_bf16(v1[2], v1[3]);
                    *(u32x4*)(rowp + bj * HALF) = w; } }
    }
};


struct DownMain : GroupedOrder {
    int v, lim;
    __device__ __forceinline__ bool next(int i, Unit& u) const { const int L = i * G + v; if (L >= lim) return false; u.pm = L >> 2; u.pn = L & 3; u.kp = 0; return true; }
};
struct DownTail : GroupedOrder {
    int v, lim, ntask, S;
    __device__ __forceinline__ bool next(int i, Unit& u) const { const int t = i * G + v; if (t >= ntask) return false; const int L = lim + t / S; u.pm = L >> 2; u.pn = L & 3; u.kp = t % S; return true; }
    __device__ __forceinline__ size_t kbytes(const Unit& u, int K) const { return (size_t)u.kp * K * 2; }
};
struct DownMainQ : DownMain { __device__ __forceinline__ int listoff(int pm) const { return pm * 256; } __device__ __forceinline__ int rows(int) const { return 256; } };
struct DownTailQ : DownTail { __device__ __forceinline__ int listoff(int pm) const { return pm * 256; } __device__ __forceinline__ int rows(int) const { return 256; } };
struct DownMain8 : GroupedOrder {
    int v, lim;
    __device__ __forceinline__ bool next(int i, Unit& u) const { const int L = i * G + v; if (L >= lim) return false; u.pm = L >> 3; u.pn = L & 7; u.kp = 0; return true; }
    __device__ __forceinline__ int listoff(int pm) const { return pm * 256; }
    __device__ __forceinline__ int rows(int) const { return 256; }
};
struct DownTail8 : GroupedOrder {
    int v, lim, ntask, S;
    __device__ __forceinline__ bool next(int i, Unit& u) const { const int t = i * G + v; if (t >= ntask) return false; const int L = lim + t / S; u.pm = L >> 3; u.pn = L & 7; u.kp = t % S; return true; }
    __device__ __forceinline__ size_t kbytes(const Unit& u, int K) const { return (size_t)u.kp * K * 2; }
    __device__ __forceinline__ int listoff(int pm) const { return pm * 256; }
    __device__ __forceinline__ int rows(int) const { return 256; }
};
struct EpiF32Res {
    static constexpr bool PERM = false, AFTER_DRAIN = false;
    const float* base; float* out; int ldc; const float* gate; int gstride;
    __device__ __forceinline__ void operator()(const f32x4 (&acc)[2][2][4][2], const Unit& u, int wr, int wc, int fr, int fq, int ui = 0, const PG8_LAS unsigned* tab = nullptr) const {
        const int row0 = u.pm * BM + wr * 64 + fr, col0 = u.pn * BM + wc * 32 + 4 * fq;
#pragma unroll
        for (int ai = 0; ai < 2; ++ai) {
            f32x4 bs[4][2][2];
#pragma unroll
            for (int m = 0; m < 4; ++m) { const size_t off = (size_t)(row0 + ai * HALF + m * 16) * ldc + col0;
#pragma unroll
                for (int bj = 0; bj < 2; ++bj)
#pragma unroll
                    for (int n = 0; n < 2; ++n) bs[m][bj][n] = *(const f32x4*)(base + off + bj * HALF + n * 16); }
#pragma unroll
            for (int m = 0; m < 4; ++m) { const int row = row0 + ai * HALF + m * 16; const size_t off = (size_t)row * ldc + col0;
                const float gs = gate ? gate[(size_t)row * gstride] : 1.0f;
#pragma unroll
                for (int bj = 0; bj < 2; ++bj)
#pragma unroll
                    for (int n = 0; n < 2; ++n) *(f32x4*)(out + off + bj * HALF + n * 16) = bs[m][bj][n] + acc[ai][bj][m][n] * gs; }
            asm volatile("" ::: "memory"); }
    }
};
__device__ __forceinline__ float part16_rstd(const float* part, int row, int fq, float inv_n, float eps) {
    const f32x4 p = *(const f32x4*)(part + (size_t)row * 16 + 4 * fq); float t = (p[0] + p[1]) + (p[2] + p[3]); t += __shfl_xor(t, 16); t += __shfl_xor(t, 32); return 1.0f / sqrtf(t * inv_n + eps); }
template <bool BASE_BF16> struct EpiResBf {
    static constexpr bool PERM = true, AFTER_DRAIN = false;
    const void* base; bf16_t* hb; float* part; int ldc;
    __device__ __forceinline__ void operator()(const f32x4 (&acc)[2][2][4][2], const Unit& u, int wr, int wc, int fr, int fq, int ui = 0, const PG8_LAS unsigned* tab = nullptr) const {
        const int row0 = u.pm * BM + wr * 64 + fr, col0 = u.pn * BM + wc * 32 + 8 * fq;
#pragma unroll
        for (int ai = 0; ai < 2; ++ai) {
            f32x4 bs[4][2][2];
#pragma unroll
            for (int m = 0; m < 4; ++m) { const size_t off = (size_t)(row0 + ai * HALF + m * 16) * ldc + col0;
#pragma unroll
                for (int bj = 0; bj < 2; ++bj) {
                    if (BASE_BF16) { const u32x4 w = *(const u32x4*)((const bf16_t*)base + off + bj * HALF);
                        bs[m][bj][0] = (f32x4){__uint_as_float(w.x << 16), __uint_as_float(w.x & 0xffff0000u), __uint_as_float(w.y << 16), __uint_as_float(w.y & 0xffff0000u)};
                        bs[m][bj][1] = (f32x4){__uint_as_float(w.z << 16), __uint_as_float(w.z & 0xffff0000u), __uint_as_float(w.w << 16), __uint_as_float(w.w & 0xffff0000u)}; }
                    else { bs[m][bj][0] = *(const f32x4*)((const float*)base + off + bj * HALF); bs[m][bj][1] = *(const f32x4*)((const float*)base + off + bj * HALF + 4); } } }
#pragma unroll
            for (int m = 0; m < 4; ++m) { const int row = row0 + ai * HALF + m * 16; const size_t off = (size_t)row * ldc + col0; float ss = 0.f;
#pragma unroll
                for (int bj = 0; bj < 2; ++bj) { const f32x4 o0 = bs[m][bj][0] + acc[ai][bj][m][0], o1 = bs[m][bj][1] + acc[ai][bj][m][1];
                    ss += ((o0[0] * o0[0] + o0[1] * o0[1]) + (o0[2] * o0[2] + o0[3] * o0[3])) + ((o1[0] * o1[0] + o1[1] * o1[1]) + (o1[2] * o1[2] + o1[3] * o1[3]));
                    u32x4 w; w.x = cvt_pk_bf16(o0[0], o0[1]); w.y = cvt_pk_bf16(o0[2], o0[3]); w.z = cvt_pk_bf16(o1[0], o1[1]); w.w = cvt_pk_bf16(o1[2], o1[3]); *(u32x4*)(hb + off + bj * HALF) = w; }
                if (part) { ss += __shfl_xor(ss, 16); ss += __shfl_xor(ss, 32); if (fq == 0) part[(size_t)row * 16 + 4 * u.pn + wc] = ss; } }
            asm volatile("" ::: "memory"); }
    }
};
struct EpiGeluSq {
    static constexpr bool PERM = true, AFTER_DRAIN = false;
    bf16_t* O; int ldc; float* vpart; int pn_sq; const PG8_LAS float* rtab;
    __device__ __forceinline__ void operator()(const f32x4 (&acc)[2][2][4][2], const Unit& u, int wr, int wc, int fr, int fq, int ui = 0, const PG8_LAS unsigned* tab = nullptr) const {
        const int row0 = u.pm * BM + wr * 64 + fr, col0 = u.pn * BM + wc * 32 + 8 * fq; const bool sq = u.pn >= pn_sq;
#pragma unroll
        for (int ai = 0; ai < 2; ++ai)
#pragma unroll
            for (int m = 0; m < 4; ++m) { const int row = row0 + ai * HALF + m * 16; bf16_t* rowp = O + (size_t)row * ldc + col0; f32x2 ss2 = {0.f, 0.f}; const float rr = rtab[ui * 256 + (row - u.pm * BM)] * GELU_K;
#pragma unroll
                for (int bj = 0; bj < 2; ++bj) { const f32x4 v0 = acc[ai][bj][m][0] * rr, v1 = acc[ai][bj][m][1] * rr;
                    const f32x2 wi[4] = {(f32x2){v0[0], v0[1]}, (f32x2){v0[2], v0[3]}, (f32x2){v1[0], v1[1]}, (f32x2){v1[2], v1[3]}}; f32x2 go[4]; gelu_w_pk4(wi, go); const f32x2 a = go[0], b = go[1], c = go[2], d = go[3];
                    if (sq) { ss2 = a * a + ss2; ss2 = b * b + ss2; ss2 = c * c + ss2; ss2 = d * d + ss2; }
                    u32x4 w; w.x = cvt_pk_bf16(a.x, a.y); w.y = cvt_pk_bf16(b.x, b.y); w.z = cvt_pk_bf16(c.x, c.y); w.w = cvt_pk_bf16(d.x, d.y);
                    *(u32x4*)(rowp + bj * HALF) = w; }
                float ss = ss2.x + ss2.y;
                if (sq) { ss += __shfl_xor(ss, 16); ss += __shfl_xor(ss, 32); if (fq == 0) vpart[(size_t)row * 48 + 4 * (u.pn - pn_sq) + wc] = ss; } }
    }
};

struct EpiHead4 {
    static constexpr bool PERM = true, AFTER_DRAIN = false;
    bf16_t* T; size_t tstride; const PG8_LAS float* g; float eps; const PG8_LAS float* rtab;
    __device__ __forceinline__ void operator()(const f32x4 (&acc)[2][2][4][2], const Unit& u, int wr, int wc, int fr, int fq, int ui = 0, const PG8_LAS unsigned* tab = nullptr) const {
        const int row0 = u.pm * BM + wr * 64 + fr, kind = u.pn >> 2; const bool nrm = (kind & 1) == 0; const int col0 = ((u.pn & 3) * 4 + wc) * 64 + 8 * fq;
        bf16_t* base = T + (size_t)kind * tstride;
        f32x4 gg[2][2];
#pragma unroll
        for (int bj = 0; bj < 2; ++bj)
#pragma unroll
            for (int n = 0; n < 2; ++n) gg[bj][n] = *(const PG8_LAS f32x4*)(g + 32 * (kind & 2) + 32 * bj + 8 * fq + 4 * n);
#pragma unroll
        for (int ai = 0; ai < 2; ++ai)
#pragma unroll
            for (int m = 0; m < 4; ++m) { bf16_t* rowp = base + (size_t)(row0 + ai * HALF + m * 16) * 1024 + col0; const float rr = rtab[ui * 256 + ai * HALF + wr * 64 + m * 16 + fr];
                f32x4 v[2][2];
#pragma unroll
                for (int bj = 0; bj < 2; ++bj)
#pragma unroll
                    for (int n = 0; n < 2; ++n) v[bj][n] = acc[ai][bj][m][n] * rr;
                if (nrm) { float ss = 0.f;
#pragma unroll
                    for (int bj = 0; bj < 2; ++bj)
#pragma unroll
                        for (int n = 0; n < 2; ++n) ss += (v[bj][n][0] * v[bj][n][0] + v[bj][n][1] * v[bj][n][1]) + (v[bj][n][2] * v[bj][n][2] + v[bj][n][3] * v[bj][n][3]);
                    ss += __shfl_xor(ss, 16); ss += __shfl_xor(ss, 32);
                    const float rs = 1.0f / sqrtf(ss * (1.0f / 64.0f) + eps);
#pragma unroll
                    for (int bj = 0; bj < 2; ++bj)
#pragma unroll
                        for (int n = 0; n < 2; ++n) v[bj][n] = v[bj][n] * rs * gg[bj][n];
                } else if (kind == 3) {
#pragma unroll
                    for (int bj = 0; bj < 2; ++bj)
#pragma unroll
                        for (int n = 0; n < 2; ++n)
#pragma unroll
                            for (int e = 0; e < 4; ++e) v[bj][n][e] = __builtin_amdgcn_rcpf(1.0f + __builtin_amdgcn_exp2f(-1.4426950408889634f * v[bj][n][e]));
                }
#pragma unroll
                for (int bj = 0; bj < 2; ++bj) { u32x4 w; w.x = cvt_pk_bf16(v[bj][0][0], v[bj][0][1]); w.y = cvt_pk_bf16(v[bj][0][2], v[bj][0][3]); w.z = cvt_pk_bf16(v[bj][1][0], v[bj][1][1]); w.w = cvt_pk_bf16(v[bj][1][2], v[bj][1][3]);
                    *(u32x4*)(rowp + 32 * bj) = w; } }
    }
};
struct EpiBf16RowScale {
    static constexpr bool PERM = true, AFTER_DRAIN = false;
    bf16_t* O; int ldc; const PG8_LAS float* rs; size_t kstride;
    __device__ __forceinline__ void operator()(const f32x4 (&acc)[2][2][4][2], const Unit& u, int wr, int wc, int fr, int fq, int ui = 0, const PG8_LAS unsigned* tab = nullptr) const {
        const int row0 = u.pm * BM + wr * 64 + fr, col0 = u.pn * BM + wc * 32 + 8 * fq;
#pragma unroll
        for (int ai = 0; ai < 2; ++ai)
#pragma unroll
            for (int m = 0; m < 4; ++m) { const int row = row0 + ai * HALF + m * 16; bf16_t* rowp = O + (size_t)u.kp * kstride + (size_t)row * ldc + col0; const float sc = rs[ui * 256 + (row - u.pm * BM)];
#pragma unroll
                for (int bj = 0; bj < 2; ++bj) { const f32x4 v0 = acc[ai][bj][m][0] * sc, v1 = acc[ai][bj][m][1] * sc;
                    u32x4 w; w.x = cvt_pk_bf16(v0[0], v0[1]); w.y = cvt_pk_bf16(v0[2], v0[3]); w.z = cvt_pk_bf16(v1[0], v1[1]); w.w = cvt_pk_bf16(v1[2], v1[3]);
                    *(u32x4*)(rowp + bj * HALF) = w; } }
    }
};
struct EpiSwiGLU {
    static constexpr bool PERM = true, AFTER_DRAIN = false;
    bf16_t* O; int ldc; const PG8_LAS float* rtab;
    static __device__ __forceinline__ float silu(float x) { return x * __builtin_amdgcn_rcpf(1.0f + __builtin_amdgcn_exp2f(-1.4426950408889634f * x)); }
    __device__ __forceinline__ void operator()(const f32x4 (&acc)[2][2][4][2], const Unit& u, int wr, int wc, int fr, int fq, int ui = 0, const PG8_LAS unsigned* tab = nullptr) const {
        const int row0 = u.pm * BM + wr * 64 + fr, col0 = u.pn * HALF + wc * 32 + 8 * fq;
#pragma unroll
        for (int ai = 0; ai < 2; ++ai)
#pragma unroll
            for (int m = 0; m < 4; ++m) { const int row = row0 + ai * HALF + m * 16; bf16_t* rowp = O + (size_t)row * ldc + col0;
                const float rs = rtab ? rtab[ui * 256 + (row - u.pm * BM)] : __uint_as_float(tab[256 + (row - u.pm * BM)]);
                const f32x4 a0 = acc[ai][0][m][0] * rs, a1 = acc[ai][0][m][1] * rs, b0 = acc[ai][1][m][0] * rs, b1 = acc[ai][1][m][1] * rs;
                const f32x4 t0 = a0 * (-1.4426950408889634f), t1 = a1 * (-1.4426950408889634f); f32x4 d0, d1;
#pragma unroll
                for (int e = 0; e < 4; ++e) { d0[e] = __builtin_amdgcn_exp2f(t0[e]); d1[e] = __builtin_amdgcn_exp2f(t1[e]); }
                d0 = d0 + 1.0f; d1 = d1 + 1.0f;
#pragma unroll
                for (int e = 0; e < 4; ++e) { d0[e] = __builtin_amdgcn_rcpf(d0[e]); d1[e] = __builtin_amdgcn_rcpf(d1[e]); }
                const f32x4 y0 = (a0 * b0) * d0, y1 = (a1 * b1) * d1;
                u32x4 w; w.x = cvt_pk_bf16(y0[0], y0[1]); w.y = cvt_pk_bf16(y0[2], y0[3]); w.z = cvt_pk_bf16(y1[0], y1[1]); w.w = cvt_pk_bf16(y1[2], y1[3]);
                *(u32x4*)rowp = w; }
    }
};
struct EpiSwiGLU8q {
    static constexpr bool PERM = true, AFTER_DRAIN = false;
    unsigned char* O; int ldc;
    __device__ __forceinline__ void operator()(const f32x4 (&acc)[2][2][4][2], const Unit& u, int wr, int wc, int fr, int fq, int ui = 0, const PG8_LAS unsigned* tab = nullptr) const {
        const int col0 = u.pn * HALF + wc * 32 + 8 * fq;
#pragma unroll
        for (int ai = 0; ai < 2; ++ai)
#pragma unroll
            for (int m = 0; m < 4; ++m) { const int r = ai * HALF + wr * 64 + m * 16 + fr; const float rs = __uint_as_float(tab[256 + r]);
                const f32x4 a0 = acc[ai][0][m][0] * rs, a1 = acc[ai][0][m][1] * rs, b0 = acc[ai][1][m][0] * rs, b1 = acc[ai][1][m][1] * rs;
                const f32x4 t0 = a0 * (-1.4426950408889634f), t1 = a1 * (-1.4426950408889634f); f32x4 d0, d1;
#pragma unroll
                for (int e = 0; e < 4; ++e) { d0[e] = __builtin_amdgcn_exp2f(t0[e]); d1[e] = __builtin_amdgcn_exp2f(t1[e]); }
                d0 = d0 + 1.0f; d1 = d1 + 1.0f;
#pragma unroll
                for (int e = 0; e < 4; ++e) { d0[e] = __builtin_amdgcn_rcpf(d0[e]); d1[e] = __builtin_amdgcn_rcpf(d1[e]); }
                const f32x4 y0 = (a0 * b0) * d0, y1 = (a1 * b1) * d1; unsigned w0 = 0u, w1 = 0u;
                w0 = __builtin_amdgcn_cvt_pk_fp8_f32(y0[0], y0[1], w0, false); w0 = __builtin_amdgcn_cvt_pk_fp8_f32(y0[2], y0[3], w0, true);
                w1 = __builtin_amdgcn_cvt_pk_fp8_f32(y1[0], y1[1], w1, false); w1 = __builtin_amdgcn_cvt_pk_fp8_f32(y1[2], y1[3], w1, true);
                uint2 w; w.x = w0; w.y = w1; *(uint2*)(O + (size_t)(u.pm * BM + r) * ldc + col0) = w; }
    }
};
struct EpiY8q {
    static constexpr bool PERM = true, AFTER_DRAIN = false;
    bf16_t* O; int ldc; size_t kstride;
    __device__ __forceinline__ void operator()(const f32x4 (&acc)[2][2][4][2], const Unit& u, int wr, int wc, int fr, int fq, int ui = 0, const PG8_LAS unsigned* tab = nullptr) const {
        const int col0 = u.pn * BM + wc * 32 + 8 * fq;
#pragma unroll
        for (int ai = 0; ai < 2; ++ai)
#pragma unroll
            for (int m = 0; m < 4; ++m) { const int r = ai * HALF + wr * 64 + m * 16 + fr; const float sc = __uint_as_float(tab[256 + r]); bf16_t* rowp = O + (size_t)u.kp * kstride + (size_t)(u.pm * BM + r) * ldc + col0;
#pragma unroll
                for (int bj = 0; bj < 2; ++bj) { const f32x4 v0 = acc[ai][bj][m][0] * sc, v1 = acc[ai][bj][m][1] * sc;
                    u32x4 w; w.x = cvt_pk_bf16(v0[0], v0[1]); w.y = cvt_pk_bf16(v0[2], v0[3]); w.z = cvt_pk_bf16(v1[0], v1[1]); w.w = cvt_pk_bf16(v1[2], v1[3]);
                    *(u32x4*)(rowp + bj * HALF) = w; } }
    }
};
constexpr float Y8_SCALE = 16.0f, Y8_INV = 0.0625f;
struct EpiY8q8 {
    static constexpr bool PERM = true, AFTER_DRAIN = false;
    unsigned char* O; int ldc;
    __device__ __forceinline__ void operator()(const f32x4 (&acc)[2][2][4][2], const Unit& u, int wr, int wc, int fr, int fq, int ui = 0, const PG8_LAS unsigned* tab = nullptr) const {
        typedef unsigned u32x2_ __attribute__((ext_vector_type(2)));
        const int col0 = u.pn * BM + wc * 32 + 8 * fq;
#pragma unroll
        for (int ai = 0; ai < 2; ++ai)
#pragma unroll
            for (int m = 0; m < 4; ++m) { const int r = ai * HALF + wr * 64 + m * 16 + fr; const float sc = __uint_as_float(tab[256 + r]) * Y8_SCALE; unsigned char* rowp = O + (size_t)(u.pm * BM + r) * ldc + col0;
#pragma unroll
                for (int bj = 0; bj < 2; ++bj) { const f32x4 v0 = acc[ai][bj][m][0] * sc, v1 = acc[ai][bj][m][1] * sc; unsigned w0 = 0u, w1 = 0u;
                    w0 = __builtin_amdgcn_cvt_pk_fp8_f32(v0[0], v0[1], w0, false); w0 = __builtin_amdgcn_cvt_pk_fp8_f32(v0[2], v0[3], w0, true);
                    w1 = __builtin_amdgcn_cvt_pk_fp8_f32(v1[0], v1[1], w1, false); w1 = __builtin_amdgcn_cvt_pk_fp8_f32(v1[2], v1[3], w1, true);
                    u32x2_ w; w.x = w0; w.y = w1; *(u32x2_*)(rowp + bj * HALF) = w; } }
    }
};
template <class Epi, class Sched, bool ALIGN_EPI = false, bool SP2 = true, bool GATHER = false>
__device__ __forceinline__ void gemm_phase(PG8_LAS unsigned char* lds, const Gemm g, const Sched& S, const Epi& E, PG8_LAS unsigned* tt = nullptr) {
    static_assert(SP2, "only the two-MFMA-blocks-per-barrier-pair loop is kept in this file");
    int tid_ = threadIdx.x; asm volatile("" : "+v"(tid_));
    const int tid = tid_, wid = __builtin_amdgcn_readfirstlane(tid >> 6), lane = tid & 63, wr = wid >> 2, wc = wid & 3, fr = lane & 15, fq = lane >> 4;
    const int K = g.K, nt = K / BK, ldb = g.ldb ? g.ldb : K;
    unsigned c0[2], c1[2], n0[2], n1[2], voffB[2]; int rA[2]; unsigned cbA[2];
    const size_t kstep = (size_t)(BK * 2);
    const size_t hstepA = (size_t)HALF * g.lda * 2, hstep = (size_t)HALF * ldb * 2;
    const size_t tstepA = 2 * hstepA, tstep = 2 * hstep;
#pragma unroll
    for (int i = 0; i < 2; ++i) { int R, C; stage_rc(tid * 16 + i * 8192, R, C); const int Rb = Epi::PERM ? ((R & ~31) + perm32(R & 31)) : R; rA[i] = R; cbA[i] = (unsigned)C * 2u;
        c0[i] = (unsigned)(R * g.lda + C) * 2u; c1[i] = c0[i] + (unsigned)hstepA; n0[i] = c0[i]; n1[i] = c1[i]; voffB[i] = (unsigned)(Rb * ldb + C) * 2u; }
    const unsigned ldsw = (unsigned)wid * 1024u;
    const int aoff = lds_byte(wr * 64 + fr, fq * 8), boff = lds_byte(wc * 32 + fr, fq * 8);
#define PG8_SA(b, h) (((b) * 2 + (h)) * HTB)
#define PG8_SB(b, h) ((4 + (b) * 2 + (h)) * HTB)
#define PG8_STAGE(bufoff, gbase, voff) do { _Pragma("unroll") for (int _i = 0; _i < 2; ++_i) \
        __builtin_amdgcn_global_load_lds((const unsigned*)((const char*)(gbase) + (voff)[_i]), (PG8_LAS unsigned*)(lds + (bufoff) + ldsw + _i * 8192), 16, 0, 0); } while (0)
#define PG8_LDA(dst, b, h) do { _Pragma("unroll") for (int m = 0; m < 4; ++m) _Pragma("unroll") for (int k = 0; k < 2; ++k) dst[m][k] = *(const PG8_LAS bf16x8*)(lds + PG8_SA(b, h) + aoff + m * 2048 + k * 1024); } while (0)
#define PG8_LDB(dst, b, h) do { _Pragma("unroll") for (int n = 0; n < 2; ++n) _Pragma("unroll") for (int k = 0; k < 2; ++k) dst[n][k] = *(const PG8_LAS bf16x8*)(lds + PG8_SB(b, h) + boff + n * 2048 + k * 1024); } while (0)
#define PG8_MMA(ai, bj, At, Bt) do { __builtin_amdgcn_s_setprio(1); _Pragma("unroll") for (int m = 0; m < 4; ++m) _Pragma("unroll") for (int n = 0; n < 2; ++n) _Pragma("unroll") for (int k = 0; k < 2; ++k) \
        acc[ai][bj][m][n] = __builtin_amdgcn_mfma_f32_16x16x32_bf16(Bt[n][k], At[m][k], acc[ai][bj][m][n], 0, 0, 0); __builtin_amdgcn_s_setprio(0); } while (0)
#define PG8_WAIT_V(n) asm volatile("s_waitcnt vmcnt(" #n ")" ::: "memory")
#define PG8_WAIT_L(n) asm volatile("s_waitcnt lgkmcnt(" #n ")" ::: "memory")
#define PG8_BAR __builtin_amdgcn_s_barrier()
#define PG8_SCHED __builtin_amdgcn_sched_barrier(0)
#define PG8_GOFF(o0, o1, tab, nv) do { _Pragma("unroll") for (int _i = 0; _i < 2; ++_i) { const unsigned e0_ = (tab)[rA[_i]], e1_ = (tab)[HALF + rA[_i]]; \
        o0[_i] = ((rA[_i] < (nv)) ? (e0_ >> 1) : 0u) * (unsigned)(g.lda * 2) + cbA[_i]; o1[_i] = ((HALF + rA[_i] < (nv)) ? (e1_ >> 1) : 0u) * (unsigned)(g.lda * 2) + cbA[_i]; } } while (0)
    Unit cur, nxt; int ui = 0;
    if (!S.next(0, cur)) return;
    f32x4 acc[2][2][4][2];
#pragma unroll
    for (int a = 0; a < 2; ++a)
#pragma unroll
        for (int b = 0; b < 2; ++b)
#pragma unroll
            for (int m = 0; m < 4; ++m)
#pragma unroll
                for (int n = 0; n < 2; ++n) acc[a][b][m][n] = (f32x4){0.f, 0.f, 0.f, 0.f};
    bf16x8 At[4][2], B0[2][2], B1[2][2];
    int tbuf = 0, tnext = 1;
    if constexpr (GATHER) {
        { const int lo_ = S.listoff(cur.pm); if (tid < 256) tt[tid] = g.rowlist[lo_ + tid]; else tt[tid] = g.wlist[lo_ + tid - 256]; }
        asm volatile("s_waitcnt vmcnt(0) lgkmcnt(0)" ::: "memory"); PG8_BAR; asm volatile("" ::: "memory");
        PG8_GOFF(c0, c1, tt, S.rows(cur.pm));
    }
    const char* cA = (GATHER ? (const char*)g.A : (const char*)g.A + (size_t)cur.pm * tstepA) + S.kbytes(cur, K); const char* cB = (const char*)g.Bt + (size_t)S.expert(cur.pm) * g.bstride + (size_t)cur.pn * tstep + S.kbytes(cur, K);
    S.a_ready(cur);
    PG8_STAGE(PG8_SB(0, 0), cB, voffB); PG8_STAGE(PG8_SB(0, 1), cB + hstep, voffB); PG8_STAGE(PG8_SA(0, 0), cA, c0); PG8_STAGE(PG8_SA(0, 1), cA, c1);
    if (wr == 1) PG8_BAR;
    PG8_WAIT_V(2); PG8_BAR;
    PG8_STAGE(PG8_SB(1, 0), cB + kstep, voffB); PG8_STAGE(PG8_SA(1, 0), cA + kstep, c0); PG8_STAGE(PG8_SB(1, 1), cB + hstep + kstep, voffB);
    PG8_WAIT_V(6); PG8_BAR;
    for (;;) {
        const bool has_next = S.next(ui + 1, nxt);
        const char* nA = GATHER ? cA : (has_next ? (const char*)g.A + (size_t)nxt.pm * tstepA + S.kbytes(nxt, K) : cA); const char* nB = has_next ? (const char*)g.Bt + (size_t)S.expert(nxt.pm) * g.bstride + (size_t)nxt.pn * tstep + S.kbytes(nxt, K) : cB;
        if constexpr (GATHER) { if (has_next) {
            const unsigned* src_ = (wid < 4 ? g.rowlist : g.wlist) + S.listoff(nxt.pm) + (wid & 3) * 64 + lane;
            __builtin_amdgcn_global_load_lds(src_, (PG8_LAS unsigned*)(tt + tnext * 512 + wid * 64), 4, 0, 0); } }
        for (int t = 0; t < nt; t += 2) {
            const bool last = (t == nt - 2);
            if constexpr (GATHER) { if (last && has_next) PG8_GOFF(n0, n1, tt + tnext * 512, S.rows(nxt.pm)); }
            const char* a1 = cA + (size_t)(t + 1) * kstep;
            const char* a2 = last ? nA : cA + (size_t)(t + 2) * kstep; const char* b2 = last ? nB : cB + (size_t)(t + 2) * kstep;
            const char* a3 = a2 + kstep; const char* b3 = b2 + kstep;
            unsigned x0[2], x1[2];
#pragma unroll
            for (int i = 0; i < 2; ++i) { x0[i] = last ? n0[i] : c0[i]; x1[i] = last ? n1[i] : c1[i]; }
            if (last && has_next) S.a_ready(nxt);
            PG8_LDB(B0, 0, 0); PG8_LDB(B1, 0, 1); PG8_SCHED; PG8_LDA(At, 0, 0); PG8_STAGE(PG8_SA(1, 1), a1, c1);
            PG8_WAIT_V(8); PG8_WAIT_L(0); PG8_BAR; PG8_MMA(0, 0, At, B0); PG8_MMA(0, 1, At, B1); PG8_BAR; PG8_SCHED;
            PG8_LDA(At, 0, 1); PG8_STAGE(PG8_SB(0, 0), b2, voffB); PG8_STAGE(PG8_SB(0, 1), b2 + hstep, voffB); PG8_STAGE(PG8_SA(0, 0), a2, x0);
            PG8_WAIT_V(8); PG8_WAIT_L(0); PG8_BAR; PG8_MMA(1, 0, At, B0); PG8_MMA(1, 1, At, B1); PG8_BAR; PG8_SCHED;
            PG8_LDB(B0, 1, 0); PG8_LDB(B1, 1, 1); PG8_SCHED; PG8_LDA(At, 1, 0); PG8_STAGE(PG8_SA(0, 1), a2, x1);
            PG8_WAIT_V(8); PG8_WAIT_L(0); PG8_BAR; PG8_MMA(0, 0, At, B0); PG8_MMA(0, 1, At, B1); PG8_BAR; PG8_SCHED;
            PG8_LDA(At, 1, 1); PG8_STAGE(PG8_SB(1, 0), b3, voffB); PG8_STAGE(PG8_SB(1, 1), b3 + hstep, voffB); PG8_STAGE(PG8_SA(1, 0), a3, x0);
            PG8_WAIT_V(8); PG8_WAIT_L(0); PG8_BAR; PG8_MMA(1, 0, At, B0); PG8_MMA(1, 1, At, B1); PG8_BAR; PG8_SCHED;
        }
        if constexpr (ALIGN_EPI) { if (wr == 0) PG8_BAR; }
        if constexpr (!Epi::AFTER_DRAIN) { E(acc, cur, wr, wc, fr, fq, ui, GATHER ? tt + tbuf * 512 : nullptr); S.done(cur); }
        if (!has_next) break;
#pragma unroll
        for (int a = 0; a < 2; ++a)
#pragma unroll
            for (int b = 0; b < 2; ++b)
#pragma unroll
                for (int m = 0; m < 4; ++m)
#pragma unroll
                    for (int n = 0; n < 2; ++n) acc[a][b][m][n] = (f32x4){0.f, 0.f, 0.f, 0.f};
        cur = nxt; cA = nA; cB = nB; ++ui; tbuf = tnext; tnext = (tnext == 2) ? 0 : tnext + 1;
        if constexpr (GATHER) {
#pragma unroll
            for (int i = 0; i < 2; ++i) { c0[i] = n0[i]; c1[i] = n1[i]; } }
        if constexpr (ALIGN_EPI) { if (wr == 1) PG8_BAR; }
    }
    PG8_WAIT_V(0);
    if constexpr (!ALIGN_EPI) { if (wr == 0) PG8_BAR; }
    PG8_BAR;
    if constexpr (Epi::AFTER_DRAIN) { E.fused(acc, cur, wr, wc, fr, fq, lds, wid, lane); S.done(cur); }
#undef PG8_SA
#undef PG8_SB
#undef PG8_STAGE
#undef PG8_LDA
#undef PG8_LDB
#undef PG8_MMA
#undef PG8_WAIT_V
#undef PG8_WAIT_L
#undef PG8_BAR
#undef PG8_SCHED
#undef PG8_GOFF
}

template <class Epi, class Sched, bool ALIGN_EPI = true, bool SP2 = true, bool GATHER = true>
__device__ __forceinline__ void gemm_phase_f8q(PG8_LAS unsigned char* lds, const Gemm g, const Sched& S, const Epi& E, PG8_LAS unsigned* tt = nullptr) {
    static_assert(SP2, "only the two-MFMA-blocks-per-barrier-pair loop is kept in this file");
    typedef int v8i_t __attribute__((ext_vector_type(8))); typedef int v4i_t __attribute__((ext_vector_type(4)));
    int tid_ = threadIdx.x; asm volatile("" : "+v"(tid_));
    const int tid = tid_, wid = __builtin_amdgcn_readfirstlane(tid >> 6), lane = tid & 63, wr = wid >> 2, wc = wid & 3, fr = lane & 15, fq = lane >> 4;
    const int K = g.K, nt = K / BK, ldb = g.ldb ? g.ldb : K;
    unsigned c0[2], c1[2], n0[2], n1[2], voffB[2]; int rA[2]; unsigned cbA[2];
    const size_t kstep = (size_t)(BK * 2);
    const size_t hstepA = (size_t)HALF * g.lda * 2, hstep = (size_t)HALF * ldb * 2;
    const size_t tstepA = 2 * hstepA, tstep = 2 * hstep;
#pragma unroll
    for (int i = 0; i < 2; ++i) { const int R = (tid >> 3) + 64 * i, x = R & 15, C = (((tid & 7) ^ (((x >> 1) & 1) | (((x >> 3) & 1) << 2))) * 16); const int Rb = (R & ~31) + perm32(R & 31);
        rA[i] = R; cbA[i] = (unsigned)C; c0[i] = (unsigned)(R * g.lda) * 2u + (unsigned)C; c1[i] = c0[i] + (unsigned)hstepA; n0[i] = c0[i]; n1[i] = c1[i]; voffB[i] = (unsigned)(Rb * ldb) * 2u + (unsigned)C; }
    const unsigned ldsw = (unsigned)wid * 1024u;
    const int fsw = ((fr >> 1) & 1) | (((fr >> 3) & 1) << 2);
    const int aoffL = (wr * 64 + fr) * 128 + (((2 * fq) ^ fsw) * 16), aoffH = (wr * 64 + fr) * 128 + (((2 * fq + 1) ^ fsw) * 16);
    const int boffL = (wc * 32 + fr) * 128 + (((2 * fq) ^ fsw) * 16), boffH = (wc * 32 + fr) * 128 + (((2 * fq + 1) ^ fsw) * 16);
#define PG8_SA(b, h) (((b) * 2 + (h)) * HTB)
#define PG8_SB(b, h) ((4 + (b) * 2 + (h)) * HTB)
#define PG8_STAGE(bufoff, gbase, voff) do { _Pragma("unroll") for (int _i = 0; _i < 2; ++_i) \
        __builtin_amdgcn_global_load_lds((const unsigned*)((const char*)(gbase) + (voff)[_i]), (PG8_LAS unsigned*)(lds + (bufoff) + ldsw + _i * 8192), 16, 0, 0); } while (0)
#define PG8_LDA(dst, b, h) do { _Pragma("unroll") for (int m = 0; m < 4; ++m) { const v4i_t l_ = *(const PG8_LAS v4i_t*)(lds + PG8_SA(b, h) + aoffL + m * 2048), h_ = *(const PG8_LAS v4i_t*)(lds + PG8_SA(b, h) + aoffH + m * 2048); \
        dst[m] = (v8i_t){l_[0], l_[1], l_[2], l_[3], h_[0], h_[1], h_[2], h_[3]}; } } while (0)
#define PG8_LDB(dst, b, h) do { _Pragma("unroll") for (int n = 0; n < 2; ++n) { const v4i_t l_ = *(const PG8_LAS v4i_t*)(lds + PG8_SB(b, h) + boffL + n * 2048), h_ = *(const PG8_LAS v4i_t*)(lds + PG8_SB(b, h) + boffH + n * 2048); \
        dst[n] = (v8i_t){l_[0], l_[1], l_[2], l_[3], h_[0], h_[1], h_[2], h_[3]}; } } while (0)
#define PG8_MMA(ai, bj, At, Bt) do { __builtin_amdgcn_s_setprio(1); _Pragma("unroll") for (int m = 0; m < 4; ++m) _Pragma("unroll") for (int n = 0; n < 2; ++n) \
        asm volatile("v_mfma_scale_f32_16x16x128_f8f6f4 %0, %1, %2, %0, %3, %4 op_sel_hi:[0,0,0]" : "+v"(acc[ai][bj][m][n]) : "v"(Bt[n]), "v"(At[m]), "v"(sclB), "v"(sclA)); __builtin_amdgcn_s_setprio(0); } while (0)
#define PG8_WAIT_V(n) asm volatile("s_waitcnt vmcnt(" #n ")" ::: "memory")
#define PG8_WAIT_L(n) asm volatile("s_waitcnt lgkmcnt(" #n ")" ::: "memory")
#define PG8_BAR __builtin_amdgcn_s_barrier()
#define PG8_SCHED __builtin_amdgcn_sched_barrier(0)
#define PG8_GOFF(o0, o1, tab, nv) do { _Pragma("unroll") for (int _i = 0; _i < 2; ++_i) { const unsigned e0_ = (tab)[rA[_i]], e1_ = (tab)[HALF + rA[_i]]; \
        o0[_i] = ((rA[_i] < (nv)) ? (e0_ >> 1) : 0u) * (unsigned)(g.lda * 2) + cbA[_i]; o1[_i] = ((HALF + rA[_i] < (nv)) ? (e1_ >> 1) : 0u) * (unsigned)(g.lda * 2) + cbA[_i]; } } while (0)
    Unit cur, nxt; int ui = 0;
    if (!S.next(0, cur)) return;
    f32x4 acc[2][2][4][2];
#pragma unroll
    for (int a = 0; a < 2; ++a)
#pragma unroll
        for (int b = 0; b < 2; ++b)
#pragma unroll
            for (int m = 0; m < 4; ++m)
#pragma unroll
                for (int n = 0; n < 2; ++n) acc[a][b][m][n] = (f32x4){0.f, 0.f, 0.f, 0.f};
    const int sclB = g.scale_b, sclA = 0x7f7f7f7f;
    v8i_t At[4], B0[2], B1[2];
    int tbuf = 0, tnext = 1;
    if constexpr (GATHER) {
        { const int lo_ = S.listoff(cur.pm); if (tid < 256) tt[tid] = g.rowlist[lo_ + tid]; else tt[tid] = g.wlist[lo_ + tid - 256]; }
        asm volatile("s_waitcnt vmcnt(0) lgkmcnt(0)" ::: "memory"); PG8_BAR; asm volatile("" ::: "memory");
        PG8_GOFF(c0, c1, tt, S.rows(cur.pm));
    }
    const char* cA = (GATHER ? (const char*)g.A : (const char*)g.A + (size_t)cur.pm * tstepA) + S.kbytes(cur, K); const char* cB = (const char*)g.Bt + (size_t)S.expert(cur.pm) * g.bstride + (size_t)cur.pn * tstep + S.kbytes(cur, K);
    S.a_ready(cur);
    PG8_STAGE(PG8_SB(0, 0), cB, voffB); PG8_STAGE(PG8_SB(0, 1), cB + hstep, voffB); PG8_STAGE(PG8_SA(0, 0), cA, c0); PG8_STAGE(PG8_SA(0, 1), cA, c1);
    if (wr == 1) PG8_BAR;
    PG8_WAIT_V(2); PG8_BAR;
    PG8_STAGE(PG8_SB(1, 0), cB + kstep, voffB); PG8_STAGE(PG8_SA(1, 0), cA + kstep, c0); PG8_STAGE(PG8_SB(1, 1), cB + hstep + kstep, voffB);
    PG8_WAIT_V(6); PG8_BAR;
    for (;;) {
        const bool has_next = S.next(ui + 1, nxt);
        const char* nA = GATHER ? cA : (has_next ? (const char*)g.A + (size_t)nxt.pm * tstepA + S.kbytes(nxt, K) : cA); const char* nB = has_next ? (const char*)g.Bt + (size_t)S.expert(nxt.pm) * g.bstride + (size_t)nxt.pn * tstep + S.kbytes(nxt, K) : cB;
        if constexpr (GATHER) { if (has_next) {
            const unsigned* src_ = (wid < 4 ? g.rowlist : g.wlist) + S.listoff(nxt.pm) + (wid & 3) * 64 + lane;
            __builtin_amdgcn_global_load_lds(src_, (PG8_LAS unsigned*)(tt + tnext * 512 + wid * 64), 4, 0, 0); } }
        for (int t = 0; t < nt; t += 2) {
            const bool last = (t == nt - 2);
            if constexpr (GATHER) { if (last && has_next) PG8_GOFF(n0, n1, tt + tnext * 512, S.rows(nxt.pm)); }
            const char* a1 = cA + (size_t)(t + 1) * kstep;
            const char* a2 = last ? nA : cA + (size_t)(t + 2) * kstep; const char* b2 = last ? nB : cB + (size_t)(t + 2) * kstep;
            const char* a3 = a2 + kstep; const char* b3 = b2 + kstep;
            unsigned x0[2], x1[2];
#pragma unroll
            for (int i = 0; i < 2; ++i) { x0[i] = last ? n0[i] : c0[i]; x1[i] = last ? n1[i] : c1[i]; }
            if (last && has_next) S.a_ready(nxt);
            PG8_LDB(B0, 0, 0); PG8_LDB(B1, 0, 1); PG8_SCHED; PG8_LDA(At, 0, 0); PG8_STAGE(PG8_SA(1, 1), a1, c1);
            PG8_WAIT_V(8); PG8_WAIT_L(0); PG8_BAR; PG8_MMA(0, 0, At, B0); PG8_MMA(0, 1, At, B1); PG8_BAR; PG8_SCHED;
            PG8_LDA(At, 0, 1); PG8_STAGE(PG8_SB(0, 0), b2, voffB); PG8_STAGE(PG8_SB(0, 1), b2 + hstep, voffB); PG8_STAGE(PG8_SA(0, 0), a2, x0);
            PG8_WAIT_V(8); PG8_WAIT_L(0); PG8_BAR; PG8_MMA(1, 0, At, B0); PG8_MMA(1, 1, At, B1); PG8_BAR; PG8_SCHED;
            PG8_LDB(B0, 1, 0); PG8_LDB(B1, 1, 1); PG8_SCHED; PG8_LDA(At, 1, 0); PG8_STAGE(PG8_SA(0, 1), a2, x1);
            PG8_WAIT_V(8); PG8_WAIT_L(0); PG8_BAR; PG8_MMA(0, 0, At, B0); PG8_MMA(0, 1, At, B1); PG8_BAR; PG8_SCHED;
            PG8_LDA(At, 1, 1); PG8_STAGE(PG8_SB(1, 0), b3, voffB); PG8_STAGE(PG8_SB(1, 1), b3 + hstep, voffB); PG8_STAGE(PG8_SA(1, 0), a3, x0);
            PG8_WAIT_V(8); PG8_WAIT_L(0); PG8_BAR; PG8_MMA(1, 0, At, B0); PG8_MMA(1, 1, At, B1); PG8_BAR; PG8_SCHED;
        }
        if constexpr (ALIGN_EPI) { if (wr == 0) PG8_BAR; }
        asm volatile("s_nop 15\n\ts_nop 15" ::: "memory");
        if constexpr (!Epi::AFTER_DRAIN) { E(acc, cur, wr, wc, fr, fq, ui, GATHER ? tt + tbuf * 512 : nullptr); S.done(cur); }
        if (!has_next) break;
#pragma unroll
        for (int a = 0; a < 2; ++a)
#pragma unroll
            for (int b = 0; b < 2; ++b)
#pragma unroll
                for (int m = 0; m < 4; ++m)
#pragma unroll
                    for (int n = 0; n < 2; ++n) acc[a][b][m][n] = (f32x4){0.f, 0.f, 0.f, 0.f};
        cur = nxt; cA = nA; cB = nB; ++ui; tbuf = tnext; tnext = (tnext == 2) ? 0 : tnext + 1;
        if constexpr (GATHER) {
#pragma unroll
            for (int i = 0; i < 2; ++i) { c0[i] = n0[i]; c1[i] = n1[i]; } }
        if constexpr (ALIGN_EPI) { if (wr == 1) PG8_BAR; }
    }
    PG8_WAIT_V(0);
    if constexpr (!ALIGN_EPI) { if (wr == 0) PG8_BAR; }
    PG8_BAR;
    if constexpr (Epi::AFTER_DRAIN) { E.fused(acc, cur, wr, wc, fr, fq, lds, wid, lane); S.done(cur); }
#undef PG8_SA
#undef PG8_SB
#undef PG8_STAGE
#undef PG8_LDA
#undef PG8_LDB
#undef PG8_MMA
#undef PG8_WAIT_V
#undef PG8_WAIT_L
#undef PG8_BAR
#undef PG8_SCHED
#undef PG8_GOFF
}

struct EpiSwiGLU64 {
    unsigned char* O; int ldc;
    __device__ __forceinline__ void operator()(const f32x4 (&acc)[2][4][2], const Unit& u, int wr, int wc, int fr, int fq, const PG8_LAS unsigned* tab) const {
        const int col0 = u.pn * 64 + wc * 16 + 4 * fq;
#pragma unroll
        for (int ai = 0; ai < 2; ++ai)
#pragma unroll
            for (int m = 0; m < 4; ++m) { const int r = ai * HALF + wr * 64 + m * 16 + fr; const float rs = __uint_as_float(tab[256 + r]);
                const f32x4 a = acc[ai][m][0] * rs, b = acc[ai][m][1] * rs; const f32x4 t = a * (-1.4426950408889634f); f32x4 d;
#pragma unroll
                for (int e = 0; e < 4; ++e) d[e] = __builtin_amdgcn_exp2f(t[e]);
                d = d + 1.0f;
#pragma unroll
                for (int e = 0; e < 4; ++e) d[e] = __builtin_amdgcn_rcpf(d[e]);
                const f32x4 y = (a * b) * d; unsigned w = 0u; w = __builtin_amdgcn_cvt_pk_fp8_f32(y[0], y[1], w, false); w = __builtin_amdgcn_cvt_pk_fp8_f32(y[2], y[3], w, true);
                *(unsigned*)(O + (size_t)(u.pm * BM + r) * ldc + col0) = w; }
    }
};
struct EpiY64 {
    bf16_t* O; int ldc; size_t kstride;
    __device__ __forceinline__ void operator()(const f32x4 (&acc)[2][4][2], const Unit& u, int wr, int wc, int fr, int fq, const PG8_LAS unsigned* tab) const {
        const int col0 = u.pn * 128 + wc * 32 + 8 * fq;
#pragma unroll
        for (int ai = 0; ai < 2; ++ai)
#pragma unroll
            for (int m = 0; m < 4; ++m) { const int r = ai * HALF + wr * 64 + m * 16 + fr; const float gw = __uint_as_float(tab[256 + r]);
                const f32x4 a = acc[ai][m][0] * gw, b = acc[ai][m][1] * gw; u32x4 w; w.x = cvt_pk_bf16(a[0], a[1]); w.y = cvt_pk_bf16(a[2], a[3]); w.z = cvt_pk_bf16(b[0], b[1]); w.w = cvt_pk_bf16(b[2], b[3]);
                *(u32x4*)(O + (size_t)u.kp * kstride + (size_t)(u.pm * BM + r) * ldc + col0) = w; }
    }
};
template <class Epi, class Sched>
__device__ __forceinline__ void gemm_phase_f8n128(PG8_LAS unsigned char* lds, const Gemm g, const Sched& S, const Epi& E, PG8_LAS unsigned* tt) {
    typedef int v8i_t __attribute__((ext_vector_type(8))); typedef int v4i_t __attribute__((ext_vector_type(4)));
    int tid_ = threadIdx.x; asm volatile("" : "+v"(tid_));
    const int tid = tid_, wid = __builtin_amdgcn_readfirstlane(tid >> 6), lane = tid & 63, wr = wid >> 2, wc = wid & 3, fr = lane & 15, fq = lane >> 4;
    const int K = g.K, nt = K / BK, ldb = g.ldb ? g.ldb : K;
    unsigned c0[2], c1[2], n0[2], n1[2], voffB[2]; int rA[2]; unsigned cbA[2];
    const size_t kstep = (size_t)(BK * 2), tstepB = (size_t)HALF * ldb * 2;
#pragma unroll
    for (int i = 0; i < 2; ++i) { const int R = (tid >> 3) + 64 * i, x = R & 15, C = (((tid & 7) ^ (((x >> 1) & 1) | (((x >> 3) & 1) << 2))) * 16); const int Rb = (R & ~31) + perm32(R & 31);
        rA[i] = R; cbA[i] = (unsigned)C; c0[i] = c1[i] = n0[i] = n1[i] = 0u; voffB[i] = (unsigned)(Rb * ldb) * 2u + (unsigned)C; }
    const unsigned ldsw = (unsigned)wid * 1024u;
    const int fsw = ((fr >> 1) & 1) | (((fr >> 3) & 1) << 2);
    const int aoffL = (wr * 64 + fr) * 128 + (((2 * fq) ^ fsw) * 16), aoffH = (wr * 64 + fr) * 128 + (((2 * fq + 1) ^ fsw) * 16);
    const int boffL = (wc * 32 + fr) * 128 + (((2 * fq) ^ fsw) * 16), boffH = (wc * 32 + fr) * 128 + (((2 * fq + 1) ^ fsw) * 16);
#define F8_SA(b, h) (((b) * 3 + (h)) * HTB)
#define F8_SB(b) (((b) * 3 + 2) * HTB)
#define F8_STAGE1(bufoff, gbase, voff, i_) __builtin_amdgcn_global_load_lds((const unsigned*)((const char*)(gbase) + (voff)[i_]), (PG8_LAS unsigned*)(lds + (bufoff) + ldsw + (i_) * 8192), 16, 0, 0)
#define F8_STAGE(bufoff, gbase, voff) do { F8_STAGE1(bufoff, gbase, voff, 0); F8_STAGE1(bufoff, gbase, voff, 1); } while (0)
#define F8_LDA1(dst, b, h, m) do { const v4i_t l_ = *(const PG8_LAS v4i_t*)(lds + F8_SA(b, h) + aoffL + (m) * 2048), h_ = *(const PG8_LAS v4i_t*)(lds + F8_SA(b, h) + aoffH + (m) * 2048); \
        dst[m] = (v8i_t){l_[0], l_[1], l_[2], l_[3], h_[0], h_[1], h_[2], h_[3]}; } while (0)
#define F8_LDB1(dst, b, n) do { const v4i_t l_ = *(const PG8_LAS v4i_t*)(lds + F8_SB(b) + boffL + (n) * 2048), h_ = *(const PG8_LAS v4i_t*)(lds + F8_SB(b) + boffH + (n) * 2048); \
        dst[n] = (v8i_t){l_[0], l_[1], l_[2], l_[3], h_[0], h_[1], h_[2], h_[3]}; } while (0)
#define F8_LDA(dst, b, h) do { F8_LDA1(dst, b, h, 0); F8_LDA1(dst, b, h, 1); F8_LDA1(dst, b, h, 2); F8_LDA1(dst, b, h, 3); } while (0)
#define F8_LDB(dst, b) do { F8_LDB1(dst, b, 0); F8_LDB1(dst, b, 1); } while (0)
#define F8_MMA1(ai, m, At, Bf) do { _Pragma("unroll") for (int n = 0; n < 2; ++n) \
        acc[ai][m][n] = __builtin_amdgcn_mfma_scale_f32_16x16x128_f8f6f4(Bf[n], At[m], acc[ai][m][n], 0, 0, 0, g.scale_b, 0, 0x7f7f7f7f); } while (0)
#define F8_WAIT_V(n) asm volatile("s_waitcnt vmcnt(" #n ")" ::: "memory")
#define F8_WAIT_L(n) asm volatile("s_waitcnt lgkmcnt(" #n ")" ::: "memory")
#define F8_BAR __builtin_amdgcn_s_barrier()
#define F8_SCHED __builtin_amdgcn_sched_barrier(0)
#define F8_GOFF(o0, o1, tab, nv) do { _Pragma("unroll") for (int _i = 0; _i < 2; ++_i) { const unsigned e0_ = (tab)[rA[_i]], e1_ = (tab)[HALF + rA[_i]]; \
        o0[_i] = ((rA[_i] < (nv)) ? (e0_ >> 1) : 0u) * (unsigned)(g.lda * 2) + cbA[_i]; o1[_i] = ((HALF + rA[_i] < (nv)) ? (e1_ >> 1) : 0u) * (unsigned)(g.lda * 2) + cbA[_i]; } } while (0)
    Unit cur, nxt; int ui = 0;
    if (!S.next(0, cur)) return;
    f32x4 acc[2][4][2];
#pragma unroll
    for (int a = 0; a < 2; ++a)
#pragma unroll
        for (int m = 0; m < 4; ++m)
#pragma unroll
            for (int n = 0; n < 2; ++n) acc[a][m][n] = (f32x4){0.f, 0.f, 0.f, 0.f};
    v8i_t AtA[4], AtB[4], BfA[2], BfB[2];
    int tbuf = 0, tnext = 1;
    { const int lo_ = S.listoff(cur.pm); if (tid < 256) tt[tid] = g.rowlist[lo_ + tid]; else tt[tid] = g.wlist[lo_ + tid - 256]; }
    asm volatile("s_waitcnt vmcnt(0) lgkmcnt(0)" ::: "memory"); F8_BAR; asm volatile("" ::: "memory");
    F8_GOFF(c0, c1, tt, S.rows(cur.pm));
    const char* cA = (const char*)g.A + S.kbytes(cur, K); const char* cB = (const char*)g.Bt + (size_t)S.expert(cur.pm) * g.bstride + (size_t)cur.pn * tstepB + S.kbytes(cur, K);
    F8_STAGE(F8_SB(0), cB, voffB); F8_STAGE(F8_SA(0, 0), cA, c0); F8_STAGE(F8_SA(0, 1), cA, c1);
    F8_STAGE(F8_SB(1), cB + kstep, voffB); F8_STAGE(F8_SA(1, 0), cA + kstep, c0); F8_STAGE(F8_SA(1, 1), cA + kstep, c1);
    F8_WAIT_V(8); F8_BAR;
    F8_LDB(BfA, 0); F8_LDA(AtA, 0, 0);
    for (;;) {
        const bool has_next = S.next(ui + 1, nxt);
        const char* nA = has_next ? (const char*)g.A + S.kbytes(nxt, K) : cA; const char* nB = has_next ? (const char*)g.Bt + (size_t)S.expert(nxt.pm) * g.bstride + (size_t)nxt.pn * tstepB + S.kbytes(nxt, K) : cB;
        if (has_next) { const unsigned* src_ = (wid < 4 ? g.rowlist : g.wlist) + S.listoff(nxt.pm) + (wid & 3) * 64 + lane;
            __builtin_amdgcn_global_load_lds(src_, (PG8_LAS unsigned*)(tt + tnext * 512 + wid * 64), 4, 0, 0); }
#pragma unroll 1
        for (int t = 0; t < nt; t += 2) {
            const bool last = (t == nt - 2);
            if (last && has_next) F8_GOFF(n0, n1, tt + tnext * 512, S.rows(nxt.pm));
            const char* a2 = last ? nA : cA + (size_t)(t + 2) * kstep; const char* b2 = last ? nB : cB + (size_t)(t + 2) * kstep;
            const char* a3 = a2 + kstep; const char* b3 = b2 + kstep;
            unsigned x0[2], x1[2];
#pragma unroll
            for (int i = 0; i < 2; ++i) { x0[i] = (last && has_next) ? n0[i] : c0[i]; x1[i] = (last && has_next) ? n1[i] : c1[i]; }
#define F8_TOP F8_WAIT_V(6); F8_WAIT_L(0); F8_BAR; F8_SCHED
#define F8_SP1(b, Bf, bp, ap, xo) F8_TOP; \
            F8_MMA1(0, 0, AtA, Bf); F8_SCHED; F8_STAGE1(F8_SB(b), bp, voffB, 0); F8_LDA1(AtB, b, 1, 0); F8_SCHED; F8_MMA1(0, 1, AtA, Bf); F8_SCHED; F8_STAGE1(F8_SB(b), bp, voffB, 1); F8_LDA1(AtB, b, 1, 1); F8_SCHED; \
            F8_MMA1(0, 2, AtA, Bf); F8_SCHED; F8_STAGE1(F8_SA(b, 0), ap, xo, 0); F8_LDA1(AtB, b, 1, 2); F8_SCHED; F8_MMA1(0, 3, AtA, Bf); F8_SCHED; F8_STAGE1(F8_SA(b, 0), ap, xo, 1); F8_LDA1(AtB, b, 1, 3); F8_SCHED
#define F8_SP2(b, Bf, Bn, ap, xo) F8_TOP; \
            F8_MMA1(1, 0, AtB, Bf); F8_SCHED; F8_STAGE1(F8_SA(b, 1), ap, xo, 0); F8_LDB1(Bn, (b) ^ 1, 0); F8_LDA1(AtA, (b) ^ 1, 0, 0); F8_SCHED; F8_MMA1(1, 1, AtB, Bf); F8_SCHED; F8_STAGE1(F8_SA(b, 1), ap, xo, 1); F8_LDB1(Bn, (b) ^ 1, 1); F8_LDA1(AtA, (b) ^ 1, 0, 1); F8_SCHED; \
            F8_MMA1(1, 2, AtB, Bf); F8_SCHED; F8_LDA1(AtA, (b) ^ 1, 0, 2); F8_SCHED; F8_MMA1(1, 3, AtB, Bf); F8_SCHED; F8_LDA1(AtA, (b) ^ 1, 0, 3); F8_SCHED
            F8_SP1(0, BfA, b2, a2, x0); F8_SP2(0, BfA, BfB, a2, x1);
            F8_SP1(1, BfB, b3, a3, x0); F8_SP2(1, BfB, BfA, a3, x1);
#undef F8_TOP
#undef F8_SP1
#undef F8_SP2
        }
        F8_WAIT_L(0);
        E(acc, cur, wr, wc, fr, fq, tt + tbuf * 512);
        if (!has_next) break;
#pragma unroll
        for (int a = 0; a < 2; ++a)
#pragma unroll
            for (int m = 0; m < 4; ++m)
#pragma unroll
                for (int n = 0; n < 2; ++n) acc[a][m][n] = (f32x4){0.f, 0.f, 0.f, 0.f};
        cur = nxt; cA = nA; cB = nB; ++ui; tbuf = tnext; tnext = (tnext == 2) ? 0 : tnext + 1;
#pragma unroll
        for (int i = 0; i < 2; ++i) { c0[i] = n0[i]; c1[i] = n1[i]; }
    }
    F8_WAIT_V(0);
    F8_BAR;
#undef F8_SA
#undef F8_SB
#undef F8_STAGE1
#undef F8_STAGE
#undef F8_LDA1
#undef F8_LDB1
#undef F8_LDA
#undef F8_LDB
#undef F8_MMA1
#undef F8_WAIT_V
#undef F8_WAIT_L
#undef F8_BAR
#undef F8_SCHED
#undef F8_GOFF
}
}
namespace attn_body {
using bf16=__hip_bfloat16;
using bf16x8=__attribute__((ext_vector_type(8)))short;
using s16x4=__attribute__((ext_vector_type(4)))short;
using f32x16=__attribute__((ext_vector_type(16)))float;
using u32x4=__attribute__((ext_vector_type(4)))unsigned;
using f32x4v=__attribute__((ext_vector_type(4)))float;
constexpr int BATCH=16,NHEAD=16,SEQ=2048,D=64,DM=NHEAD*D;
constexpr int NW=8,QBLK=32,QB=QBLK*NW,KVBLK=64,NQB=SEQ/QB;
constexpr int ATTN_PITCH=DM, ATTN_UNIT_ROWS=QB;
__device__ __forceinline__ int crow(int r,int hi){return (r&3)+8*(r>>2)+4*hi;}
#define SBAR() __builtin_amdgcn_sched_barrier(0)
__device__ __forceinline__ void cmask(f32x16&p0,f32x16&p1,int jb,int qrel,int hi){
  const float NEG=-INFINITY; int kb=64*jb+4*hi;
  #pragma unroll
  for(int r=0;r<16;++r){int kv=kb+(r&3)+8*(r>>2); if(kv>qrel)p0[r]=NEG; if(kv+32>qrel)p1[r]=NEG;}
}

constexpr int NSLOT=3, SLOTB=8192;
constexpr int LDS_K=0, LDS_V=NSLOT*SLOTB, LDS_WS=2*NSLOT*SLOTB, LDS_OST=LDS_WS+NW*64*4, LDS_FB=LDS_OST+NW*4096, LDS_BYTES=LDS_FB+SEQ*16;
constexpr float C2=0.125f*1.4426950408889634f;
__device__ __forceinline__ void glds16(const void*gsrc,unsigned lds_dst){unsigned keep;
  asm volatile("s_mov_b32 %0, m0\n\ts_mov_b32 m0, %2\n\ts_nop 0\n\tglobal_load_lds_dwordx4 %1, off\n\ts_mov_b32 m0, %0":"=&s"(keep):"v"(gsrc),"s"(lds_dst):"memory");}
__device__ __forceinline__ float max3f(float a,float b,float c){float r;asm("v_max3_f32 %0, %1, %2, %3":"=v"(r):"v"(a),"v"(b),"v"(c));return r;}
__device__ __forceinline__ float max2f(float a,float b){float r;asm("v_max_f32_e32 %0, %1, %2":"=v"(r):"v"(a),"v"(b));return r;}
__device__ __forceinline__ float fadd_s(float a,float b){float r;asm("v_add_f32_e32 %0, %1, %2":"=v"(r):"v"(a),"v"(b));return r;}
__device__ __forceinline__ float fsub_s(float a,float b){float r;asm("v_sub_f32_e32 %0, %1, %2":"=v"(r):"v"(a),"v"(b));return r;}
typedef float f32x2_t __attribute__((ext_vector_type(2))); typedef __bf16 bf16x2_t __attribute__((ext_vector_type(2)));
__device__ __forceinline__ unsigned cvtpk_s(float lo,float hi){f32x2_t v={lo,hi};bf16x2_t b=__builtin_convertvector(v,bf16x2_t);return __builtin_bit_cast(unsigned,b);}
#define WAIT_BAR(N) asm volatile("s_waitcnt vmcnt(" #N ") lgkmcnt(0)\n\ts_barrier":::"memory")

__device__ __forceinline__ bf16x8 mk_qbias(float mhat,int hi){
  const float x=-mhat; const unsigned h=cvtpk_s(x,0.f)&0xffffu; const float r1=x-__uint_as_float(h<<16); const unsigned m=cvtpk_s(r1,0.f)&0xffffu; const float r2=r1-__uint_as_float(m<<16); const unsigned l=cvtpk_s(r2,0.f)&0xffffu;
  u32x4 w; w[0]=0x3F803F80u; w[1]=0x3F80u|(h<<16); w[2]=m|(l<<16); w[3]=0u; if(hi){w[0]=0u;w[1]=0u;w[2]=0u;} return __builtin_bit_cast(bf16x8,w);
}
__device__ __forceinline__ void qkt(f32x16&p0,f32x16&p1,const char*Kslot,const bf16x8*qr,bf16x8 fk0,bf16x8 fk1,bf16x8 qbias,int r32,int hi){
  const char*kb=Kslot+hi*1024+r32*16;
  p0=__builtin_amdgcn_mfma_f32_32x32x16_bf16(fk0,qbias,f32x16{},0,0,0);p1=__builtin_amdgcn_mfma_f32_32x32x16_bf16(fk1,qbias,f32x16{},0,0,0);
  #pragma unroll
  for(int d0=0;d0<4;++d0){
    const bf16x8 b0=*reinterpret_cast<const bf16x8*>(kb+d0*2048);
    const bf16x8 b1=*reinterpret_cast<const bf16x8*>(kb+d0*2048+512);
    p0=__builtin_amdgcn_mfma_f32_32x32x16_bf16(b0,qr[d0],p0,0,0,0);p1=__builtin_amdgcn_mfma_f32_32x32x16_bf16(b1,qr[d0],p1,0,0,0);}
}
typedef __attribute__((address_space(3))) const char* lds_cptr;
typedef short v4i16_t __attribute__((ext_vector_type(4)));
__device__ __forceinline__ void kload8(bf16x8*kf,lds_cptr kp){
  kf[0]=*(const __attribute__((address_space(3))) bf16x8*)(kp);      kf[1]=*(const __attribute__((address_space(3))) bf16x8*)(kp+512);
  kf[2]=*(const __attribute__((address_space(3))) bf16x8*)(kp+2048); kf[3]=*(const __attribute__((address_space(3))) bf16x8*)(kp+2560);
  kf[4]=*(const __attribute__((address_space(3))) bf16x8*)(kp+4096); kf[5]=*(const __attribute__((address_space(3))) bf16x8*)(kp+4608);
  kf[6]=*(const __attribute__((address_space(3))) bf16x8*)(kp+6144); kf[7]=*(const __attribute__((address_space(3))) bf16x8*)(kp+6656);
}
__device__ __forceinline__ void kload2(bf16x8*kf,lds_cptr kp,int j){ kf[2*j]=*(const __attribute__((address_space(3))) bf16x8*)(kp+j*2048); kf[2*j+1]=*(const __attribute__((address_space(3))) bf16x8*)(kp+j*2048+512); }
__device__ __forceinline__ s16x4 vtr(lds_cptr p){ return __builtin_bit_cast(s16x4,__builtin_amdgcn_ds_read_tr16_b64_v4i16((__attribute__((address_space(3))) v4i16_t*)p)); }
__device__ __forceinline__ float rowmax(const f32x16&p0,const f32x16&p1){
  float a=max3f(p0[0],p0[1],p1[0]),b=max3f(p0[2],p0[3],p1[1]);a=max3f(a,p1[2],p1[3]);
  #pragma unroll
  for(int r=4;r<16;r+=4){a=max3f(a,p0[r],p0[r+1]);b=max3f(b,p0[r+2],p0[r+3]);a=max3f(a,p1[r],p1[r+1]);b=max3f(b,p1[r+2],p1[r+3]);}
  const float m=max2f(a,b);
  auto rr=__builtin_amdgcn_permlane32_swap(__float_as_uint(m),__float_as_uint(m),false,false);
  return max2f(__uint_as_float(rr[0]),__uint_as_float(rr[1]));
}
__device__ __forceinline__ void pv(f32x16*o,int vb,bf16x8 pa0,bf16x8 pa1,bf16x8 pa2,bf16x8 pa3){
  #pragma unroll
  for(int d0=0;d0<2;++d0){s16x4 lo[4],hi[4];
    #pragma unroll
    for(int ks=0;ks<4;++ks){
      asm volatile("ds_read_b64_tr_b16 %0,%1 offset:%c2":"=&v"(lo[ks]):"v"(vb),"i"(d0*4096+ks*1024):"memory");
      asm volatile("ds_read_b64_tr_b16 %0,%1 offset:%c2":"=&v"(hi[ks]):"v"(vb),"i"(d0*4096+ks*1024+512):"memory");}
    asm volatile("s_waitcnt lgkmcnt(0)":::"memory");SBAR();
    #define PK(k) (bf16x8){lo[k][0],lo[k][1],lo[k][2],lo[k][3],hi[k][0],hi[k][1],hi[k][2],hi[k][3]}
    o[d0]=__builtin_amdgcn_mfma_f32_32x32x16_bf16(pa0,PK(0),o[d0],0,0,0);
    o[d0]=__builtin_amdgcn_mfma_f32_32x32x16_bf16(pa1,PK(1),o[d0],0,0,0);
    o[d0]=__builtin_amdgcn_mfma_f32_32x32x16_bf16(pa2,PK(2),o[d0],0,0,0);
    o[d0]=__builtin_amdgcn_mfma_f32_32x32x16_bf16(pa3,PK(3),o[d0],0,0,0);
    #undef PK
  }
}

#ifndef ATTN_STORE16
#define ATTN_STORE16(p,v) (*(u32x4*)(p)=(v))
#endif
template<int THRL> __device__ __forceinline__ void attn_unit(int b,int h,int qb,const bf16*Q,const bf16*__restrict__ K,const bf16*__restrict__ V,const bf16*__restrict__ G,bf16*O,char*shm){
  int tid_=threadIdx.x; asm volatile("":"+v"(tid_)); const int tid=tid_,lane=tid&63,r32=lane&31,hi=lane>>5; const int wid=__builtin_amdgcn_readfirstlane(tid>>6);
  const long rowbase=(long)b*SEQ; const int q0=qb*QB;
  const bf16*Qw=Q+(rowbase+q0+wid*QBLK)*DM+h*D;
  const bf16*Kh=K+rowbase*DM+h*D,*Vh=V+rowbase*DM+h*D;
  const unsigned lds0=(unsigned)(uintptr_t)shm;
  float*wsf=(float*)(shm+LDS_WS)+wid*64;
  const bf16*ksrc=Kh+(long)lane*DM+wid*8;
  const bf16*vsrc=Vh+(long)(16*(wid&3)+(lane>>2))*DM+(wid>>2)*32+(lane&3)*8;
  const unsigned kdst=lds0+LDS_K+wid*1024, vdst=lds0+LDS_V+wid*1024;
  #define DMA_K(t,slot) glds16(ksrc+(long)(t)*KVBLK*DM,(unsigned)__builtin_amdgcn_readfirstlane(kdst+(slot)))
  #define DMA_V(t,slot) glds16(vsrc+(long)(t)*KVBLK*DM,(unsigned)__builtin_amdgcn_readfirstlane(vdst+(slot)))
  const int vb0=(int)(lds0+LDS_V)+((lane>>4)&1)*32+(lane&3)*8+(4*hi+((lane&15)>>2))*64;
  const char*Kbase=shm+LDS_K; bf16x8 kf[8];
  const lds_cptr shm3=(lds_cptr)shm; const lds_cptr kp0=shm3+LDS_K+hi*1024+r32*16; const lds_cptr vp0=shm3+LDS_V+((lane>>4)&1)*32+(lane&3)*8+(4*hi+((lane&15)>>2))*64;
  const int NT=(q0+QB)/KVBLK;
  DMA_K(0,0);DMA_V(0,0);DMA_K(1,SLOTB);
  bf16x8 qr[4];
  #pragma unroll
  for(int d0=0;d0<4;++d0)qr[d0]=*reinterpret_cast<const bf16x8*>(&Qw[(long)r32*DM+d0*16+hi*8]);
  float mhat; { const u32x4 eq=*(const __attribute__((address_space(3))) u32x4*)(shm3+LDS_FB+(q0+wid*QBLK+r32)*16); mhat=__uint_as_float(eq[0]<<16)+__uint_as_float(eq[0]&0xffff0000u)+__uint_as_float(eq[1]<<16); }
  float l_reg=0.f;f32x16 o[2];o[0]=f32x16{};o[1]=f32x16{};bf16x8 qbias=mk_qbias(mhat,hi);asm volatile("":"+v"(qbias));
  const int qrel=wid*QBLK+r32;
  #define CMASK(P0,P1,t) do{int jb_=(t)-(NT-4); if(jb_>=0)cmask(P0,P1,jb_,qrel,hi);}while(0)
  const lds_cptr fbt=shm3+LDS_FB+r32*16;
  #define FKLD(t,blk) (*(const __attribute__((address_space(3))) bf16x8*)(fbt+((t)*64+(blk)*32)*16))
  bool resc=false;
  #define START(P0,P1) do{ const float rm=rowmax(P0,P1); resc=false; \
    { const float dl=rm; mhat=fadd_s(mhat,dl); \
      _Pragma("unroll") for(int r=0;r<16;++r){P0[r]=fsub_s(P0[r],dl);P1[r]=fsub_s(P1[r],dl);} \
      qbias=mk_qbias(mhat,hi); asm volatile("":"+v"(qbias)); } \
    _Pragma("unroll") for(int r=0;r<16;++r)P0[r]=__builtin_amdgcn_exp2f(P0[r]); }while(0)
  #define RESC() do{ if(resc){ asm volatile("s_waitcnt lgkmcnt(0)":::"memory"); \
      _Pragma("unroll") for(int d_=0;d_<2;++d_) _Pragma("unroll") for(int r=0;r<16;++r)o[d_][r]*=wsf[crow(r,hi)]; } }while(0)
  f32x16 pA0,pA1,pB0,pB1;
  int sl_prev=0,sl_cur=0,sl_next=SLOTB;
  #define ROT() do{sl_prev=sl_cur;sl_cur=sl_next;sl_next=(sl_next==(NSLOT-1)*SLOTB)?0:sl_next+SLOTB;}while(0)
  DMA_K(2,2*SLOTB);
  WAIT_BAR(3);
  qkt(pA0,pA1,Kbase,qr,FKLD(0,0),FKLD(0,1),qbias,r32,hi);asm volatile("s_nop 15\n\ts_nop 7":"+v"(pA0),"+v"(pA1));CMASK(pA0,pA1,0);
  START(pA0,pA1);
  _Pragma("unroll") for(int r=0;r<16;++r)pA1[r]=__builtin_amdgcn_exp2f(pA1[r]);
  WAIT_BAR(0);
  DMA_K(3,0);DMA_V(1,SLOTB);
  ROT();
  kload8(kf,kp0+sl_cur);
  WAIT_BAR(2);
  s16x4 vlo[8],vhi[8]; u32x4 pw0,pw1,pw2,pw3;
  #define PKW(P,B) cvtpk_s(P[B],P[B+1])
  #define PAF(k) __builtin_bit_cast(bf16x8,pw##k)
  #define VFR(i) (bf16x8){vlo[i][0],vlo[i][1],vlo[i][2],vlo[i][3],vhi[i][0],vhi[i][1],vhi[i][2],vhi[i][3]}
  #define PIN(x) asm volatile("":"+v"(x))
  #define MX3(a,b,c) __builtin_fmaxf(__builtin_fmaxf((a),(b)),(c))
  #define GAPA(MF,A0,A1,A2,A3,W0,W1,PW) do{ MF; sacc+=A0; sacc+=A1; sacc+=A2; sacc+=A3; PIN(sacc); W0; W1; PIN(PW); SBAR(); }while(0)
  #define EX(v) __builtin_amdgcn_exp2f(v)
  #define GAPB(MF,X,B) do{ MF; X[B]=EX(X[B]); X[B+1]=EX(X[B+1]); X[B+2]=EX(X[B+2]); X[B+3]=EX(X[B+3]); PIN(X); SBAR(); }while(0)
  #define VRD(i) do{ vlo[i]=vtr(vp_+(((i)>>2)*4096+((i)&3)*1024)); vhi[i]=vtr(vp_+(((i)>>2)*4096+((i)&3)*1024+512)); }while(0)
  #define KRD(G,j) do{ if(G){ kload2(kf,kp0+sl_next,j); SBAR(); } }while(0)
  #define STEP(C0,C1,P0,P1,t,GK,GV,GL) do{ SBAR(); \
    const lds_cptr vp_=vp0+sl_prev; const bf16x8 fk0_=FKLD(t,0), fk1_=FKLD(t,1); \
    VRD(0); SBAR(); float sacc=(P0[0]+P0[1]); \
    GAPA(C0=__builtin_amdgcn_mfma_f32_32x32x16_bf16(kf[0],qr[0],f32x16{},0,0,0), P0[2],P0[3],P0[4],P0[5],     pw0[0]=PKW(P0,0), pw0[1]=PKW(P0,2), pw0); \
    VRD(4); SBAR(); GAPA(C1=__builtin_amdgcn_mfma_f32_32x32x16_bf16(kf[1],qr[0],f32x16{},0,0,0), P0[6],P0[7],P0[8],P0[9],     pw0[2]=PKW(P0,4), pw0[3]=PKW(P0,6), pw0); \
    VRD(1); SBAR(); GAPA(C0=__builtin_amdgcn_mfma_f32_32x32x16_bf16(kf[2],qr[1],C0,0,0,0),   P0[10],P0[11],P0[12],P0[13], pw1[0]=PKW(P0,8), pw1[1]=PKW(P0,10), pw1); \
    VRD(5); SBAR(); GAPA(C1=__builtin_amdgcn_mfma_f32_32x32x16_bf16(kf[3],qr[1],C1,0,0,0),   P0[14],P0[15],P1[0],P1[1],   pw1[2]=PKW(P0,12),pw1[3]=PKW(P0,14), pw1); \
    VRD(2); SBAR(); GAPA(C0=__builtin_amdgcn_mfma_f32_32x32x16_bf16(kf[4],qr[2],C0,0,0,0),   P1[2],P1[3],P1[4],P1[5],     pw2[0]=PKW(P1,0), pw2[1]=PKW(P1,2), pw2); \
    VRD(6); SBAR(); GAPA(C1=__builtin_amdgcn_mfma_f32_32x32x16_bf16(kf[5],qr[2],C1,0,0,0),   P1[6],P1[7],P1[8],P1[9],     pw2[2]=PKW(P1,4), pw2[3]=PKW(P1,6), pw2); \
    VRD(3); SBAR(); GAPA(C0=__builtin_amdgcn_mfma_f32_32x32x16_bf16(kf[6],qr[3],C0,0,0,0),   P1[10],P1[11],P1[12],P1[13], pw3[0]=PKW(P1,8), pw3[1]=PKW(P1,10), pw3); \
    VRD(7); SBAR(); GAPA(C1=__builtin_amdgcn_mfma_f32_32x32x16_bf16(kf[7],qr[3],C1,0,0,0),   P1[14],P1[15],0.f,0.f,       pw3[2]=PKW(P1,12),pw3[3]=PKW(P1,14), pw3); \
    C0=__builtin_amdgcn_mfma_f32_32x32x16_bf16(fk0_,qbias,C0,0,0,0); C1=__builtin_amdgcn_mfma_f32_32x32x16_bf16(fk1_,qbias,C1,0,0,0); \
    l_reg+=sacc; \
    if(GK){DMA_K((t)+3,sl_cur);} if(GV){DMA_V((t)+1,sl_next);} \
    CMASK(C0,C1,t); \
    { float a=MX3(C0[0],C0[1],C1[0]),b=MX3(C0[2],C0[3],C1[1]); a=MX3(a,C1[2],C1[3]); \
      _Pragma("unroll") for(int r=4;r<16;r+=4){a=MX3(a,C0[r],C0[r+1]);b=MX3(b,C0[r+2],C0[r+3]);a=MX3(a,C1[r],C1[r+1]);b=MX3(b,C1[r+2],C1[r+3]);} \
      float rm=__builtin_fmaxf(a,b); { auto rr=__builtin_amdgcn_permlane32_swap(__float_as_uint(rm),__float_as_uint(rm),false,false); rm=__builtin_fmaxf(__uint_as_float(rr[0]),__uint_as_float(rr[1])); } \
      resc=false; \
      if(__builtin_expect(__any(rm>(float)THRL),0)){ const float dl=__builtin_fmaxf(rm,0.f); mhat+=dl; \
        _Pragma("unroll") for(int r=0;r<16;++r){C0[r]-=dl;C1[r]-=dl;} \
        qbias=mk_qbias(mhat,hi); asm volatile("":"+v"(qbias)); \
        const float f=__builtin_amdgcn_exp2f(-dl); l_reg*=f; if(hi==0)wsf[r32]=f; resc=true; } } \
    SBAR(); \
    GAPB(o[0]=__builtin_amdgcn_mfma_f32_32x32x16_bf16(PAF(0),VFR(0),o[0],0,0,0), C0,0); \
    GAPB(o[1]=__builtin_amdgcn_mfma_f32_32x32x16_bf16(PAF(0),VFR(4),o[1],0,0,0), C0,4); \
    KRD(GL,0); GAPB(o[0]=__builtin_amdgcn_mfma_f32_32x32x16_bf16(PAF(1),VFR(1),o[0],0,0,0), C0,8); \
    KRD(GL,1); GAPB(o[1]=__builtin_amdgcn_mfma_f32_32x32x16_bf16(PAF(1),VFR(5),o[1],0,0,0), C0,12); \
    KRD(GL,2); GAPB(o[0]=__builtin_amdgcn_mfma_f32_32x32x16_bf16(PAF(2),VFR(2),o[0],0,0,0), C1,0); \
    KRD(GL,3); GAPB(o[1]=__builtin_amdgcn_mfma_f32_32x32x16_bf16(PAF(2),VFR(6),o[1],0,0,0), C1,4); \
    GAPB(o[0]=__builtin_amdgcn_mfma_f32_32x32x16_bf16(PAF(3),VFR(3),o[0],0,0,0), C1,8); \
    GAPB(o[1]=__builtin_amdgcn_mfma_f32_32x32x16_bf16(PAF(3),VFR(7),o[1],0,0,0), C1,12); \
    }while(0)
  int t=1;
  #undef CMASK
  #define CMASK(P0,P1,t) do{}while(0)
  for(;t+5<NT;t+=2){
    STEP(pB0,pB1,pA0,pA1,t,true,true,true);     WAIT_BAR(2); RESC(); ROT();
    STEP(pA0,pA1,pB0,pB1,t+1,true,true,true);   WAIT_BAR(2); RESC(); ROT();
  }
  #undef CMASK
  #define CMASK(P0,P1,t) do{int jb_=(t)-(NT-4); if(jb_>=0)cmask(P0,P1,jb_,qrel,hi);}while(0)
  #define ENDW(tt) do{ if((tt)+3<NT){WAIT_BAR(2);} else if((tt)+2<NT){WAIT_BAR(1);} else {WAIT_BAR(0);} }while(0)
  for(;t+1<NT;t+=2){
    STEP(pB0,pB1,pA0,pA1,t,(t+3<NT),(t+1<NT),(t+1<NT));       ENDW(t);   RESC(); ROT();
    STEP(pA0,pA1,pB0,pB1,t+1,(t+4<NT),(t+2<NT),(t+2<NT));     ENDW(t+1); RESC(); ROT();
  }
  STEP(pB0,pB1,pA0,pA1,NT-1,false,false,false); RESC();
  u32x4 ggv[4];
  { const bf16*Gw_=G+(rowbase+q0+wid*QBLK)*DM+h*D;
    #pragma unroll
    for(int i=0;i<4;++i)ggv[i]=*(const u32x4*)(Gw_+(long)(i*8+(lane>>3))*DM+(lane&7)*8); }
  { float sacc=pB0[0]+pB0[1]; _Pragma("unroll") for(int r=2;r<16;++r)sacc+=pB0[r]; _Pragma("unroll") for(int r=0;r<16;++r)sacc+=pB1[r]; l_reg+=sacc;
    pw0=(u32x4){PKW(pB0,0),PKW(pB0,2),PKW(pB0,4),PKW(pB0,6)};pw1=(u32x4){PKW(pB0,8),PKW(pB0,10),PKW(pB0,12),PKW(pB0,14)};pw2=(u32x4){PKW(pB1,0),PKW(pB1,2),PKW(pB1,4),PKW(pB1,6)};pw3=(u32x4){PKW(pB1,8),PKW(pB1,10),PKW(pB1,12),PKW(pB1,14)};
    SBAR(); pv(o,vb0+sl_cur,PAF(0),PAF(1),PAF(2),PAF(3)); }
  #undef PKW
  #undef PAF
  #undef VFR
  #undef PIN
  #undef MX3
  #undef GAPA
  #undef GAPB
  #undef EX
  #undef VRD
  #undef KRD
  #undef STEP
  #undef ENDW
  {auto rr=__builtin_amdgcn_permlane32_swap(__float_as_uint(l_reg),__float_as_uint(l_reg),false,false);l_reg=__uint_as_float(rr[0])+__uint_as_float(rr[1]);}
  if(hi==0)wsf[32+r32]=l_reg;asm volatile("s_waitcnt lgkmcnt(0)":::"memory");
  float rli[16];
  #pragma unroll
  for(int r=0;r<16;++r)rli[r]=__builtin_amdgcn_rcpf(wsf[32+crow(r,hi)]);
  bf16*Ow=O+(rowbase+q0+wid*QBLK)*DM+h*D;
  { bf16*stg=(bf16*)(shm+LDS_OST)+wid*2048;
    #pragma unroll
    for(int r=0;r<16;++r){const int orow=crow(r,hi);
      #pragma unroll
      for(int d0=0;d0<2;++d0)stg[orow*64+d0*32+r32]=__float2bfloat16(o[d0][r]*rli[r]);}
    asm volatile("s_waitcnt lgkmcnt(0)":::"memory");
    #pragma unroll
    for(int i=0;i<4;++i){const int row=i*8+(lane>>3),ch=lane&7; const u32x4 v=*(const u32x4*)(stg+row*64+ch*8); const u32x4 gg=ggv[i]; u32x4 w;
      #pragma unroll
      for(int c=0;c<4;++c){ const float lo=__uint_as_float(v[c]<<16)*__uint_as_float(gg[c]<<16), hh=__uint_as_float(v[c]&0xffff0000u)*__uint_as_float(gg[c]&0xffff0000u); w[c]=cvtpk_s(lo,hh); }
      ATTN_STORE16(Ow+(long)row*DM+ch*8,w);} }
  asm volatile("s_waitcnt lgkmcnt(0)\n\ts_barrier":::"memory");
  #undef DMA_K
  #undef DMA_V
  #undef CMASK
  #undef FKLD
  #undef START
  #undef RESC
  #undef ROT
}
constexpr int ATTN_LDS_BYTES=LDS_BYTES;
struct AttnTensors { const bf16* Q; const bf16* K; const bf16* V; const bf16* G; bf16* O; const u32x4* FBT; };
struct AttnUnit { int bh; int qb; };
struct StaticOrder {
  int vcu, G;
  __device__ __forceinline__ bool next(int i,AttnUnit&u)const{ u.bh=vcu+(i>>3)*G; if(u.bh>=BATCH*NHEAD)return false; u.qb=(i+(vcu&7))&7; return true; }
};
__device__ __forceinline__ void scan_bias_table(char*lds,const float*FG,const float*bfp,int bh,u32x4*tab){
  float*wtot=(float*)lds; const int b_=bh/NHEAD,h_=bh%NHEAD,t_=threadIdx.x,ln_=t_&63,wv_=t_>>6; const float bf_=bfp[h_]; float p_[4]; float run=0.f;
  #pragma unroll
  for(int i=0;i<4;++i){ const float xg=FG[((size_t)b_*SEQ+4*t_+i)*NHEAD+h_]+bf_; run+=(xg>=0.f?-log1pf(expf(-xg)):xg-log1pf(expf(xg))); p_[i]=run; }
  float inc=run;
  #pragma unroll
  for(int o=1;o<64;o<<=1){ const float tt=__shfl_up(inc,o); if(ln_>=o)inc+=tt; }
  __syncthreads();
  if(ln_==63)wtot[wv_]=inc;
  __syncthreads();
  float base_=inc-run; for(int w=0;w<wv_;++w)base_+=wtot[w];
  #pragma unroll
  for(int i=0;i<4;++i){ const float x=-1.4426950408889634f*(base_+p_[i]); const unsigned h=cvtpk_s(x,0.f)&0xffffu; const float r1=x-__uint_as_float(h<<16); const unsigned m=cvtpk_s(r1,0.f)&0xffffu;
    const float r2=r1-__uint_as_float(m<<16); const unsigned l=cvtpk_s(r2,0.f)&0xffffu; u32x4 w; w[0]=h|(m<<16); w[1]=l|(0x3F80u<<16); w[2]=0x3F803F80u; w[3]=0u; tab[(size_t)bh*SEQ+4*t_+i]=w; }
}
template<class Sched,int THRL=8> __device__ __forceinline__ void attn_phase(char*lds,const AttnTensors&T,const Sched&S){
  AttnUnit u; int cur=-1;
  for(int i=0;S.next(i,u);++i){
    if(u.bh!=cur){ cur=u.bh; u32x4*fb=(u32x4*)(lds+LDS_FB); const u32x4*src=T.FBT+(size_t)u.bh*SEQ;
      #pragma unroll
      for(int k=0;k<SEQ/(NW*64);++k)fb[threadIdx.x+k*NW*64]=src[threadIdx.x+k*NW*64];
      asm volatile("s_waitcnt vmcnt(0) lgkmcnt(0)\n\ts_barrier":::"memory"); }
    attn_unit<THRL>(u.bh/NHEAD,u.bh%NHEAD,u.qb,T.Q,T.K,T.V,T.G,T.O,lds);
  }
}
#undef SBAR
#undef WAIT_BAR
}
#define GAS __attribute__((address_space(1)))
#define LAS __attribute__((address_space(3)))
typedef unsigned short bf16;
typedef unsigned v4u __attribute__((ext_vector_type(4)));
typedef float f32x4 __attribute__((ext_vector_type(4)));
typedef short bf16x8 __attribute__((ext_vector_type(8)));
typedef GAS unsigned gu32;
typedef GAS unsigned long long gu64;
#define RLX_AGENT __ATOMIC_RELAXED, __HIP_MEMORY_SCOPE_AGENT
#define LDS_WAIT() asm volatile("s_waitcnt lgkmcnt(0)" ::: "memory")
#define VM_WAIT() asm volatile("s_waitcnt vmcnt(0)" ::: "memory")
__device__ __forceinline__ unsigned long long rt() { return __builtin_amdgcn_s_memrealtime(); }
__device__ __forceinline__ unsigned f2bf(float f) { unsigned u = __builtin_bit_cast(unsigned, f); return (u + 0x7fffu + ((u >> 16) & 1u)) >> 16; }
__device__ __forceinline__ unsigned pk2(float lo, float hi) { return f2bf(lo) | (f2bf(hi) << 16); }

#define XB_TMO      128
#define XB_XCNT(j)  (256  + 64 * (j))
#define XB_XSUB(j)  (1280 + 64 * (j))
#define XB_XGEN(j)  (2304 + 64 * (j))
#define XB_TOP      3328
#define XB_TOPGEN   3392
#define XCD_BAR_WORDS 3456
#define XB_SPIN_CAP (1u << 18)

__device__ __forceinline__ unsigned xb_ld(unsigned* p)              { return __hip_atomic_load(p, __ATOMIC_RELAXED, __HIP_MEMORY_SCOPE_AGENT); }
__device__ __forceinline__ unsigned xb_add(unsigned* p, unsigned v) { return __hip_atomic_fetch_add(p, v, __ATOMIC_RELAXED, __HIP_MEMORY_SCOPE_AGENT); }
__device__ __forceinline__ unsigned xb_xcc_id() { return (unsigned)__builtin_amdgcn_s_getreg((3 << 11) | 20) & 0xFu; }
#define XB_SPIN(cond, bar) do { unsigned _sp = 0; while (cond) { __builtin_amdgcn_s_sleep(1); \
    if ((++_sp & 255u) == 0u) { if (xb_ld(&(bar)[XB_TMO])) break; if (_sp > XB_SPIN_CAP) { atomicAdd(&(bar)[XB_TMO], 1u); break; } } } } while (0)

struct XcdBarrier {
    unsigned* bar; unsigned x;
    volatile LAS unsigned* st;
};

__device__ __forceinline__ XcdBarrier xcd_barrier_post(unsigned* bar, volatile LAS unsigned* st) {
    XcdBarrier b; b.bar = bar; b.x = xb_xcc_id(); b.st = st;
    if (threadIdx.x == 0) (void)xb_add(&bar[XB_XCNT(b.x)], 1u);
    return b;
}
__device__ __forceinline__ void xcd_barrier_complete(unsigned* bar, unsigned x, unsigned& nloc, unsigned& nx) {
    const unsigned G = gridDim.x * gridDim.y * gridDim.z;
    unsigned sum, cnt, mine, sp = 0u;
    for (;;) {
        sum = 0u; cnt = 0u; mine = 0u;
#pragma unroll
        for (unsigned j = 0; j < 16; ++j) { const unsigned c = xb_ld(&bar[XB_XCNT(j)]); sum += c; cnt += (c > 0u) ? 1u : 0u; mine = (j == x) ? c : mine; }
        if (sum == G) break;
        __builtin_amdgcn_s_sleep(1);
        if ((++sp & 255u) == 0u) { if (xb_ld(&bar[XB_TMO])) break; if (sp > XB_SPIN_CAP) { atomicAdd(&bar[XB_TMO], 1u); break; } }
    }
    nloc = mine > 0u ? mine : 1u; nx = cnt > 0u ? cnt : 1u;
}

__device__ __forceinline__ void xcd_barrier(const XcdBarrier& b) {
    asm volatile("s_waitcnt vmcnt(0)" ::: "memory");
    __syncthreads();
    if (threadIdx.x == 0) {
        unsigned* bar = b.bar;
        __builtin_amdgcn_s_waitcnt(0);
        unsigned nloc = b.st[0], nx = b.st[1];
        if (nloc == 0u) { xcd_barrier_complete(bar, b.x, nloc, nx); b.st[0] = nloc; b.st[1] = nx; }
        const unsigned old = xb_add(&bar[XB_XSUB(b.x)], 1u);
        const unsigned gen = old / nloc;
        if (old + 1u == (gen + 1u) * nloc) {
            __builtin_amdgcn_fence(__ATOMIC_RELEASE, "agent");
            asm volatile("s_waitcnt vmcnt(0)" ::: "memory");
            const unsigned og = xb_add(&bar[XB_TOP], 1u);
            const unsigned tg = og / nx;
            if (og + 1u == (tg + 1u) * nx) xb_add(&bar[XB_TOPGEN], 1u);
            else XB_SPIN(xb_ld(&bar[XB_TOPGEN]) == tg, bar);
            __builtin_amdgcn_fence(__ATOMIC_ACQUIRE, "agent");
            xb_add(&bar[XB_XGEN(b.x)], 1u);
            asm volatile("s_waitcnt vmcnt(0)" ::: "memory");
        } else {
            XB_SPIN(xb_ld(&bar[XB_XGEN(b.x)]) == gen, bar);
            __builtin_amdgcn_fence(__ATOMIC_ACQUIRE, "agent");
            asm volatile("s_waitcnt vmcnt(0)" ::: "memory");
        }
    }
    __syncthreads();
}

constexpr int NWAVES = 8;
constexpr int DM = 1024, BATCH = 16, SEQ = 2048, MROWS = BATCH * SEQ;
constexpr int A_FFN = 6144, A_HALF = 3072, A_GROUPS = 8, A_GD = 384, GCH = 128, CHK = 64;
constexpr int D_FF = 2816, NEXP = 8, D_EXP = 3584, NHEAD = 16, HD = 64;
constexpr int KVW_LD = 2 * DM + NHEAD;
constexpr float RMS_EPS = 1e-6f;
constexpr float W8_SCALE = 64.0f;
constexpr int W8_SCALE_E8M0 = 0x79797979;
enum { I_X = 0, I_A_NORM_G, I_A_W_IN, I_A_V_NORM_G, I_A_W_SP, I_A_B_SP, I_A_W_OUT, I_F_NORM_G, I_F_W_IN, I_F_W_OUT, I_KV_NORM_G, I_KV_W, I_KV_B_F, I_K_NORM_G,
       I_B_NORM_G, I_B_W_IN, I_Q_NORM_G, I_B_W_OUT, I_M_NORM_G, I_M_W_ROUTER, I_M_W_IN, I_M_W_OUT, N_IN };

constexpr size_t MiB = 1u << 20;
constexpr size_t WS_CTL = 0, CTL_ZERO_BYTES = 1 * MiB;
constexpr size_t WS_RSQ = 4 * MiB;
constexpr size_t WS_VPART = 286 * MiB;
constexpr size_t WS_FG = 2 * MiB;
constexpr size_t WS_GW = 6 * MiB;
constexpr size_t WS_TOKSLOT = 7 * MiB;
constexpr size_t WS_WA_IN = 8 * MiB, WS_WA_OUT = 20 * MiB, WS_WF_IN = 26 * MiB, WS_WF_OUT = 37 * MiB, WS_WKV = 43 * MiB, WS_WBIN = 47 * MiB, WS_WBOUT = 51 * MiB;
constexpr size_t WS_WM_IN = 53 * MiB, WS_WM_OUT = 165 * MiB;
constexpr size_t WS_XN = 222 * MiB, WS_XQ = 286 * MiB;
constexpr size_t WS_BIG = 350 * MiB;
constexpr int MAXSLOT = MROWS * 2 + NEXP * 256;
constexpr size_t WS_XG = 286 * MiB;
constexpr size_t WS_ACT = 418 * MiB;
constexpr size_t WS_Y = 8 * MiB;
constexpr size_t WS_ELIST = 880 * MiB, WS_EWL = 881 * MiB;
constexpr size_t WS_FBT = 700 * MiB;
constexpr int YP_ROWS = 16 * 256;
constexpr size_t WS_END = 883 * MiB;
constexpr int CW_BAR = 4096, CW_CNT = 64;

constexpr int RING_OFF = 0, RING_BYTES = 131072;
constexpr int LDSCTL_OFF = RING_BYTES, MISC_OFF = LDSCTL_OFF + 320;
constexpr int LDS_BYTES = 147456;

typedef short s16x4 __attribute__((ext_vector_type(4)));
__device__ __forceinline__ unsigned off_b(unsigned row, unsigned ch) { return 256u * row + 16u * (ch ^ (((row & 3u) << 2) | ((row >> 2) & 3u))); }
struct Frame {
    LAS unsigned char* lds; volatile LAS unsigned* MISC; gu32* ctl;
    int tid, lane, wave, vcu, G;
};
__device__ __forceinline__ float wave_sum(float v) {
#pragma unroll
    for (int o = 1; o < 64; o <<= 1) v += __shfl_xor(v, o);
    return v;
}
__device__ __forceinline__ void tr_load(float (&tmp)[32], const float* W, int ldw, int k0, int n0, int lane) {
#pragma unroll
    for (int i = 0; i < 32; ++i) { const int kk = 2 * i + (lane >> 5); tmp[i] = W[(size_t)(k0 + kk) * ldw + n0 + (lane & 31)]; }
}
template <class RowMap>
__device__ __forceinline__ void tr_store(float (&tmp)[32], int K, bf16* WT, LAS float* scr, int k0, int n0, int lane, const RowMap& rowmap, const float* gk, float f8scale = 0.f) {
    if (gk) {
#pragma unroll
        for (int i = 0; i < 32; ++i) tmp[i] *= gk[k0 + 2 * i + (lane >> 5)]; }
#pragma unroll
    for (int i = 0; i < 32; ++i) { const int kk = 2 * i + (lane >> 5); scr[kk * 33 + (lane & 31)] = tmp[i]; }
    LDS_WAIT(); asm volatile("" ::: "memory");
    const int c = lane & 7;
#pragma unroll
    for (int j = 0; j < 4; ++j) { const int n = (lane >> 3) + 8 * j; const LAS float* s = scr + (8 * c) * 33 + n;
        if (f8scale != 0.f) { unsigned lo = 0u, hi = 0u;
            lo = __builtin_amdgcn_cvt_pk_fp8_f32(s[0 * 33] * f8scale, s[1 * 33] * f8scale, lo, false); lo = __builtin_amdgcn_cvt_pk_fp8_f32(s[2 * 33] * f8scale, s[3 * 33] * f8scale, lo, true);
            hi = __builtin_amdgcn_cvt_pk_fp8_f32(s[4 * 33] * f8scale, s[5 * 33] * f8scale, hi, false); hi = __builtin_amdgcn_cvt_pk_fp8_f32(s[6 * 33] * f8scale, s[7 * 33] * f8scale, hi, true);
            *(GAS unsigned long long*)((GAS unsigned char*)WT + (size_t)rowmap(n0 + n) * K + k0 + 8 * c) = (unsigned long long)lo | ((unsigned long long)hi << 32); }
        else { v4u o; o.x = pk2(s[0 * 33], s[1 * 33]); o.y = pk2(s[2 * 33], s[3 * 33]); o.z = pk2(s[4 * 33], s[5 * 33]); o.w = pk2(s[6 * 33], s[7 * 33]);
            *(GAS v4u*)(WT + (size_t)rowmap(n0 + n) * K + k0 + 8 * c) = o; } }
    LDS_WAIT(); asm volatile("" ::: "memory");
}
struct MapId { __device__ __forceinline__ int operator()(int n) const { return n; } };
struct MapGlu { int half; __device__ __forceinline__ int operator()(int n) const { const int b = n >= half ? 1 : 0, x = n - b * half; return (x >> 7) * 256 + b * 128 + (x & 127); } };
struct MapGlu64 { int half; __device__ __forceinline__ int operator()(int n) const { const int b = n >= half ? 1 : 0, x = n - b * half, pn = x >> 6, xx = x & 63; return pn * 128 + (xx >> 4) * 32 + ((xx >> 2) & 3) * 8 + b * 4 + (xx & 3); } };
struct MapHead { __device__ __forceinline__ int operator()(int n) const { const int blk = n >> 10, hh = (n >> 6) & 15, d = n & 63; return (blk * 4 + (hh >> 2)) * 256 + (d >> 5) * 128 + (hh & 3) * 32 + (d & 31); } };
template <class RowMap>
__device__ __forceinline__ void tr_matrix(Frame& F, const float* W, int ldw, int K, int ncols, bf16* WT, const RowMap& rm, int& gwoff, const float* gk = nullptr, float f8scale = 0.f) {
    LAS float* scr = (LAS float*)(F.lds + RING_OFF + F.wave * 16384);
    const int NGW = F.G * NWAVES, nblk = ncols / 32, items = (K / 64) * nblk;
    int gw = F.vcu * NWAVES + F.wave - gwoff; if (gw < 0) gw += NGW;
    int it = gw; if (it < items) { float ta[32], tb[32]; tr_load(ta, W, ldw, 64 * (it / nblk), 32 * (it % nblk), F.lane);
        for (;;) { const int n1 = it + NGW; if (n1 < items) tr_load(tb, W, ldw, 64 * (n1 / nblk), 32 * (n1 % nblk), F.lane);
            tr_store(ta, K, WT, scr, 64 * (it / nblk), 32 * (it % nblk), F.lane, rm, gk, f8scale); if (n1 >= items) break;
            const int n2 = n1 + NGW; if (n2 < items) tr_load(ta, W, ldw, 64 * (n2 / nblk), 32 * (n2 % nblk), F.lane);
            tr_store(tb, K, WT, scr, 64 * (n1 / nblk), 32 * (n1 % nblk), F.lane, rm, gk, f8scale); if (n2 >= items) break;
            it = n2; } }
    gwoff = (gwoff + items) % NGW;
}
__device__ __forceinline__ void row_load(const float* xrow, int lane, f32x4 (&v)[4]) {
    const GAS f32x4* xr = (const GAS f32x4*)xrow + lane;
#pragma unroll
    for (int j = 0; j < 4; ++j) v[j] = xr[64 * j];
}
__device__ __forceinline__ void row_load(const bf16* xrow, int lane, f32x4 (&v)[4]) {
    const GAS unsigned long long* xr = (const GAS unsigned long long*)xrow + lane;
#pragma unroll
    for (int j = 0; j < 4; ++j) { const unsigned long long w = xr[64 * j]; const unsigned lo = (unsigned)w, hi = (unsigned)(w >> 32);
        v[j] = (f32x4){__uint_as_float(lo << 16), __uint_as_float(lo & 0xffff0000u), __uint_as_float(hi << 16), __uint_as_float(hi & 0xffff0000u)}; }
}
__device__ __forceinline__ float row_rstd(const f32x4 (&v)[4]) { float s = 0.f;
#pragma unroll
    for (int j = 0; j < 4; ++j) s += (v[j].x * v[j].x + v[j].y * v[j].y) + (v[j].z * v[j].z + v[j].w * v[j].w);
    return 1.0f / sqrtf(wave_sum(s) * (1.f / DM) + RMS_EPS);
}
#define ROW_LOOP_BEGIN(src) { f32x4 vn_[4]; if (gw < MROWS) row_load((src) + (size_t)gw * DM, F.lane, vn_); \
        for (int m = gw; m < MROWS; m += NGW) { f32x4 v[4]; _Pragma("unroll") for (int j_ = 0; j_ < 4; ++j_) v[j_] = vn_[j_]; \
            if (m + NGW < MROWS) row_load((src) + (size_t)(m + NGW) * DM, F.lane, vn_); const float r = row_rstd(v);
#define ROW_LOOP_END } }
__device__ __forceinline__ void rms_row_store(const f32x4 (&v)[4], float rstd, const float* g, bf16* orow, int lane, float extra = 1.0f) {
    const GAS f32x4* gr = (const GAS f32x4*)g + lane; GAS unsigned long long* o8 = (GAS unsigned long long*)orow + lane;
#pragma unroll
    for (int j = 0; j < 4; ++j) { const f32x4 gg = gr[64 * j]; const f32x4 y = (v[j] * rstd) * gg * extra;
        o8[64 * j] = (unsigned long long)pk2(y.x, y.y) | ((unsigned long long)pk2(y.z, y.w) << 32); }
}
template <int N> __device__ __forceinline__ float wave_tr_reduce(float (&v)[N], int lane) {
    static_assert(N == 16 || N == 8, "N");
#define TRR_STEP(M, NN) if (N >= NN) { const bool up = (lane & M) != 0; _Pragma("unroll") for (int i = 0; i < NN / 2; ++i) { const float keep = up ? v[i + NN / 2] : v[i], send = up ? v[i] : v[i + NN / 2]; v[i] = keep + __shfl_xor(send, M); } }
    TRR_STEP(8, 16) TRR_STEP(4, 8) TRR_STEP(2, 4) TRR_STEP(1, 2)
#undef TRR_STEP
    float t = v[0];
#pragma unroll
    for (int o = N; o < 64; o <<= 1) t += __shfl_xor(t, o);
    return t;
}
__device__ __forceinline__ float bflo(unsigned u) { return __uint_as_float(u << 16); }
__device__ __forceinline__ float bfhi(unsigned u) { return __uint_as_float(u & 0xffff0000u); }
__device__ __forceinline__ float log_sigmoid(float x) { return x >= 0.f ? -log1pf(expf(-x)) : x - log1pf(expf(x)); }

enum { PH_PRO = 0, PH_GEMM1, PH_SPATIAL, PH_GEMM2, PH_FFN_UP, PH_FFN_DOWN, PH_KVQ, PH_ATTN, PH_OPROJ, PH_ROUTER, PH_MOE_UP, PH_MOE_DOWN, PH_COMBINE, PH_END };
#ifndef MK_ONE_LAUNCH
#define MK_ONE_LAUNCH 1
#endif
#ifndef MK_PH_STOP
#define MK_PH_STOP PH_END
#endif

struct Args { const float* in[N_IN]; float* out; unsigned char* ws; int ph_lo, ph_hi, li, pad; };
__global__ void __launch_bounds__(NWAVES * 64, 2) yoco_fwd(Args args) {
    extern __shared__ __attribute__((aligned(16))) unsigned char lds[];
    Frame F;
    F.lds = (LAS unsigned char*)lds; F.MISC = (volatile LAS unsigned*)(F.lds + MISC_OFF);
    F.tid = threadIdx.x; F.lane = F.tid & 63; F.wave = __builtin_amdgcn_readfirstlane(F.tid >> 6);
    F.G = gridDim.x; { const int bx = blockIdx.x; F.vcu = (F.G % 8 == 0) ? (bx % 8) * (F.G / 8) + bx / 8 : bx; }
    unsigned char* ws = args.ws; F.ctl = (gu32*)(ws + WS_CTL);
    for (int u = F.tid; u < (LDS_BYTES - LDSCTL_OFF) / 4; u += NWAVES * 64) ((LAS unsigned*)(F.lds + LDSCTL_OFF))[u] = 0u;
    __syncthreads();
    XcdBarrier bar; bar.bar = (unsigned*)(F.ctl + CW_BAR) + args.li * XCD_BAR_WORDS; bar.x = 0; bar.st = nullptr;
    if (MK_ONE_LAUNCH) bar = xcd_barrier_post((unsigned*)(F.ctl + CW_BAR) + args.li * XCD_BAR_WORDS, F.MISC + 8);
#define GRID_BAR() do { if (MK_ONE_LAUNCH) xcd_barrier(bar); } while (0)
    const int lo = args.ph_lo, hi = args.ph_hi;
#ifndef MK_PHMASK
#define MK_PHMASK 0xffffffffu
#endif
#define IN(k) (((MK_PHMASK >> (k)) & 1u) && lo <= (k) && (k) < hi)
#define BOTH(k) (IN(k) && IN((k) + 1))
    const float* x = args.in[I_X]; float* H = args.out;
    bf16* WA_IN = (bf16*)(ws + WS_WA_IN); bf16* WA_OUT = (bf16*)(ws + WS_WA_OUT); bf16* WF_IN = (bf16*)(ws + WS_WF_IN); bf16* WF_OUT = (bf16*)(ws + WS_WF_OUT);
    bf16* WKV = (bf16*)(ws + WS_WKV); bf16* WBIN = (bf16*)(ws + WS_WBIN); bf16* WBOUT = (bf16*)(ws + WS_WBOUT); bf16* WM_IN = (bf16*)(ws + WS_WM_IN); bf16* WM_OUT = (bf16*)(ws + WS_WM_OUT);
    float* RX = (float*)(ws + 1 * MiB + 131072);
    bf16* WF16 = (bf16*)(ws + 1 * MiB);
    bf16* XN = (bf16*)(ws + WS_XN); bf16* XQ = (bf16*)(ws + WS_XQ); bf16* BIG = (bf16*)(ws + WS_BIG);
    float* RSQ_V = (float*)(ws + WS_VPART); float* RSQ_H1 = (float*)(ws + WS_RSQ); bf16* HB = XQ;
 float* FG = (float*)(ws + WS_FG); unsigned* IDL = (unsigned*)(ws + WS_GW + 512 * 1024);   float* GW = (float*)(ws + WS_GW); unsigned* TOKSLOT = (unsigned*)(ws + WS_TOKSLOT); unsigned* ELIST = (unsigned*)(ws + WS_ELIST); float* EWL = (float*)(ws + WS_EWL); unsigned* ERS = (unsigned*)(ws + WS_EWL + 1 * MiB);
    bf16* ACT = (bf16*)(ws + WS_ACT); bf16* YB = (bf16*)(ws + WS_Y); bf16* YP = (bf16*)(ws + WS_BIG);
    bf16* KB = BIG; bf16* VB = BIG + (size_t)MROWS * DM; bf16* QB = BIG + (size_t)2 * MROWS * DM; bf16* GB = BIG + (size_t)3 * MROWS * DM;
    const int gw = F.vcu * NWAVES + F.wave, NGW = F.G * NWAVES;

    if (IN(PH_PRO)) {
        int go = 0;
        tr_matrix(F, args.in[I_A_W_IN], A_FFN, DM, A_FFN, WA_IN, MapId{}, go, args.in[I_A_NORM_G]);
        tr_matrix(F, args.in[I_A_W_OUT], DM, A_HALF, DM, WA_OUT, MapId{}, go);
        tr_matrix(F, args.in[I_F_W_IN], 2 * D_FF, DM, 2 * D_FF, WF_IN, MapGlu{D_FF}, go, args.in[I_F_NORM_G]);
        tr_matrix(F, args.in[I_F_W_OUT], DM, D_FF, DM, WF_OUT, MapId{}, go);
        tr_matrix(F, args.in[I_KV_W], KVW_LD, DM, 2 * DM, WKV, MapHead{}, go, args.in[I_KV_NORM_G]);
        tr_matrix(F, args.in[I_B_W_IN], 2 * DM, DM, 2 * DM, WBIN, MapHead{}, go, args.in[I_B_NORM_G]);
        tr_matrix(F, args.in[I_B_W_OUT], DM, DM, DM, WBOUT, MapId{}, go);
        for (int e = 0; e < NEXP; ++e) {
            tr_matrix(F, args.in[I_M_W_IN] + (size_t)e * DM * 2 * D_EXP, 2 * D_EXP, DM, 2 * D_EXP, (bf16*)((unsigned char*)WM_IN + (size_t)e * 2 * D_EXP * DM), MapGlu{D_EXP}, go, args.in[I_M_NORM_G], W8_SCALE);
            tr_matrix(F, args.in[I_M_W_OUT] + (size_t)e * D_EXP * DM, DM, D_EXP, DM, (bf16*)((unsigned char*)WM_OUT + (size_t)e * DM * D_EXP), MapId{}, go, nullptr, W8_SCALE);
        }
        ROW_LOOP_BEGIN(x) { GAS unsigned long long* o8 = (GAS unsigned long long*)(XN + (size_t)m * DM) + F.lane;
#pragma unroll
            for (int j = 0; j < 4; ++j) o8[64 * j] = (unsigned long long)pk2(v[j].x, v[j].y) | ((unsigned long long)pk2(v[j].z, v[j].w) << 32);
            if (F.lane == 0) RX[m] = r; } ROW_LOOP_END
        for (int e = blockIdx.x * (NWAVES * 64) + F.tid; e < NHEAD * DM; e += F.G * NWAVES * 64) { const int h = e >> 10, k = e & 1023; WF16[e] = (bf16)f2bf(args.in[I_KV_W][(size_t)k * KVW_LD + 2 * DM + h] * args.in[I_KV_NORM_G][k]); }
        if (BOTH(PH_PRO)) GRID_BAR();
    }
    if (IN(PH_GEMM1)) {
        pg8::Gemm g{XN, WA_IN, MROWS, A_FFN, DM, DM, 0, nullptr, 0, nullptr, 0}; pg8::StaticOrder S; S.init(MROWS, A_FFN, F.G, (int)blockIdx.x);
        LAS float* RT = (LAS float*)(F.lds + LDSCTL_OFF + 4096);
        { pg8::Unit uu; __syncthreads();
          for (int i0 = 0; i0 < 12; i0 += 2) { const int i = i0 + (F.tid >> 8); if (!S.next(i, uu)) continue; RT[i * 256 + (F.tid & 255)] = RX[uu.pm * 256 + (F.tid & 255)]; }
          __syncthreads(); }
        pg8::EpiGeluSq E{BIG, A_FFN, RSQ_V, A_HALF / 256, RT};
        pg8::gemm_phase<pg8::EpiGeluSq, pg8::StaticOrder, true, true>(F.lds + RING_OFF, g, S, E);
        if (BOTH(PH_GEMM1)) GRID_BAR();
    }
    if (IN(PH_SPATIAL)) {
        int tid_ = threadIdx.x; asm volatile("" : "+v"(tid_));
        const int tid = tid_, lane = tid & 63, wid = __builtin_amdgcn_readfirstlane(tid >> 6), wr = wid >> 2, wc = wid & 3, L15 = lane & 15, G4 = lane >> 4, q_ = (lane & 15) >> 2, p_ = lane & 3;
        LAS unsigned char* VI = F.lds + RING_OFF; LAS unsigned char* WI = F.lds + RING_OFF + 98304; LAS float* RVS = (LAS float*)(F.lds + LDSCTL_OFF + 1024);
        const float* wsp = args.in[I_A_W_SP]; const float* bsp = args.in[I_A_B_SP]; const float* gvn = args.in[I_A_V_NORM_G];
        for (int u = F.vcu; u < (MROWS / GCH) * A_GROUPS; u += F.G) {
            const int cc = u / A_GROUPS, g = u % A_GROUPS; const size_t r0 = (size_t)cc * GCH;
            __syncthreads();
            if (tid < GCH) { const GAS f32x4* pp = (const GAS f32x4*)(RSQ_V + (r0 + tid) * 48); float t = 0.f;
#pragma unroll
                for (int k = 0; k < 12; ++k) { const f32x4 p = pp[k]; t += (p[0] + p[1]) + (p[2] + p[3]); }
                RVS[tid] = 1.0f / sqrtf(t * (1.f / A_HALF) + RMS_EPS); }
            __syncthreads();
            { const unsigned char* vbase = (const unsigned char*)(BIG + r0 * A_FFN + A_HALF + g * A_GD);
#pragma unroll
              for (int hb = 0; hb < 2; ++hb) { v4u vreg[6];
#pragma unroll
                  for (int k = 0; k < 6; ++k) { const unsigned q = tid + 512 * (6 * hb + k), row = q / 48u, c48 = q % 48u; vreg[k] = *(const GAS v4u*)(vbase + (row * A_FFN + c48 * 8u) * 2u); }
                  if (hb == 0) {
#pragma unroll
                      for (int k = 0; k < 4; ++k) { const unsigned q = tid + 512 * k, i = q >> 4, ch = q & 15; v4u o = (v4u){0u, 0u, 0u, 0u};
                          if ((ch >> 3) <= (i >> 6)) { const GAS f32x4* wp = (const GAS f32x4*)(wsp + (size_t)g * GCH * GCH + i * GCH + ch * 8); const LAS f32x4* rp = (const LAS f32x4*)(RVS + ch * 8); const f32x4 r0v = rp[0], r1v = rp[1];
                              const f32x4 w0 = wp[0] * r0v, w1 = wp[1] * r1v; o.x = pk2(w0.x, w0.y); o.y = pk2(w0.z, w0.w); o.z = pk2(w1.x, w1.y); o.w = pk2(w1.z, w1.w); }
                          *(LAS v4u*)(WI + off_b(i, ch)) = o; } }
#pragma unroll
                  for (int k = 0; k < 6; ++k) { const unsigned q = tid + 512 * (6 * hb + k), row = q / 48u, c48 = q % 48u; *(LAS v4u*)(VI + (c48 >> 4) * 32768u + off_b(row, c48 & 15u)) = vreg[k]; }
                  asm volatile("" ::: "memory"); } }
            __syncthreads();
            f32x4 acc[4][6];
#pragma unroll
            for (int m = 0; m < 4; ++m)
#pragma unroll
                for (int n = 0; n < 6; ++n) acc[m][n] = (f32x4){0.f, 0.f, 0.f, 0.f};
            const int nks = wr ? 4 : 2;
            const unsigned fW = ((L15 & 3u) << 2) | (L15 >> 2);
            const unsigned wbase = 256u * (wr * 64 + L15) + 16u * ((unsigned)G4 ^ (fW & 3u));
            const unsigned tb0 = 256u * (8 * G4 + q_) + 16u * ((unsigned)p_ ^ ((2u * G4) & 3u)), tb1 = 256u * (8 * G4 + 4 + q_) + 16u * ((unsigned)p_ ^ ((2u * G4 + 1u) & 3u));
            unsigned xc[3];
#pragma unroll
            for (int c32 = 0; c32 < 3; ++c32) { const unsigned col32 = wc * 96 + c32 * 32; xc[c32] = (col32 >> 7) * 32768u + 16u * (((col32 & 127u) >> 3) ^ ((unsigned)q_ << 2)); }
#pragma unroll 1
            for (int ks = 0; ks < nks; ++ks) {
                bf16x8 wf[4]; const LAS unsigned char* wp = WI + wbase + 16u * ((4u * ks) ^ (fW & 12u));
#pragma unroll
                for (int m = 0; m < 4; ++m) wf[m] = *(const LAS bf16x8*)(wp + m * 4096);
#pragma unroll
                for (int c32 = 0; c32 < 3; ++c32) { const LAS unsigned char* ib = VI + xc[c32] + 8192u * ks;
#pragma unroll
                    for (int nn = 0; nn < 2; ++nn) {
                        const s16x4 t0 = __builtin_bit_cast(s16x4, __builtin_amdgcn_ds_read_tr16_b64_v4i16((LAS s16x4*)(ib + tb0 + 8 * nn)));
                        const s16x4 t1 = __builtin_bit_cast(s16x4, __builtin_amdgcn_ds_read_tr16_b64_v4i16((LAS s16x4*)(ib + tb1 + 8 * nn)));
                        const bf16x8 vf = (bf16x8){t0[0], t0[1], t0[2], t0[3], t1[0], t1[1], t1[2], t1[3]};
#pragma unroll
                        for (int m = 0; m < 4; ++m) acc[m][2 * c32 + nn] = __builtin_amdgcn_mfma_f32_16x16x32_bf16(vf, wf[m], acc[m][2 * c32 + nn], 0, 0, 0); } }
            }
            f32x4 gvv[3][2];
#pragma unroll
            for (int c32 = 0; c32 < 3; ++c32) { const GAS f32x4* gp = (const GAS f32x4*)(gvn + g * A_GD + wc * 96 + c32 * 32 + 8 * G4); gvv[c32][0] = gp[0]; gvv[c32][1] = gp[1]; }
#pragma unroll
            for (int m = 0; m < 4; ++m) { const int i = wr * 64 + 16 * m + L15; const float bi = bsp[g * GCH + i]; bf16* rowp = BIG + (r0 + i) * A_FFN + g * A_GD + wc * 96 + 8 * G4;
#pragma unroll
                for (int c32 = 0; c32 < 3; ++c32) { const v4u uu = *(const GAS v4u*)(rowp + c32 * 32); const f32x4 a = acc[m][2 * c32] * gvv[c32][0] + bi, b = acc[m][2 * c32 + 1] * gvv[c32][1] + bi; v4u o;
                    o.x = pk2(bflo(uu.x) * a.x, bfhi(uu.x) * a.y); o.y = pk2(bflo(uu.y) * a.z, bfhi(uu.y) * a.w); o.z = pk2(bflo(uu.z) * b.x, bfhi(uu.z) * b.y); o.w = pk2(bflo(uu.w) * b.z, bfhi(uu.w) * b.w);
                    *(GAS v4u*)(rowp + c32 * 32) = o; } }
        }
        if (BOTH(PH_SPATIAL)) GRID_BAR();
    }
    if (IN(PH_GEMM2)) {
        pg8::Gemm g{BIG, WA_OUT, MROWS, DM, A_HALF, A_FFN, 0, nullptr, 0, nullptr, 0}; pg8::StaticOrder S; S.init(MROWS, DM, F.G, (int)blockIdx.x);
        pg8::EpiResBf<true> E{XN, HB, RSQ_H1, DM};
        pg8::gemm_phase<pg8::EpiResBf<true>, pg8::StaticOrder, true, true>(F.lds + RING_OFF, g, S, E);
        if (BOTH(PH_GEMM2)) GRID_BAR();
    }
    if (IN(PH_FFN_UP)) {
        pg8::Gemm g{HB, WF_IN, MROWS, 2 * D_FF, DM, DM, 0, nullptr, 0, nullptr, 0}; pg8::StaticOrder S; S.init(MROWS, 2 * D_FF, F.G, (int)blockIdx.x);
        LAS float* RT = (LAS float*)(F.lds + LDSCTL_OFF + 4096);
        { pg8::Unit uu; __syncthreads();
          for (int i0 = 0; i0 < 12; i0 += 2) { const int i = i0 + (F.tid >> 8); if (!S.next(i, uu)) continue; const int r = F.tid & 255; const GAS f32x4* pp = (const GAS f32x4*)(RSQ_H1 + (size_t)(uu.pm * 256 + r) * 16); float t = 0.f;
#pragma unroll
              for (int k = 0; k < 4; ++k) { const f32x4 p = pp[k]; t += (p[0] + p[1]) + (p[2] + p[3]); }
              RT[i * 256 + r] = 1.0f / sqrtf(t * (1.f / DM) + RMS_EPS); }
          __syncthreads(); }
        pg8::EpiSwiGLU E{BIG, D_FF, RT};
        pg8::gemm_phase<pg8::EpiSwiGLU, pg8::StaticOrder, true, true>(F.lds + RING_OFF, g, S, E);
        if (BOTH(PH_FFN_UP)) GRID_BAR();
    }
    if (IN(PH_FFN_DOWN)) {
        pg8::Gemm g{BIG, WF_OUT, MROWS, DM, D_FF, D_FF, 0, nullptr, 0, nullptr, 0}; pg8::StaticOrder S; S.init(MROWS, DM, F.G, (int)blockIdx.x);
        pg8::EpiResBf<true> E{HB, XN, RSQ_H1, DM};
        pg8::gemm_phase<pg8::EpiResBf<true>, pg8::StaticOrder, true, true>(F.lds + RING_OFF, g, S, E);
        if (BOTH(PH_FFN_DOWN)) GRID_BAR();
    }
    if (IN(PH_KVQ)) {
        LAS float* HG = (LAS float*)(F.lds + LDSCTL_OFF + 1024);
        LAS float* RT = (LAS float*)(F.lds + LDSCTL_OFF + 4096);
        pg8::StaticOrder S; S.init(MROWS, 4 * DM, F.G, (int)blockIdx.x);
        __syncthreads();
        if (F.tid < 64) HG[F.tid] = args.in[I_K_NORM_G][F.tid]; else if (F.tid < 128) HG[F.tid] = args.in[I_Q_NORM_G][F.tid - 64] * attn_body::C2;
        { pg8::Unit uu;
          for (int i0 = 0; i0 < 12; i0 += 2) { const int i = i0 + (F.tid >> 8); if (!S.next(i, uu)) continue; const int r = F.tid & 255; const GAS f32x4* pp = (const GAS f32x4*)(RSQ_H1 + (size_t)(uu.pm * 256 + r) * 16); float t = 0.f;
#pragma unroll
              for (int k = 0; k < 4; ++k) { const f32x4 p = pp[k]; t += (p[0] + p[1]) + (p[2] + p[3]); }
              RT[i * 256 + r] = 1.0f / sqrtf(t * (1.f / DM) + RMS_EPS); } }
        { const int L15 = F.lane & 15, KQ = F.lane >> 4; const size_t row0 = (size_t)F.vcu * 128 + F.wave * 16;
          if (row0 < MROWS) {
              const bf16* ap = XN + (row0 + L15) * DM + 8 * KQ; const bf16* bp = WF16 + (size_t)L15 * DM + 8 * KQ; f32x4 fa = (f32x4){0.f, 0.f, 0.f, 0.f};
#pragma unroll
              for (int jb = 0; jb < 4; ++jb) { bf16x8 af[8], bfr[8];
#pragma unroll
                  for (int j = 0; j < 8; ++j) { af[j] = *(const GAS bf16x8*)(ap + 32 * (8 * jb + j)); bfr[j] = *(const GAS bf16x8*)(bp + 32 * (8 * jb + j)); }
#pragma unroll
                  for (int j = 0; j < 8; ++j) fa = __builtin_amdgcn_mfma_f32_16x16x32_bf16(af[j], bfr[j], fa, 0, 0, 0); }
#pragma unroll
              for (int e = 0; e < 4; ++e) { const size_t row = row0 + 4 * KQ + e; const GAS f32x4* pp = (const GAS f32x4*)(RSQ_H1 + row * 16); float t = 0.f;
#pragma unroll
                  for (int k = 0; k < 4; ++k) { const f32x4 p = pp[k]; t += (p[0] + p[1]) + (p[2] + p[3]); }
                  FG[row * NHEAD + L15] = fa[e] * (1.0f / sqrtf(t * (1.f / DM) + RMS_EPS)); } } }
        __syncthreads();
        { pg8::Gemm g{XN, WKV, MROWS, 4 * DM, DM, DM, 0, nullptr, 0, nullptr, 0};
          pg8::EpiHead4 E{KB, (size_t)MROWS * DM, HG, RMS_EPS, RT};
          pg8::gemm_phase<pg8::EpiHead4, pg8::StaticOrder, true, true>(F.lds + RING_OFF, g, S, E); }
        if (BOTH(PH_KVQ)) GRID_BAR();
    }
    if (IN(PH_ATTN)) {
        __syncthreads();
        for (int bh = F.vcu; bh < BATCH * NHEAD; bh += F.G) attn_body::scan_bias_table((char*)lds + RING_OFF, FG, args.in[I_KV_B_F], bh, (attn_body::u32x4*)(ws + WS_FBT));
        asm volatile("s_waitcnt vmcnt(0)" ::: "memory"); __syncthreads();
        const attn_body::AttnTensors AT{(const attn_body::bf16*)QB, (const attn_body::bf16*)KB, (const attn_body::bf16*)VB, (const attn_body::bf16*)GB, (attn_body::bf16*)QB, (const attn_body::u32x4*)(ws + WS_FBT)};
        const attn_body::StaticOrder AS{F.vcu, F.G}; attn_body::attn_phase<attn_body::StaticOrder>((char*)lds + RING_OFF, AT, AS);
        if (BOTH(PH_ATTN)) GRID_BAR();
    }
    if (IN(PH_OPROJ)) {
        pg8::Gemm g{QB, WBOUT, MROWS, DM, DM, DM, 0, nullptr, 0, nullptr, 0}; pg8::StaticOrder S; S.init(MROWS, DM, F.G, (int)blockIdx.x);
        pg8::EpiResBf<true> E{XN, HB, nullptr, DM};
        pg8::gemm_phase<pg8::EpiResBf<true>, pg8::StaticOrder, true, true>(F.lds + RING_OFF, g, S, E);
        if (BOTH(PH_OPROJ)) GRID_BAR();
    }
    if (IN(PH_ROUTER)) {
        LAS float* Wr = (LAS float*)(F.lds + RING_OFF);
        LAS unsigned* CNTL = (LAS unsigned*)(F.lds + RING_OFF + 65536); LAS unsigned* RREC = CNTL + 64;
        if (F.tid < 16) CNTL[F.tid] = 0u;
        __syncthreads();
        for (int idx = F.tid; idx < DM * NEXP; idx += NWAVES * 64) { const int c = idx & 3, ln = (idx >> 2) & 63, q = (idx >> 8) & 1, kk = idx >> 9, k = 4 * ln + 256 * (kk >> 2) + (kk & 3);
            Wr[idx] = args.in[I_M_W_ROUTER][(size_t)k * NEXP + 4 * q + c]; }
        __syncthreads();
        ROW_LOOP_BEGIN(HB)
            { GAS unsigned* o8 = (GAS unsigned*)((GAS unsigned char*)XN + (size_t)m * DM) + F.lane;
#pragma unroll
              for (int j = 0; j < 4; ++j) { unsigned w = 0u; w = __builtin_amdgcn_cvt_pk_fp8_f32(v[j].x, v[j].y, w, false); w = __builtin_amdgcn_cvt_pk_fp8_f32(v[j].z, v[j].w, w, true); o8[64 * j] = w; } }
            float a[NEXP];
#pragma unroll
            for (int h = 0; h < NEXP; ++h) a[h] = 0.f;
            const GAS f32x4* gr = (const GAS f32x4*)args.in[I_M_NORM_G] + F.lane;
#pragma unroll
            for (int j = 0; j < 4; ++j) { const f32x4 s4 = (v[j] * r) * gr[64 * j];
#pragma unroll
                for (int e = 0; e < 4; ++e) { const float sk = s4[e];
#pragma unroll
                    for (int q = 0; q < 2; ++q) { const f32x4 w = *(const LAS f32x4*)(Wr + (((4 * j + e) * 2 + q) * 64 + F.lane) * 4); a[4 * q] += sk * w.x; a[4 * q + 1] += sk * w.y; a[4 * q + 2] += sk * w.z; a[4 * q + 3] += sk * w.w; } } }
            { const float mine = wave_tr_reduce<8>(a, F.lane);
#pragma unroll
              for (int h = 0; h < NEXP; ++h) a[h] = __shfl(mine, h); }
            int i1 = 0; float v1 = a[0];
#pragma unroll
            for (int h = 1; h < NEXP; ++h) if (a[h] > v1) { v1 = a[h]; i1 = h; }
            int i2 = -1; float v2 = -INFINITY;
#pragma unroll
            for (int h = 0; h < NEXP; ++h) if (h != i1 && a[h] > v2) { v2 = a[h]; i2 = h; }
            const float e2 = expf(v2 - v1), w1 = 1.0f / (1.0f + e2), w2 = e2 / (1.0f + e2);
            if (F.lane == 0) { const int k = (m - gw) / NGW; LAS unsigned* rec = RREC + (F.wave * 16 + k) * 8;
                const unsigned p1 = __hip_atomic_fetch_add(CNTL + i1, 1u, __ATOMIC_RELAXED, __HIP_MEMORY_SCOPE_WORKGROUP), p2 = __hip_atomic_fetch_add(CNTL + i2, 1u, __ATOMIC_RELAXED, __HIP_MEMORY_SCOPE_WORKGROUP);
                rec[0] = (unsigned)i1; rec[1] = p1; rec[2] = __float_as_uint(w1); rec[3] = (unsigned)i2; rec[4] = p2; rec[5] = __float_as_uint(w2); rec[6] = (unsigned)m; rec[7] = __float_as_uint(r); } ROW_LOOP_END
        __syncthreads();
        if (F.tid < NEXP) CNTL[8 + F.tid] = __hip_atomic_fetch_add(F.ctl + CW_CNT + F.tid, CNTL[F.tid], __ATOMIC_RELAXED, __HIP_MEMORY_SCOPE_AGENT);
        __syncthreads();
        if (F.lane < 16) { const int m = gw + F.lane * NGW; if (m < MROWS) { const LAS unsigned* rec = RREC + (F.wave * 16 + F.lane) * 8;
#pragma unroll
            for (int k = 0; k < 2; ++k) { const unsigned e = rec[3 * k], p = CNTL[8 + e] + rec[3 * k + 1]; ELIST[(size_t)e * MROWS + p] = rec[6] * 2u + (unsigned)k; EWL[(size_t)e * MROWS + p] = __uint_as_float(rec[3 * k + 2]); ERS[(size_t)e * MROWS + p] = rec[7]; } } }
        if (BOTH(PH_ROUTER)) GRID_BAR();
    }
    pg8::GroupedOrder GS; int ecnt[NEXP];
    if (hi > PH_ROUTER) { GS.ts[0] = 0;
#pragma unroll
        for (int e = 0; e < NEXP; ++e) { ecnt[e] = (int)__builtin_amdgcn_readfirstlane(__hip_atomic_load(F.ctl + CW_CNT + e, RLX_AGENT)); GS.cnt[e] = ecnt[e]; GS.ts[e + 1] = GS.ts[e] + (ecnt[e] + 255) / 256; } GS.cap = MROWS; }
    const int NT = GS.ts[NEXP];
    if (IN(PH_MOE_UP)) {
        for (int sl = gw * 64 + F.lane; sl < NT * 256; sl += NGW * 64) { const int tile = sl >> 8; const int e = GS.expert(tile);
            int cnt_e = GS.cnt[0], ts_e = 0;
#pragma unroll
            for (int k = 1; k < NEXP; ++k) { cnt_e = (e == k) ? GS.cnt[k] : cnt_e; ts_e = (e == k) ? GS.ts[k] : ts_e; }
            const int p = sl - ts_e * 256;
            IDL[sl] = 2u * (unsigned)sl;
            if (p < cnt_e) { const unsigned ent = ELIST[(size_t)e * MROWS + p]; GW[sl] = EWL[(size_t)e * MROWS + p]; TOKSLOT[ent] = (unsigned)sl; } else GW[sl] = 0.f; }
        pg8::Gemm g{XN, WM_IN, NT * 256, 2 * D_EXP, DM / 2, DM / 2, (size_t)2 * D_EXP * DM, ELIST, 0, ERS, W8_SCALE_E8M0}; GS.init(NT * 256, 2 * D_EXP, F.G, (int)blockIdx.x);
        pg8::EpiSwiGLU8q E{(unsigned char*)ACT, D_EXP};
        pg8::gemm_phase_f8q<pg8::EpiSwiGLU8q, pg8::GroupedOrder>(F.lds + RING_OFF, g, GS, E, (LAS unsigned*)(F.lds + LDSCTL_OFF + 2048));
        if (BOTH(PH_MOE_UP)) GRID_BAR();
    }
    const int DU = NT * 4, DLIM = (DU / F.G) * F.G, DTS = 2, DKP = D_EXP / DTS;
    if (IN(PH_MOE_DOWN)) {
        { pg8::DownMainQ DM_; (pg8::GroupedOrder&)DM_ = GS; DM_.init(NT * 256, DM, F.G, (int)blockIdx.x); DM_.v = F.vcu; DM_.lim = DLIM < DU ? DLIM : DU;
          pg8::Gemm g{ACT, WM_OUT, NT * 256, DM, D_EXP / 2, D_EXP / 2, (size_t)DM * D_EXP, IDL, 0, (const unsigned*)GW, W8_SCALE_E8M0};
          pg8::EpiY8q8 E{(unsigned char*)YB, DM};
          pg8::gemm_phase_f8q<pg8::EpiY8q8, pg8::DownMainQ>(F.lds + RING_OFF, g, DM_, E, (LAS unsigned*)(F.lds + LDSCTL_OFF + 2048)); }
        if (DU > DLIM) {
            pg8::DownTailQ DT_; (pg8::GroupedOrder&)DT_ = GS; DT_.init(NT * 256, DM, F.G, (int)blockIdx.x); DT_.v = F.vcu; DT_.lim = DLIM; DT_.S = DTS; DT_.ntask = (DU - DLIM) * DTS;
            pg8::Gemm g{ACT, WM_OUT, NT * 256, DM, DKP / 2, D_EXP / 2, (size_t)DM * D_EXP, IDL, D_EXP / 2, (const unsigned*)GW, W8_SCALE_E8M0};
            pg8::EpiY8q E{YP - (size_t)(DLIM / 4) * 256 * DM, DM, (size_t)YP_ROWS * DM};
            pg8::gemm_phase_f8q<pg8::EpiY8q, pg8::DownTailQ>(F.lds + RING_OFF, g, DT_, E, (LAS unsigned*)(F.lds + LDSCTL_OFF + 2048));
        }
        if (BOTH(PH_MOE_DOWN)) GRID_BAR();
    }
    if (IN(PH_COMBINE)) {
        typedef unsigned v2u __attribute__((ext_vector_type(2)));
        const unsigned tail0 = (unsigned)(DLIM / 4) * 256u;
        const GAS unsigned char* Y8 = (const GAS unsigned char*)YB;
#define CB_LOAD(hd, yd, mm, sa, sb) do { const GAS v4u* hp_ = (const GAS v4u*)(HB + (size_t)(mm) * DM) + F.lane; const GAS v2u* ya_ = (const GAS v2u*)(Y8 + (size_t)(sa) * DM) + F.lane; const GAS v2u* yb_ = (const GAS v2u*)(Y8 + (size_t)(sb) * DM) + F.lane; \
            _Pragma("unroll") for (int j = 0; j < 2; ++j) { hd[j] = hp_[64 * j]; yd[j] = ya_[64 * j]; yd[2 + j] = yb_[64 * j]; } } while (0)
        unsigned sa0 = 0, sa1 = 0, sb0 = 0, sb1 = 0; v4u hn[2]; v2u yn[4];
        if (gw < MROWS) { sa0 = TOKSLOT[2 * gw]; sa1 = TOKSLOT[2 * gw + 1]; if (gw + NGW < MROWS) { sb0 = TOKSLOT[2 * (gw + NGW)]; sb1 = TOKSLOT[2 * (gw + NGW) + 1]; } CB_LOAD(hn, yn, gw, sa0, sa1); }
        for (int m = gw; m < MROWS; m += NGW) {
            f32x4 h[4]; v2u y[4]; const unsigned s0 = sa0, s1 = sa1;
#pragma unroll
            for (int j = 0; j < 2; ++j) { const v4u a = hn[j]; h[2 * j] = (f32x4){bflo(a.x), bfhi(a.x), bflo(a.y), bfhi(a.y)}; h[2 * j + 1] = (f32x4){bflo(a.z), bfhi(a.z), bflo(a.w), bfhi(a.w)}; }
#pragma unroll
            for (int j = 0; j < 4; ++j) y[j] = yn[j];
            sa0 = sb0; sa1 = sb1;
            if (m + 2 * NGW < MROWS) { sb0 = TOKSLOT[2 * (m + 2 * NGW)]; sb1 = TOKSLOT[2 * (m + 2 * NGW) + 1]; }
            if (m + NGW < MROWS) CB_LOAD(hn, yn, m + NGW, sa0, sa1);
#pragma unroll
            for (int k = 0; k < 2; ++k) {
                const unsigned sl = k ? s1 : s0;
                if ((DU > DLIM) && sl >= tail0) {
                    for (int p = 0; p < DTS; ++p) { const GAS v4u* yp = (const GAS v4u*)(YP + (size_t)(sl - tail0) * DM + (size_t)p * YP_ROWS * DM) + F.lane;
#pragma unroll
                        for (int j = 0; j < 2; ++j) { const v4u a = yp[64 * j];
                            h[2 * j].x += bflo(a.x); h[2 * j].y += bfhi(a.x); h[2 * j].z += bflo(a.y); h[2 * j].w += bfhi(a.y); h[2 * j + 1].x += bflo(a.z); h[2 * j + 1].y += bfhi(a.z); h[2 * j + 1].z += bflo(a.w); h[2 * j + 1].w += bfhi(a.w); } }
                } else {
#pragma unroll
                    for (int j = 0; j < 2; ++j) { const v2u a = y[2 * k + j];
#pragma unroll
                        for (int q = 0; q < 2; ++q) { const auto lo2 = __builtin_amdgcn_cvt_pk_f32_fp8((int)a[q], false), hi2 = __builtin_amdgcn_cvt_pk_f32_fp8((int)a[q], true);
                            h[2 * j + q].x += lo2[0] * pg8::Y8_INV; h[2 * j + q].y += lo2[1] * pg8::Y8_INV; h[2 * j + q].z += hi2[0] * pg8::Y8_INV; h[2 * j + q].w += hi2[1] * pg8::Y8_INV; } } } }
            GAS f32x4* hp = (GAS f32x4*)(H + (size_t)m * DM) + 2 * F.lane;
#pragma unroll
            for (int j = 0; j < 2; ++j) { hp[128 * j] = h[2 * j]; hp[128 * j + 1] = h[2 * j + 1]; } }
#undef CB_LOAD
    }
#undef IN
#undef BOTH
}

extern "C" void kernel_launch(void* const* d_in, const int* in_sizes, int n_in, void* d_out, int out_size, void* d_ws, size_t ws_size, hipStream_t stream) {
    static int grid = 0;
    if (grid == 0) {
        if (n_in != N_IN || in_sizes[0] != MROWS * DM || out_size != MROWS * DM || ws_size < WS_END) { fprintf(stderr, "kernel_launch: unexpected shapes / workspace (n_in %d, in0 %d, out %d, ws %zu < %zu)\n", n_in, n_in > 0 ? in_sizes[0] : -1, out_size, ws_size, (size_t)WS_END); grid = -1; return; }
        int dev = 0, cus = 0, per_cu = 0;
        if (hipGetDevice(&dev) != hipSuccess || hipDeviceGetAttribute(&cus, hipDeviceAttributeMultiprocessorCount, dev) != hipSuccess) { grid = -1; return; }
        if (hipFuncSetAttribute((const void*)yoco_fwd, hipFuncAttributeMaxDynamicSharedMemorySize, LDS_BYTES) != hipSuccess) { fprintf(stderr, "kernel_launch: hipFuncSetAttribute failed\n"); grid = -1; return; }
        if (hipOccupancyMaxActiveBlocksPerMultiprocessor(&per_cu, (const void*)yoco_fwd, NWAVES * 64, LDS_BYTES) != hipSuccess || per_cu < 1) fprintf(stderr, "kernel_launch: occupancy query reports %d\n", per_cu);
        (void)hipGetLastError();
        if (cus != 256) { fprintf(stderr, "kernel_launch: built for a 256-CU device (got %d)\n", cus); grid = -1; return; }
        grid = cus;
    }
    if (grid < 0) return;
    if (hipMemsetAsync((char*)d_ws + WS_CTL, 0, CTL_ZERO_BYTES, stream) != hipSuccess) return;
    Args a{};
    for (int i = 0; i < N_IN; ++i) a.in[i] = (const float*)d_in[i];
    a.out = (float*)d_out; a.ws = (unsigned char*)d_ws;
#if MK_ONE_LAUNCH
    a.ph_lo = 0; a.ph_hi = MK_PH_STOP; a.li = 0;
    hipLaunchKernelGGL(yoco_fwd, dim3(grid), dim3(NWAVES * 64), LDS_BYTES, stream, a);
#else
    for (int p = 0; p < MK_PH_STOP; ++p) { a.ph_lo = p; a.ph_hi = p + 1; a.li = 0; hipLaunchKernelGGL(yoco_fwd, dim3(grid), dim3(NWAVES * 64), LDS_BYTES, stream, a); }
#endif
}
```

```cpp
#include <hip/hip_runtime.h>
#include <hip/hip_bf16.h>
#include <cstdio>
#include <cstdint>
#include <cmath>
namespace pg8 {
#define PG8_LAS __attribute__((address_space(3)))
typedef unsigned short bf16_t;
typedef short bf16x8 __attribute__((ext_vector_type(8)));
typedef float f32x4 __attribute__((ext_vector_type(4)));
typedef unsigned u32x4 __attribute__((ext_vector_type(4)));
constexpr int BM = 256, BK = 64, HALF = 128, HTB = HALF * BK * 2  , STAGE_BYTES = 8 * HTB, NXCD = 8, WGM = 8;

__host__ __device__ __forceinline__ int lds_byte(int r, int c) { const int st = (r >> 4) * 2 + (c >> 5), rr = r & 15, cc = c & 31, ob = rr * 64 + cc * 2; return st * 1024 + (ob ^ (((ob >> 9) & 1) << 5)); }
__host__ __device__ __forceinline__ void stage_rc(int b, int& R, int& C) { const int st = b / 1024, sb = b % 1024, swz = sb ^ (((sb >> 9) & 1) << 5); R = (st >> 1) * 16 + swz / 64; C = (st & 1) * 32 + (swz % 64) / 2; }
__host__ __device__ __forceinline__ int perm32(int rho) { const int n = rho >> 4, i = rho & 15; return 8 * (i >> 2) + 4 * n + (i & 3); }

struct Unit { int pm, pn, kp; };
struct Gemm { const bf16_t* A; const bf16_t* Bt; int M, N, K, lda; size_t bstride; const unsigned* rowlist; int ldb; const unsigned* wlist; int scale_b; };

struct StaticOrder {
    int nM, nN, nwg, G, c;
    __host__ __device__ __forceinline__ void init(int M, int N, int G_, int c_) { nM = M / BM; nN = N / BM; nwg = nM * nN; G = G_; c = c_; }
    __host__ __device__ __forceinline__ bool next(int i, Unit& u) const {
        const long L = (long)i * G + c; if (L >= nwg) return false;
        int wgid = (int)L; { const int q = nwg / NXCD, r = nwg % NXCD, xcd = wgid % NXCD, off = wgid / NXCD; wgid = (xcd < r ? xcd * (q + 1) : r * (q + 1) + (xcd - r) * q) + off; }
        const int nig = WGM * nN, gid = wgid / nig, fm = gid * WGM, gsz = (nM - fm) < WGM ? (nM - fm) : WGM;
        u.pm = fm + ((wgid % nig) % gsz); u.pn = (wgid % nig) / gsz; u.kp = 0; return true;
    }
    __device__ __forceinline__ void a_ready(const Unit&) const {}
    __device__ __forceinline__ void done(const Unit&) const {}
    __device__ __forceinline__ int expert(int) const { return 0; }
    __device__ __forceinline__ size_t kbytes(const Unit&, int) const { return 0; }
    __device__ __forceinline__ int listoff(int) const { return 0; }
    __device__ __forceinline__ int rows(int) const { return 256; }
};
struct GroupedOrder : StaticOrder {
    int ts[9], cnt[8], cap;
    __device__ __forceinline__ int listoff(int pm) const { const int e = expert(pm); int t0 = 0;
#pragma unroll
        for (int k = 1; k < 8; ++k) t0 = (e == k) ? ts[k] : t0;
        return e * cap + (pm - t0) * 256; }
    __device__ __forceinline__ int rows(int pm) const { const int e = expert(pm); int t0 = 0, c = cnt[0];
#pragma unroll
        for (int k = 1; k < 8; ++k) { t0 = (e == k) ? ts[k] : t0; c = (e == k) ? cnt[k] : c; }
        const int r = c - (pm - t0) * 256; return r < 0 ? 0 : (r > 256 ? 256 : r); }
    __device__ __forceinline__ int expert(int pm) const { int e = 0;
#pragma unroll
        for (int k = 1; k < 8; ++k) e += (pm >= ts[k]) ? 1 : 0;
        return e; }
};

__device__ __forceinline__ unsigned cvt_pk_bf16(float lo, float hi) { unsigned r; asm volatile("v_cvt_pk_bf16_f32 %0, %1, %2" : "=v"(r) : "v"(lo), "v"(hi)); return r; }
typedef float f32x2 __attribute__((ext_vector_type(2)));
__device__ __forceinline__ f32x2 gelu_pk(f32x2 v) {
    const f32x2 av = __builtin_elementwise_abs(v), d = av * 0.2316418882f + 1.0f;
    f32x2 t; t.x = __builtin_amdgcn_rcpf(d.x); t.y = __builtin_amdgcn_rcpf(d.y);
    f32x2 q = t * 0.5307027145f + (-0.7265760135f); q = q * t + 0.7107068705f; q = q * t + (-0.142248368f); q = q * t + 0.127414796f; q = q * t;
    const f32x2 s = (v * v) * (-0.72134752044f);
    f32x2 e; e.x = __builtin_amdgcn_exp2f(s.x); e.y = __builtin_amdgcn_exp2f(s.y);
    const f32x2 m = v * (q * e), r = v - m;
    f32x2 o; o.x = v.x < 0.f ? m.x : r.x; o.y = v.y < 0.f ? m.y : r.y; return o;
}
constexpr float GELU_K = 0.84932180f;
__device__ __forceinline__ void gelu_w_pk4(const f32x2 (&w)[4], f32x2 (&o)[4]) {
    constexpr float C[9] = {5.886622071e-01f, -5.522741079e-01f, 4.032063782e-01f, -2.406371087e-01f, 1.149394065e-01f, -4.112898186e-02f, 1.002788637e-02f, -1.450342475e-03f, 9.243155364e-05f};
    f32x2 y[4], p[4], e[4];
#pragma unroll
    for (int i = 0; i < 4; ++i) { y[i].x = __builtin_fabsf(w[i].x); y[i].y = __builtin_fabsf(w[i].y); }
#pragma unroll
    for (int i = 0; i < 4; ++i) p[i] = y[i] * C[8] + C[7];
#pragma unroll
    for (int c = 6; c >= 0; --c)
#pragma unroll
        for (int i = 0; i < 4; ++i) p[i] = p[i] * y[i] + C[c];
#pragma unroll
    for (int i = 0; i < 4; ++i) { const f32x2 s = w[i] * w[i]; e[i].x = __builtin_amdgcn_exp2f(-s.x); e[i].y = __builtin_amdgcn_exp2f(-s.y); }
#pragma unroll
    for (int i = 0; i < 4; ++i) { const f32x2 h = 0.588705011f - p[i] * e[i]; o[i] = w[i] * 0.588705011f + y[i] * h; }
}

template <int ACT  > struct EpiBf16 {
    static constexpr bool PERM = true, AFTER_DRAIN = false; static_assert(ACT == 0 || ACT == 1, "EpiBf16: ACT is 0 (none) or 1 (gelu_pk)");
    bf16_t* O; int ldc; const float* bias; int split_cols; size_t split_stride; float scale0;
    __device__ __forceinline__ void operator()(const f32x4 (&acc)[2][2][4][2], const Unit& u, int wr, int wc, int fr, int fq, int ui = 0, const PG8_LAS unsigned* tab = nullptr) const {
        const int row0 = u.pm * BM + wr * 64 + fr; int colt = u.pn * BM; bf16_t* base = O;
        float sc = 1.f; if (split_cols) { const int t = colt / split_cols; base += (size_t)t * split_stride; colt -= t * split_cols; if (t == 0) sc = scale0; }
        const int col0 = colt + wc * 32 + 8 * fq, bcol0 = u.pn * BM + wc * 32 + 8 * fq;
        f32x4 bv[2][2];
#pragma unroll
        for (int bj = 0; bj < 2; ++bj)
#pragma unroll
            for (int n = 0; n < 2; ++n) bv[bj][n] = bias ? *(const f32x4*)(bias + bcol0 + bj * HALF + 4 * n) : (f32x4){0.f, 0.f, 0.f, 0.f};
#pragma unroll
        for (int ai = 0; ai < 2; ++ai)
#pragma unroll
            for (int m = 0; m < 4; ++m) { bf16_t* rowp = base + (size_t)(row0 + ai * HALF + m * 16) * ldc + col0;
#pragma unroll
                for (int bj = 0; bj < 2; ++bj) { f32x4 v0 = acc[ai][bj][m][0] + bv[bj][0], v1 = acc[ai][bj][m][1] + bv[bj][1];
                    if (ACT == 1) { f32x2 a = gelu_pk((f32x2){v0[0], v0[1]}), b = gelu_pk((f32x2){v0[2], v0[3]}), c = gelu_pk((f32x2){v1[0], v1[1]}), d = gelu_pk((f32x2){v1[2], v1[3]});
                        v0 = (f32x4){a.x, a.y, b.x, b.y}; v1 = (f32x4){c.x, c.y, d.x, d.y}; }
                    v0 = v0 * sc; v1 = v1 * sc; u32x4 w; w.x = cvt_pk_bf16(v0[0], v0[1]); w.y = cvt_pk_bf16(v0[2], v0[3]); w.z = cvt_pk_bf16(v1[0], v1[1]); w.w = cvt_pk_bf16(v1[2], v1[3]);
                    *(u32x4*)(rowp + bj * HALF) = w; } }
    }
};


struct DownMain : GroupedOrder {
    int v, lim;
    __device__ __forceinline__ bool next(int i, Unit& u) const { const int L = i * G + v; if (L >= lim) return false; u.pm = L >> 2; u.pn = L & 3; u.kp = 0; return true; }
};
struct DownTail : GroupedOrder {
    int v, lim, ntask, S;
    __device__ __forceinline__ bool next(int i, Unit& u) const { const int t = i * G + v; if (t >= ntask) return false; const int L = lim + t / S; u.pm = L >> 2; u.pn = L & 3; u.kp = t % S; return true; }
    __device__ __forceinline__ size_t kbytes(const Unit& u, int K) const { return (size_t)u.kp * K * 2; }
};
struct DownMainQ : DownMain { __device__ __forceinline__ int listoff(int pm) const { return pm * 256; } __device__ __forceinline__ int rows(int) const { return 256; } };
struct DownTailQ : DownTail { __device__ __forceinline__ int listoff(int pm) const { return pm * 256; } __device__ __forceinline__ int rows(int) const { return 256; } };
struct DownMain8 : GroupedOrder {
    int v, lim;
    __device__ __forceinline__ bool next(int i, Unit& u) const { const int L = i * G + v; if (L >= lim) return false; u.pm = L >> 3; u.pn = L & 7; u.kp = 0; return true; }
    __device__ __forceinline__ int listoff(int pm) const { return pm * 256; }
    __device__ __forceinline__ int rows(int) const { return 256; }
};
struct DownTail8 : GroupedOrder {
    int v, lim, ntask, S;
    __device__ __forceinline__ bool next(int i, Unit& u) const { const int t = i * G + v; if (t >= ntask) return false; const int L = lim + t / S; u.pm = L >> 3; u.pn = L & 7; u.kp = t % S; return true; }
    __device__ __forceinline__ size_t kbytes(const Unit& u, int K) const { return (size_t)u.kp * K * 2; }
    __device__ __forceinline__ int listoff(int pm) const { return pm * 256; }
    __device__ __forceinline__ int rows(int) const { return 256; }
};
struct EpiF32Res {
    static constexpr bool PERM = false, AFTER_DRAIN = false;
    const float* base; float* out; int ldc; const float* gate; int gstride;
    __device__ __forceinline__ void operator()(const f32x4 (&acc)[2][2][4][2], const Unit& u, int wr, int wc, int fr, int fq, int ui = 0, const PG8_LAS unsigned* tab = nullptr) const {
        const int row0 = u.pm * BM + wr * 64 + fr, col0 = u.pn * BM + wc * 32 + 4 * fq;
#pragma unroll
        for (int ai = 0; ai < 2; ++ai) {
            f32x4 bs[4][2][2];
#pragma unroll
            for (int m = 0; m < 4; ++m) { const size_t off = (size_t)(row0 + ai * HALF + m * 16) * ldc + col0;
#pragma unroll
                for (int bj = 0; bj < 2; ++bj)
#pragma unroll
                    for (int n = 0; n < 2; ++n) bs[m][bj][n] = *(const f32x4*)(base + off + bj * HALF + n * 16); }
#pragma unroll
            for (int m = 0; m < 4; ++m) { const int row = row0 + ai * HALF + m * 16; const size_t off = (size_t)row * ldc + col0;
                const float gs = gate ? gate[(size_t)row * gstride] : 1.0f;
#pragma unroll
                for (int bj = 0; bj < 2; ++bj)
#pragma unroll
                    for (int n = 0; n < 2; ++n) *(f32x4*)(out + off + bj * HALF + n * 16) = bs[m][bj][n] + acc[ai][bj][m][n] * gs; }
            asm volatile("" ::: "memory"); }
    }
};
__device__ __forceinline__ float part16_rstd(const float* part, int row, int fq, float inv_n, float eps) {
    const f32x4 p = *(const f32x4*)(part + (size_t)row * 16 + 4 * fq); float t = (p[0] + p[1]) + (p[2] + p[3]); t += __shfl_xor(t, 16); t += __shfl_xor(t, 32); return 1.0f / sqrtf(t * inv_n + eps); }
template <bool BASE_BF16> struct EpiResBf {
    static constexpr bool PERM = true, AFTER_DRAIN = false;
    const void* base; bf16_t* hb; float* part; int ldc;
    __device__ __forceinline__ void operator()(const f32x4 (&acc)[2][2][4][2], const Unit& u, int wr, int wc, int fr, int fq, int ui = 0, const PG8_LAS unsigned* tab = nullptr) const {
        const int row0 = u.pm * BM + wr * 64 + fr, col0 = u.pn * BM + wc * 32 + 8 * fq;
#pragma unroll
        for (int ai = 0; ai < 2; ++ai) {
            f32x4 bs[4][2][2];
#pragma unroll
            for (int m = 0; m < 4; ++m) { const size_t off = (size_t)(row0 + ai * HALF + m * 16) * ldc + col0;
#pragma unroll
                for (int bj = 0; bj < 2; ++bj) {
                    if (BASE_BF16) { const u32x4 w = *(const u32x4*)((const bf16_t*)base + off + bj * HALF);
                        bs[m][bj][0] = (f32x4){__uint_as_float(w.x << 16), __uint_as_float(w.x & 0xffff0000u), __uint_as_float(w.y << 16), __uint_as_float(w.y & 0xffff0000u)};
                        bs[m][bj][1] = (f32x4){__uint_as_float(w.z << 16), __uint_as_float(w.z & 0xffff0000u), __uint_as_float(w.w << 16), __uint_as_float(w.w & 0xffff0000u)}; }
                    else { bs[m][bj][0] = *(const f32x4*)((const float*)base + off + bj * HALF); bs[m][bj][1] = *(const f32x4*)((const float*)base + off + bj * HALF + 4); } } }
#pragma unroll
            for (int m = 0; m < 4; ++m) { const int row = row0 + ai * HALF + m * 16; const size_t off = (size_t)row * ldc + col0; float ss = 0.f;
#pragma unroll
                for (int bj = 0; bj < 2; ++bj) { const f32x4 o0 = bs[m][bj][0] + acc[ai][bj][m][0], o1 = bs[m][bj][1] + acc[ai][bj][m][1];
                    ss += ((o0[0] * o0[0] + o0[1] * o0[1]) + (o0[2] * o0[2] + o0[3] * o0[3])) + ((o1[0] * o1[0] + o1[1] * o1[1]) + (o1[2] * o1[2] + o1[3] * o1[3]));
                    u32x4 w; w.x = cvt_pk_bf16(o0[0], o0[1]); w.y = cvt_pk_bf16(o0[2], o0[3]); w.z = cvt_pk_bf16(o1[0], o1[1]); w.w = cvt_pk_bf16(o1[2], o1[3]); *(u32x4*)(hb + off + bj * HALF) = w; }
                if (part) { ss += __shfl_xor(ss, 16); ss += __shfl_xor(ss, 32); if (fq == 0) part[(size_t)row * 16 + 4 * u.pn + wc] = ss; } }
            asm volatile("" ::: "memory"); }
    }
};
struct EpiGeluSq {
    static constexpr bool PERM = true, AFTER_DRAIN = false;
    bf16_t* O; int ldc; float* vpart; int pn_sq; const PG8_LAS float* rtab;
    __device__ __forceinline__ void operator()(const f32x4 (&acc)[2][2][4][2], const Unit& u, int wr, int wc, int fr, int fq, int ui = 0, const PG8_LAS unsigned* tab = nullptr) const {
        const int row0 = u.pm * BM + wr * 64 + fr, col0 = u.pn * BM + wc * 32 + 8 * fq; const bool sq = u.pn >= pn_sq;
#pragma unroll
        for (int ai = 0; ai < 2; ++ai)
#pragma unroll
            for (int m = 0; m < 4; ++m) { const int row = row0 + ai * HALF + m * 16; bf16_t* rowp = O + (size_t)row * ldc + col0; f32x2 ss2 = {0.f, 0.f}; const float rr = rtab[ui * 256 + (row - u.pm * BM)] * GELU_K;
#pragma unroll
                for (int bj = 0; bj < 2; ++bj) { const f32x4 v0 = acc[ai][bj][m][0] * rr, v1 = acc[ai][bj][m][1] * rr;
                    const f32x2 wi[4] = {(f32x2){v0[0], v0[1]}, (f32x2){v0[2], v0[3]}, (f32x2){v1[0], v1[1]}, (f32x2){v1[2], v1[3]}}; f32x2 go[4]; gelu_w_pk4(wi, go); const f32x2 a = go[0], b = go[1], c = go[2], d = go[3];
                    if (sq) { ss2 = a * a + ss2; ss2 = b * b + ss2; ss2 = c * c + ss2; ss2 = d * d + ss2; }
                    u32x4 w; w.x = cvt_pk_bf16(a.x, a.y); w.y = cvt_pk_bf16(b.x, b.y); w.z = cvt_pk_bf16(c.x, c.y); w.w = cvt_pk_bf16(d.x, d.y);
                    *(u32x4*)(rowp + bj * HALF) = w; }
                float ss = ss2.x + ss2.y;
                if (sq) { ss += __shfl_xor(ss, 16); ss += __shfl_xor(ss, 32); if (fq == 0) vpart[(size_t)row * 48 + 4 * (u.pn - pn_sq) + wc] = ss; } }
    }
};

struct EpiHead4 {
    static constexpr bool PERM = true, AFTER_DRAIN = false;
    bf16_t* T; size_t tstride; const PG8_LAS float* g; float eps; const PG8_LAS float* rtab;
    __device__ __forceinline__ void operator()(const f32x4 (&acc)[2][2][4][2], const Unit& u, int wr, int wc, int fr, int fq, int ui = 0, const PG8_LAS unsigned* tab = nullptr) const {
        const int row0 = u.pm * BM + wr * 64 + fr, kind = u.pn >> 2; const bool nrm = (kind & 1) == 0; const int col0 = ((u.pn & 3) * 4 + wc) * 64 + 8 * fq;
        bf16_t* base = T + (size_t)kind * tstride;
        f32x4 gg[2][2];
#pragma unroll
        for (int bj = 0; bj < 2; ++bj)
#pragma unroll
            for (int n = 0; n < 2; ++n) gg[bj][n] = *(const PG8_LAS f32x4*)(g + 32 * (kind & 2) + 32 * bj + 8 * fq + 4 * n);
#pragma unroll
        for (int ai = 0; ai < 2; ++ai)
#pragma unroll
            for (int m = 0; m < 4; ++m) { bf16_t* rowp = base + (size_t)(row0 + ai * HALF + m * 16) * 1024 + col0; const float rr = rtab[ui * 256 + ai * HALF + wr * 64 + m * 16 + fr];
                f32x4 v[2][2];
#pragma unroll
                for (int bj = 0; bj < 2; ++bj)
#pragma unroll
                    for (int n = 0; n < 2; ++n) v[bj][n] = acc[ai][bj][m][n] * rr;
                if (nrm) { float ss = 0.f;
#pragma unroll
                    for (int bj = 0; bj < 2; ++bj)
#pragma unroll
                        for (int n = 0; n < 2; ++n) ss += (v[bj][n][0] * v[bj][n][0] + v[bj][n][1] * v[bj][n][1]) + (v[bj][n][2] * v[bj][n][2] + v[bj][n][3] * v[bj][n][3]);
                    ss += __shfl_xor(ss, 16); ss += __shfl_xor(ss, 32);
                    const float rs = 1.0f / sqrtf(ss * (1.0f / 64.0f) + eps);
#pragma unroll
                    for (int bj = 0; bj < 2; ++bj)
#pragma unroll
                        for (int n = 0; n < 2; ++n) v[bj][n] = v[bj][n] * rs * gg[bj][n];
                } else if (kind == 3) {
#pragma unroll
                    for (int bj = 0; bj < 2; ++bj)
#pragma unroll
                        for (int n = 0; n < 2; ++n)
#pragma unroll
                            for (int e = 0; e < 4; ++e) v[bj][n][e] = __builtin_amdgcn_rcpf(1.0f + __builtin_amdgcn_exp2f(-1.4426950408889634f * v[bj][n][e]));
                }
#pragma unroll
                for (int bj = 0; bj < 2; ++bj) { u32x4 w; w.x = cvt_pk_bf16(v[bj][0][0], v[bj][0][1]); w.y = cvt_pk_bf16(v[bj][0][2], v[bj][0][3]); w.z = cvt_pk_bf16(v[bj][1][0], v[bj][1][1]); w.w = cvt_pk_bf16(v[bj][1][2], v[bj][1][3]);
                    *(u32x4*)(rowp + 32 * bj) = w; } }
    }
};
struct EpiBf16RowScale {
    static constexpr bool PERM = true, AFTER_DRAIN = false;
    bf16_t* O; int ldc; const PG8_LAS float* rs; size_t kstride;
    __device__ __forceinline__ void operator()(const f32x4 (&acc)[2][2][4][2], const Unit& u, int wr, int wc, int fr, int fq, int ui = 0, const PG8_LAS unsigned* tab = nullptr) const {
        const int row0 = u.pm * BM + wr * 64 + fr, col0 = u.pn * BM + wc * 32 + 8 * fq;
#pragma unroll
        for (int ai = 0; ai < 2; ++ai)
#pragma unroll
            for (int m = 0; m < 4; ++m) { const int row = row0 + ai * HALF + m * 16; bf16_t* rowp = O + (size_t)u.kp * kstride + (size_t)row * ldc + col0; const float sc = rs[ui * 256 + (row - u.pm * BM)];
#pragma unroll
                for (int bj = 0; bj < 2; ++bj) { const f32x4 v0 = acc[ai][bj][m][0] * sc, v1 = acc[ai][bj][m][1] * sc;
                    u32x4 w; w.x = cvt_pk_bf16(v0[0], v0[1]); w.y = cvt_pk_bf16(v0[2], v0[3]); w.z = cvt_pk_bf16(v1[0], v1[1]); w.w = cvt_pk_bf16(v1[2], v1[3]);
                    *(u32x4*)(rowp + bj * HALF) = w; } }
    }
};
struct EpiSwiGLU {
    static constexpr bool PERM = true, AFTER_DRAIN = false;
    bf16_t* O; int ldc; const PG8_LAS float* rtab;
    static __device__ __forceinline__ float silu(float x) { return x * __builtin_amdgcn_rcpf(1.0f + __builtin_amdgcn_exp2f(-1.4426950408889634f * x)); }
    __device__ __forceinline__ void operator()(const f32x4 (&acc)[2][2][4][2], const Unit& u, int wr, int wc, int fr, int fq, int ui = 0, const PG8_LAS unsigned* tab = nullptr) const {
        const int row0 = u.pm * BM + wr * 64 + fr, col0 = u.pn * HALF + wc * 32 + 8 * fq;
#pragma unroll
        for (int ai = 0; ai < 2; ++ai)
#pragma unroll
            for (int m = 0; m < 4; ++m) { const int row = row0 + ai * HALF + m * 16; bf16_t* rowp = O + (size_t)row * ldc + col0;
                const float rs = rtab ? rtab[ui * 256 + (row - u.pm * BM)] : __uint_as_float(tab[256 + (row - u.pm * BM)]);
                const f32x4 a0 = acc[ai][0][m][0] * rs, a1 = acc[ai][0][m][1] * rs, b0 = acc[ai][1][m][0] * rs, b1 = acc[ai][1][m][1] * rs;
                const f32x4 t0 = a0 * (-1.4426950408889634f), t1 = a1 * (-1.4426950408889634f); f32x4 d0, d1;
#pragma unroll
                for (int e = 0; e < 4; ++e) { d0[e] = __builtin_amdgcn_exp2f(t0[e]); d1[e] = __builtin_amdgcn_exp2f(t1[e]); }
                d0 = d0 + 1.0f; d1 = d1 + 1.0f;
#pragma unroll
                for (int e = 0; e < 4; ++e) { d0[e] = __builtin_amdgcn_rcpf(d0[e]); d1[e] = __builtin_amdgcn_rcpf(d1[e]); }
                const f32x4 y0 = (a0 * b0) * d0, y1 = (a1 * b1) * d1;
                u32x4 w; w.x = cvt_pk_bf16(y0[0], y0[1]); w.y = cvt_pk_bf16(y0[2], y0[3]); w.z = cvt_pk_bf16(y1[0], y1[1]); w.w = cvt_pk_bf16(y1[2], y1[3]);
                *(u32x4*)rowp = w; }
    }
};
struct EpiSwiGLU8q {
    static constexpr bool PERM = true, AFTER_DRAIN = false;
    unsigned char* O; int ldc;
    __device__ __forceinline__ void operator()(const f32x4 (&acc)[2][2][4][2], const Unit& u, int wr, int wc, int fr, int fq, int ui = 0, const PG8_LAS unsigned* tab = nullptr) const {
        const int col0 = u.pn * HALF + wc * 32 + 8 * fq;
#pragma unroll
        for (int ai = 0; ai < 2; ++ai)
#pragma unroll
            for (int m = 0; m < 4; ++m) { const int r = ai * HALF + wr * 64 + m * 16 + fr; const float rs = __uint_as_float(tab[256 + r]);
                const f32x4 a0 = acc[ai][0][m][0] * rs, a1 = acc[ai][0][m][1] * rs, b0 = acc[ai][1][m][0] * rs, b1 = acc[ai][1][m][1] * rs;
                const f32x4 t0 = a0 * (-1.4426950408889634f), t1 = a1 * (-1.4426950408889634f); f32x4 d0, d1;
#pragma unroll
                for (int e = 0; e < 4; ++e) { d0[e] = __builtin_amdgcn_exp2f(t0[e]); d1[e] = __builtin_amdgcn_exp2f(t1[e]); }
                d0 = d0 + 1.0f; d1 = d1 + 1.0f;
#pragma unroll
                for (int e = 0; e < 4; ++e) { d0[e] = __builtin_amdgcn_rcpf(d0[e]); d1[e] = __builtin_amdgcn_rcpf(d1[e]); }
                const f32x4 y0 = (a0 * b0) * d0, y1 = (a1 * b1) * d1; unsigned w0 = 0u, w1 = 0u;
                w0 = __builtin_amdgcn_cvt_pk_fp8_f32(y0[0], y0[1], w0, false); w0 = __builtin_amdgcn_cvt_pk_fp8_f32(y0[2], y0[3], w0, true);
                w1 = __builtin_amdgcn_cvt_pk_fp8_f32(y1[0], y1[1], w1, false); w1 = __builtin_amdgcn_cvt_pk_fp8_f32(y1[2], y1[3], w1, true);
                uint2 w; w.x = w0; w.y = w1; *(uint2*)(O + (size_t)(u.pm * BM + r) * ldc + col0) = w; }
    }
};
struct EpiY8q {
    static constexpr bool PERM = true, AFTER_DRAIN = false;
    bf16_t* O; int ldc; size_t kstride;
    __device__ __forceinline__ void operator()(const f32x4 (&acc)[2][2][4][2], const Unit& u, int wr, int wc, int fr, int fq, int ui = 0, const PG8_LAS unsigned* tab = nullptr) const {
        const int col0 = u.pn * BM + wc * 32 + 8 * fq;
#pragma unroll
        for (int ai = 0; ai < 2; ++ai)
#pragma unroll
            for (int m = 0; m < 4; ++m) { const int r = ai * HALF + wr * 64 + m * 16 + fr; const float sc = __uint_as_float(tab[256 + r]); bf16_t* rowp = O + (size_t)u.kp * kstride + (size_t)(u.pm * BM + r) * ldc + col0;
#pragma unroll
                for (int bj = 0; bj < 2; ++bj) { const f32x4 v0 = acc[ai][bj][m][0] * sc, v1 = acc[ai][bj][m][1] * sc;
                    u32x4 w; w.x = cvt_pk_bf16(v0[0], v0[1]); w.y = cvt_pk_bf16(v0[2], v0[3]); w.z = cvt_pk_bf16(v1[0], v1[1]); w.w = cvt_pk_bf16(v1[2], v1[3]);
                    *(u32x4*)(rowp + bj * HALF) = w; } }
    }
};
template <class Epi, class Sched, bool ALIGN_EPI = false, bool SP2 = true, bool GATHER = false>
__device__ __forceinline__ void gemm_phase(PG8_LAS unsigned char* lds, const Gemm g, const Sched& S, const Epi& E, PG8_LAS unsigned* tt = nullptr) {
    static_assert(SP2, "only the two-MFMA-blocks-per-barrier-pair loop is kept in this file");
    int tid_ = threadIdx.x; asm volatile("" : "+v"(tid_));
    const int tid = tid_, wid = __builtin_amdgcn_readfirstlane(tid >> 6), lane = tid & 63, wr = wid >> 2, wc = wid & 3, fr = lane & 15, fq = lane >> 4;
    const int K = g.K, nt = K / BK, ldb = g.ldb ? g.ldb : K;
    unsigned c0[2], c1[2], n0[2], n1[2], voffB[2]; int rA[2]; unsigned cbA[2];
    const size_t kstep = (size_t)(BK * 2);
    const size_t hstepA = (size_t)HALF * g.lda * 2, hstep = (size_t)HALF * ldb * 2;
    const size_t tstepA = 2 * hstepA, tstep = 2 * hstep;
#pragma unroll
    for (int i = 0; i < 2; ++i) { int R, C; stage_rc(tid * 16 + i * 8192, R, C); const int Rb = Epi::PERM ? ((R & ~31) + perm32(R & 31)) : R; rA[i] = R; cbA[i] = (unsigned)C * 2u;
        c0[i] = (unsigned)(R * g.lda + C) * 2u; c1[i] = c0[i] + (unsigned)hstepA; n0[i] = c0[i]; n1[i] = c1[i]; voffB[i] = (unsigned)(Rb * ldb + C) * 2u; }
    const unsigned ldsw = (unsigned)wid * 1024u;
    const int aoff = lds_byte(wr * 64 + fr, fq * 8), boff = lds_byte(wc * 32 + fr, fq * 8);
#define PG8_SA(b, h) (((b) * 2 + (h)) * HTB)
#define PG8_SB(b, h) ((4 + (b) * 2 + (h)) * HTB)
#define PG8_STAGE(bufoff, gbase, voff) do { _Pragma("unroll") for (int _i = 0; _i < 2; ++_i) \
        __builtin_amdgcn_global_load_lds((const unsigned*)((const char*)(gbase) + (voff)[_i]), (PG8_LAS unsigned*)(lds + (bufoff) + ldsw + _i * 8192), 16, 0, 0); } while (0)
#define PG8_LDA(dst, b, h) do { _Pragma("unroll") for (int m = 0; m < 4; ++m) _Pragma("unroll") for (int k = 0; k < 2; ++k) dst[m][k] = *(const PG8_LAS bf16x8*)(lds + PG8_SA(b, h) + aoff + m * 2048 + k * 1024); } while (0)
#define PG8_LDB(dst, b, h) do { _Pragma("unroll") for (int n = 0; n < 2; ++n) _Pragma("unroll") for (int k = 0; k < 2; ++k) dst[n][k] = *(const PG8_LAS bf16x8*)(lds + PG8_SB(b, h) + boff + n * 2048 + k * 1024); } while (0)
#define PG8_MMA(ai, bj, At, Bt) do { __builtin_amdgcn_s_setprio(1); _Pragma("unroll") for (int m = 0; m < 4; ++m) _Pragma("unroll") for (int n = 0; n < 2; ++n) _Pragma("unroll") for (int k = 0; k < 2; ++k) \
        acc[ai][bj][m][n] = __builtin_amdgcn_mfma_f32_16x16x32_bf16(Bt[n][k], At[m][k], acc[ai][bj][m][n], 0, 0, 0); __builtin_amdgcn_s_setprio(0); } while (0)
#define PG8_WAIT_V(n) asm volatile("s_waitcnt vmcnt(" #n ")" ::: "memory")
#define PG8_WAIT_L(n) asm volatile("s_waitcnt lgkmcnt(" #n ")" ::: "memory")
#define PG8_BAR __builtin_amdgcn_s_barrier()
#define PG8_SCHED __builtin_amdgcn_sched_barrier(0)
#define PG8_GOFF(o0, o1, tab, nv) do { _Pragma("unroll") for (int _i = 0; _i < 2; ++_i) { const unsigned e0_ = (tab)[rA[_i]], e1_ = (tab)[HALF + rA[_i]]; \
        o0[_i] = ((rA[_i] < (nv)) ? (e0_ >> 1) : 0u) * (unsigned)(g.lda * 2) + cbA[_i]; o1[_i] = ((HALF + rA[_i] < (nv)) ? (e1_ >> 1) : 0u) * (unsigned)(g.lda * 2) + cbA[_i]; } } while (0)
    Unit cur, nxt; int ui = 0;
    if (!S.next(0, cur)) return;
    f32x4 acc[2][2][4][2];
#pragma unroll
    for (int a = 0; a < 2; ++a)
#pragma unroll
        for (int b = 0; b < 2; ++b)
#pragma unroll
            for (int m = 0; m < 4; ++m)
#pragma unroll
                for (int n = 0; n < 2; ++n) acc[a][b][m][n] = (f32x4){0.f, 0.f, 0.f, 0.f};
    bf16x8 At[4][2], B0[2][2], B1[2][2];
    int tbuf = 0, tnext = 1;
    if constexpr (GATHER) {
        { const int lo_ = S.listoff(cur.pm); if (tid < 256) tt[tid] = g.rowlist[lo_ + tid]; else tt[tid] = g.wlist[lo_ + tid - 256]; }
        asm volatile("s_waitcnt vmcnt(0) lgkmcnt(0)" ::: "memory"); PG8_BAR; asm volatile("" ::: "memory");
        PG8_GOFF(c0, c1, tt, S.rows(cur.pm));
    }
    const char* cA = (GATHER ? (const char*)g.A : (const char*)g.A + (size_t)cur.pm * tstepA) + S.kbytes(cur, K); const char* cB = (const char*)g.Bt + (size_t)S.expert(cur.pm) * g.bstride + (size_t)cur.pn * tstep + S.kbytes(cur, K);
    S.a_ready(cur);
    PG8_STAGE(PG8_SB(0, 0), cB, voffB); PG8_STAGE(PG8_SB(0, 1), cB + hstep, voffB); PG8_STAGE(PG8_SA(0, 0), cA, c0); PG8_STAGE(PG8_SA(0, 1), cA, c1);
    if (wr == 1) PG8_BAR;
    PG8_WAIT_V(2); PG8_BAR;
    PG8_STAGE(PG8_SB(1, 0), cB + kstep, voffB); PG8_STAGE(PG8_SA(1, 0), cA + kstep, c0); PG8_STAGE(PG8_SB(1, 1), cB + hstep + kstep, voffB);
    PG8_WAIT_V(6); PG8_BAR;
    for (;;) {
        const bool has_next = S.next(ui + 1, nxt);
        const char* nA = GATHER ? cA : (has_next ? (const char*)g.A + (size_t)nxt.pm * tstepA + S.kbytes(nxt, K) : cA); const char* nB = has_next ? (const char*)g.Bt + (size_t)S.expert(nxt.pm) * g.bstride + (size_t)nxt.pn * tstep + S.kbytes(nxt, K) : cB;
        if constexpr (GATHER) { if (has_next) {
            const unsigned* src_ = (wid < 4 ? g.rowlist : g.wlist) + S.listoff(nxt.pm) + (wid & 3) * 64 + lane;
            __builtin_amdgcn_global_load_lds(src_, (PG8_LAS unsigned*)(tt + tnext * 512 + wid * 64), 4, 0, 0); } }
        for (int t = 0; t < nt; t += 2) {
            const bool last = (t == nt - 2);
            if constexpr (GATHER) { if (last && has_next) PG8_GOFF(n0, n1, tt + tnext * 512, S.rows(nxt.pm)); }
            const char* a1 = cA + (size_t)(t + 1) * kstep;
            const char* a2 = last ? nA : cA + (size_t)(t + 2) * kstep; const char* b2 = last ? nB : cB + (size_t)(t + 2) * kstep;
            const char* a3 = a2 + kstep; const char* b3 = b2 + kstep;
            unsigned x0[2], x1[2];
#pragma unroll
            for (int i = 0; i < 2; ++i) { x0[i] = last ? n0[i] : c0[i]; x1[i] = last ? n1[i] : c1[i]; }
            if (last && has_next) S.a_ready(nxt);
            PG8_LDB(B0, 0, 0); PG8_LDB(B1, 0, 1); PG8_SCHED; PG8_LDA(At, 0, 0); PG8_STAGE(PG8_SA(1, 1), a1, c1);
            PG8_WAIT_V(8); PG8_WAIT_L(0); PG8_BAR; PG8_MMA(0, 0, At, B0); PG8_MMA(0, 1, At, B1); PG8_BAR; PG8_SCHED;
            PG8_LDA(At, 0, 1); PG8_STAGE(PG8_SB(0, 0), b2, voffB); PG8_STAGE(PG8_SB(0, 1), b2 + hstep, voffB); PG8_STAGE(PG8_SA(0, 0), a2, x0);
            PG8_WAIT_V(8); PG8_WAIT_L(0); PG8_BAR; PG8_MMA(1, 0, At, B0); PG8_MMA(1, 1, At, B1); PG8_BAR; PG8_SCHED;
            PG8_LDB(B0, 1, 0); PG8_LDB(B1, 1, 1); PG8_SCHED; PG8_LDA(At, 1, 0); PG8_STAGE(PG8_SA(0, 1), a2, x1);
            PG8_WAIT_V(8); PG8_WAIT_L(0); PG8_BAR; PG8_MMA(0, 0, At, B0); PG8_MMA(0, 1, At, B1); PG8_BAR; PG8_SCHED;
            PG8_LDA(At, 1, 1); PG8_STAGE(PG8_SB(1, 0), b3, voffB); PG8_STAGE(PG8_SB(1, 1), b3 + hstep, voffB); PG8_STAGE(PG8_SA(1, 0), a3, x0);
            PG8_WAIT_V(8); PG8_WAIT_L(0); PG8_BAR; PG8_MMA(1, 0, At, B0); PG8_MMA(1, 1, At, B1); PG8_BAR; PG8_SCHED;
        }
        if constexpr (ALIGN_EPI) { if (wr == 0) PG8_BAR; }
        if constexpr (!Epi::AFTER_DRAIN) { E(acc, cur, wr, wc, fr, fq, ui, GATHER ? tt + tbuf * 512 : nullptr); S.done(cur); }
        if (!has_next) break;
#pragma unroll
        for (int a = 0; a < 2; ++a)
#pragma unroll
            for (int b = 0; b < 2; ++b)
#pragma unroll
                for (int m = 0; m < 4; ++m)
#pragma unroll
                    for (int n = 0; n < 2; ++n) acc[a][b][m][n] = (f32x4){0.f, 0.f, 0.f, 0.f};
        cur = nxt; cA = nA; cB = nB; ++ui; tbuf = tnext; tnext = (tnext == 2) ? 0 : tnext + 1;
        if constexpr (GATHER) {
#pragma unroll
            for (int i = 0; i < 2; ++i) { c0[i] = n0[i]; c1[i] = n1[i]; } }
        if constexpr (ALIGN_EPI) { if (wr == 1) PG8_BAR; }
    }
    PG8_WAIT_V(0);
    if constexpr (!ALIGN_EPI) { if (wr == 0) PG8_BAR; }
    PG8_BAR;
    if constexpr (Epi::AFTER_DRAIN) { E.fused(acc, cur, wr, wc, fr, fq, lds, wid, lane); S.done(cur); }
#undef PG8_SA
#undef PG8_SB
#undef PG8_STAGE
#undef PG8_LDA
#undef PG8_LDB
#undef PG8_MMA
#undef PG8_WAIT_V
#undef PG8_WAIT_L
#undef PG8_BAR
#undef PG8_SCHED
#undef PG8_GOFF
}

template <class Epi, class Sched, bool ALIGN_EPI = true, bool SP2 = true, bool GATHER = true>
__device__ __forceinline__ void gemm_phase_f8q(PG8_LAS unsigned char* lds, const Gemm g, const Sched& S, const Epi& E, PG8_LAS unsigned* tt = nullptr) {
    static_assert(SP2, "only the two-MFMA-blocks-per-barrier-pair loop is kept in this file");
    typedef int v8i_t __attribute__((ext_vector_type(8))); typedef int v4i_t __attribute__((ext_vector_type(4)));
    int tid_ = threadIdx.x; asm volatile("" : "+v"(tid_));
    const int tid = tid_, wid = __builtin_amdgcn_readfirstlane(tid >> 6), lane = tid & 63, wr = wid >> 2, wc = wid & 3, fr = lane & 15, fq = lane >> 4;
    const int K = g.K, nt = K / BK, ldb = g.ldb ? g.ldb : K;
    unsigned c0[2], c1[2], n0[2], n1[2], voffB[2]; int rA[2]; unsigned cbA[2];
    const size_t kstep = (size_t)(BK * 2);
    const size_t hstepA = (size_t)HALF * g.lda * 2, hstep = (size_t)HALF * ldb * 2;
    const size_t tstepA = 2 * hstepA, tstep = 2 * hstep;
#pragma unroll
    for (int i = 0; i < 2; ++i) { const int R = (tid >> 3) + 64 * i, x = R & 15, C = (((tid & 7) ^ (((x >> 1) & 1) | (((x >> 3) & 1) << 2))) * 16); const int Rb = (R & ~31) + perm32(R & 31);
        rA[i] = R; cbA[i] = (unsigned)C; c0[i] = (unsigned)(R * g.lda) * 2u + (unsigned)C; c1[i] = c0[i] + (unsigned)hstepA; n0[i] = c0[i]; n1[i] = c1[i]; voffB[i] = (unsigned)(Rb * ldb) * 2u + (unsigned)C; }
    const unsigned ldsw = (unsigned)wid * 1024u;
    const int fsw = ((fr >> 1) & 1) | (((fr >> 3) & 1) << 2);
    const int aoffL = (wr * 64 + fr) * 128 + (((2 * fq) ^ fsw) * 16), aoffH = (wr * 64 + fr) * 128 + (((2 * fq + 1) ^ fsw) * 16);
    const int boffL = (wc * 32 + fr) * 128 + (((2 * fq) ^ fsw) * 16), boffH = (wc * 32 + fr) * 128 + (((2 * fq + 1) ^ fsw) * 16);
#define PG8_SA(b, h) (((b) * 2 + (h)) * HTB)
#define PG8_SB(b, h) ((4 + (b) * 2 + (h)) * HTB)
#define PG8_STAGE(bufoff, gbase, voff) do { _Pragma("unroll") for (int _i = 0; _i < 2; ++_i) \
        __builtin_amdgcn_global_load_lds((const unsigned*)((const char*)(gbase) + (voff)[_i]), (PG8_LAS unsigned*)(lds + (bufoff) + ldsw + _i * 8192), 16, 0, 0); } while (0)
#define PG8_LDA(dst, b, h) do { _Pragma("unroll") for (int m = 0; m < 4; ++m) { const v4i_t l_ = *(const PG8_LAS v4i_t*)(lds + PG8_SA(b, h) + aoffL + m * 2048), h_ = *(const PG8_LAS v4i_t*)(lds + PG8_SA(b, h) + aoffH + m * 2048); \
        dst[m] = (v8i_t){l_[0], l_[1], l_[2], l_[3], h_[0], h_[1], h_[2], h_[3]}; } } while (0)
#define PG8_LDB(dst, b, h) do { _Pragma("unroll") for (int n = 0; n < 2; ++n) { const v4i_t l_ = *(const PG8_LAS v4i_t*)(lds + PG8_SB(b, h) + boffL + n * 2048), h_ = *(const PG8_LAS v4i_t*)(lds + PG8_SB(b, h) + boffH + n * 2048); \
        dst[n] = (v8i_t){l_[0], l_[1], l_[2], l_[3], h_[0], h_[1], h_[2], h_[3]}; } } while (0)
#define PG8_MMA(ai, bj, At, Bt) do { __builtin_amdgcn_s_setprio(1); _Pragma("unroll") for (int m = 0; m < 4; ++m) _Pragma("unroll") for (int n = 0; n < 2; ++n) \
        asm volatile("v_mfma_scale_f32_16x16x128_f8f6f4 %0, %1, %2, %0, %3, %4 op_sel_hi:[0,0,0]" : "+v"(acc[ai][bj][m][n]) : "v"(Bt[n]), "v"(At[m]), "v"(sclB), "v"(sclA)); __builtin_amdgcn_s_setprio(0); } while (0)
#define PG8_WAIT_V(n) asm volatile("s_waitcnt vmcnt(" #n ")" ::: "memory")
#define PG8_WAIT_L(n) asm volatile("s_waitcnt lgkmcnt(" #n ")" ::: "memory")
#define PG8_BAR __builtin_amdgcn_s_barrier()
#define PG8_SCHED __builtin_amdgcn_sched_barrier(0)
#define PG8_GOFF(o0, o1, tab, nv) do { _Pragma("unroll") for (int _i = 0; _i < 2; ++_i) { const unsigned e0_ = (tab)[rA[_i]], e1_ = (tab)[HALF + rA[_i]]; \
        o0[_i] = ((rA[_i] < (nv)) ? (e0_ >> 1) : 0u) * (unsigned)(g.lda * 2) + cbA[_i]; o1[_i] = ((HALF + rA[_i] < (nv)) ? (e1_ >> 1) : 0u) * (unsigned)(g.lda * 2) + cbA[_i]; } } while (0)
    Unit cur, nxt; int ui = 0;
    if (!S.next(0, cur)) return;
    f32x4 acc[2][2][4][2];
#pragma unroll
    for (int a = 0; a < 2; ++a)
#pragma unroll
        for (int b = 0; b < 2; ++b)
#pragma unroll
            for (int m = 0; m < 4; ++m)
#pragma unroll
                for (int n = 0; n < 2; ++n) acc[a][b][m][n] = (f32x4){0.f, 0.f, 0.f, 0.f};
    const int sclB = g.scale_b, sclA = 0x7f7f7f7f;
    v8i_t At[4], B0[2], B1[2];
    int tbuf = 0, tnext = 1;
    if constexpr (GATHER) {
        { const int lo_ = S.listoff(cur.pm); if (tid < 256) tt[tid] = g.rowlist[lo_ + tid]; else tt[tid] = g.wlist[lo_ + tid - 256]; }
        asm volatile("s_waitcnt vmcnt(0) lgkmcnt(0)" ::: "memory"); PG8_BAR; asm volatile("" ::: "memory");
        PG8_GOFF(c0, c1, tt, S.rows(cur.pm));
    }
    const char* cA = (GATHER ? (const char*)g.A : (const char*)g.A + (size_t)cur.pm * tstepA) + S.kbytes(cur, K); const char* cB = (const char*)g.Bt + (size_t)S.expert(cur.pm) * g.bstride + (size_t)cur.pn * tstep + S.kbytes(cur, K);
    S.a_ready(cur);
    PG8_STAGE(PG8_SB(0, 0), cB, voffB); PG8_STAGE(PG8_SB(0, 1), cB + hstep, voffB); PG8_STAGE(PG8_SA(0, 0), cA, c0); PG8_STAGE(PG8_SA(0, 1), cA, c1);
    if (wr == 1) PG8_BAR;
    PG8_WAIT_V(2); PG8_BAR;
    PG8_STAGE(PG8_SB(1, 0), cB + kstep, voffB); PG8_STAGE(PG8_SA(1, 0), cA + kstep, c0); PG8_STAGE(PG8_SB(1, 1), cB + hstep + kstep, voffB);
    PG8_WAIT_V(6); PG8_BAR;
    for (;;) {
        const bool has_next = S.next(ui + 1, nxt);
        const char* nA = GATHER ? cA : (has_next ? (const char*)g.A + (size_t)nxt.pm * tstepA + S.kbytes(nxt, K) : cA); const char* nB = has_next ? (const char*)g.Bt + (size_t)S.expert(nxt.pm) * g.bstride + (size_t)nxt.pn * tstep + S.kbytes(nxt, K) : cB;
        if constexpr (GATHER) { if (has_next) {
            const unsigned* src_ = (wid < 4 ? g.rowlist : g.wlist) + S.listoff(nxt.pm) + (wid & 3) * 64 + lane;
            __builtin_amdgcn_global_load_lds(src_, (PG8_LAS unsigned*)(tt + tnext * 512 + wid * 64), 4, 0, 0); } }
        for (int t = 0; t < nt; t += 2) {
            const bool last = (t == nt - 2);
            if constexpr (GATHER) { if (last && has_next) PG8_GOFF(n0, n1, tt + tnext * 512, S.rows(nxt.pm)); }
            const char* a1 = cA + (size_t)(t + 1) * kstep;
            const char* a2 = last ? nA : cA + (size_t)(t + 2) * kstep; const char* b2 = last ? nB : cB + (size_t)(t + 2) * kstep;
            const char* a3 = a2 + kstep; const char* b3 = b2 + kstep;
            unsigned x0[2], x1[2];
#pragma unroll
            for (int i = 0; i < 2; ++i) { x0[i] = last ? n0[i] : c0[i]; x1[i] = last ? n1[i] : c1[i]; }
            if (last && has_next) S.a_ready(nxt);
            PG8_LDB(B0, 0, 0); PG8_LDB(B1, 0, 1); PG8_SCHED; PG8_LDA(At, 0, 0); PG8_STAGE(PG8_SA(1, 1), a1, c1);
            PG8_WAIT_V(8); PG8_WAIT_L(0); PG8_BAR; PG8_MMA(0, 0, At, B0); PG8_MMA(0, 1, At, B1); PG8_BAR; PG8_SCHED;
            PG8_LDA(At, 0, 1); PG8_STAGE(PG8_SB(0, 0), b2, voffB); PG8_STAGE(PG8_SB(0, 1), b2 + hstep, voffB); PG8_STAGE(PG8_SA(0, 0), a2, x0);
            PG8_WAIT_V(8); PG8_WAIT_L(0); PG8_BAR; PG8_MMA(1, 0, At, B0); PG8_MMA(1, 1, At, B1); PG8_BAR; PG8_SCHED;
            PG8_LDB(B0, 1, 0); PG8_LDB(B1, 1, 1); PG8_SCHED; PG8_LDA(At, 1, 0); PG8_STAGE(PG8_SA(0, 1), a2, x1);
            PG8_WAIT_V(8); PG8_WAIT_L(0); PG8_BAR; PG8_MMA(0, 0, At, B0); PG8_MMA(0, 1, At, B1); PG8_BAR; PG8_SCHED;
            PG8_LDA(At, 1, 1); PG8_STAGE(PG8_SB(1, 0), b3, voffB); PG8_STAGE(PG8_SB(1, 1), b3 + hstep, voffB); PG8_STAGE(PG8_SA(1, 0), a3, x0);
            PG8_WAIT_V(8); PG8_WAIT_L(0); PG8_BAR; PG8_MMA(1, 0, At, B0); PG8_MMA(1, 1, At, B1); PG8_BAR; PG8_SCHED;
        }
        if constexpr (ALIGN_EPI) { if (wr == 0) PG8_BAR; }
        asm volatile("s_nop 15\n\ts_nop 15" ::: "memory");
        if constexpr (!Epi::AFTER_DRAIN) { E(acc, cur, wr, wc, fr, fq, ui, GATHER ? tt + tbuf * 512 : nullptr); S.done(cur); }
        if (!has_next) break;
#pragma unroll
        for (int a = 0; a < 2; ++a)
#pragma unroll
            for (int b = 0; b < 2; ++b)
#pragma unroll
                for (int m = 0; m < 4; ++m)
#pragma unroll
                    for (int n = 0; n < 2; ++n) acc[a][b][m][n] = (f32x4){0.f, 0.f, 0.f, 0.f};
        cur = nxt; cA = nA; cB = nB; ++ui; tbuf = tnext; tnext = (tnext == 2) ? 0 : tnext + 1;
        if constexpr (GATHER) {
#pragma unroll
            for (int i = 0; i < 2; ++i) { c0[i] = n0[i]; c1[i] = n1[i]; } }
        if constexpr (ALIGN_EPI) { if (wr == 1) PG8_BAR; }
    }
    PG8_WAIT_V(0);
    if constexpr (!ALIGN_EPI) { if (wr == 0) PG8_BAR; }
    PG8_BAR;
    if constexpr (Epi::AFTER_DRAIN) { E.fused(acc, cur, wr, wc, fr, fq, lds, wid, lane); S.done(cur); }
#undef PG8_SA
#undef PG8_SB
#undef PG8_STAGE
#undef PG8_LDA
#undef PG8_LDB
#undef PG8_MMA
#undef PG8_WAIT_V
#undef PG8_WAIT_L
#undef PG8_BAR
#undef PG8_SCHED
#undef PG8_GOFF
}

struct EpiSwiGLU64 {
    unsigned char* O; int ldc;
    __device__ __forceinline__ void operator()(const f32x4 (&acc)[2][4][2], const Unit& u, int wr, int wc, int fr, int fq, const PG8_LAS unsigned* tab) const {
        const int col0 = u.pn * 64 + wc * 16 + 4 * fq;
#pragma unroll
        for (int ai = 0; ai < 2; ++ai)
#pragma unroll
            for (int m = 0; m < 4; ++m) { const int r = ai * HALF + wr * 64 + m * 16 + fr; const float rs = __uint_as_float(tab[256 + r]);
                const f32x4 a = acc[ai][m][0] * rs, b = acc[ai][m][1] * rs; const f32x4 t = a * (-1.4426950408889634f); f32x4 d;
#pragma unroll
                for (int e = 0; e < 4; ++e) d[e] = __builtin_amdgcn_exp2f(t[e]);
                d = d + 1.0f;
#pragma unroll
                for (int e = 0; e < 4; ++e) d[e] = __builtin_amdgcn_rcpf(d[e]);
                const f32x4 y = (a * b) * d; unsigned w = 0u; w = __builtin_amdgcn_cvt_pk_fp8_f32(y[0], y[1], w, false); w = __builtin_amdgcn_cvt_pk_fp8_f32(y[2], y[3], w, true);
                *(unsigned*)(O + (size_t)(u.pm * BM + r) * ldc + col0) = w; }
    }
};
struct EpiY64 {
    bf16_t* O; int ldc; size_t kstride;
    __device__ __forceinline__ void operator()(const f32x4 (&acc)[2][4][2], const Unit& u, int wr, int wc, int fr, int fq, const PG8_LAS unsigned* tab) const {
        const int col0 = u.pn * 128 + wc * 32 + 8 * fq;
#pragma unroll
        for (int ai = 0; ai < 2; ++ai)
#pragma unroll
            for (int m = 0; m < 4; ++m) { const int r = ai * HALF + wr * 64 + m * 16 + fr; const float gw = __uint_as_float(tab[256 + r]);
                const f32x4 a = acc[ai][m][0] * gw, b = acc[ai][m][1] * gw; u32x4 w; w.x = cvt_pk_bf16(a[0], a[1]); w.y = cvt_pk_bf16(a[2], a[3]); w.z = cvt_pk_bf16(b[0], b[1]); w.w = cvt_pk_bf16(b[2], b[3]);
                *(u32x4*)(O + (size_t)u.kp * kstride + (size_t)(u.pm * BM + r) * ldc + col0) = w; }
    }
};
template <class Epi, class Sched>
__device__ __forceinline__ void gemm_phase_f8n128(PG8_LAS unsigned char* lds, const Gemm g, const Sched& S, const Epi& E, PG8_LAS unsigned* tt) {
    typedef int v8i_t __attribute__((ext_vector_type(8))); typedef int v4i_t __attribute__((ext_vector_type(4)));
    int tid_ = threadIdx.x; asm volatile("" : "+v"(tid_));
    const int tid = tid_, wid = __builtin_amdgcn_readfirstlane(tid >> 6), lane = tid & 63, wr = wid >> 2, wc = wid & 3, fr = lane & 15, fq = lane >> 4;
    const int K = g.K, nt = K / BK, ldb = g.ldb ? g.ldb : K;
    unsigned c0[2], c1[2], n0[2], n1[2], voffB[2]; int rA[2]; unsigned cbA[2];
    const size_t kstep = (size_t)(BK * 2), tstepB = (size_t)HALF * ldb * 2;
#pragma unroll
    for (int i = 0; i < 2; ++i) { const int R = (tid >> 3) + 64 * i, x = R & 15, C = (((tid & 7) ^ (((x >> 1) & 1) | (((x >> 3) & 1) << 2))) * 16); const int Rb = (R & ~31) + perm32(R & 31);
        rA[i] = R; cbA[i] = (unsigned)C; c0[i] = c1[i] = n0[i] = n1[i] = 0u; voffB[i] = (unsigned)(Rb * ldb) * 2u + (unsigned)C; }
    const unsigned ldsw = (unsigned)wid * 1024u;
    const int fsw = ((fr >> 1) & 1) | (((fr >> 3) & 1) << 2);
    const int aoffL = (wr * 64 + fr) * 128 + (((2 * fq) ^ fsw) * 16), aoffH = (wr * 64 + fr) * 128 + (((2 * fq + 1) ^ fsw) * 16);
    const int boffL = (wc * 32 + fr) * 128 + (((2 * fq) ^ fsw) * 16), boffH = (wc * 32 + fr) * 128 + (((2 * fq + 1) ^ fsw) * 16);
#define F8_SA(b, h) (((b) * 3 + (h)) * HTB)
#define F8_SB(b) (((b) * 3 + 2) * HTB)
#define F8_STAGE1(bufoff, gbase, voff, i_) __builtin_amdgcn_global_load_lds((const unsigned*)((const char*)(gbase) + (voff)[i_]), (PG8_LAS unsigned*)(lds + (bufoff) + ldsw + (i_) * 8192), 16, 0, 0)
#define F8_STAGE(bufoff, gbase, voff) do { F8_STAGE1(bufoff, gbase, voff, 0); F8_STAGE1(bufoff, gbase, voff, 1); } while (0)
#define F8_LDA1(dst, b, h, m) do { const v4i_t l_ = *(const PG8_LAS v4i_t*)(lds + F8_SA(b, h) + aoffL + (m) * 2048), h_ = *(const PG8_LAS v4i_t*)(lds + F8_SA(b, h) + aoffH + (m) * 2048); \
        dst[m] = (v8i_t){l_[0], l_[1], l_[2], l_[3], h_[0], h_[1], h_[2], h_[3]}; } while (0)
#define F8_LDB1(dst, b, n) do { const v4i_t l_ = *(const PG8_LAS v4i_t*)(lds + F8_SB(b) + boffL + (n) * 2048), h_ = *(const PG8_LAS v4i_t*)(lds + F8_SB(b) + boffH + (n) * 2048); \
        dst[n] = (v8i_t){l_[0], l_[1], l_[2], l_[3], h_[0], h_[1], h_[2], h_[3]}; } while (0)
#define F8_LDA(dst, b, h) do { F8_LDA1(dst, b, h, 0); F8_LDA1(dst, b, h, 1); F8_LDA1(dst, b, h, 2); F8_LDA1(dst, b, h, 3); } while (0)
#define F8_LDB(dst, b) do { F8_LDB1(dst, b, 0); F8_LDB1(dst, b, 1); } while (0)
#define F8_MMA1(ai, m, At, Bf) do { _Pragma("unroll") for (int n = 0; n < 2; ++n) \
        acc[ai][m][n] = __builtin_amdgcn_mfma_scale_f32_16x16x128_f8f6f4(Bf[n], At[m], acc[ai][m][n], 0, 0, 0, g.scale_b, 0, 0x7f7f7f7f); } while (0)
#define F8_WAIT_V(n) asm volatile("s_waitcnt vmcnt(" #n ")" ::: "memory")
#define F8_WAIT_L(n) asm volatile("s_waitcnt lgkmcnt(" #n ")" ::: "memory")
#define F8_BAR __builtin_amdgcn_s_barrier()
#define F8_SCHED __builtin_amdgcn_sched_barrier(0)
#define F8_GOFF(o0, o1, tab, nv) do { _Pragma("unroll") for (int _i = 0; _i < 2; ++_i) { const unsigned e0_ = (tab)[rA[_i]], e1_ = (tab)[HALF + rA[_i]]; \
        o0[_i] = ((rA[_i] < (nv)) ? (e0_ >> 1) : 0u) * (unsigned)(g.lda * 2) + cbA[_i]; o1[_i] = ((HALF + rA[_i] < (nv)) ? (e1_ >> 1) : 0u) * (unsigned)(g.lda * 2) + cbA[_i]; } } while (0)
    Unit cur, nxt; int ui = 0;
    if (!S.next(0, cur)) return;
    f32x4 acc[2][4][2];
#pragma unroll
    for (int a = 0; a < 2; ++a)
#pragma unroll
        for (int m = 0; m < 4; ++m)
#pragma unroll
            for (int n = 0; n < 2; ++n) acc[a][m][n] = (f32x4){0.f, 0.f, 0.f, 0.f};
    v8i_t AtA[4], AtB[4], BfA[2], BfB[2];
    int tbuf = 0, tnext = 1;
    { const int lo_ = S.listoff(cur.pm); if (tid < 256) tt[tid] = g.rowlist[lo_ + tid]; else tt[tid] = g.wlist[lo_ + tid - 256]; }
    asm volatile("s_waitcnt vmcnt(0) lgkmcnt(0)" ::: "memory"); F8_BAR; asm volatile("" ::: "memory");
    F8_GOFF(c0, c1, tt, S.rows(cur.pm));
    const char* cA = (const char*)g.A + S.kbytes(cur, K); const char* cB = (const char*)g.Bt + (size_t)S.expert(cur.pm) * g.bstride + (size_t)cur.pn * tstepB + S.kbytes(cur, K);
    F8_STAGE(F8_SB(0), cB, voffB); F8_STAGE(F8_SA(0, 0), cA, c0); F8_STAGE(F8_SA(0, 1), cA, c1);
    F8_STAGE(F8_SB(1), cB + kstep, voffB); F8_STAGE(F8_SA(1, 0), cA + kstep, c0); F8_STAGE(F8_SA(1, 1), cA + kstep, c1);
    F8_WAIT_V(8); F8_BAR;
    F8_LDB(BfA, 0); F8_LDA(AtA, 0, 0);
    for (;;) {
        const bool has_next = S.next(ui + 1, nxt);
        const char* nA = has_next ? (const char*)g.A + S.kbytes(nxt, K) : cA; const char* nB = has_next ? (const char*)g.Bt + (size_t)S.expert(nxt.pm) * g.bstride + (size_t)nxt.pn * tstepB + S.kbytes(nxt, K) : cB;
        if (has_next) { const unsigned* src_ = (wid < 4 ? g.rowlist : g.wlist) + S.listoff(nxt.pm) + (wid & 3) * 64 + lane;
            __builtin_amdgcn_global_load_lds(src_, (PG8_LAS unsigned*)(tt + tnext * 512 + wid * 64), 4, 0, 0); }
#pragma unroll 1
        for (int t = 0; t < nt; t += 2) {
            const bool last = (t == nt - 2);
            if (last && has_next) F8_GOFF(n0, n1, tt + tnext * 512, S.rows(nxt.pm));
            const char* a2 = last ? nA : cA + (size_t)(t + 2) * kstep; const char* b2 = last ? nB : cB + (size_t)(t + 2) * kstep;
            const char* a3 = a2 + kstep; const char* b3 = b2 + kstep;
            unsigned x0[2], x1[2];
#pragma unroll
            for (int i = 0; i < 2; ++i) { x0[i] = (last && has_next) ? n0[i] : c0[i]; x1[i] = (last && has_next) ? n1[i] : c1[i]; }
#define F8_TOP F8_WAIT_V(6); F8_WAIT_L(0); F8_BAR; F8_SCHED
#define F8_SP1(b, Bf, bp, ap, xo) F8_TOP; \
            F8_MMA1(0, 0, AtA, Bf); F8_SCHED; F8_STAGE1(F8_SB(b), bp, voffB, 0); F8_LDA1(AtB, b, 1, 0); F8_SCHED; F8_MMA1(0, 1, AtA, Bf); F8_SCHED; F8_STAGE1(F8_SB(b), bp, voffB, 1); F8_LDA1(AtB, b, 1, 1); F8_SCHED; \
            F8_MMA1(0, 2, AtA, Bf); F8_SCHED; F8_STAGE1(F8_SA(b, 0), ap, xo, 0); F8_LDA1(AtB, b, 1, 2); F8_SCHED; F8_MMA1(0, 3, AtA, Bf); F8_SCHED; F8_STAGE1(F8_SA(b, 0), ap, xo, 1); F8_LDA1(AtB, b, 1, 3); F8_SCHED
#define F8_SP2(b, Bf, Bn, ap, xo) F8_TOP; \
            F8_MMA1(1, 0, AtB, Bf); F8_SCHED; F8_STAGE1(F8_SA(b, 1), ap, xo, 0); F8_LDB1(Bn, (b) ^ 1, 0); F8_LDA1(AtA, (b) ^ 1, 0, 0); F8_SCHED; F8_MMA1(1, 1, AtB, Bf); F8_SCHED; F8_STAGE1(F8_SA(b, 1), ap, xo, 1); F8_LDB1(Bn, (b) ^ 1, 1); F8_LDA1(AtA, (b) ^ 1, 0, 1); F8_SCHED; \
            F8_MMA1(1, 2, AtB, Bf); F8_SCHED; F8_LDA1(AtA, (b) ^ 1, 0, 2); F8_SCHED; F8_MMA1(1, 3, AtB, Bf); F8_SCHED; F8_LDA1(AtA, (b) ^ 1, 0, 3); F8_SCHED
            F8_SP1(0, BfA, b2, a2, x0); F8_SP2(0, BfA, BfB, a2, x1);
            F8_SP1(1, BfB, b3, a3, x0); F8_SP2(1, BfB, BfA, a3, x1);
#undef F8_TOP
#undef F8_SP1
#undef F8_SP2
        }
        F8_WAIT_L(0);
        E(acc, cur, wr, wc, fr, fq, tt + tbuf * 512);
        if (!has_next) break;
#pragma unroll
        for (int a = 0; a < 2; ++a)
#pragma unroll
            for (int m = 0; m < 4; ++m)
#pragma unroll
                for (int n = 0; n < 2; ++n) acc[a][m][n] = (f32x4){0.f, 0.f, 0.f, 0.f};
        cur = nxt; cA = nA; cB = nB; ++ui; tbuf = tnext; tnext = (tnext == 2) ? 0 : tnext + 1;
#pragma unroll
        for (int i = 0; i < 2; ++i) { c0[i] = n0[i]; c1[i] = n1[i]; }
    }
    F8_WAIT_V(0);
    F8_BAR;
#undef F8_SA
#undef F8_SB
#undef F8_STAGE1
#undef F8_STAGE
#undef F8_LDA1
#undef F8_LDB1
#undef F8_LDA
#undef F8_LDB
#undef F8_MMA1
#undef F8_WAIT_V
#undef F8_WAIT_L
#undef F8_BAR
#undef F8_SCHED
#undef F8_GOFF
}
}
namespace attn_body {
using bf16=__hip_bfloat16;
using bf16x8=__attribute__((ext_vector_type(8)))short;
using s16x4=__attribute__((ext_vector_type(4)))short;
using f32x16=__attribute__((ext_vector_type(16)))float;
using u32x4=__attribute__((ext_vector_type(4)))unsigned;
using f32x4v=__attribute__((ext_vector_type(4)))float;
constexpr int BATCH=16,NHEAD=16,SEQ=2048,D=64,DM=NHEAD*D;
constexpr int NW=8,QBLK=32,QB=QBLK*NW,KVBLK=64,NQB=SEQ/QB;
constexpr int ATTN_PITCH=DM, ATTN_UNIT_ROWS=QB;
__device__ __forceinline__ int crow(int r,int hi){return (r&3)+8*(r>>2)+4*hi;}
#define SBAR() __builtin_amdgcn_sched_barrier(0)
__device__ __forceinline__ void cmask(f32x16&p0,f32x16&p1,int jb,int qrel,int hi){
  const float NEG=-INFINITY; int kb=64*jb+4*hi;
  #pragma unroll
  for(int r=0;r<16;++r){int kv=kb+(r&3)+8*(r>>2); if(kv>qrel)p0[r]=NEG; if(kv+32>qrel)p1[r]=NEG;}
}

constexpr int NSLOT=3, SLOTB=8192;
constexpr int LDS_K=0, LDS_V=NSLOT*SLOTB, LDS_WS=2*NSLOT*SLOTB, LDS_OST=LDS_WS+NW*64*4, LDS_FB=LDS_OST+NW*4096, LDS_BYTES=LDS_FB+SEQ*16;
constexpr float C2=0.125f*1.4426950408889634f;
__device__ __forceinline__ void glds16(const void*gsrc,unsigned lds_dst){unsigned keep;
  asm volatile("s_mov_b32 %0, m0\n\ts_mov_b32 m0, %2\n\ts_nop 0\n\tglobal_load_lds_dwordx4 %1, off\n\ts_mov_b32 m0, %0":"=&s"(keep):"v"(gsrc),"s"(lds_dst):"memory");}
__device__ __forceinline__ float max3f(float a,float b,float c){float r;asm("v_max3_f32 %0, %1, %2, %3":"=v"(r):"v"(a),"v"(b),"v"(c));return r;}
__device__ __forceinline__ float max2f(float a,float b){float r;asm("v_max_f32_e32 %0, %1, %2":"=v"(r):"v"(a),"v"(b));return r;}
__device__ __forceinline__ float fadd_s(float a,float b){float r;asm("v_add_f32_e32 %0, %1, %2":"=v"(r):"v"(a),"v"(b));return r;}
__device__ __forceinline__ float fsub_s(float a,float b){float r;asm("v_sub_f32_e32 %0, %1, %2":"=v"(r):"v"(a),"v"(b));return r;}
typedef float f32x2_t __attribute__((ext_vector_type(2))); typedef __bf16 bf16x2_t __attribute__((ext_vector_type(2)));
__device__ __forceinline__ unsigned cvtpk_s(float lo,float hi){f32x2_t v={lo,hi};bf16x2_t b=__builtin_convertvector(v,bf16x2_t);return __builtin_bit_cast(unsigned,b);}
#define WAIT_BAR(N) asm volatile("s_waitcnt vmcnt(" #N ") lgkmcnt(0)\n\ts_barrier":::"memory")

__device__ __forceinline__ bf16x8 mk_qbias(float mhat,int hi){
  const float x=-mhat; const unsigned h=cvtpk_s(x,0.f)&0xffffu; const float r1=x-__uint_as_float(h<<16); const unsigned m=cvtpk_s(r1,0.f)&0xffffu; const float r2=r1-__uint_as_float(m<<16); const unsigned l=cvtpk_s(r2,0.f)&0xffffu;
  u32x4 w; w[0]=0x3F803F80u; w[1]=0x3F80u|(h<<16); w[2]=m|(l<<16); w[3]=0u; if(hi){w[0]=0u;w[1]=0u;w[2]=0u;} return __builtin_bit_cast(bf16x8,w);
}
__device__ __forceinline__ void qkt(f32x16&p0,f32x16&p1,const char*Kslot,const bf16x8*qr,bf16x8 fk0,bf16x8 fk1,bf16x8 qbias,int r32,int hi){
  const char*kb=Kslot+hi*1024+r32*16;
  p0=__builtin_amdgcn_mfma_f32_32x32x16_bf16(fk0,qbias,f32x16{},0,0,0);p1=__builtin_amdgcn_mfma_f32_32x32x16_bf16(fk1,qbias,f32x16{},0,0,0);
  #pragma unroll
  for(int d0=0;d0<4;++d0){
    const bf16x8 b0=*reinterpret_cast<const bf16x8*>(kb+d0*2048);
    const bf16x8 b1=*reinterpret_cast<const bf16x8*>(kb+d0*2048+512);
    p0=__builtin_amdgcn_mfma_f32_32x32x16_bf16(b0,qr[d0],p0,0,0,0);p1=__builtin_amdgcn_mfma_f32_32x32x16_bf16(b1,qr[d0],p1,0,0,0);}
}
typedef __attribute__((address_space(3))) const char* lds_cptr;
typedef short v4i16_t __attribute__((ext_vector_type(4)));
__device__ __forceinline__ void kload8(bf16x8*kf,lds_cptr kp){
  kf[0]=*(const __attribute__((address_space(3))) bf16x8*)(kp);      kf[1]=*(const __attribute__((address_space(3))) bf16x8*)(kp+512);
  kf[2]=*(const __attribute__((address_space(3))) bf16x8*)(kp+2048); kf[3]=*(const __attribute__((address_space(3))) bf16x8*)(kp+2560);
  kf[4]=*(const __attribute__((address_space(3))) bf16x8*)(kp+4096); kf[5]=*(const __attribute__((address_space(3))) bf16x8*)(kp+4608);
  kf[6]=*(const __attribute__((address_space(3))) bf16x8*)(kp+6144); kf[7]=*(const __attribute__((address_space(3))) bf16x8*)(kp+6656);
}
__device__ __forceinline__ void kload2(bf16x8*kf,lds_cptr kp,int j){ kf[2*j]=*(const __attribute__((address_space(3))) bf16x8*)(kp+j*2048); kf[2*j+1]=*(const __attribute__((address_space(3))) bf16x8*)(kp+j*2048+512); }
__device__ __forceinline__ s16x4 vtr(lds_cptr p){ return __builtin_bit_cast(s16x4,__builtin_amdgcn_ds_read_tr16_b64_v4i16((__attribute__((address_space(3))) v4i16_t*)p)); }
__device__ __forceinline__ float rowmax(const f32x16&p0,const f32x16&p1){
  float a=max3f(p0[0],p0[1],p1[0]),b=max3f(p0[2],p0[3],p1[1]);a=max3f(a,p1[2],p1[3]);
  #pragma unroll
  for(int r=4;r<16;r+=4){a=max3f(a,p0[r],p0[r+1]);b=max3f(b,p0[r+2],p0[r+3]);a=max3f(a,p1[r],p1[r+1]);b=max3f(b,p1[r+2],p1[r+3]);}
  const float m=max2f(a,b);
  auto rr=__builtin_amdgcn_permlane32_swap(__float_as_uint(m),__float_as_uint(m),false,false);
  return max2f(__uint_as_float(rr[0]),__uint_as_float(rr[1]));
}
__device__ __forceinline__ void pv(f32x16*o,int vb,bf16x8 pa0,bf16x8 pa1,bf16x8 pa2,bf16x8 pa3){
  #pragma unroll
  for(int d0=0;d0<2;++d0){s16x4 lo[4],hi[4];
    #pragma unroll
    for(int ks=0;ks<4;++ks){
      asm volatile("ds_read_b64_tr_b16 %0,%1 offset:%c2":"=&v"(lo[ks]):"v"(vb),"i"(d0*4096+ks*1024):"memory");
      asm volatile("ds_read_b64_tr_b16 %0,%1 offset:%c2":"=&v"(hi[ks]):"v"(vb),"i"(d0*4096+ks*1024+512):"memory");}
    asm volatile("s_waitcnt lgkmcnt(0)":::"memory");SBAR();
    #define PK(k) (bf16x8){lo[k][0],lo[k][1],lo[k][2],lo[k][3],hi[k][0],hi[k][1],hi[k][2],hi[k][3]}
    o[d0]=__builtin_amdgcn_mfma_f32_32x32x16_bf16(pa0,PK(0),o[d0],0,0,0);
    o[d0]=__builtin_amdgcn_mfma_f32_32x32x16_bf16(pa1,PK(1),o[d0],0,0,0);
    o[d0]=__builtin_amdgcn_mfma_f32_32x32x16_bf16(pa2,PK(2),o[d0],0,0,0);
    o[d0]=__builtin_amdgcn_mfma_f32_32x32x16_bf16(pa3,PK(3),o[d0],0,0,0);
    #undef PK
  }
}

#ifndef ATTN_STORE16
#define ATTN_STORE16(p,v) (*(u32x4*)(p)=(v))
#endif
template<int THRL> __device__ __forceinline__ void attn_unit(int b,int h,int qb,const bf16*Q,const bf16*__restrict__ K,const bf16*__restrict__ V,const bf16*__restrict__ G,bf16*O,char*shm){
  int tid_=threadIdx.x; asm volatile("":"+v"(tid_)); const int tid=tid_,lane=tid&63,r32=lane&31,hi=lane>>5; const int wid=__builtin_amdgcn_readfirstlane(tid>>6);
  const long rowbase=(long)b*SEQ; const int q0=qb*QB;
  const bf16*Qw=Q+(rowbase+q0+wid*QBLK)*DM+h*D;
  const bf16*Kh=K+rowbase*DM+h*D,*Vh=V+rowbase*DM+h*D;
  const unsigned lds0=(unsigned)(uintptr_t)shm;
  float*wsf=(float*)(shm+LDS_WS)+wid*64;
  const bf16*ksrc=Kh+(long)lane*DM+wid*8;
  const bf16*vsrc=Vh+(long)(16*(wid&3)+(lane>>2))*DM+(wid>>2)*32+(lane&3)*8;
  const unsigned kdst=lds0+LDS_K+wid*1024, vdst=lds0+LDS_V+wid*1024;
  #define DMA_K(t,slot) glds16(ksrc+(long)(t)*KVBLK*DM,(unsigned)__builtin_amdgcn_readfirstlane(kdst+(slot)))
  #define DMA_V(t,slot) glds16(vsrc+(long)(t)*KVBLK*DM,(unsigned)__builtin_amdgcn_readfirstlane(vdst+(slot)))
  const int vb0=(int)(lds0+LDS_V)+((lane>>4)&1)*32+(lane&3)*8+(4*hi+((lane&15)>>2))*64;
  const char*Kbase=shm+LDS_K; bf16x8 kf[8];
  const lds_cptr shm3=(lds_cptr)shm; const lds_cptr kp0=shm3+LDS_K+hi*1024+r32*16; const lds_cptr vp0=shm3+LDS_V+((lane>>4)&1)*32+(lane&3)*8+(4*hi+((lane&15)>>2))*64;
  const int NT=(q0+QB)/KVBLK;
  DMA_K(0,0);DMA_V(0,0);DMA_K(1,SLOTB);
  bf16x8 qr[4];
  #pragma unroll
  for(int d0=0;d0<4;++d0)qr[d0]=*reinterpret_cast<const bf16x8*>(&Qw[(long)r32*DM+d0*16+hi*8]);
  float mhat; { const u32x4 eq=*(const __attribute__((address_space(3))) u32x4*)(shm3+LDS_FB+(q0+wid*QBLK+r32)*16); mhat=__uint_as_float(eq[0]<<16)+__uint_as_float(eq[0]&0xffff0000u)+__uint_as_float(eq[1]<<16); }
  float l_reg=0.f;f32x16 o[2];o[0]=f32x16{};o[1]=f32x16{};bf16x8 qbias=mk_qbias(mhat,hi);asm volatile("":"+v"(qbias));
  const int qrel=wid*QBLK+r32;
  #define CMASK(P0,P1,t) do{int jb_=(t)-(NT-4); if(jb_>=0)cmask(P0,P1,jb_,qrel,hi);}while(0)
  const lds_cptr fbt=shm3+LDS_FB+r32*16;
  #define FKLD(t,blk) (*(const __attribute__((address_space(3))) bf16x8*)(fbt+((t)*64+(blk)*32)*16))
  bool resc=false;
  #define START(P0,P1) do{ const float rm=rowmax(P0,P1); resc=false; \
    { const float dl=rm; mhat=fadd_s(mhat,dl); \
      _Pragma("unroll") for(int r=0;r<16;++r){P0[r]=fsub_s(P0[r],dl);P1[r]=fsub_s(P1[r],dl);} \
      qbias=mk_qbias(mhat,hi); asm volatile("":"+v"(qbias)); } \
    _Pragma("unroll") for(int r=0;r<16;++r)P0[r]=__builtin_amdgcn_exp2f(P0[r]); }while(0)
  #define RESC() do{ if(resc){ asm volatile("s_waitcnt lgkmcnt(0)":::"memory"); \
      _Pragma("unroll") for(int d_=0;d_<2;++d_) _Pragma("unroll") for(int r=0;r<16;++r)o[d_][r]*=wsf[crow(r,hi)]; } }while(0)
  f32x16 pA0,pA1,pB0,pB1;
  int sl_prev=0,sl_cur=0,sl_next=SLOTB;
  #define ROT() do{sl_prev=sl_cur;sl_cur=sl_next;sl_next=(sl_next==(NSLOT-1)*SLOTB)?0:sl_next+SLOTB;}while(0)
  DMA_K(2,2*SLOTB);
  WAIT_BAR(3);
  qkt(pA0,pA1,Kbase,qr,FKLD(0,0),FKLD(0,1),qbias,r32,hi);asm volatile("s_nop 15\n\ts_nop 7":"+v"(pA0),"+v"(pA1));CMASK(pA0,pA1,0);
  START(pA0,pA1);
  _Pragma("unroll") for(int r=0;r<16;++r)pA1[r]=__builtin_amdgcn_exp2f(pA1[r]);
  WAIT_BAR(0);
  DMA_K(3,0);DMA_V(1,SLOTB);
  ROT();
  kload8(kf,kp0+sl_cur);
  WAIT_BAR(2);
  s16x4 vlo[8],vhi[8]; u32x4 pw0,pw1,pw2,pw3;
  #define PKW(P,B) cvtpk_s(P[B],P[B+1])
  #define PAF(k) __builtin_bit_cast(bf16x8,pw##k)
  #define VFR(i) (bf16x8){vlo[i][0],vlo[i][1],vlo[i][2],vlo[i][3],vhi[i][0],vhi[i][1],vhi[i][2],vhi[i][3]}
  #define PIN(x) asm volatile("":"+v"(x))
  #define MX3(a,b,c) __builtin_fmaxf(__builtin_fmaxf((a),(b)),(c))
  #define GAPA(MF,A0,A1,A2,A3,W0,W1,PW) do{ MF; sacc+=A0; sacc+=A1; sacc+=A2; sacc+=A3; PIN(sacc); W0; W1; PIN(PW); SBAR(); }while(0)
  #define EX(v) __builtin_amdgcn_exp2f(v)
  #define GAPB(MF,X,B) do{ MF; X[B]=EX(X[B]); X[B+1]=EX(X[B+1]); X[B+2]=EX(X[B+2]); X[B+3]=EX(X[B+3]); PIN(X); SBAR(); }while(0)
  #define VRD(i) do{ vlo[i]=vtr(vp_+(((i)>>2)*4096+((i)&3)*1024)); vhi[i]=vtr(vp_+(((i)>>2)*4096+((i)&3)*1024+512)); }while(0)
  #define KRD(G,j) do{ if(G){ kload2(kf,kp0+sl_next,j); SBAR(); } }while(0)
  #define STEP(C0,C1,P0,P1,t,GK,GV,GL) do{ SBAR(); \
    const lds_cptr vp_=vp0+sl_prev; const bf16x8 fk0_=FKLD(t,0), fk1_=FKLD(t,1); \
    VRD(0); SBAR(); float sacc=(P0[0]+P0[1]); \
    GAPA(C0=__builtin_amdgcn_mfma_f32_32x32x16_bf16(kf[0],qr[0],f32x16{},0,0,0), P0[2],P0[3],P0[4],P0[5],     pw0[0]=PKW(P0,0), pw0[1]=PKW(P0,2), pw0); \
    VRD(4); SBAR(); GAPA(C1=__builtin_amdgcn_mfma_f32_32x32x16_bf16(kf[1],qr[0],f32x16{},0,0,0), P0[6],P0[7],P0[8],P0[9],     pw0[2]=PKW(P0,4), pw0[3]=PKW(P0,6), pw0); \
    VRD(1); SBAR(); GAPA(C0=__builtin_amdgcn_mfma_f32_32x32x16_bf16(kf[2],qr[1],C0,0,0,0),   P0[10],P0[11],P0[12],P0[13], pw1[0]=PKW(P0,8), pw1[1]=PKW(P0,10), pw1); \
    VRD(5); SBAR(); GAPA(C1=__builtin_amdgcn_mfma_f32_32x32x16_bf16(kf[3],qr[1],C1,0,0,0),   P0[14],P0[15],P1[0],P1[1],   pw1[2]=PKW(P0,12),pw1[3]=PKW(P0,14), pw1); \
    VRD(2); SBAR(); GAPA(C0=__builtin_amdgcn_mfma_f32_32x32x16_bf16(kf[4],qr[2],C0,0,0,0),   P1[2],P1[3],P1[4],P1[5],     pw2[0]=PKW(P1,0), pw2[1]=PKW(P1,2), pw2); \
    VRD(6); SBAR(); GAPA(C1=__builtin_amdgcn_mfma_f32_32x32x16_bf16(kf[5],qr[2],C1,0,0,0),   P1[6],P1[7],P1[8],P1[9],     pw2[2]=PKW(P1,4), pw2[3]=PKW(P1,6), pw2); \
    VRD(3); SBAR(); GAPA(C0=__builtin_amdgcn_mfma_f32_32x32x16_bf16(kf[6],qr[3],C0,0,0,0),   P1[10],P1[11],P1[12],P1[13], pw3[0]=PKW(P1,8), pw3[1]=PKW(P1,10), pw3); \
    VRD(7); SBAR(); GAPA(C1=__builtin_amdgcn_mfma_f32_32x32x16_bf16(kf[7],qr[3],C1,0,0,0),   P1[14],P1[15],0.f,0.f,       pw3[2]=PKW(P1,12),pw3[3]=PKW(P1,14), pw3); \
    C0=__builtin_amdgcn_mfma_f32_32x32x16_bf16(fk0_,qbias,C0,0,0,0); C1=__builtin_amdgcn_mfma_f32_32x32x16_bf16(fk1_,qbias,C1,0,0,0); \
    l_reg+=sacc; \
    if(GK){DMA_K((t)+3,sl_cur);} if(GV){DMA_V((t)+1,sl_next);} \
    CMASK(C0,C1,t); \
    { float a=MX3(C0[0],C0[1],C1[0]),b=MX3(C0[2],C0[3],C1[1]); a=MX3(a,C1[2],C1[3]); \
      _Pragma("unroll") for(int r=4;r<16;r+=4){a=MX3(a,C0[r],C0[r+1]);b=MX3(b,C0[r+2],C0[r+3]);a=MX3(a,C1[r],C1[r+1]);b=MX3(b,C1[r+2],C1[r+3]);} \
      float rm=__builtin_fmaxf(a,b); { auto rr=__builtin_amdgcn_permlane32_swap(__float_as_uint(rm),__float_as_uint(rm),false,false); rm=__builtin_fmaxf(__uint_as_float(rr[0]),__uint_as_float(rr[1])); } \
      resc=false; \
      if(__builtin_expect(__any(rm>(float)THRL),0)){ const float dl=__builtin_fmaxf(rm,0.f); mhat+=dl; \
        _Pragma("unroll") for(int r=0;r<16;++r){C0[r]-=dl;C1[r]-=dl;} \
        qbias=mk_qbias(mhat,hi); asm volatile("":"+v"(qbias)); \
        const float f=__builtin_amdgcn_exp2f(-dl); l_reg*=f; if(hi==0)wsf[r32]=f; resc=true; } } \
    SBAR(); \
    GAPB(o[0]=__builtin_amdgcn_mfma_f32_32x32x16_bf16(PAF(0),VFR(0),o[0],0,0,0), C0,0); \
    GAPB(o[1]=__builtin_amdgcn_mfma_f32_32x32x16_bf16(PAF(0),VFR(4),o[1],0,0,0), C0,4); \
    KRD(GL,0); GAPB(o[0]=__builtin_amdgcn_mfma_f32_32x32x16_bf16(PAF(1),VFR(1),o[0],0,0,0), C0,8); \
    KRD(GL,1); GAPB(o[1]=__builtin_amdgcn_mfma_f32_32x32x16_bf16(PAF(1),VFR(5),o[1],0,0,0), C0,12); \
    KRD(GL,2); GAPB(o[0]=__builtin_amdgcn_mfma_f32_32x32x16_bf16(PAF(2),VFR(2),o[0],0,0,0), C1,0); \
    KRD(GL,3); GAPB(o[1]=__builtin_amdgcn_mfma_f32_32x32x16_bf16(PAF(2),VFR(6),o[1],0,0,0), C1,4); \
    GAPB(o[0]=__builtin_amdgcn_mfma_f32_32x32x16_bf16(PAF(3),VFR(3),o[0],0,0,0), C1,8); \
    GAPB(o[1]=__builtin_amdgcn_mfma_f32_32x32x16_bf16(PAF(3),VFR(7),o[1],0,0,0), C1,12); \
    }while(0)
  int t=1;
  #undef CMASK
  #define CMASK(P0,P1,t) do{}while(0)
  for(;t+5<NT;t+=2){
    STEP(pB0,pB1,pA0,pA1,t,true,true,true);     WAIT_BAR(2); RESC(); ROT();
    STEP(pA0,pA1,pB0,pB1,t+1,true,true,true);   WAIT_BAR(2); RESC(); ROT();
  }
  #undef CMASK
  #define CMASK(P0,P1,t) do{int jb_=(t)-(NT-4); if(jb_>=0)cmask(P0,P1,jb_,qrel,hi);}while(0)
  #define ENDW(tt) do{ if((tt)+3<NT){WAIT_BAR(2);} else if((tt)+2<NT){WAIT_BAR(1);} else {WAIT_BAR(0);} }while(0)
  for(;t+1<NT;t+=2){
    STEP(pB0,pB1,pA0,pA1,t,(t+3<NT),(t+1<NT),(t+1<NT));       ENDW(t);   RESC(); ROT();
    STEP(pA0,pA1,pB0,pB1,t+1,(t+4<NT),(t+2<NT),(t+2<NT));     ENDW(t+1); RESC(); ROT();
  }
  STEP(pB0,pB1,pA0,pA1,NT-1,false,false,false); RESC();
  u32x4 ggv[4];
  { const bf16*Gw_=G+(rowbase+q0+wid*QBLK)*DM+h*D;
    #pragma unroll
    for(int i=0;i<4;++i)ggv[i]=*(const u32x4*)(Gw_+(long)(i*8+(lane>>3))*DM+(lane&7)*8); }
  { float sacc=pB0[0]+pB0[1]; _Pragma("unroll") for(int r=2;r<16;++r)sacc+=pB0[r]; _Pragma("unroll") for(int r=0;r<16;++r)sacc+=pB1[r]; l_reg+=sacc;
    pw0=(u32x4){PKW(pB0,0),PKW(pB0,2),PKW(pB0,4),PKW(pB0,6)};pw1=(u32x4){PKW(pB0,8),PKW(pB0,10),PKW(pB0,12),PKW(pB0,14)};pw2=(u32x4){PKW(pB1,0),PKW(pB1,2),PKW(pB1,4),PKW(pB1,6)};pw3=(u32x4){PKW(pB1,8),PKW(pB1,10),PKW(pB1,12),PKW(pB1,14)};
    SBAR(); pv(o,vb0+sl_cur,PAF(0),PAF(1),PAF(2),PAF(3)); }
  #undef PKW
  #undef PAF
  #undef VFR
  #undef PIN
  #undef MX3
  #undef GAPA
  #undef GAPB
  #undef EX
  #undef VRD
  #undef KRD
  #undef STEP
  #undef ENDW
  {auto rr=__builtin_amdgcn_permlane32_swap(__float_as_uint(l_reg),__float_as_uint(l_reg),false,false);l_reg=__uint_as_float(rr[0])+__uint_as_float(rr[1]);}
  if(hi==0)wsf[32+r32]=l_reg;asm volatile("s_waitcnt lgkmcnt(0)":::"memory");
  float rli[16];
  #pragma unroll
  for(int r=0;r<16;++r)rli[r]=__builtin_amdgcn_rcpf(wsf[32+crow(r,hi)]);
  bf16*Ow=O+(rowbase+q0+wid*QBLK)*DM+h*D;
  { bf16*stg=(bf16*)(shm+LDS_OST)+wid*2048;
    #pragma unroll
    for(int r=0;r<16;++r){const int orow=crow(r,hi);
      #pragma unroll
      for(int d0=0;d0<2;++d0)stg[orow*64+d0*32+r32]=__float2bfloat16(o[d0][r]*rli[r]);}
    asm volatile("s_waitcnt lgkmcnt(0)":::"memory");
    #pragma unroll
    for(int i=0;i<4;++i){const int row=i*8+(lane>>3),ch=lane&7; const u32x4 v=*(const u32x4*)(stg+row*64+ch*8); const u32x4 gg=ggv[i]; u32x4 w;
      #pragma unroll
      for(int c=0;c<4;++c){ const float lo=__uint_as_float(v[c]<<16)*__uint_as_float(gg[c]<<16), hh=__uint_as_float(v[c]&0xffff0000u)*__uint_as_float(gg[c]&0xffff0000u); w[c]=cvtpk_s(lo,hh); }
      ATTN_STORE16(Ow+(long)row*DM+ch*8,w);} }
  asm volatile("s_waitcnt lgkmcnt(0)\n\ts_barrier":::"memory");
  #undef DMA_K
  #undef DMA_V
  #undef CMASK
  #undef FKLD
  #undef START
  #undef RESC
  #undef ROT
}
constexpr int ATTN_LDS_BYTES=LDS_BYTES;
struct AttnTensors { const bf16* Q; const bf16* K; const bf16* V; const bf16* G; bf16* O; const u32x4* FBT; };
struct AttnUnit { int bh; int qb; };
struct StaticOrder {
  int vcu, G;
  __device__ __forceinline__ bool next(int i,AttnUnit&u)const{ u.bh=vcu+(i>>3)*G; if(u.bh>=BATCH*NHEAD)return false; u.qb=(i+(vcu&7))&7; return true; }
};
__device__ __forceinline__ void scan_bias_table(char*lds,const float*FG,const float*bfp,int bh,u32x4*tab){
  float*wtot=(float*)lds; const int b_=bh/NHEAD,h_=bh%NHEAD,t_=threadIdx.x,ln_=t_&63,wv_=t_>>6; const float bf_=bfp[h_]; float p_[4]; float run=0.f;
  #pragma unroll
  for(int i=0;i<4;++i){ const float xg=FG[((size_t)b_*SEQ+4*t_+i)*NHEAD+h_]+bf_; run+=(xg>=0.f?-log1pf(expf(-xg)):xg-log1pf(expf(xg))); p_[i]=run; }
  float inc=run;
  #pragma unroll
  for(int o=1;o<64;o<<=1){ const float tt=__shfl_up(inc,o); if(ln_>=o)inc+=tt; }
  __syncthreads();
  if(ln_==63)wtot[wv_]=inc;
  __syncthreads();
  float base_=inc-run; for(int w=0;w<wv_;++w)base_+=wtot[w];
  #pragma unroll
  for(int i=0;i<4;++i){ const float x=-1.4426950408889634f*(base_+p_[i]); const unsigned h=cvtpk_s(x,0.f)&0xffffu; const float r1=x-__uint_as_float(h<<16); const unsigned m=cvtpk_s(r1,0.f)&0xffffu;
    const float r2=r1-__uint_as_float(m<<16); const unsigned l=cvtpk_s(r2,0.f)&0xffffu; u32x4 w; w[0]=h|(m<<16); w[1]=l|(0x3F80u<<16); w[2]=0x3F803F80u; w[3]=0u; tab[(size_t)bh*SEQ+4*t_+i]=w; }
}
template<class Sched,int THRL=8> __device__ __forceinline__ void attn_phase(char*lds,const AttnTensors&T,const Sched&S){
  AttnUnit u; int cur=-1;
  for(int i=0;S.next(i,u);++i){
    if(u.bh!=cur){ cur=u.bh; u32x4*fb=(u32x4*)(lds+LDS_FB); const u32x4*src=T.FBT+(size_t)u.bh*SEQ;
      #pragma unroll
      for(int k=0;k<SEQ/(NW*64);++k)fb[threadIdx.x+k*NW*64]=src[threadIdx.x+k*NW*64];
      asm volatile("s_waitcnt vmcnt(0) lgkmcnt(0)\n\ts_barrier":::"memory"); }
    attn_unit<THRL>(u.bh/NHEAD,u.bh%NHEAD,u.qb,T.Q,T.K,T.V,T.G,T.O,lds);
  }
}
#undef SBAR
#undef WAIT_BAR
}
#define GAS __attribute__((address_space(1)))
#define LAS __attribute__((address_space(3)))
typedef unsigned short bf16;
typedef unsigned v4u __attribute__((ext_vector_type(4)));
typedef float f32x4 __attribute__((ext_vector_type(4)));
typedef short bf16x8 __attribute__((ext_vector_type(8)));
typedef GAS unsigned gu32;
typedef GAS unsigned long long gu64;
#define RLX_AGENT __ATOMIC_RELAXED, __HIP_MEMORY_SCOPE_AGENT
#define LDS_WAIT() asm volatile("s_waitcnt lgkmcnt(0)" ::: "memory")
#define VM_WAIT() asm volatile("s_waitcnt vmcnt(0)" ::: "memory")
__device__ __forceinline__ unsigned long long rt() { return __builtin_amdgcn_s_memrealtime(); }
__device__ __forceinline__ unsigned f2bf(float f) { unsigned u = __builtin_bit_cast(unsigned, f); return (u + 0x7fffu + ((u >> 16) & 1u)) >> 16; }
__device__ __forceinline__ unsigned pk2(float lo, float hi) { return f2bf(lo) | (f2bf(hi) << 16); }

#define XB_TMO      128
#define XB_XCNT(j)  (256  + 64 * (j))
#define XB_XSUB(j)  (1280 + 64 * (j))
#define XB_XGEN(j)  (2304 + 64 * (j))
#define XB_TOP      3328
#define XB_TOPGEN   3392
#define XCD_BAR_WORDS 3456
#define XB_SPIN_CAP (1u << 18)

__device__ __forceinline__ unsigned xb_ld(unsigned* p)              { return __hip_atomic_load(p, __ATOMIC_RELAXED, __HIP_MEMORY_SCOPE_AGENT); }
__device__ __forceinline__ unsigned xb_add(unsigned* p, unsigned v) { return __hip_atomic_fetch_add(p, v, __ATOMIC_RELAXED, __HIP_MEMORY_SCOPE_AGENT); }
__device__ __forceinline__ unsigned xb_xcc_id() { return (unsigned)__builtin_amdgcn_s_getreg((3 << 11) | 20) & 0xFu; }
#define XB_SPIN(cond, bar) do { unsigned _sp = 0; while (cond) { __builtin_amdgcn_s_sleep(1); \
    if ((++_sp & 255u) == 0u) { if (xb_ld(&(bar)[XB_TMO])) break; if (_sp > XB_SPIN_CAP) { atomicAdd(&(bar)[XB_TMO], 1u); break; } } } } while (0)

struct XcdBarrier {
    unsigned* bar; unsigned x;
    volatile LAS unsigned* st;
};

__device__ __forceinline__ XcdBarrier xcd_barrier_post(unsigned* bar, volatile LAS unsigned* st) {
    XcdBarrier b; b.bar = bar; b.x = xb_xcc_id(); b.st = st;
    if (threadIdx.x == 0) (void)xb_add(&bar[XB_XCNT(b.x)], 1u);
    return b;
}
__device__ __forceinline__ void xcd_barrier_complete(unsigned* bar, unsigned x, unsigned& nloc, unsigned& nx) {
    const unsigned G = gridDim.x * gridDim.y * gridDim.z;
    unsigned sum, cnt, mine, sp = 0u;
    for (;;) {
        sum = 0u; cnt = 0u; mine = 0u;
#pragma unroll
        for (unsigned j = 0; j < 16; ++j) { const unsigned c = xb_ld(&bar[XB_XCNT(j)]); sum += c; cnt += (c > 0u) ? 1u : 0u; mine = (j == x) ? c : mine; }
        if (sum == G) break;
        __builtin_amdgcn_s_sleep(1);
        if ((++sp & 255u) == 0u) { if (xb_ld(&bar[XB_TMO])) break; if (sp > XB_SPIN_CAP) { atomicAdd(&bar[XB_TMO], 1u); break; } }
    }
    nloc = mine > 0u ? mine : 1u; nx = cnt > 0u ? cnt : 1u;
}

__device__ __forceinline__ void xcd_barrier(const XcdBarrier& b) {
    asm volatile("s_waitcnt vmcnt(0)" ::: "memory");
    __syncthreads();
    if (threadIdx.x == 0) {
        unsigned* bar = b.bar;
        __builtin_amdgcn_s_waitcnt(0);
        unsigned nloc = b.st[0], nx = b.st[1];
        if (nloc == 0u) { xcd_barrier_complete(bar, b.x, nloc, nx); b.st[0] = nloc; b.st[1] = nx; }
        const unsigned old = xb_add(&bar[XB_XSUB(b.x)], 1u);
        const unsigned gen = old / nloc;
        if (old + 1u == (gen + 1u) * nloc) {
            __builtin_amdgcn_fence(__ATOMIC_RELEASE, "agent");
            asm volatile("s_waitcnt vmcnt(0)" ::: "memory");
            const unsigned og = xb_add(&bar[XB_TOP], 1u);
            const unsigned tg = og / nx;
            if (og + 1u == (tg + 1u) * nx) xb_add(&bar[XB_TOPGEN], 1u);
            else XB_SPIN(xb_ld(&bar[XB_TOPGEN]) == tg, bar);
            __builtin_amdgcn_fence(__ATOMIC_ACQUIRE, "agent");
            xb_add(&bar[XB_XGEN(b.x)], 1u);
            asm volatile("s_waitcnt vmcnt(0)" ::: "memory");
        } else {
            XB_SPIN(xb_ld(&bar[XB_XGEN(b.x)]) == gen, bar);
            __builtin_amdgcn_fence(__ATOMIC_ACQUIRE, "agent");
            asm volatile("s_waitcnt vmcnt(0)" ::: "memory");
        }
    }
    __syncthreads();
}

constexpr int NWAVES = 8;
constexpr int DM = 1024, BATCH = 16, SEQ = 2048, MROWS = BATCH * SEQ;
constexpr int A_FFN = 6144, A_HALF = 3072, A_GROUPS = 8, A_GD = 384, GCH = 128, CHK = 64;
constexpr int D_FF = 2816, NEXP = 8, D_EXP = 3584, NHEAD = 16, HD = 64;
constexpr int KVW_LD = 2 * DM + NHEAD;
constexpr float RMS_EPS = 1e-6f;
constexpr float W8_SCALE = 64.0f;
constexpr int W8_SCALE_E8M0 = 0x79797979;
enum { I_X = 0, I_A_NORM_G, I_A_W_IN, I_A_V_NORM_G, I_A_W_SP, I_A_B_SP, I_A_W_OUT, I_F_NORM_G, I_F_W_IN, I_F_W_OUT, I_KV_NORM_G, I_KV_W, I_KV_B_F, I_K_NORM_G,
       I_B_NORM_G, I_B_W_IN, I_Q_NORM_G, I_B_W_OUT, I_M_NORM_G, I_M_W_ROUTER, I_M_W_IN, I_M_W_OUT, N_IN };

constexpr size_t MiB = 1u << 20;
constexpr size_t WS_CTL = 0, CTL_ZERO_BYTES = 1 * MiB;
constexpr size_t WS_RSQ = 4 * MiB;
constexpr size_t WS_VPART = 286 * MiB;
constexpr size_t WS_FG = 2 * MiB;
constexpr size_t WS_GW = 6 * MiB;
constexpr size_t WS_TOKSLOT = 7 * MiB;
constexpr size_t WS_WA_IN = 8 * MiB, WS_WA_OUT = 20 * MiB, WS_WF_IN = 26 * MiB, WS_WF_OUT = 37 * MiB, WS_WKV = 43 * MiB, WS_WBIN = 47 * MiB, WS_WBOUT = 51 * MiB;
constexpr size_t WS_WM_IN = 53 * MiB, WS_WM_OUT = 165 * MiB;
constexpr size_t WS_XN = 222 * MiB, WS_XQ = 286 * MiB;
constexpr size_t WS_BIG = 350 * MiB;
constexpr int MAXSLOT = MROWS * 2 + NEXP * 256;
constexpr size_t WS_XG = 286 * MiB;
constexpr size_t WS_ACT = 418 * MiB;
constexpr size_t WS_Y = 8 * MiB;
constexpr size_t WS_ELIST = 880 * MiB, WS_EWL = 881 * MiB;
constexpr size_t WS_FBT = 700 * MiB;
constexpr int YP_ROWS = 16 * 256;
constexpr size_t WS_END = 883 * MiB;
constexpr int CW_BAR = 4096, CW_CNT = 64;

constexpr int RING_OFF = 0, RING_BYTES = 131072;
constexpr int LDSCTL_OFF = RING_BYTES, MISC_OFF = LDSCTL_OFF + 320;
constexpr int LDS_BYTES = 147456;

typedef short s16x4 __attribute__((ext_vector_type(4)));
__device__ __forceinline__ unsigned off_b(unsigned row, unsigned ch) { return 256u * row + 16u * (ch ^ (((row & 3u) << 2) | ((row >> 2) & 3u))); }
struct Frame {
    LAS unsigned char* lds; volatile LAS unsigned* MISC; gu32* ctl;
    int tid, lane, wave, vcu, G;
};
__device__ __forceinline__ float wave_sum(float v) {
#pragma unroll
    for (int o = 1; o < 64; o <<= 1) v += __shfl_xor(v, o);
    return v;
}
__device__ __forceinline__ void tr_load(float (&tmp)[32], const float* W, int ldw, int k0, int n0, int lane) {
#pragma unroll
    for (int i = 0; i < 32; ++i) { const int kk = 2 * i + (lane >> 5); tmp[i] = W[(size_t)(k0 + kk) * ldw + n0 + (lane & 31)]; }
}
template <class RowMap>
__device__ __forceinline__ void tr_store(float (&tmp)[32], int K, bf16* WT, LAS float* scr, int k0, int n0, int lane, const RowMap& rowmap, const float* gk, float f8scale = 0.f) {
    if (gk) {
#pragma unroll
        for (int i = 0; i < 32; ++i) tmp[i] *= gk[k0 + 2 * i + (lane >> 5)]; }
#pragma unroll
    for (int i = 0; i < 32; ++i) { const int kk = 2 * i + (lane >> 5); scr[kk * 33 + (lane & 31)] = tmp[i]; }
    LDS_WAIT(); asm volatile("" ::: "memory");
    const int c = lane & 7;
#pragma unroll
    for (int j = 0; j < 4; ++j) { const int n = (lane >> 3) + 8 * j; const LAS float* s = scr + (8 * c) * 33 + n;
        if (f8scale != 0.f) { unsigned lo = 0u, hi = 0u;
            lo = __builtin_amdgcn_cvt_pk_fp8_f32(s[0 * 33] * f8scale, s[1 * 33] * f8scale, lo, false); lo = __builtin_amdgcn_cvt_pk_fp8_f32(s[2 * 33] * f8scale, s[3 * 33] * f8scale, lo, true);
            hi = __builtin_amdgcn_cvt_pk_fp8_f32(s[4 * 33] * f8scale, s[5 * 33] * f8scale, hi, false); hi = __builtin_amdgcn_cvt_pk_fp8_f32(s[6 * 33] * f8scale, s[7 * 33] * f8scale, hi, true);
            *(GAS unsigned long long*)((GAS unsigned char*)WT + (size_t)rowmap(n0 + n) * K + k0 + 8 * c) = (unsigned long long)lo | ((unsigned long long)hi << 32); }
        else { v4u o; o.x = pk2(s[0 * 33], s[1 * 33]); o.y = pk2(s[2 * 33], s[3 * 33]); o.z = pk2(s[4 * 33], s[5 * 33]); o.w = pk2(s[6 * 33], s[7 * 33]);
            *(GAS v4u*)(WT + (size_t)rowmap(n0 + n) * K + k0 + 8 * c) = o; } }
    LDS_WAIT(); asm volatile("" ::: "memory");
}
struct MapId { __device__ __forceinline__ int operator()(int n) const { return n; } };
struct MapGlu { int half; __device__ __forceinline__ int operator()(int n) const { const int b = n >= half ? 1 : 0, x = n - b * half; return (x >> 7) * 256 + b * 128 + (x & 127); } };
struct MapGlu64 { int half; __device__ __forceinline__ int operator()(int n) const { const int b = n >= half ? 1 : 0, x = n - b * half, pn = x >> 6, xx = x & 63; return pn * 128 + (xx >> 4) * 32 + ((xx >> 2) & 3) * 8 + b * 4 + (xx & 3); } };
struct MapHead { __device__ __forceinline__ int operator()(int n) const { const int blk = n >> 10, hh = (n >> 6) & 15, d = n & 63; return (blk * 4 + (hh >> 2)) * 256 + (d >> 5) * 128 + (hh & 3) * 32 + (d & 31); } };
template <class RowMap>
__device__ __forceinline__ void tr_matrix(Frame& F, const float* W, int ldw, int K, int ncols, bf16* WT, const RowMap& rm, int& gwoff, const float* gk = nullptr, float f8scale = 0.f) {
    LAS float* scr = (LAS float*)(F.lds + RING_OFF + F.wave * 16384);
    const int NGW = F.G * NWAVES, nblk = ncols / 32, items = (K / 64) * nblk;
    int gw = F.vcu * NWAVES + F.wave - gwoff; if (gw < 0) gw += NGW;
    int it = gw; if (it < items) { float ta[32], tb[32]; tr_load(ta, W, ldw, 64 * (it / nblk), 32 * (it % nblk), F.lane);
        for (;;) { const int n1 = it + NGW; if (n1 < items) tr_load(tb, W, ldw, 64 * (n1 / nblk), 32 * (n1 % nblk), F.lane);
            tr_store(ta, K, WT, scr, 64 * (it / nblk), 32 * (it % nblk), F.lane, rm, gk, f8scale); if (n1 >= items) break;
            const int n2 = n1 + NGW; if (n2 < items) tr_load(ta, W, ldw, 64 * (n2 / nblk), 32 * (n2 % nblk), F.lane);
            tr_store(tb, K, WT, scr, 64 * (n1 / nblk), 32 * (n1 % nblk), F.lane, rm, gk, f8scale); if (n2 >= items) break;
            it = n2; } }
    gwoff = (gwoff + items) % NGW;
}
__device__ __forceinline__ void row_load(const float* xrow, int lane, f32x4 (&v)[4]) {
    const GAS f32x4* xr = (const GAS f32x4*)xrow + lane;
#pragma unroll
    for (int j = 0; j < 4; ++j) v[j] = xr[64 * j];
}
__device__ __forceinline__ void row_load(const bf16* xrow, int lane, f32x4 (&v)[4]) {
    const GAS unsigned long long* xr = (const GAS unsigned long long*)xrow + lane;
#pragma unroll
    for (int j = 0; j < 4; ++j) { const unsigned long long w = xr[64 * j]; const unsigned lo = (unsigned)w, hi = (unsigned)(w >> 32);
        v[j] = (f32x4){__uint_as_float(lo << 16), __uint_as_float(lo & 0xffff0000u), __uint_as_float(hi << 16), __uint_as_float(hi & 0xffff0000u)}; }
}
__device__ __forceinline__ float row_rstd(const f32x4 (&v)[4]) { float s = 0.f;
#pragma unroll
    for (int j = 0; j < 4; ++j) s += (v[j].x * v[j].x + v[j].y * v[j].y) + (v[j].z * v[j].z + v[j].w * v[j].w);
    return 1.0f / sqrtf(wave_sum(s) * (1.f / DM) + RMS_EPS);
}
struct RowRawF { f32x4 w[4];
    __device__ __forceinline__ void load(const float* xrow, int lane) { const GAS f32x4* xr = (const GAS f32x4*)xrow + lane;
#pragma unroll
        for (int j = 0; j < 4; ++j) w[j] = xr[64 * j]; }
    __device__ __forceinline__ void unpack(f32x4 (&v)[4]) const {
#pragma unroll
        for (int j = 0; j < 4; ++j) v[j] = w[j]; } };
struct RowRawB { unsigned long long w[4];
    __device__ __forceinline__ void load(const bf16* xrow, int lane) { const GAS unsigned long long* xr = (const GAS unsigned long long*)xrow + lane;
#pragma unroll
        for (int j = 0; j < 4; ++j) w[j] = xr[64 * j]; }
    __device__ __forceinline__ void unpack(f32x4 (&v)[4]) const {
#pragma unroll
        for (int j = 0; j < 4; ++j) { const unsigned lo = (unsigned)w[j], hi = (unsigned)(w[j] >> 32);
            v[j] = (f32x4){__uint_as_float(lo << 16), __uint_as_float(lo & 0xffff0000u), __uint_as_float(hi << 16), __uint_as_float(hi & 0xffff0000u)}; } } };
__device__ RowRawF rowraw_of(const float*); __device__ RowRawB rowraw_of(const bf16*);
#define ROW_LOOP_BEGIN(src) { decltype(rowraw_of(src)) q0_, q1_, q2_; \
        if (gw < MROWS) q0_.load((src) + (size_t)gw * DM, F.lane); if (gw + NGW < MROWS) q1_.load((src) + (size_t)(gw + NGW) * DM, F.lane); if (gw + 2 * NGW < MROWS) q2_.load((src) + (size_t)(gw + 2 * NGW) * DM, F.lane); \
        for (int m = gw; m < MROWS; m += NGW) { f32x4 v[4]; q0_.unpack(v); q0_ = q1_; q1_ = q2_; \
            if (m + 3 * NGW < MROWS) q2_.load((src) + (size_t)(m + 3 * NGW) * DM, F.lane); const float r = row_rstd(v);
#define ROW_LOOP_END } }
__device__ __forceinline__ void rms_row_store(const f32x4 (&v)[4], float rstd, const float* g, bf16* orow, int lane, float extra = 1.0f) {
    const GAS f32x4* gr = (const GAS f32x4*)g + lane; GAS unsigned long long* o8 = (GAS unsigned long long*)orow + lane;
#pragma unroll
    for (int j = 0; j < 4; ++j) { const f32x4 gg = gr[64 * j]; const f32x4 y = (v[j] * rstd) * gg * extra;
        o8[64 * j] = (unsigned long long)pk2(y.x, y.y) | ((unsigned long long)pk2(y.z, y.w) << 32); }
}
template <int N> __device__ __forceinline__ float wave_tr_reduce(float (&v)[N], int lane) {
    static_assert(N == 16 || N == 8, "N");
#define TRR_STEP(M, NN) if (N >= NN) { const bool up = (lane & M) != 0; _Pragma("unroll") for (int i = 0; i < NN / 2; ++i) { const float keep = up ? v[i + NN / 2] : v[i], send = up ? v[i] : v[i + NN / 2]; v[i] = keep + __shfl_xor(send, M); } }
    TRR_STEP(8, 16) TRR_STEP(4, 8) TRR_STEP(2, 4) TRR_STEP(1, 2)
#undef TRR_STEP
    float t = v[0];
#pragma unroll
    for (int o = N; o < 64; o <<= 1) t += __shfl_xor(t, o);
    return t;
}
__device__ __forceinline__ float bflo(unsigned u) { return __uint_as_float(u << 16); }
__device__ __forceinline__ float bfhi(unsigned u) { return __uint_as_float(u & 0xffff0000u); }
__device__ __forceinline__ float log_sigmoid(float x) { return x >= 0.f ? -log1pf(expf(-x)) : x - log1pf(expf(x)); }

enum { PH_PRO = 0, PH_GEMM1, PH_SPATIAL, PH_GEMM2, PH_FFN_UP, PH_FFN_DOWN, PH_KVQ, PH_ATTN, PH_OPROJ, PH_ROUTER, PH_MOE_UP, PH_MOE_DOWN, PH_COMBINE, PH_END };
#ifndef MK_ONE_LAUNCH
#define MK_ONE_LAUNCH 1
#endif
#ifndef MK_PH_STOP
#define MK_PH_STOP PH_END
#endif

struct Args { const float* in[N_IN]; float* out; unsigned char* ws; int ph_lo, ph_hi, li, pad; };
__global__ void __launch_bounds__(NWAVES * 64, 2) yoco_fwd(Args args) {
    extern __shared__ __attribute__((aligned(16))) unsigned char lds[];
    Frame F;
    F.lds = (LAS unsigned char*)lds; F.MISC = (volatile LAS unsigned*)(F.lds + MISC_OFF);
    F.tid = threadIdx.x; F.lane = F.tid & 63; F.wave = __builtin_amdgcn_readfirstlane(F.tid >> 6);
    F.G = gridDim.x; { const int bx = blockIdx.x; F.vcu = (F.G % 8 == 0) ? (bx % 8) * (F.G / 8) + bx / 8 : bx; }
    unsigned char* ws = args.ws; F.ctl = (gu32*)(ws + WS_CTL);
    for (int u = F.tid; u < (LDS_BYTES - LDSCTL_OFF) / 4; u += NWAVES * 64) ((LAS unsigned*)(F.lds + LDSCTL_OFF))[u] = 0u;
    __syncthreads();
    XcdBarrier bar; bar.bar = (unsigned*)(F.ctl + CW_BAR) + args.li * XCD_BAR_WORDS; bar.x = 0; bar.st = nullptr;
    if (MK_ONE_LAUNCH) bar = xcd_barrier_post((unsigned*)(F.ctl + CW_BAR) + args.li * XCD_BAR_WORDS, F.MISC + 8);
#define GRID_BAR() do { if (MK_ONE_LAUNCH) xcd_barrier(bar); } while (0)
    const int lo = args.ph_lo, hi = args.ph_hi;
#ifndef MK_PHMASK
#define MK_PHMASK 0xffffffffu
#endif
#define IN(k) (((MK_PHMASK >> (k)) & 1u) && lo <= (k) && (k) < hi)
#define BOTH(k) (IN(k) && IN((k) + 1))
    const float* x = args.in[I_X]; float* H = args.out;
    bf16* WA_IN = (bf16*)(ws + WS_WA_IN); bf16* WA_OUT = (bf16*)(ws + WS_WA_OUT); bf16* WF_IN = (bf16*)(ws + WS_WF_IN); bf16* WF_OUT = (bf16*)(ws + WS_WF_OUT);
    bf16* WKV = (bf16*)(ws + WS_WKV); bf16* WBIN = (bf16*)(ws + WS_WBIN); bf16* WBOUT = (bf16*)(ws + WS_WBOUT); bf16* WM_IN = (bf16*)(ws + WS_WM_IN); bf16* WM_OUT = (bf16*)(ws + WS_WM_OUT);
    float* RX = (float*)(ws + 1 * MiB + 131072);
    bf16* WF16 = (bf16*)(ws + 1 * MiB);
    bf16* XN = (bf16*)(ws + WS_XN); bf16* XQ = (bf16*)(ws + WS_XQ); bf16* BIG = (bf16*)(ws + WS_BIG);
    float* RSQ_V = (float*)(ws + WS_VPART); float* RSQ_H1 = (float*)(ws + WS_RSQ); bf16* HB = XQ;
 float* FG = (float*)(ws + WS_FG); unsigned* IDL = (unsigned*)(ws + WS_GW + 512 * 1024);   float* GW = (float*)(ws + WS_GW); unsigned* TOKSLOT = (unsigned*)(ws + WS_TOKSLOT); unsigned* ELIST = (unsigned*)(ws + WS_ELIST); float* EWL = (float*)(ws + WS_EWL); unsigned* ERS = (unsigned*)(ws + WS_EWL + 1 * MiB);
    bf16* ACT = (bf16*)(ws + WS_ACT); bf16* YB = (bf16*)(ws + WS_Y); bf16* YP = (bf16*)(ws + WS_BIG);
    bf16* KB = BIG; bf16* VB = BIG + (size_t)MROWS * DM; bf16* QB = BIG + (size_t)2 * MROWS * DM; bf16* GB = BIG + (size_t)3 * MROWS * DM;
    const int gw = F.vcu * NWAVES + F.wave, NGW = F.G * NWAVES;

    if (IN(PH_PRO)) {
        int go = 0;
        tr_matrix(F, args.in[I_A_W_IN], A_FFN, DM, A_FFN, WA_IN, MapId{}, go, args.in[I_A_NORM_G]);
        tr_matrix(F, args.in[I_A_W_OUT], DM, A_HALF, DM, WA_OUT, MapId{}, go);
        tr_matrix(F, args.in[I_F_W_IN], 2 * D_FF, DM, 2 * D_FF, WF_IN, MapGlu{D_FF}, go, args.in[I_F_NORM_G]);
        tr_matrix(F, args.in[I_F_W_OUT], DM, D_FF, DM, WF_OUT, MapId{}, go);
        tr_matrix(F, args.in[I_KV_W], KVW_LD, DM, 2 * DM, WKV, MapHead{}, go, args.in[I_KV_NORM_G]);
        tr_matrix(F, args.in[I_B_W_IN], 2 * DM, DM, 2 * DM, WBIN, MapHead{}, go, args.in[I_B_NORM_G]);
        tr_matrix(F, args.in[I_B_W_OUT], DM, DM, DM, WBOUT, MapId{}, go);
        for (int e = 0; e < NEXP; ++e) {
            tr_matrix(F, args.in[I_M_W_IN] + (size_t)e * DM * 2 * D_EXP, 2 * D_EXP, DM, 2 * D_EXP, (bf16*)((unsigned char*)WM_IN + (size_t)e * 2 * D_EXP * DM), MapGlu{D_EXP}, go, args.in[I_M_NORM_G], W8_SCALE);
            tr_matrix(F, args.in[I_M_W_OUT] + (size_t)e * D_EXP * DM, DM, D_EXP, DM, (bf16*)((unsigned char*)WM_OUT + (size_t)e * DM * D_EXP), MapId{}, go, nullptr, W8_SCALE);
        }
        ROW_LOOP_BEGIN(x) { GAS unsigned long long* o8 = (GAS unsigned long long*)(XN + (size_t)m * DM) + F.lane;
#pragma unroll
            for (int j = 0; j < 4; ++j) o8[64 * j] = (unsigned long long)pk2(v[j].x, v[j].y) | ((unsigned long long)pk2(v[j].z, v[j].w) << 32);
            if (F.lane == 0) RX[m] = r; } ROW_LOOP_END
        for (int e = blockIdx.x * (NWAVES * 64) + F.tid; e < NHEAD * DM; e += F.G * NWAVES * 64) { const int h = e >> 10, k = e & 1023; WF16[e] = (bf16)f2bf(args.in[I_KV_W][(size_t)k * KVW_LD + 2 * DM + h] * args.in[I_KV_NORM_G][k]); }
        if (BOTH(PH_PRO)) GRID_BAR();
    }
    if (IN(PH_GEMM1)) {
        pg8::Gemm g{XN, WA_IN, MROWS, A_FFN, DM, DM, 0, nullptr, 0, nullptr, 0}; pg8::StaticOrder S; S.init(MROWS, A_FFN, F.G, (int)blockIdx.x);
        LAS float* RT = (LAS float*)(F.lds + LDSCTL_OFF + 4096);
        { pg8::Unit uu; __syncthreads();
          for (int i0 = 0; i0 < 12; i0 += 2) { const int i = i0 + (F.tid >> 8); if (!S.next(i, uu)) continue; RT[i * 256 + (F.tid & 255)] = RX[uu.pm * 256 + (F.tid & 255)]; }
          __syncthreads(); }
        pg8::EpiGeluSq E{BIG, A_FFN, RSQ_V, A_HALF / 256, RT};
        pg8::gemm_phase<pg8::EpiGeluSq, pg8::StaticOrder, true, true>(F.lds + RING_OFF, g, S, E);
        if (BOTH(PH_GEMM1)) GRID_BAR();
    }
    if (IN(PH_SPATIAL)) {
        int tid_ = threadIdx.x; asm volatile("" : "+v"(tid_));
        const int tid = tid_, lane = tid & 63, wid = __builtin_amdgcn_readfirstlane(tid >> 6), wr = wid >> 2, wc = wid & 3, L15 = lane & 15, G4 = lane >> 4, q_ = (lane & 15) >> 2, p_ = lane & 3;
        LAS unsigned char* VI = F.lds + RING_OFF; LAS unsigned char* WI = F.lds + RING_OFF + 98304; LAS float* RVS = (LAS float*)(F.lds + LDSCTL_OFF + 1024);
        const float* wsp = args.in[I_A_W_SP]; const float* bsp = args.in[I_A_B_SP]; const float* gvn = args.in[I_A_V_NORM_G];
        constexpr int NU = (MROWS / GCH) * A_GROUPS;
        const int g = F.vcu % A_GROUPS;
        const int nun = F.vcu < NU ? (NU - 1 - F.vcu) / F.G + 1 : 0, nit = 3 * nun;
#define SP_BAR() do { asm volatile("s_waitcnt lgkmcnt(0)" ::: "memory"); __builtin_amdgcn_s_barrier(); asm volatile("" ::: "memory"); } while (0)
        if (nun > 0 && (F.G % A_GROUPS) == 0) {
            f32x4 wreg[4][2];
#pragma unroll
            for (int k = 0; k < 4; ++k) { const unsigned q = tid + 512 * k, i = q >> 4, ch = q & 15; wreg[k][0] = (f32x4){0.f, 0.f, 0.f, 0.f}; wreg[k][1] = wreg[k][0];
                if ((ch >> 3) <= (i >> 6)) { const GAS f32x4* wp = (const GAS f32x4*)(wsp + (size_t)g * GCH * GCH + i * GCH + ch * 8); wreg[k][0] = wp[0]; wreg[k][1] = wp[1]; } }
            f32x4 gvv[3][2]; float bi[4];
#pragma unroll
            for (int t3 = 0; t3 < 3; ++t3) { const GAS f32x4* gp = (const GAS f32x4*)(gvn + g * A_GD + t3 * 128 + wc * 32 + 8 * G4); gvv[t3][0] = gp[0]; gvv[t3][1] = gp[1]; }
#pragma unroll
            for (int m = 0; m < 4; ++m) bi[m] = bsp[g * GCH + wr * 64 + 16 * m + L15];
            unsigned dvo[4];
#pragma unroll
            for (int i = 0; i < 4; ++i) { const unsigned r = 4u * (4 * wid + i) + (lane >> 4), ch = (lane & 15u) ^ ((((unsigned)lane >> 4) << 2) | (unsigned)i); dvo[i] = (r * A_FFN + ch * 8u) * 2u; }
#define SP_DMA(un_, t3_, slot_) do { const unsigned char* vb_ = (const unsigned char*)(BIG + (size_t)((un_) / A_GROUPS) * GCH * A_FFN + A_HALF + g * A_GD + (t3_) * 128); \
                _Pragma("unroll") for (int i = 0; i < 4; ++i) attn_body::glds16(vb_ + dvo[i], (unsigned)__builtin_amdgcn_readfirstlane((int)(unsigned)(size_t)(VI + (slot_) * 32768 + (4 * wid + i) * 1024))); \
                asm volatile("" ::: "memory"); } while (0)
#define SP_ULOAD(dst, un_, t3_) do { const bf16* up_ = BIG + ((size_t)((un_) / A_GROUPS) * GCH + wr * 64 + L15) * A_FFN + g * A_GD + (t3_) * 128 + wc * 32 + 8 * G4; \
                _Pragma("unroll") for (int m = 0; m < 4; ++m) dst[m] = *(const GAS v4u*)(up_ + (size_t)16 * m * A_FFN); } while (0)
            const unsigned fW = ((L15 & 3u) << 2) | (L15 >> 2);
            const unsigned wbase = 256u * (wr * 64 + L15) + 16u * ((unsigned)G4 ^ (fW & 3u));
            const unsigned tb0 = 256u * (8 * G4 + q_) + 16u * ((unsigned)p_ ^ ((2u * G4) & 3u)), tb1 = 256u * (8 * G4 + 4 + q_) + 16u * ((unsigned)p_ ^ ((2u * G4 + 1u) & 3u));
            const unsigned xc = 16u * ((4u * wc) ^ ((unsigned)q_ << 2));
            const int nks = wr ? 4 : 2;
            __syncthreads();
            if (tid < GCH) { const GAS f32x4* pp = (const GAS f32x4*)(RSQ_V + ((size_t)(F.vcu / A_GROUPS) * GCH + tid) * 48); float t = 0.f;
#pragma unroll
                for (int k = 0; k < 12; ++k) { const f32x4 p = pp[k]; t += (p[0] + p[1]) + (p[2] + p[3]); }
                RVS[tid] = 1.0f / sqrtf(t * (1.f / A_HALF) + RMS_EPS); }
            SP_DMA(F.vcu, 0, 0);
            v4u us[3][4];
            asm volatile("s_waitcnt vmcnt(0)" ::: "memory");
            SP_DMA(F.vcu, 1, 1);
            f32x4 pn[3];
            for (int kun = 0; kun < nun; ++kun) { const int un = F.vcu + kun * F.G;
#pragma unroll
            for (int t3 = 0; t3 < 3; ++t3) { const int s = 3 * kun + t3; constexpr int slot_dummy = 0; (void)slot_dummy; const int slot = t3;
                asm volatile("s_waitcnt vmcnt(8)" ::: "memory"); SP_BAR();
                if (s + 2 < nit) { const int t2 = t3 == 0 ? 2 : t3 - 1, u2 = t3 == 0 ? un : un + F.G; SP_DMA(u2, t2, t2); }
                if (t3 == 0) {
                    SP_ULOAD(us[0], un, 0);
                    const LAS float* rv = RVS + (kun & 1) * GCH;
#pragma unroll
                    for (int k = 0; k < 4; ++k) { const unsigned q = tid + 512 * k, i = q >> 4, ch = q & 15; const LAS f32x4* rp = (const LAS f32x4*)(rv + ch * 8); const f32x4 w0 = wreg[k][0] * rp[0], w1 = wreg[k][1] * rp[1];
                        v4u o; o.x = pk2(w0.x, w0.y); o.y = pk2(w0.z, w0.w); o.z = pk2(w1.x, w1.y); o.w = pk2(w1.z, w1.w); *(LAS v4u*)(WI + off_b(i, ch)) = o; }
                    if (kun + 1 < nun) { const GAS f32x4* pp = (const GAS f32x4*)(RSQ_V + ((size_t)((un + F.G) / A_GROUPS) * GCH + (tid >> 2)) * 48 + (tid & 3) * 12);
#pragma unroll
                        for (int k = 0; k < 3; ++k) pn[k] = pp[k]; }
                    SP_BAR();
                }
                f32x4 acc[4][2];
#pragma unroll
                for (int m = 0; m < 4; ++m) { acc[m][0] = (f32x4){0.f, 0.f, 0.f, 0.f}; acc[m][1] = acc[m][0]; }
                { const LAS unsigned char* ib0 = VI + slot * 32768 + xc;
#pragma unroll 1
                  for (int ks = 0; ks < nks; ++ks) {
                      bf16x8 wf[4]; const LAS unsigned char* wp = WI + wbase + 16u * ((4u * ks) ^ (fW & 12u)); const LAS unsigned char* ib = ib0 + 8192u * ks;
#pragma unroll
                      for (int m = 0; m < 4; ++m) wf[m] = *(const LAS bf16x8*)(wp + m * 4096);
#pragma unroll
                      for (int nn = 0; nn < 2; ++nn) {
                          const s16x4 t0 = __builtin_bit_cast(s16x4, __builtin_amdgcn_ds_read_tr16_b64_v4i16((LAS s16x4*)(ib + tb0 + 8 * nn)));
                          const s16x4 t1 = __builtin_bit_cast(s16x4, __builtin_amdgcn_ds_read_tr16_b64_v4i16((LAS s16x4*)(ib + tb1 + 8 * nn)));
                          const bf16x8 vf = (bf16x8){t0[0], t0[1], t0[2], t0[3], t1[0], t1[1], t1[2], t1[3]};
#pragma unroll
                          for (int m = 0; m < 4; ++m) acc[m][nn] = __builtin_amdgcn_mfma_f32_16x16x32_bf16(vf, wf[m], acc[m][nn], 0, 0, 0); } } }
                if (t3 < 2) SP_ULOAD(us[t3 < 2 ? t3 + 1 : 0], un, t3 + 1);
                if (t3 == 2 && kun + 1 < nun) { float t = 0.f;
#pragma unroll
                    for (int k = 0; k < 3; ++k) { const f32x4 p = pn[k]; t += (p[0] + p[1]) + (p[2] + p[3]); }
                    t += __shfl_xor(t, 1); t += __shfl_xor(t, 2);
                    if ((tid & 3) == 0) RVS[((kun + 1) & 1) * GCH + (tid >> 2)] = 1.0f / sqrtf(t * (1.f / A_HALF) + RMS_EPS); }
                { bf16* op = BIG + ((size_t)(un / A_GROUPS) * GCH + wr * 64 + L15) * A_FFN + g * A_GD + t3 * 128 + wc * 32 + 8 * G4;
                  const f32x4 g0 = t3 == 0 ? gvv[0][0] : t3 == 1 ? gvv[1][0] : gvv[2][0], g1 = t3 == 0 ? gvv[0][1] : t3 == 1 ? gvv[1][1] : gvv[2][1];
#pragma unroll
                  for (int m = 0; m < 4; ++m) { const v4u uu = us[t3][m]; const f32x4 a = acc[m][0] * g0 + bi[m], b = acc[m][1] * g1 + bi[m]; v4u o;
                      o.x = pk2(bflo(uu.x) * a.x, bfhi(uu.x) * a.y); o.y = pk2(bflo(uu.y) * a.z, bfhi(uu.y) * a.w); o.z = pk2(bflo(uu.z) * b.x, bfhi(uu.z) * b.y); o.w = pk2(bflo(uu.w) * b.z, bfhi(uu.w) * b.w);
                      *(GAS v4u*)(op + (size_t)16 * m * A_FFN) = o; } }
            } }
            asm volatile("s_waitcnt vmcnt(0)" ::: "memory");
        }
#undef SP_BAR
#undef SP_DMA
#undef SP_ULOAD
        if (BOTH(PH_SPATIAL)) GRID_BAR();
    }
    if (IN(PH_GEMM2)) {
        pg8::Gemm g{BIG, WA_OUT, MROWS, DM, A_HALF, A_FFN, 0, nullptr, 0, nullptr, 0}; pg8::StaticOrder S; S.init(MROWS, DM, F.G, (int)blockIdx.x);
        pg8::EpiResBf<true> E{XN, HB, RSQ_H1, DM};
        pg8::gemm_phase<pg8::EpiResBf<true>, pg8::StaticOrder, true, true>(F.lds + RING_OFF, g, S, E);
        if (BOTH(PH_GEMM2)) GRID_BAR();
    }
    if (IN(PH_FFN_UP)) {
        pg8::Gemm g{HB, WF_IN, MROWS, 2 * D_FF, DM, DM, 0, nullptr, 0, nullptr, 0}; pg8::StaticOrder S; S.init(MROWS, 2 * D_FF, F.G, (int)blockIdx.x);
        LAS float* RT = (LAS float*)(F.lds + LDSCTL_OFF + 4096);
        { pg8::Unit uu; __syncthreads();
          for (int i0 = 0; i0 < 12; i0 += 2) { const int i = i0 + (F.tid >> 8); if (!S.next(i, uu)) continue; const int r = F.tid & 255; const GAS f32x4* pp = (const GAS f32x4*)(RSQ_H1 + (size_t)(uu.pm * 256 + r) * 16); float t = 0.f;
#pragma unroll
              for (int k = 0; k < 4; ++k) { const f32x4 p = pp[k]; t += (p[0] + p[1]) + (p[2] + p[3]); }
              RT[i * 256 + r] = 1.0f / sqrtf(t * (1.f / DM) + RMS_EPS); }
          __syncthreads(); }
        pg8::EpiSwiGLU E{BIG, D_FF, RT};
        pg8::gemm_phase<pg8::EpiSwiGLU, pg8::StaticOrder, true, true>(F.lds + RING_OFF, g, S, E);
        if (BOTH(PH_FFN_UP)) GRID_BAR();
    }
    if (IN(PH_FFN_DOWN)) {
        pg8::Gemm g{BIG, WF_OUT, MROWS, DM, D_FF, D_FF, 0, nullptr, 0, nullptr, 0}; pg8::StaticOrder S; S.init(MROWS, DM, F.G, (int)blockIdx.x);
        pg8::EpiResBf<true> E{HB, XN, RSQ_H1, DM};
        pg8::gemm_phase<pg8::EpiResBf<true>, pg8::StaticOrder, true, true>(F.lds + RING_OFF, g, S, E);
        if (BOTH(PH_FFN_DOWN)) GRID_BAR();
    }
    if (IN(PH_KVQ)) {
        LAS float* HG = (LAS float*)(F.lds + LDSCTL_OFF + 1024);
        LAS float* RT = (LAS float*)(F.lds + LDSCTL_OFF + 4096);
        pg8::StaticOrder S; S.init(MROWS, 4 * DM, F.G, (int)blockIdx.x);
        __syncthreads();
        if (F.tid < 64) HG[F.tid] = args.in[I_K_NORM_G][F.tid]; else if (F.tid < 128) HG[F.tid] = args.in[I_Q_NORM_G][F.tid - 64] * attn_body::C2;
        { pg8::Unit uu;
          for (int i0 = 0; i0 < 12; i0 += 2) { const int i = i0 + (F.tid >> 8); if (!S.next(i, uu)) continue; const int r = F.tid & 255; const GAS f32x4* pp = (const GAS f32x4*)(RSQ_H1 + (size_t)(uu.pm * 256 + r) * 16); float t = 0.f;
#pragma unroll
              for (int k = 0; k < 4; ++k) { const f32x4 p = pp[k]; t += (p[0] + p[1]) + (p[2] + p[3]); }
              RT[i * 256 + r] = 1.0f / sqrtf(t * (1.f / DM) + RMS_EPS); } }
        { const int L15 = F.lane & 15, KQ = F.lane >> 4; const size_t row0 = (size_t)F.vcu * 128 + F.wave * 16;
          if (row0 < MROWS) {
              const bf16* ap = XN + (row0 + L15) * DM + 8 * KQ; const bf16* bp = WF16 + (size_t)L15 * DM + 8 * KQ; f32x4 fa = (f32x4){0.f, 0.f, 0.f, 0.f};
#pragma unroll
              for (int jb = 0; jb < 4; ++jb) { bf16x8 af[8], bfr[8];
#pragma unroll
                  for (int j = 0; j < 8; ++j) { af[j] = *(const GAS bf16x8*)(ap + 32 * (8 * jb + j)); bfr[j] = *(const GAS bf16x8*)(bp + 32 * (8 * jb + j)); }
#pragma unroll
                  for (int j = 0; j < 8; ++j) fa = __builtin_amdgcn_mfma_f32_16x16x32_bf16(af[j], bfr[j], fa, 0, 0, 0); }
#pragma unroll
              for (int e = 0; e < 4; ++e) { const size_t row = row0 + 4 * KQ + e; const GAS f32x4* pp = (const GAS f32x4*)(RSQ_H1 + row * 16); float t = 0.f;
#pragma unroll
                  for (int k = 0; k < 4; ++k) { const f32x4 p = pp[k]; t += (p[0] + p[1]) + (p[2] + p[3]); }
                  FG[row * NHEAD + L15] = fa[e] * (1.0f / sqrtf(t * (1.f / DM) + RMS_EPS)); } } }
        __syncthreads();
        { pg8::Gemm g{XN, WKV, MROWS, 4 * DM, DM, DM, 0, nullptr, 0, nullptr, 0};
          pg8::EpiHead4 E{KB, (size_t)MROWS * DM, HG, RMS_EPS, RT};
          pg8::gemm_phase<pg8::EpiHead4, pg8::StaticOrder, true, true>(F.lds + RING_OFF, g, S, E); }
        if (BOTH(PH_KVQ)) GRID_BAR();
    }
    if (IN(PH_ATTN)) {
        __syncthreads();
        for (int bh = F.vcu; bh < BATCH * NHEAD; bh += F.G) attn_body::scan_bias_table((char*)lds + RING_OFF, FG, args.in[I_KV_B_F], bh, (attn_body::u32x4*)(ws + WS_FBT));
        asm volatile("s_waitcnt vmcnt(0)" ::: "memory"); __syncthreads();
        const attn_body::AttnTensors AT{(const attn_body::bf16*)QB, (const attn_body::bf16*)KB, (const attn_body::bf16*)VB, (const attn_body::bf16*)GB, (attn_body::bf16*)QB, (const attn_body::u32x4*)(ws + WS_FBT)};
        const attn_body::StaticOrder AS{F.vcu, F.G}; attn_body::attn_phase<attn_body::StaticOrder>((char*)lds + RING_OFF, AT, AS);
        if (BOTH(PH_ATTN)) GRID_BAR();
    }
    if (IN(PH_OPROJ)) {
        pg8::Gemm g{QB, WBOUT, MROWS, DM, DM, DM, 0, nullptr, 0, nullptr, 0}; pg8::StaticOrder S; S.init(MROWS, DM, F.G, (int)blockIdx.x);
        pg8::EpiResBf<true> E{XN, HB, nullptr, DM};
        pg8::gemm_phase<pg8::EpiResBf<true>, pg8::StaticOrder, true, true>(F.lds + RING_OFF, g, S, E);
        if (BOTH(PH_OPROJ)) GRID_BAR();
    }
    if (IN(PH_ROUTER)) {
        LAS float* Wr = (LAS float*)(F.lds + RING_OFF);
        LAS unsigned* CNTL = (LAS unsigned*)(F.lds + RING_OFF + 65536); LAS unsigned* RREC = CNTL + 64;
        if (F.tid < 16) CNTL[F.tid] = 0u;
        __syncthreads();
        for (int idx = F.tid; idx < DM * NEXP; idx += NWAVES * 64) { const int c = idx & 3, ln = (idx >> 2) & 63, q = (idx >> 8) & 1, kk = idx >> 9, k = 4 * ln + 256 * (kk >> 2) + (kk & 3);
            Wr[idx] = args.in[I_M_W_ROUTER][(size_t)k * NEXP + 4 * q + c]; }
        __syncthreads();
        f32x4 g4[4];
        { const GAS f32x4* gr = (const GAS f32x4*)args.in[I_M_NORM_G] + F.lane;
#pragma unroll
          for (int j = 0; j < 4; ++j) g4[j] = gr[64 * j]; }
        ROW_LOOP_BEGIN(HB)
            { GAS unsigned* o8 = (GAS unsigned*)((GAS unsigned char*)XN + (size_t)m * DM) + F.lane;
#pragma unroll
              for (int j = 0; j < 4; ++j) { unsigned w = 0u; w = __builtin_amdgcn_cvt_pk_fp8_f32(v[j].x, v[j].y, w, false); w = __builtin_amdgcn_cvt_pk_fp8_f32(v[j].z, v[j].w, w, true); o8[64 * j] = w; } }
            float a[NEXP];
#pragma unroll
            for (int h = 0; h < NEXP; ++h) a[h] = 0.f;
#pragma unroll
            for (int j = 0; j < 4; ++j) { const f32x4 s4 = (v[j] * r) * g4[j];
#pragma unroll
                for (int e = 0; e < 4; ++e) { const float sk = s4[e];
#pragma unroll
                    for (int q = 0; q < 2; ++q) { const f32x4 w = *(const LAS f32x4*)(Wr + (((4 * j + e) * 2 + q) * 64 + F.lane) * 4); a[4 * q] += sk * w.x; a[4 * q + 1] += sk * w.y; a[4 * q + 2] += sk * w.z; a[4 * q + 3] += sk * w.w; } } }
            { const float mine = wave_tr_reduce<8>(a, F.lane);
#pragma unroll
              for (int h = 0; h < NEXP; ++h) a[h] = __shfl(mine, h); }
            int i1 = 0; float v1 = a[0];
#pragma unroll
            for (int h = 1; h < NEXP; ++h) if (a[h] > v1) { v1 = a[h]; i1 = h; }
            int i2 = -1; float v2 = -INFINITY;
#pragma unroll
            for (int h = 0; h < NEXP; ++h) if (h != i1 && a[h] > v2) { v2 = a[h]; i2 = h; }
            const float e2 = expf(v2 - v1), w1 = 1.0f / (1.0f + e2), w2 = e2 / (1.0f + e2);
            if (F.lane == 0) { const int k = (m - gw) / NGW; LAS unsigned* rec = RREC + (F.wave * 16 + k) * 8;
                const unsigned p1 = __hip_atomic_fetch_add(CNTL + i1, 1u, __ATOMIC_RELAXED, __HIP_MEMORY_SCOPE_WORKGROUP), p2 = __hip_atomic_fetch_add(CNTL + i2, 1u, __ATOMIC_RELAXED, __HIP_MEMORY_SCOPE_WORKGROUP);
                rec[0] = (unsigned)i1; rec[1] = p1; rec[2] = __float_as_uint(w1); rec[3] = (unsigned)i2; rec[4] = p2; rec[5] = __float_as_uint(w2); rec[6] = (unsigned)m; rec[7] = __float_as_uint(r); } ROW_LOOP_END
        __syncthreads();
        if (F.tid < NEXP) CNTL[8 + F.tid] = __hip_atomic_fetch_add(F.ctl + CW_CNT + F.tid, CNTL[F.tid], __ATOMIC_RELAXED, __HIP_MEMORY_SCOPE_AGENT);
        __syncthreads();
        if (F.lane < 16) { const int m = gw + F.lane * NGW; if (m < MROWS) { const LAS unsigned* rec = RREC + (F.wave * 16 + F.lane) * 8;
#pragma unroll
            for (int k = 0; k < 2; ++k) { const unsigned e = rec[3 * k], p = CNTL[8 + e] + rec[3 * k + 1]; ELIST[(size_t)e * MROWS + p] = rec[6] * 2u + (unsigned)k; EWL[(size_t)e * MROWS + p] = __uint_as_float(rec[3 * k + 2]); ERS[(size_t)e * MROWS + p] = rec[7]; } } }
        if (BOTH(PH_ROUTER)) GRID_BAR();
    }
    pg8::GroupedOrder GS; int ecnt[NEXP];
    if (hi > PH_ROUTER) { GS.ts[0] = 0;
#pragma unroll
        for (int e = 0; e < NEXP; ++e) { ecnt[e] = (int)__builtin_amdgcn_readfirstlane(__hip_atomic_load(F.ctl + CW_CNT + e, RLX_AGENT)); GS.cnt[e] = ecnt[e]; GS.ts[e + 1] = GS.ts[e] + (ecnt[e] + 255) / 256; } GS.cap = MROWS; }
    const int NT = GS.ts[NEXP];
    if (IN(PH_MOE_UP)) {
        for (int sl = gw * 64 + F.lane; sl < NT * 256; sl += NGW * 64) { const int tile = sl >> 8; const int e = GS.expert(tile);
            int cnt_e = GS.cnt[0], ts_e = 0;
#pragma unroll
            for (int k = 1; k < NEXP; ++k) { cnt_e = (e == k) ? GS.cnt[k] : cnt_e; ts_e = (e == k) ? GS.ts[k] : ts_e; }
            const int p = sl - ts_e * 256;
            IDL[sl] = 2u * (unsigned)sl;
            if (p < cnt_e) { const unsigned ent = ELIST[(size_t)e * MROWS + p]; GW[sl] = EWL[(size_t)e * MROWS + p]; TOKSLOT[ent] = (unsigned)sl; } else GW[sl] = 0.f; }
        pg8::Gemm g{XN, WM_IN, NT * 256, 2 * D_EXP, DM / 2, DM / 2, (size_t)2 * D_EXP * DM, ELIST, 0, ERS, W8_SCALE_E8M0}; GS.init(NT * 256, 2 * D_EXP, F.G, (int)blockIdx.x);
        pg8::EpiSwiGLU8q E{(unsigned char*)ACT, D_EXP};
        pg8::gemm_phase_f8q<pg8::EpiSwiGLU8q, pg8::GroupedOrder>(F.lds + RING_OFF, g, GS, E, (LAS unsigned*)(F.lds + LDSCTL_OFF + 2048));
        if (BOTH(PH_MOE_UP)) GRID_BAR();
    }
    const int DU = NT * 4, DLIM = (DU / F.G) * F.G, DTS = 2, DKP = D_EXP / DTS;
    if (IN(PH_MOE_DOWN)) {
        { pg8::DownMainQ DM_; (pg8::GroupedOrder&)DM_ = GS; DM_.init(NT * 256, DM, F.G, (int)blockIdx.x); DM_.v = F.vcu; DM_.lim = DLIM < DU ? DLIM : DU;
          pg8::Gemm g{ACT, WM_OUT, NT * 256, DM, D_EXP / 2, D_EXP / 2, (size_t)DM * D_EXP, IDL, 0, (const unsigned*)GW, W8_SCALE_E8M0};
          pg8::EpiY8q E{YB, DM, 0};
          pg8::gemm_phase_f8q<pg8::EpiY8q, pg8::DownMainQ>(F.lds + RING_OFF, g, DM_, E, (LAS unsigned*)(F.lds + LDSCTL_OFF + 2048)); }
        if (DU > DLIM) {
            pg8::DownTailQ DT_; (pg8::GroupedOrder&)DT_ = GS; DT_.init(NT * 256, DM, F.G, (int)blockIdx.x); DT_.v = F.vcu; DT_.lim = DLIM; DT_.S = DTS; DT_.ntask = (DU - DLIM) * DTS;
            pg8::Gemm g{ACT, WM_OUT, NT * 256, DM, DKP / 2, D_EXP / 2, (size_t)DM * D_EXP, IDL, D_EXP / 2, (const unsigned*)GW, W8_SCALE_E8M0};
            pg8::EpiY8q E{YP - (size_t)(DLIM / 4) * 256 * DM, DM, (size_t)YP_ROWS * DM};
            pg8::gemm_phase_f8q<pg8::EpiY8q, pg8::DownTailQ>(F.lds + RING_OFF, g, DT_, E, (LAS unsigned*)(F.lds + LDSCTL_OFF + 2048));
        }
        if (BOTH(PH_MOE_DOWN)) GRID_BAR();
    }
    if (IN(PH_COMBINE)) {
        const unsigned tail0 = (unsigned)(DLIM / 4) * 256u;
#define CB_YBASE(sl) ((((DU > DLIM) && (sl) >= tail0) ? YP + (size_t)((sl) - tail0) * DM : YB + (size_t)(sl) * DM))
#define CB_LOAD(hd, yd, mm, sa, sb) do { const GAS v4u* hp_ = (const GAS v4u*)(HB + (size_t)(mm) * DM) + F.lane; const GAS v4u* ya_ = (const GAS v4u*)CB_YBASE(sa) + F.lane; const GAS v4u* yb_ = (const GAS v4u*)CB_YBASE(sb) + F.lane; \
            _Pragma("unroll") for (int j = 0; j < 2; ++j) { hd[j] = hp_[64 * j]; yd[j] = ya_[64 * j]; yd[2 + j] = yb_[64 * j]; } } while (0)
        unsigned sa0 = 0, sa1 = 0, sb0 = 0, sb1 = 0; v4u hn[2]; v4u yn[4];
        if (gw < MROWS) { sa0 = TOKSLOT[2 * gw]; sa1 = TOKSLOT[2 * gw + 1]; if (gw + NGW < MROWS) { sb0 = TOKSLOT[2 * (gw + NGW)]; sb1 = TOKSLOT[2 * (gw + NGW) + 1]; } CB_LOAD(hn, yn, gw, sa0, sa1); }
        for (int m = gw; m < MROWS; m += NGW) {
            f32x4 h[4]; v4u y[4]; const unsigned s0 = sa0, s1 = sa1;
#pragma unroll
            for (int j = 0; j < 2; ++j) { const v4u a = hn[j]; h[2 * j] = (f32x4){bflo(a.x), bfhi(a.x), bflo(a.y), bfhi(a.y)}; h[2 * j + 1] = (f32x4){bflo(a.z), bfhi(a.z), bflo(a.w), bfhi(a.w)}; }
#pragma unroll
            for (int j = 0; j < 4; ++j) y[j] = yn[j];
            sa0 = sb0; sa1 = sb1;
            if (m + 2 * NGW < MROWS) { sb0 = TOKSLOT[2 * (m + 2 * NGW)]; sb1 = TOKSLOT[2 * (m + 2 * NGW) + 1]; }
            if (m + NGW < MROWS) CB_LOAD(hn, yn, m + NGW, sa0, sa1);
#pragma unroll
            for (int k = 0; k < 2; ++k) {
#pragma unroll
                for (int j = 0; j < 2; ++j) { const v4u a = y[2 * k + j];
                    h[2 * j].x += bflo(a.x); h[2 * j].y += bfhi(a.x); h[2 * j].z += bflo(a.y); h[2 * j].w += bfhi(a.y); h[2 * j + 1].x += bflo(a.z); h[2 * j + 1].y += bfhi(a.z); h[2 * j + 1].z += bflo(a.w); h[2 * j + 1].w += bfhi(a.w); }
                const unsigned sl = k ? s1 : s0;
                if ((DU > DLIM) && sl >= tail0) {
                    for (int p = 1; p < DTS; ++p) { const GAS v4u* yp = (const GAS v4u*)(YP + (size_t)(sl - tail0) * DM + (size_t)p * YP_ROWS * DM) + F.lane;
#pragma unroll
                        for (int j = 0; j < 2; ++j) { const v4u a = yp[64 * j];
                            h[2 * j].x += bflo(a.x); h[2 * j].y += bfhi(a.x); h[2 * j].z += bflo(a.y); h[2 * j].w += bfhi(a.y); h[2 * j + 1].x += bflo(a.z); h[2 * j + 1].y += bfhi(a.z); h[2 * j + 1].z += bflo(a.w); h[2 * j + 1].w += bfhi(a.w); } } } }
            GAS f32x4* hp = (GAS f32x4*)(H + (size_t)m * DM) + 2 * F.lane;
#pragma unroll
            for (int j = 0; j < 2; ++j) { hp[128 * j] = h[2 * j]; hp[128 * j + 1] = h[2 * j + 1]; } }
#undef CB_YBASE
#undef CB_LOAD
    }
#undef IN
#undef BOTH
}

extern "C" void kernel_launch(void* const* d_in, const int* in_sizes, int n_in, void* d_out, int out_size, void* d_ws, size_t ws_size, hipStream_t stream) {
    static int grid = 0;
    if (grid == 0) {
        if (n_in != N_IN || in_sizes[0] != MROWS * DM || out_size != MROWS * DM || ws_size < WS_END) { fprintf(stderr, "kernel_launch: unexpected shapes / workspace (n_in %d, in0 %d, out %d, ws %zu < %zu)\n", n_in, n_in > 0 ? in_sizes[0] : -1, out_size, ws_size, (size_t)WS_END); grid = -1; return; }
        int dev = 0, cus = 0, per_cu = 0;
        if (hipGetDevice(&dev) != hipSuccess || hipDeviceGetAttribute(&cus, hipDeviceAttributeMultiprocessorCount, dev) != hipSuccess) { grid = -1; return; }
        if (hipFuncSetAttribute((const void*)yoco_fwd, hipFuncAttributeMaxDynamicSharedMemorySize, LDS_BYTES) != hipSuccess) { fprintf(stderr, "kernel_launch: hipFuncSetAttribute failed\n"); grid = -1; return; }
        if (hipOccupancyMaxActiveBlocksPerMultiprocessor(&per_cu, (const void*)yoco_fwd, NWAVES * 64, LDS_BYTES) != hipSuccess || per_cu < 1) fprintf(stderr, "kernel_launch: occupancy query reports %d\n", per_cu);
        (void)hipGetLastError();
        if (cus != 256) { fprintf(stderr, "kernel_launch: built for a 256-CU device (got %d)\n", cus); grid = -1; return; }
        grid = cus;
    }
    if (grid < 0) return;
    if (hipMemsetAsync((char*)d_ws + WS_CTL, 0, CTL_ZERO_BYTES, stream) != hipSuccess) return;
    Args a{};
    for (int i = 0; i < N_IN; ++i) a.in[i] = (const float*)d_in[i];
    a.out = (float*)d_out; a.ws = (unsigned char*)d_ws;
#if MK_ONE_LAUNCH
    a.ph_lo = 0; a.ph_hi = MK_PH_STOP; a.li = 0;
    hipLaunchKernelGGL(yoco_fwd, dim3(grid), dim3(NWAVES * 64), LDS_BYTES, stream, a);
#else
    for (int p = 0; p < MK_PH_STOP; ++p) { a.ph_lo = p; a.ph_hi = p + 1; a.li = 0; hipLaunchKernelGGL(yoco_fwd, dim3(grid), dim3(NWAVES * 64), LDS_BYTES, stream, a); }
#endif
}
```

```cpp
#include <hip/hip_runtime.h>
#include <hip/hip_bf16.h>
#include <cstdio>
#include <cstdint>
#include <cmath>
namespace pg8 {
#define PG8_LAS __attribute__((address_space(3)))
typedef unsigned short bf16_t;
typedef short bf16x8 __attribute__((ext_vector_type(8)));
typedef float f32x4 __attribute__((ext_vector_type(4)));
typedef unsigned u32x4 __attribute__((ext_vector_type(4)));
constexpr int BM = 256, BK = 64, HALF = 128, HTB = HALF * BK * 2  , STAGE_BYTES = 8 * HTB, NXCD = 8, WGM = 8;

__host__ __device__ __forceinline__ int lds_byte(int r, int c) { const int st = (r >> 4) * 2 + (c >> 5), rr = r & 15, cc = c & 31, ob = rr * 64 + cc * 2; return st * 1024 + (ob ^ (((ob >> 9) & 1) << 5)); }
__host__ __device__ __forceinline__ void stage_rc(int b, int& R, int& C) { const int st = b / 1024, sb = b % 1024, swz = sb ^ (((sb >> 9) & 1) << 5); R = (st >> 1) * 16 + swz / 64; C = (st & 1) * 32 + (swz % 64) / 2; }
__host__ __device__ __forceinline__ int perm32(int rho) { const int n = rho >> 4, i = rho & 15; return 8 * (i >> 2) + 4 * n + (i & 3); }

struct Unit { int pm, pn, kp; };
struct Gemm { const bf16_t* A; const bf16_t* Bt; int M, N, K, lda; size_t bstride; const unsigned* rowlist; int ldb; const unsigned* wlist; int scale_b; };

struct StaticOrder {
    int nM, nN, nwg, G, c;
    __host__ __device__ __forceinline__ void init(int M, int N, int G_, int c_) { nM = M / BM; nN = N / BM; nwg = nM * nN; G = G_; c = c_; }
    __host__ __device__ __forceinline__ bool next(int i, Unit& u) const {
        const long L = (long)i * G + c; if (L >= nwg) return false;
        int wgid = (int)L; { const int q = nwg / NXCD, r = nwg % NXCD, xcd = wgid % NXCD, off = wgid / NXCD; wgid = (xcd < r ? xcd * (q + 1) : r * (q + 1) + (xcd - r) * q) + off; }
        const int nig = WGM * nN, gid = wgid / nig, fm = gid * WGM, gsz = (nM - fm) < WGM ? (nM - fm) : WGM;
        u.pm = fm + ((wgid % nig) % gsz); u.pn = (wgid % nig) / gsz; u.kp = 0; return true;
    }
    __device__ __forceinline__ void a_ready(const Unit&) const {}
    __device__ __forceinline__ void done(const Unit&) const {}
    __device__ __forceinline__ int expert(int) const { return 0; }
    __device__ __forceinline__ size_t kbytes(const Unit&, int) const { return 0; }
    __device__ __forceinline__ int listoff(int) const { return 0; }
    __device__ __forceinline__ int rows(int) const { return 256; }
};
struct GroupedOrder : StaticOrder {
    int ts[9], cnt[8], cap;
    __device__ __forceinline__ int listoff(int pm) const { const int e = expert(pm); int t0 = 0;
#pragma unroll
        for (int k = 1; k < 8; ++k) t0 = (e == k) ? ts[k] : t0;
        return e * cap + (pm - t0) * 256; }
    __device__ __forceinline__ int rows(int pm) const { const int e = expert(pm); int t0 = 0, c = cnt[0];
#pragma unroll
        for (int k = 1; k < 8; ++k) { t0 = (e == k) ? ts[k] : t0; c = (e == k) ? cnt[k] : c; }
        const int r = c - (pm - t0) * 256; return r < 0 ? 0 : (r > 256 ? 256 : r); }
    __device__ __forceinline__ int expert(int pm) const { int e = 0;
#pragma unroll
        for (int k = 1; k < 8; ++k) e += (pm >= ts[k]) ? 1 : 0;
        return e; }
};

__device__ __forceinline__ unsigned cvt_pk_bf16(float lo, float hi) { unsigned r; asm volatile("v_cvt_pk_bf16_f32 %0, %1, %2" : "=v"(r) : "v"(lo), "v"(hi)); return r; }
typedef float f32x2 __attribute__((ext_vector_type(2)));
__device__ __forceinline__ f32x2 gelu_pk(f32x2 v) {
    const f32x2 av = __builtin_elementwise_abs(v), d = av * 0.2316418882f + 1.0f;
    f32x2 t; t.x = __builtin_amdgcn_rcpf(d.x); t.y = __builtin_amdgcn_rcpf(d.y);
    f32x2 q = t * 0.5307027145f + (-0.7265760135f); q = q * t + 0.7107068705f; q = q * t + (-0.142248368f); q = q * t + 0.127414796f; q = q * t;
    const f32x2 s = (v * v) * (-0.72134752044f);
    f32x2 e; e.x = __builtin_amdgcn_exp2f(s.x); e.y = __builtin_amdgcn_exp2f(s.y);
    const f32x2 m = v * (q * e), r = v - m;
    f32x2 o; o.x = v.x < 0.f ? m.x : r.x; o.y = v.y < 0.f ? m.y : r.y; return o;
}
constexpr float GELU_K = 0.84932180f;
__device__ __forceinline__ void gelu_w_pk4(const f32x2 (&w)[4], f32x2 (&o)[4]) {
    constexpr float C[9] = {5.886622071e-01f, -5.522741079e-01f, 4.032063782e-01f, -2.406371087e-01f, 1.149394065e-01f, -4.112898186e-02f, 1.002788637e-02f, -1.450342475e-03f, 9.243155364e-05f};
    f32x2 y[4], p[4], e[4];
#pragma unroll
    for (int i = 0; i < 4; ++i) { y[i].x = __builtin_fabsf(w[i].x); y[i].y = __builtin_fabsf(w[i].y); }
#pragma unroll
    for (int i = 0; i < 4; ++i) p[i] = y[i] * C[8] + C[7];
#pragma unroll
    for (int c = 6; c >= 0; --c)
#pragma unroll
        for (int i = 0; i < 4; ++i) p[i] = p[i] * y[i] + C[c];
#pragma unroll
    for (int i = 0; i < 4; ++i) { const f32x2 s = w[i] * w[i]; e[i].x = __builtin_amdgcn_exp2f(-s.x); e[i].y = __builtin_amdgcn_exp2f(-s.y); }
#pragma unroll
    for (int i = 0; i < 4; ++i) { const f32x2 h = 0.588705011f - p[i] * e[i]; o[i] = w[i] * 0.588705011f + y[i] * h; }
}

template <int ACT  > struct EpiBf16 {
    static constexpr bool PERM = true, AFTER_DRAIN = false; static_assert(ACT == 0 || ACT == 1, "EpiBf16: ACT is 0 (none) or 1 (gelu_pk)");
    bf16_t* O; int ldc; const float* bias; int split_cols; size_t split_stride; float scale0;
    __device__ __forceinline__ void operator()(const f32x4 (&acc)[2][2][4][2], const Unit& u, int wr, int wc, int fr, int fq, int ui = 0, const PG8_LAS unsigned* tab = nullptr) const {
        const int row0 = u.pm * BM + wr * 64 + fr; int colt = u.pn * BM; bf16_t* base = O;
        float sc = 1.f; if (split_cols) { const int t = colt / split_cols; base += (size_t)t * split_stride; colt -= t * split_cols; if (t == 0) sc = scale0; }
        const int col0 = colt + wc * 32 + 8 * fq, bcol0 = u.pn * BM + wc * 32 + 8 * fq;
        f32x4 bv[2][2];
#pragma unroll
        for (int bj = 0; bj < 2; ++bj)
#pragma unroll
            for (int n = 0; n < 2; ++n) bv[bj][n] = bias ? *(const f32x4*)(bias + bcol0 + bj * HALF + 4 * n) : (f32x4){0.f, 0.f, 0.f, 0.f};
#pragma unroll
        for (int ai = 0; ai < 2; ++ai)
#pragma unroll
            for (int m = 0; m < 4; ++m) { bf16_t* rowp = base + (size_t)(row0 + ai * HALF + m * 16) * ldc + col0;
#pragma unroll
                for (int bj = 0; bj < 2; ++bj) { f32x4 v0 = acc[ai][bj][m][0] + bv[bj][0], v1 = acc[ai][bj][m][1] + bv[bj][1];
                    if (ACT == 1) { f32x2 a = gelu_pk((f32x2){v0[0], v0[1]}), b = gelu_pk((f32x2){v0[2], v0[3]}), c = gelu_pk((f32x2){v1[0], v1[1]}), d = gelu_pk((f32x2){v1[2], v1[3]});
                        v0 = (f32x4){a.x, a.y, b.x, b.y}; v1 = (f32x4){c.x, c.y, d.x, d.y}; }
                    v0 = v0 * sc; v1 = v1 * sc; u32x4 w; w.x = cvt_pk_bf16(v0[0], v0[1]); w.y = cvt_pk_bf16(v0[2], v0[3]); w.z = cvt_pk_bf16(v1[0], v1[1]); w.w = cvt_pk_bf16(v1[2], v1[3]);
                    *(u32x4*)(rowp + bj * HALF) = w; } }
    }
};


struct DownMain : GroupedOrder {
    int v, lim;
    __device__ __forceinline__ bool next(int i, Unit& u) const { const int L = i * G + v; if (L >= lim) return false; u.pm = L >> 2; u.pn = L & 3; u.kp = 0; return true; }
};
struct DownTail : GroupedOrder {
    int v, lim, ntask, S;
    __device__ __forceinline__ bool next(int i, Unit& u) const { const int t = i * G + v; if (t >= ntask) return false; const int L = lim + t / S; u.pm = L >> 2; u.pn = L & 3; u.kp = t % S; return true; }
    __device__ __forceinline__ size_t kbytes(const Unit& u, int K) const { return (size_t)u.kp * K * 2; }
};
struct DownMainQ : DownMain { __device__ __forceinline__ int listoff(int pm) const { return pm * 256; } __device__ __forceinline__ int rows(int) const { return 256; } };
struct DownTailQ : DownTail { __device__ __forceinline__ int listoff(int pm) const { return pm * 256; } __device__ __forceinline__ int rows(int) const { return 256; } };
struct DownMain8 : GroupedOrder {
    int v, lim;
    __device__ __forceinline__ bool next(int i, Unit& u) const { const int L = i * G + v; if (L >= lim) return false; u.pm = L >> 3; u.pn = L & 7; u.kp = 0; return true; }
    __device__ __forceinline__ int listoff(int pm) const { return pm * 256; }
    __device__ __forceinline__ int rows(int) const { return 256; }
};
struct DownTail8 : GroupedOrder {
    int v, lim, ntask, S;
    __device__ __forceinline__ bool next(int i, Unit& u) const { const int t = i * G + v; if (t >= ntask) return false; const int L = lim + t / S; u.pm = L >> 3; u.pn = L & 7; u.kp = t % S; return true; }
    __device__ __forceinline__ size_t kbytes(const Unit& u, int K) const { return (size_t)u.kp * K * 2; }
    __device__ __forceinline__ int listoff(int pm) const { return pm * 256; }
    __device__ __forceinline__ int rows(int) const { return 256; }
};
struct EpiF32Res {
    static constexpr bool PERM = false, AFTER_DRAIN = false;
    const float* base; float* out; int ldc; const float* gate; int gstride;
    __device__ __forceinline__ void operator()(const f32x4 (&acc)[2][2][4][2], const Unit& u, int wr, int wc, int fr, int fq, int ui = 0, const PG8_LAS unsigned* tab = nullptr) const {
        const int row0 = u.pm * BM + wr * 64 + fr, col0 = u.pn * BM + wc * 32 + 4 * fq;
#pragma unroll
        for (int ai = 0; ai < 2; ++ai) {
            f32x4 bs[4][2][2];
#pragma unroll
            for (int m = 0; m < 4; ++m) { const size_t off = (size_t)(row0 + ai * HALF + m * 16) * ldc + col0;
#pragma unroll
                for (int bj = 0; bj < 2; ++bj)
#pragma unroll
                    for (int n = 0; n < 2; ++n) bs[m][bj][n] = *(const f32x4*)(base + off + bj * HALF + n * 16); }
#pragma unroll
            for (int m = 0; m < 4; ++m) { const int row = row0 + ai * HALF + m * 16; const size_t off = (size_t)row * ldc + col0;
                const float gs = gate ? gate[(size_t)row * gstride] : 1.0f;
#pragma unroll
                for (int bj = 0; bj < 2; ++bj)
#pragma unroll
                    for (int n = 0; n < 2; ++n) *(f32x4*)(out + off + bj * HALF + n * 16) = bs[m][bj][n] + acc[ai][bj][m][n] * gs; }
            asm volatile("" ::: "memory"); }
    }
};
__device__ __forceinline__ float part16_rstd(const float* part, int row, int fq, float inv_n, float eps) {
    const f32x4 p = *(const f32x4*)(part + (size_t)row * 16 + 4 * fq); float t = (p[0] + p[1]) + (p[2] + p[3]); t += __shfl_xor(t, 16); t += __shfl_xor(t, 32); return 1.0f / sqrtf(t * inv_n + eps); }
template <bool BASE_BF16> struct EpiResBf {
    static constexpr bool PERM = true, AFTER_DRAIN = false;
    const void* base; bf16_t* hb; float* part; int ldc;
    __device__ __forceinline__ void operator()(const f32x4 (&acc)[2][2][4][2], const Unit& u, int wr, int wc, int fr, int fq, int ui = 0, const PG8_LAS unsigned* tab = nullptr) const {
        const int row0 = u.pm * BM + wr * 64 + fr, col0 = u.pn * BM + wc * 32 + 8 * fq;
#pragma unroll
        for (int ai = 0; ai < 2; ++ai) {
            f32x4 bs[4][2][2];
#pragma unroll
            for (int m = 0; m < 4; ++m) { const size_t off = (size_t)(row0 + ai * HALF + m * 16) * ldc + col0;
#pragma unroll
                for (int bj = 0; bj < 2; ++bj) {
                    if (BASE_BF16) { const u32x4 w = *(const u32x4*)((const bf16_t*)base + off + bj * HALF);
                        bs[m][bj][0] = (f32x4){__uint_as_float(w.x << 16), __uint_as_float(w.x & 0xffff0000u), __uint_as_float(w.y << 16), __uint_as_float(w.y & 0xffff0000u)};
                        bs[m][bj][1] = (f32x4){__uint_as_float(w.z << 16), __uint_as_float(w.z & 0xffff0000u), __uint_as_float(w.w << 16), __uint_as_float(w.w & 0xffff0000u)}; }
                    else { bs[m][bj][0] = *(const f32x4*)((const float*)base + off + bj * HALF); bs[m][bj][1] = *(const f32x4*)((const float*)base + off + bj * HALF + 4); } } }
#pragma unroll
            for (int m = 0; m < 4; ++m) { const int row = row0 + ai * HALF + m * 16; const size_t off = (size_t)row * ldc + col0; float ss = 0.f;
#pragma unroll
                for (int bj = 0; bj < 2; ++bj) { const f32x4 o0 = bs[m][bj][0] + acc[ai][bj][m][0], o1 = bs[m][bj][1] + acc[ai][bj][m][1];
                    ss += ((o0[0] * o0[0] + o0[1] * o0[1]) + (o0[2] * o0[2] + o0[3] * o0[3])) + ((o1[0] * o1[0] + o1[1] * o1[1]) + (o1[2] * o1[2] + o1[3] * o1[3]));
                    u32x4 w; w.x = cvt_pk_bf16(o0[0], o0[1]); w.y = cvt_pk_bf16(o0[2], o0[3]); w.z = cvt_pk_bf16(o1[0], o1[1]); w.w = cvt_pk_bf16(o1[2], o1[3]); *(u32x4*)(hb + off + bj * HALF) = w; }
                if (part) { ss += __shfl_xor(ss, 16); ss += __shfl_xor(ss, 32); if (fq == 0) part[(size_t)row * 16 + 4 * u.pn + wc] = ss; } }
            asm volatile("" ::: "memory"); }
    }
};
struct EpiGeluSq {
    static constexpr bool PERM = true, AFTER_DRAIN = false;
    bf16_t* O; int ldc; float* vpart; int pn_sq; const PG8_LAS float* rtab;
    __device__ __forceinline__ void operator()(const f32x4 (&acc)[2][2][4][2], const Unit& u, int wr, int wc, int fr, int fq, int ui = 0, const PG8_LAS unsigned* tab = nullptr) const {
        const int row0 = u.pm * BM + wr * 64 + fr, col0 = u.pn * BM + wc * 32 + 8 * fq; const bool sq = u.pn >= pn_sq;
#pragma unroll
        for (int ai = 0; ai < 2; ++ai)
#pragma unroll
            for (int m = 0; m < 4; ++m) { const int row = row0 + ai * HALF + m * 16; bf16_t* rowp = O + (size_t)row * ldc + col0; f32x2 ss2 = {0.f, 0.f}; const float rr = rtab[ui * 256 + (row - u.pm * BM)] * GELU_K;
#pragma unroll
                for (int bj = 0; bj < 2; ++bj) { const f32x4 v0 = acc[ai][bj][m][0] * rr, v1 = acc[ai][bj][m][1] * rr;
                    const f32x2 wi[4] = {(f32x2){v0[0], v0[1]}, (f32x2){v0[2], v0[3]}, (f32x2){v1[0], v1[1]}, (f32x2){v1[2], v1[3]}}; f32x2 go[4]; gelu_w_pk4(wi, go); const f32x2 a = go[0], b = go[1], c = go[2], d = go[3];
                    if (sq) { ss2 = a * a + ss2; ss2 = b * b + ss2; ss2 = c * c + ss2; ss2 = d * d + ss2; }
                    u32x4 w; w.x = cvt_pk_bf16(a.x, a.y); w.y = cvt_pk_bf16(b.x, b.y); w.z = cvt_pk_bf16(c.x, c.y); w.w = cvt_pk_bf16(d.x, d.y);
                    *(u32x4*)(rowp + bj * HALF) = w; }
                float ss = ss2.x + ss2.y;
                if (sq) { ss += __shfl_xor(ss, 16); ss += __shfl_xor(ss, 32); if (fq == 0) vpart[(size_t)row * 48 + 4 * (u.pn - pn_sq) + wc] = ss; } }
    }
};

struct EpiHead4 {
    static constexpr bool PERM = true, AFTER_DRAIN = false;
    bf16_t* T; size_t tstride; const PG8_LAS float* g; float eps; const PG8_LAS float* rtab;
    __device__ __forceinline__ void operator()(const f32x4 (&acc)[2][2][4][2], const Unit& u, int wr, int wc, int fr, int fq, int ui = 0, const PG8_LAS unsigned* tab = nullptr) const {
        const int row0 = u.pm * BM + wr * 64 + fr, kind = u.pn >> 2; const bool nrm = (kind & 1) == 0; const int col0 = ((u.pn & 3) * 4 + wc) * 64 + 8 * fq;
        bf16_t* base = T + (size_t)kind * tstride;
        f32x4 gg[2][2];
#pragma unroll
        for (int bj = 0; bj < 2; ++bj)
#pragma unroll
            for (int n = 0; n < 2; ++n) gg[bj][n] = *(const PG8_LAS f32x4*)(g + 32 * (kind & 2) + 32 * bj + 8 * fq + 4 * n);
#pragma unroll
        for (int ai = 0; ai < 2; ++ai)
#pragma unroll
            for (int m = 0; m < 4; ++m) { bf16_t* rowp = base + (size_t)(row0 + ai * HALF + m * 16) * 1024 + col0; const float rr = rtab[ui * 256 + ai * HALF + wr * 64 + m * 16 + fr];
                f32x4 v[2][2];
#pragma unroll
                for (int bj = 0; bj < 2; ++bj)
#pragma unroll
                    for (int n = 0; n < 2; ++n) v[bj][n] = acc[ai][bj][m][n] * rr;
                if (nrm) { float ss = 0.f;
#pragma unroll
                    for (int bj = 0; bj < 2; ++bj)
#pragma unroll
                        for (int n = 0; n < 2; ++n) ss += (v[bj][n][0] * v[bj][n][0] + v[bj][n][1] * v[bj][n][1]) + (v[bj][n][2] * v[bj][n][2] + v[bj][n][3] * v[bj][n][3]);
                    ss += __shfl_xor(ss, 16); ss += __shfl_xor(ss, 32);
                    const float rs = 1.0f / sqrtf(ss * (1.0f / 64.0f) + eps);
#pragma unroll
                    for (int bj = 0; bj < 2; ++bj)
#pragma unroll
                        for (int n = 0; n < 2; ++n) v[bj][n] = v[bj][n] * rs * gg[bj][n];
                } else if (kind == 3) {
#pragma unroll
                    for (int bj = 0; bj < 2; ++bj)
#pragma unroll
                        for (int n = 0; n < 2; ++n)
#pragma unroll
                            for (int e = 0; e < 4; ++e) v[bj][n][e] = __builtin_amdgcn_rcpf(1.0f + __builtin_amdgcn_exp2f(-1.4426950408889634f * v[bj][n][e]));
                }
#pragma unroll
                for (int bj = 0; bj < 2; ++bj) { u32x4 w; w.x = cvt_pk_bf16(v[bj][0][0], v[bj][0][1]); w.y = cvt_pk_bf16(v[bj][0][2], v[bj][0][3]); w.z = cvt_pk_bf16(v[bj][1][0], v[bj][1][1]); w.w = cvt_pk_bf16(v[bj][1][2], v[bj][1][3]);
                    *(u32x4*)(rowp + 32 * bj) = w; } }
    }
};
struct EpiBf16RowScale {
    static constexpr bool PERM = true, AFTER_DRAIN = false;
    bf16_t* O; int ldc; const PG8_LAS float* rs; size_t kstride;
    __device__ __forceinline__ void operator()(const f32x4 (&acc)[2][2][4][2], const Unit& u, int wr, int wc, int fr, int fq, int ui = 0, const PG8_LAS unsigned* tab = nullptr) const {
        const int row0 = u.pm * BM + wr * 64 + fr, col0 = u.pn * BM + wc * 32 + 8 * fq;
#pragma unroll
        for (int ai = 0; ai < 2; ++ai)
#pragma unroll
            for (int m = 0; m < 4; ++m) { const int row = row0 + ai * HALF + m * 16; bf16_t* rowp = O + (size_t)u.kp * kstride + (size_t)row * ldc + col0; const float sc = rs[ui * 256 + (row - u.pm * BM)];
#pragma unroll
                for (int bj = 0; bj < 2; ++bj) { const f32x4 v0 = acc[ai][bj][m][0] * sc, v1 = acc[ai][bj][m][1] * sc;
                    u32x4 w; w.x = cvt_pk_bf16(v0[0], v0[1]); w.y = cvt_pk_bf16(v0[2], v0[3]); w.z = cvt_pk_bf16(v1[0], v1[1]); w.w = cvt_pk_bf16(v1[2], v1[3]);
                    *(u32x4*)(rowp + bj * HALF) = w; } }
    }
};
struct EpiSwiGLU {
    static constexpr bool PERM = true, AFTER_DRAIN = false;
    bf16_t* O; int ldc; const PG8_LAS float* rtab;
    static __device__ __forceinline__ float silu(float x) { return x * __builtin_amdgcn_rcpf(1.0f + __builtin_amdgcn_exp2f(-1.4426950408889634f * x)); }
    __device__ __forceinline__ void operator()(const f32x4 (&acc)[2][2][4][2], const Unit& u, int wr, int wc, int fr, int fq, int ui = 0, const PG8_LAS unsigned* tab = nullptr) const {
        const int row0 = u.pm * BM + wr * 64 + fr, col0 = u.pn * HALF + wc * 32 + 8 * fq;
#pragma unroll
        for (int ai = 0; ai < 2; ++ai)
#pragma unroll
            for (int m = 0; m < 4; ++m) { const int row = row0 + ai * HALF + m * 16; bf16_t* rowp = O + (size_t)row * ldc + col0;
                const float rs = rtab ? rtab[ui * 256 + (row - u.pm * BM)] : __uint_as_float(tab[256 + (row - u.pm * BM)]);
                const f32x4 a0 = acc[ai][0][m][0] * rs, a1 = acc[ai][0][m][1] * rs, b0 = acc[ai][1][m][0] * rs, b1 = acc[ai][1][m][1] * rs;
                const f32x4 t0 = a0 * (-1.4426950408889634f), t1 = a1 * (-1.4426950408889634f); f32x4 d0, d1;
#pragma unroll
                for (int e = 0; e < 4; ++e) { d0[e] = __builtin_amdgcn_exp2f(t0[e]); d1[e] = __builtin_amdgcn_exp2f(t1[e]); }
                d0 = d0 + 1.0f; d1 = d1 + 1.0f;
#pragma unroll
                for (int e = 0; e < 4; ++e) { d0[e] = __builtin_amdgcn_rcpf(d0[e]); d1[e] = __builtin_amdgcn_rcpf(d1[e]); }
                const f32x4 y0 = (a0 * b0) * d0, y1 = (a1 * b1) * d1;
                u32x4 w; w.x = cvt_pk_bf16(y0[0], y0[1]); w.y = cvt_pk_bf16(y0[2], y0[3]); w.z = cvt_pk_bf16(y1[0], y1[1]); w.w = cvt_pk_bf16(y1[2], y1[3]);
                *(u32x4*)rowp = w; }
    }
};
constexpr float W8_INV = 1.0f / 64.0f;
struct EpiSwiGLU8q {
    static constexpr bool PERM = true, AFTER_DRAIN = false;
    unsigned char* O; int ldc;
    __device__ __forceinline__ void operator()(const f32x4 (&acc)[2][2][4][2], const Unit& u, int wr, int wc, int fr, int fq, int ui = 0, const PG8_LAS unsigned* tab = nullptr) const {
        const int col0 = u.pn * HALF + wc * 32 + 8 * fq;
#pragma unroll
        for (int ai = 0; ai < 2; ++ai)
#pragma unroll
            for (int m = 0; m < 4; ++m) { const int r = ai * HALF + wr * 64 + m * 16 + fr; const float rs = __uint_as_float(tab[256 + r]) * W8_INV;
                const f32x4 a0 = acc[ai][0][m][0] * rs, a1 = acc[ai][0][m][1] * rs, b0 = acc[ai][1][m][0] * rs, b1 = acc[ai][1][m][1] * rs;
                const f32x4 t0 = a0 * (-1.4426950408889634f), t1 = a1 * (-1.4426950408889634f); f32x4 d0, d1;
#pragma unroll
                for (int e = 0; e < 4; ++e) { d0[e] = __builtin_amdgcn_exp2f(t0[e]); d1[e] = __builtin_amdgcn_exp2f(t1[e]); }
                d0 = d0 + 1.0f; d1 = d1 + 1.0f;
#pragma unroll
                for (int e = 0; e < 4; ++e) { d0[e] = __builtin_amdgcn_rcpf(d0[e]); d1[e] = __builtin_amdgcn_rcpf(d1[e]); }
                const f32x4 y0 = (a0 * b0) * d0, y1 = (a1 * b1) * d1; unsigned w0 = 0u, w1 = 0u;
                w0 = __builtin_amdgcn_cvt_pk_fp8_f32(y0[0], y0[1], w0, false); w0 = __builtin_amdgcn_cvt_pk_fp8_f32(y0[2], y0[3], w0, true);
                w1 = __builtin_amdgcn_cvt_pk_fp8_f32(y1[0], y1[1], w1, false); w1 = __builtin_amdgcn_cvt_pk_fp8_f32(y1[2], y1[3], w1, true);
                uint2 w; w.x = w0; w.y = w1; *(uint2*)(O + (size_t)(u.pm * BM + r) * ldc + col0) = w; }
    }
};
struct EpiY8q {
    static constexpr bool PERM = true, AFTER_DRAIN = false;
    bf16_t* O; int ldc; size_t kstride;
    __device__ __forceinline__ void operator()(const f32x4 (&acc)[2][2][4][2], const Unit& u, int wr, int wc, int fr, int fq, int ui = 0, const PG8_LAS unsigned* tab = nullptr) const {
        const int col0 = u.pn * BM + wc * 32 + 8 * fq;
#pragma unroll
        for (int ai = 0; ai < 2; ++ai)
#pragma unroll
            for (int m = 0; m < 4; ++m) { const int r = ai * HALF + wr * 64 + m * 16 + fr; const float sc = __uint_as_float(tab[256 + r]) * W8_INV; bf16_t* rowp = O + (size_t)u.kp * kstride + (size_t)(u.pm * BM + r) * ldc + col0;
#pragma unroll
                for (int bj = 0; bj < 2; ++bj) { const f32x4 v0 = acc[ai][bj][m][0] * sc, v1 = acc[ai][bj][m][1] * sc;
                    u32x4 w; w.x = cvt_pk_bf16(v0[0], v0[1]); w.y = cvt_pk_bf16(v0[2], v0[3]); w.z = cvt_pk_bf16(v1[0], v1[1]); w.w = cvt_pk_bf16(v1[2], v1[3]);
                    *(u32x4*)(rowp + bj * HALF) = w; } }
    }
};
template <class Epi, class Sched, bool ALIGN_EPI = false, bool SP2 = true, bool GATHER = false>
__device__ __forceinline__ void gemm_phase(PG8_LAS unsigned char* lds, const Gemm g, const Sched& S, const Epi& E, PG8_LAS unsigned* tt = nullptr) {
    static_assert(SP2, "only the two-MFMA-blocks-per-barrier-pair loop is kept in this file");
    int tid_ = threadIdx.x; asm volatile("" : "+v"(tid_));
    const int tid = tid_, wid = __builtin_amdgcn_readfirstlane(tid >> 6), lane = tid & 63, wr = wid >> 2, wc = wid & 3, fr = lane & 15, fq = lane >> 4;
    const int K = g.K, nt = K / BK, ldb = g.ldb ? g.ldb : K;
    unsigned c0[2], c1[2], n0[2], n1[2], voffB[2]; int rA[2]; unsigned cbA[2];
    const size_t kstep = (size_t)(BK * 2);
    const size_t hstepA = (size_t)HALF * g.lda * 2, hstep = (size_t)HALF * ldb * 2;
    const size_t tstepA = 2 * hstepA, tstep = 2 * hstep;
#pragma unroll
    for (int i = 0; i < 2; ++i) { int R, C; stage_rc(tid * 16 + i * 8192, R, C); const int Rb = Epi::PERM ? ((R & ~31) + perm32(R & 31)) : R; rA[i] = R; cbA[i] = (unsigned)C * 2u;
        c0[i] = (unsigned)(R * g.lda + C) * 2u; c1[i] = c0[i] + (unsigned)hstepA; n0[i] = c0[i]; n1[i] = c1[i]; voffB[i] = (unsigned)(Rb * ldb + C) * 2u; }
    const unsigned ldsw = (unsigned)wid * 1024u;
    const int aoff = lds_byte(wr * 64 + fr, fq * 8), boff = lds_byte(wc * 32 + fr, fq * 8);
#define PG8_SA(b, h) (((b) * 2 + (h)) * HTB)
#define PG8_SB(b, h) ((4 + (b) * 2 + (h)) * HTB)
#define PG8_STAGE(bufoff, gbase, voff) do { _Pragma("unroll") for (int _i = 0; _i < 2; ++_i) \
        __builtin_amdgcn_global_load_lds((const unsigned*)((const char*)(gbase) + (voff)[_i]), (PG8_LAS unsigned*)(lds + (bufoff) + ldsw + _i * 8192), 16, 0, 0); } while (0)
#define PG8_LDA(dst, b, h) do { _Pragma("unroll") for (int m = 0; m < 4; ++m) _Pragma("unroll") for (int k = 0; k < 2; ++k) dst[m][k] = *(const PG8_LAS bf16x8*)(lds + PG8_SA(b, h) + aoff + m * 2048 + k * 1024); } while (0)
#define PG8_LDB(dst, b, h) do { _Pragma("unroll") for (int n = 0; n < 2; ++n) _Pragma("unroll") for (int k = 0; k < 2; ++k) dst[n][k] = *(const PG8_LAS bf16x8*)(lds + PG8_SB(b, h) + boff + n * 2048 + k * 1024); } while (0)
#define PG8_MMA(ai, bj, At, Bt) do { __builtin_amdgcn_s_setprio(1); _Pragma("unroll") for (int m = 0; m < 4; ++m) _Pragma("unroll") for (int n = 0; n < 2; ++n) _Pragma("unroll") for (int k = 0; k < 2; ++k) \
        acc[ai][bj][m][n] = __builtin_amdgcn_mfma_f32_16x16x32_bf16(Bt[n][k], At[m][k], acc[ai][bj][m][n], 0, 0, 0); __builtin_amdgcn_s_setprio(0); } while (0)
#define PG8_WAIT_V(n) asm volatile("s_waitcnt vmcnt(" #n ")" ::: "memory")
#define PG8_WAIT_L(n) asm volatile("s_waitcnt lgkmcnt(" #n ")" ::: "memory")
#define PG8_BAR __builtin_amdgcn_s_barrier()
#define PG8_SCHED __builtin_amdgcn_sched_barrier(0)
#define PG8_GOFF(o0, o1, tab, nv) do { _Pragma("unroll") for (int _i = 0; _i < 2; ++_i) { const unsigned e0_ = (tab)[rA[_i]], e1_ = (tab)[HALF + rA[_i]]; \
        o0[_i] = ((rA[_i] < (nv)) ? (e0_ >> 1) : 0u) * (unsigned)(g.lda * 2) + cbA[_i]; o1[_i] = ((HALF + rA[_i] < (nv)) ? (e1_ >> 1) : 0u) * (unsigned)(g.lda * 2) + cbA[_i]; } } while (0)
    Unit cur, nxt; int ui = 0;
    if (!S.next(0, cur)) return;
    f32x4 acc[2][2][4][2];
#pragma unroll
    for (int a = 0; a < 2; ++a)
#pragma unroll
        for (int b = 0; b < 2; ++b)
#pragma unroll
            for (int m = 0; m < 4; ++m)
#pragma unroll
                for (int n = 0; n < 2; ++n) acc[a][b][m][n] = (f32x4){0.f, 0.f, 0.f, 0.f};
    bf16x8 At[4][2], B0[2][2], B1[2][2];
    int tbuf = 0, tnext = 1;
    if constexpr (GATHER) {
        { const int lo_ = S.listoff(cur.pm); if (tid < 256) tt[tid] = g.rowlist[lo_ + tid]; else tt[tid] = g.wlist[lo_ + tid - 256]; }
        asm volatile("s_waitcnt vmcnt(0) lgkmcnt(0)" ::: "memory"); PG8_BAR; asm volatile("" ::: "memory");
        PG8_GOFF(c0, c1, tt, S.rows(cur.pm));
    }
    const char* cA = (GATHER ? (const char*)g.A : (const char*)g.A + (size_t)cur.pm * tstepA) + S.kbytes(cur, K); const char* cB = (const char*)g.Bt + (size_t)S.expert(cur.pm) * g.bstride + (size_t)cur.pn * tstep + S.kbytes(cur, K);
    S.a_ready(cur);
    PG8_STAGE(PG8_SB(0, 0), cB, voffB); PG8_STAGE(PG8_SB(0, 1), cB + hstep, voffB); PG8_STAGE(PG8_SA(0, 0), cA, c0); PG8_STAGE(PG8_SA(0, 1), cA, c1);
    if (wr == 1) PG8_BAR;
    PG8_WAIT_V(2); PG8_BAR;
    PG8_STAGE(PG8_SB(1, 0), cB + kstep, voffB); PG8_STAGE(PG8_SA(1, 0), cA + kstep, c0); PG8_STAGE(PG8_SB(1, 1), cB + hstep + kstep, voffB);
    PG8_WAIT_V(6); PG8_BAR;
    for (;;) {
        const bool has_next = S.next(ui + 1, nxt);
        const char* nA = GATHER ? cA : (has_next ? (const char*)g.A + (size_t)nxt.pm * tstepA + S.kbytes(nxt, K) : cA); const char* nB = has_next ? (const char*)g.Bt + (size_t)S.expert(nxt.pm) * g.bstride + (size_t)nxt.pn * tstep + S.kbytes(nxt, K) : cB;
        if constexpr (GATHER) { if (has_next) {
            const unsigned* src_ = (wid < 4 ? g.rowlist : g.wlist) + S.listoff(nxt.pm) + (wid & 3) * 64 + lane;
            __builtin_amdgcn_global_load_lds(src_, (PG8_LAS unsigned*)(tt + tnext * 512 + wid * 64), 4, 0, 0); } }
        for (int t = 0; t < nt; t += 2) {
            const bool last = (t == nt - 2);
            if constexpr (GATHER) { if (last && has_next) PG8_GOFF(n0, n1, tt + tnext * 512, S.rows(nxt.pm)); }
            const char* a1 = cA + (size_t)(t + 1) * kstep;
            const char* a2 = last ? nA : cA + (size_t)(t + 2) * kstep; const char* b2 = last ? nB : cB + (size_t)(t + 2) * kstep;
            const char* a3 = a2 + kstep; const char* b3 = b2 + kstep;
            unsigned x0[2], x1[2];
#pragma unroll
            for (int i = 0; i < 2; ++i) { x0[i] = last ? n0[i] : c0[i]; x1[i] = last ? n1[i] : c1[i]; }
            if (last && has_next) S.a_ready(nxt);
            PG8_LDB(B0, 0, 0); PG8_LDB(B1, 0, 1); PG8_SCHED; PG8_LDA(At, 0, 0); PG8_STAGE(PG8_SA(1, 1), a1, c1);
            PG8_WAIT_V(8); PG8_WAIT_L(0); PG8_BAR; PG8_MMA(0, 0, At, B0); PG8_MMA(0, 1, At, B1); PG8_BAR; PG8_SCHED;
            PG8_LDA(At, 0, 1); PG8_STAGE(PG8_SB(0, 0), b2, voffB); PG8_STAGE(PG8_SB(0, 1), b2 + hstep, voffB); PG8_STAGE(PG8_SA(0, 0), a2, x0);
            PG8_WAIT_V(8); PG8_WAIT_L(0); PG8_BAR; PG8_MMA(1, 0, At, B0); PG8_MMA(1, 1, At, B1); PG8_BAR; PG8_SCHED;
            PG8_LDB(B0, 1, 0); PG8_LDB(B1, 1, 1); PG8_SCHED; PG8_LDA(At, 1, 0); PG8_STAGE(PG8_SA(0, 1), a2, x1);
            PG8_WAIT_V(8); PG8_WAIT_L(0); PG8_BAR; PG8_MMA(0, 0, At, B0); PG8_MMA(0, 1, At, B1); PG8_BAR; PG8_SCHED;
            PG8_LDA(At, 1, 1); PG8_STAGE(PG8_SB(1, 0), b3, voffB); PG8_STAGE(PG8_SB(1, 1), b3 + hstep, voffB); PG8_STAGE(PG8_SA(1, 0), a3, x0);
            PG8_WAIT_V(8); PG8_WAIT_L(0); PG8_BAR; PG8_MMA(1, 0, At, B0); PG8_MMA(1, 1, At, B1); PG8_BAR; PG8_SCHED;
        }
        if constexpr (ALIGN_EPI) { if (wr == 0) PG8_BAR; }
        if constexpr (!Epi::AFTER_DRAIN) { E(acc, cur, wr, wc, fr, fq, ui, GATHER ? tt + tbuf * 512 : nullptr); S.done(cur); }
        if (!has_next) break;
#pragma unroll
        for (int a = 0; a < 2; ++a)
#pragma unroll
            for (int b = 0; b < 2; ++b)
#pragma unroll
                for (int m = 0; m < 4; ++m)
#pragma unroll
                    for (int n = 0; n < 2; ++n) acc[a][b][m][n] = (f32x4){0.f, 0.f, 0.f, 0.f};
        cur = nxt; cA = nA; cB = nB; ++ui; tbuf = tnext; tnext = (tnext == 2) ? 0 : tnext + 1;
        if constexpr (GATHER) {
#pragma unroll
            for (int i = 0; i < 2; ++i) { c0[i] = n0[i]; c1[i] = n1[i]; } }
        if constexpr (ALIGN_EPI) { if (wr == 1) PG8_BAR; }
    }
    PG8_WAIT_V(0);
    if constexpr (!ALIGN_EPI) { if (wr == 0) PG8_BAR; }
    PG8_BAR;
    if constexpr (Epi::AFTER_DRAIN) { E.fused(acc, cur, wr, wc, fr, fq, lds, wid, lane); S.done(cur); }
#undef PG8_SA
#undef PG8_SB
#undef PG8_STAGE
#undef PG8_LDA
#undef PG8_LDB
#undef PG8_MMA
#undef PG8_WAIT_V
#undef PG8_WAIT_L
#undef PG8_BAR
#undef PG8_SCHED
#undef PG8_GOFF
}

template <class Epi, class Sched, bool ALIGN_EPI = true, bool SP2 = true, bool GATHER = true>
__device__ __forceinline__ void gemm_phase_f8q(PG8_LAS unsigned char* lds, const Gemm g, const Sched& S, const Epi& E, PG8_LAS unsigned* tt = nullptr) {
    static_assert(SP2, "only the two-MFMA-blocks-per-barrier-pair loop is kept in this file");
    typedef int v8i_t __attribute__((ext_vector_type(8))); typedef int v4i_t __attribute__((ext_vector_type(4)));
    int tid_ = threadIdx.x; asm volatile("" : "+v"(tid_));
    const int tid = tid_, wid = __builtin_amdgcn_readfirstlane(tid >> 6), lane = tid & 63, wr = wid >> 2, wc = wid & 3, fr = lane & 15, fq = lane >> 4;
    const int K = g.K, nt = K / BK, ldb = g.ldb ? g.ldb : K;
    unsigned c0[2], c1[2], n0[2], n1[2], voffB[2]; int rA[2]; unsigned cbA[2];
    const size_t kstep = (size_t)(BK * 2);
    const size_t hstepA = (size_t)HALF * g.lda * 2, hstep = (size_t)HALF * ldb * 2;
    const size_t tstepA = 2 * hstepA, tstep = 2 * hstep;
#pragma unroll
    for (int i = 0; i < 2; ++i) { const int R = (tid >> 3) + 64 * i, x = R & 15, C = (((tid & 7) ^ (((x >> 1) & 1) | (((x >> 3) & 1) << 2))) * 16); const int Rb = (R & ~31) + perm32(R & 31);
        rA[i] = R; cbA[i] = (unsigned)C; c0[i] = (unsigned)(R * g.lda) * 2u + (unsigned)C; c1[i] = c0[i] + (unsigned)hstepA; n0[i] = c0[i]; n1[i] = c1[i]; voffB[i] = (unsigned)(Rb * ldb) * 2u + (unsigned)C; }
    const unsigned ldsw = (unsigned)wid * 1024u;
    const int fsw = ((fr >> 1) & 1) | (((fr >> 3) & 1) << 2);
    const int aoffL = (wr * 64 + fr) * 128 + (((2 * fq) ^ fsw) * 16), aoffH = (wr * 64 + fr) * 128 + (((2 * fq + 1) ^ fsw) * 16);
    const int boffL = (wc * 32 + fr) * 128 + (((2 * fq) ^ fsw) * 16), boffH = (wc * 32 + fr) * 128 + (((2 * fq + 1) ^ fsw) * 16);
#define PG8_SA(b, h) (((b) * 2 + (h)) * HTB)
#define PG8_SB(b, h) ((4 + (b) * 2 + (h)) * HTB)
#define PG8_STAGE(bufoff, gbase, voff) do { _Pragma("unroll") for (int _i = 0; _i < 2; ++_i) \
        __builtin_amdgcn_global_load_lds((const unsigned*)((const char*)(gbase) + (voff)[_i]), (PG8_LAS unsigned*)(lds + (bufoff) + ldsw + _i * 8192), 16, 0, 0); } while (0)
#define PG8_LDA(dst, b, h) do { _Pragma("unroll") for (int m = 0; m < 4; ++m) { const v4i_t l_ = *(const PG8_LAS v4i_t*)(lds + PG8_SA(b, h) + aoffL + m * 2048), h_ = *(const PG8_LAS v4i_t*)(lds + PG8_SA(b, h) + aoffH + m * 2048); \
        dst[m] = (v8i_t){l_[0], l_[1], l_[2], l_[3], h_[0], h_[1], h_[2], h_[3]}; } } while (0)
#define PG8_LDB(dst, b, h) do { _Pragma("unroll") for (int n = 0; n < 2; ++n) { const v4i_t l_ = *(const PG8_LAS v4i_t*)(lds + PG8_SB(b, h) + boffL + n * 2048), h_ = *(const PG8_LAS v4i_t*)(lds + PG8_SB(b, h) + boffH + n * 2048); \
        dst[n] = (v8i_t){l_[0], l_[1], l_[2], l_[3], h_[0], h_[1], h_[2], h_[3]}; } } while (0)
#define PG8_MMA(ai, bj, At, Bt) do { __builtin_amdgcn_s_setprio(1); _Pragma("unroll") for (int m = 0; m < 4; ++m) _Pragma("unroll") for (int n = 0; n < 2; ++n) \
        asm volatile("v_mfma_f32_16x16x128_f8f6f4 %0, %1, %2, %0" : "+v"(acc[ai][bj][m][n]) : "v"(Bt[n]), "v"(At[m])); __builtin_amdgcn_s_setprio(0); } while (0)
#define PG8_WAIT_V(n) asm volatile("s_waitcnt vmcnt(" #n ")" ::: "memory")
#define PG8_WAIT_L(n) asm volatile("s_waitcnt lgkmcnt(" #n ")" ::: "memory")
#define PG8_BAR __builtin_amdgcn_s_barrier()
#define PG8_SCHED __builtin_amdgcn_sched_barrier(0)
#define PG8_GOFF(o0, o1, tab, nv) do { _Pragma("unroll") for (int _i = 0; _i < 2; ++_i) { const unsigned e0_ = (tab)[rA[_i]], e1_ = (tab)[HALF + rA[_i]]; \
        o0[_i] = ((rA[_i] < (nv)) ? (e0_ >> 1) : 0u) * (unsigned)(g.lda * 2) + cbA[_i]; o1[_i] = ((HALF + rA[_i] < (nv)) ? (e1_ >> 1) : 0u) * (unsigned)(g.lda * 2) + cbA[_i]; } } while (0)
    Unit cur, nxt; int ui = 0;
    if (!S.next(0, cur)) return;
    f32x4 acc[2][2][4][2];
#pragma unroll
    for (int a = 0; a < 2; ++a)
#pragma unroll
        for (int b = 0; b < 2; ++b)
#pragma unroll
            for (int m = 0; m < 4; ++m)
#pragma unroll
                for (int n = 0; n < 2; ++n) acc[a][b][m][n] = (f32x4){0.f, 0.f, 0.f, 0.f};
    v8i_t At[4], B0[2], B1[2];
    int tbuf = 0, tnext = 1;
    if constexpr (GATHER) {
        { const int lo_ = S.listoff(cur.pm); if (tid < 256) tt[tid] = g.rowlist[lo_ + tid]; else tt[tid] = g.wlist[lo_ + tid - 256]; }
        asm volatile("s_waitcnt vmcnt(0) lgkmcnt(0)" ::: "memory"); PG8_BAR; asm volatile("" ::: "memory");
        PG8_GOFF(c0, c1, tt, S.rows(cur.pm));
    }
    const char* cA = (GATHER ? (const char*)g.A : (const char*)g.A + (size_t)cur.pm * tstepA) + S.kbytes(cur, K); const char* cB = (const char*)g.Bt + (size_t)S.expert(cur.pm) * g.bstride + (size_t)cur.pn * tstep + S.kbytes(cur, K);
    S.a_ready(cur);
    PG8_STAGE(PG8_SB(0, 0), cB, voffB); PG8_STAGE(PG8_SB(0, 1), cB + hstep, voffB); PG8_STAGE(PG8_SA(0, 0), cA, c0); PG8_STAGE(PG8_SA(0, 1), cA, c1);
    if (wr == 1) PG8_BAR;
    PG8_WAIT_V(2); PG8_BAR;
    PG8_STAGE(PG8_SB(1, 0), cB + kstep, voffB); PG8_STAGE(PG8_SA(1, 0), cA + kstep, c0); PG8_STAGE(PG8_SB(1, 1), cB + hstep + kstep, voffB);
    PG8_WAIT_V(6); PG8_BAR;
    for (;;) {
        const bool has_next = S.next(ui + 1, nxt);
        const char* nA = GATHER ? cA : (has_next ? (const char*)g.A + (size_t)nxt.pm * tstepA + S.kbytes(nxt, K) : cA); const char* nB = has_next ? (const char*)g.Bt + (size_t)S.expert(nxt.pm) * g.bstride + (size_t)nxt.pn * tstep + S.kbytes(nxt, K) : cB;
        if constexpr (GATHER) { if (has_next) {
            const unsigned* src_ = (wid < 4 ? g.rowlist : g.wlist) + S.listoff(nxt.pm) + (wid & 3) * 64 + lane;
            __builtin_amdgcn_global_load_lds(src_, (PG8_LAS unsigned*)(tt + tnext * 512 + wid * 64), 4, 0, 0); } }
        for (int t = 0; t < nt; t += 2) {
            const bool last = (t == nt - 2);
            if constexpr (GATHER) { if (last && has_next) PG8_GOFF(n0, n1, tt + tnext * 512, S.rows(nxt.pm)); }
            const char* a1 = cA + (size_t)(t + 1) * kstep;
            const char* a2 = last ? nA : cA + (size_t)(t + 2) * kstep; const char* b2 = last ? nB : cB + (size_t)(t + 2) * kstep;
            const char* a3 = a2 + kstep; const char* b3 = b2 + kstep;
            unsigned x0[2], x1[2];
#pragma unroll
            for (int i = 0; i < 2; ++i) { x0[i] = last ? n0[i] : c0[i]; x1[i] = last ? n1[i] : c1[i]; }
            if (last && has_next) S.a_ready(nxt);
            PG8_LDB(B0, 0, 0); PG8_LDB(B1, 0, 1); PG8_SCHED; PG8_LDA(At, 0, 0); PG8_STAGE(PG8_SA(1, 1), a1, c1);
            PG8_WAIT_V(8); PG8_WAIT_L(0); PG8_BAR; PG8_MMA(0, 0, At, B0); PG8_MMA(0, 1, At, B1); PG8_BAR; PG8_SCHED;
            PG8_LDA(At, 0, 1); PG8_STAGE(PG8_SB(0, 0), b2, voffB); PG8_STAGE(PG8_SB(0, 1), b2 + hstep, voffB); PG8_STAGE(PG8_SA(0, 0), a2, x0);
            PG8_WAIT_V(8); PG8_WAIT_L(0); PG8_BAR; PG8_MMA(1, 0, At, B0); PG8_MMA(1, 1, At, B1); PG8_BAR; PG8_SCHED;
            PG8_LDB(B0, 1, 0); PG8_LDB(B1, 1, 1); PG8_SCHED; PG8_LDA(At, 1, 0); PG8_STAGE(PG8_SA(0, 1), a2, x1);
            PG8_WAIT_V(8); PG8_WAIT_L(0); PG8_BAR; PG8_MMA(0, 0, At, B0); PG8_MMA(0, 1, At, B1); PG8_BAR; PG8_SCHED;
            PG8_LDA(At, 1, 1); PG8_STAGE(PG8_SB(1, 0), b3, voffB); PG8_STAGE(PG8_SB(1, 1), b3 + hstep, voffB); PG8_STAGE(PG8_SA(1, 0), a3, x0);
            PG8_WAIT_V(8); PG8_WAIT_L(0); PG8_BAR; PG8_MMA(1, 0, At, B0); PG8_MMA(1, 1, At, B1); PG8_BAR; PG8_SCHED;
        }
        if constexpr (ALIGN_EPI) { if (wr == 0) PG8_BAR; }
        asm volatile("s_nop 15\n\ts_nop 15" ::: "memory");
        if constexpr (!Epi::AFTER_DRAIN) { E(acc, cur, wr, wc, fr, fq, ui, GATHER ? tt + tbuf * 512 : nullptr); S.done(cur); }
        if (!has_next) break;
#pragma unroll
        for (int a = 0; a < 2; ++a)
#pragma unroll
            for (int b = 0; b < 2; ++b)
#pragma unroll
                for (int m = 0; m < 4; ++m)
#pragma unroll
                    for (int n = 0; n < 2; ++n) acc[a][b][m][n] = (f32x4){0.f, 0.f, 0.f, 0.f};
        cur = nxt; cA = nA; cB = nB; ++ui; tbuf = tnext; tnext = (tnext == 2) ? 0 : tnext + 1;
        if constexpr (GATHER) {
#pragma unroll
            for (int i = 0; i < 2; ++i) { c0[i] = n0[i]; c1[i] = n1[i]; } }
        if constexpr (ALIGN_EPI) { if (wr == 1) PG8_BAR; }
    }
    PG8_WAIT_V(0);
    if constexpr (!ALIGN_EPI) { if (wr == 0) PG8_BAR; }
    PG8_BAR;
    if constexpr (Epi::AFTER_DRAIN) { E.fused(acc, cur, wr, wc, fr, fq, lds, wid, lane); S.done(cur); }
#undef PG8_SA
#undef PG8_SB
#undef PG8_STAGE
#undef PG8_LDA
#undef PG8_LDB
#undef PG8_MMA
#undef PG8_WAIT_V
#undef PG8_WAIT_L
#undef PG8_BAR
#undef PG8_SCHED
#undef PG8_GOFF
}

struct EpiSwiGLU64 {
    unsigned char* O; int ldc;
    __device__ __forceinline__ void operator()(const f32x4 (&acc)[2][4][2], const Unit& u, int wr, int wc, int fr, int fq, const PG8_LAS unsigned* tab) const {
        const int col0 = u.pn * 64 + wc * 16 + 4 * fq;
#pragma unroll
        for (int ai = 0; ai < 2; ++ai)
#pragma unroll
            for (int m = 0; m < 4; ++m) { const int r = ai * HALF + wr * 64 + m * 16 + fr; const float rs = __uint_as_float(tab[256 + r]);
                const f32x4 a = acc[ai][m][0] * rs, b = acc[ai][m][1] * rs; const f32x4 t = a * (-1.4426950408889634f); f32x4 d;
#pragma unroll
                for (int e = 0; e < 4; ++e) d[e] = __builtin_amdgcn_exp2f(t[e]);
                d = d + 1.0f;
#pragma unroll
                for (int e = 0; e < 4; ++e) d[e] = __builtin_amdgcn_rcpf(d[e]);
                const f32x4 y = (a * b) * d; unsigned w = 0u; w = __builtin_amdgcn_cvt_pk_fp8_f32(y[0], y[1], w, false); w = __builtin_amdgcn_cvt_pk_fp8_f32(y[2], y[3], w, true);
                *(unsigned*)(O + (size_t)(u.pm * BM + r) * ldc + col0) = w; }
    }
};
struct EpiY64 {
    bf16_t* O; int ldc; size_t kstride;
    __device__ __forceinline__ void operator()(const f32x4 (&acc)[2][4][2], const Unit& u, int wr, int wc, int fr, int fq, const PG8_LAS unsigned* tab) const {
        const int col0 = u.pn * 128 + wc * 32 + 8 * fq;
#pragma unroll
        for (int ai = 0; ai < 2; ++ai)
#pragma unroll
            for (int m = 0; m < 4; ++m) { const int r = ai * HALF + wr * 64 + m * 16 + fr; const float gw = __uint_as_float(tab[256 + r]);
                const f32x4 a = acc[ai][m][0] * gw, b = acc[ai][m][1] * gw; u32x4 w; w.x = cvt_pk_bf16(a[0], a[1]); w.y = cvt_pk_bf16(a[2], a[3]); w.z = cvt_pk_bf16(b[0], b[1]); w.w = cvt_pk_bf16(b[2], b[3]);
                *(u32x4*)(O + (size_t)u.kp * kstride + (size_t)(u.pm * BM + r) * ldc + col0) = w; }
    }
};
template <class Epi, class Sched>
__device__ __forceinline__ void gemm_phase_f8n128(PG8_LAS unsigned char* lds, const Gemm g, const Sched& S, const Epi& E, PG8_LAS unsigned* tt) {
    typedef int v8i_t __attribute__((ext_vector_type(8))); typedef int v4i_t __attribute__((ext_vector_type(4)));
    int tid_ = threadIdx.x; asm volatile("" : "+v"(tid_));
    const int tid = tid_, wid = __builtin_amdgcn_readfirstlane(tid >> 6), lane = tid & 63, wr = wid >> 2, wc = wid & 3, fr = lane & 15, fq = lane >> 4;
    const int K = g.K, nt = K / BK, ldb = g.ldb ? g.ldb : K;
    unsigned c0[2], c1[2], n0[2], n1[2], voffB[2]; int rA[2]; unsigned cbA[2];
    const size_t kstep = (size_t)(BK * 2), tstepB = (size_t)HALF * ldb * 2;
#pragma unroll
    for (int i = 0; i < 2; ++i) { const int R = (tid >> 3) + 64 * i, x = R & 15, C = (((tid & 7) ^ (((x >> 1) & 1) | (((x >> 3) & 1) << 2))) * 16); const int Rb = (R & ~31) + perm32(R & 31);
        rA[i] = R; cbA[i] = (unsigned)C; c0[i] = c1[i] = n0[i] = n1[i] = 0u; voffB[i] = (unsigned)(Rb * ldb) * 2u + (unsigned)C; }
    const unsigned ldsw = (unsigned)wid * 1024u;
    const int fsw = ((fr >> 1) & 1) | (((fr >> 3) & 1) << 2);
    const int aoffL = (wr * 64 + fr) * 128 + (((2 * fq) ^ fsw) * 16), aoffH = (wr * 64 + fr) * 128 + (((2 * fq + 1) ^ fsw) * 16);
    const int boffL = (wc * 32 + fr) * 128 + (((2 * fq) ^ fsw) * 16), boffH = (wc * 32 + fr) * 128 + (((2 * fq + 1) ^ fsw) * 16);
#define F8_SA(b, h) (((b) * 3 + (h)) * HTB)
#define F8_SB(b) (((b) * 3 + 2) * HTB)
#define F8_STAGE1(bufoff, gbase, voff, i_) __builtin_amdgcn_global_load_lds((const unsigned*)((const char*)(gbase) + (voff)[i_]), (PG8_LAS unsigned*)(lds + (bufoff) + ldsw + (i_) * 8192), 16, 0, 0)
#define F8_STAGE(bufoff, gbase, voff) do { F8_STAGE1(bufoff, gbase, voff, 0); F8_STAGE1(bufoff, gbase, voff, 1); } while (0)
#define F8_LDA1(dst, b, h, m) do { const v4i_t l_ = *(const PG8_LAS v4i_t*)(lds + F8_SA(b, h) + aoffL + (m) * 2048), h_ = *(const PG8_LAS v4i_t*)(lds + F8_SA(b, h) + aoffH + (m) * 2048); \
        dst[m] = (v8i_t){l_[0], l_[1], l_[2], l_[3], h_[0], h_[1], h_[2], h_[3]}; } while (0)
#define F8_LDB1(dst, b, n) do { const v4i_t l_ = *(const PG8_LAS v4i_t*)(lds + F8_SB(b) + boffL + (n) * 2048), h_ = *(const PG8_LAS v4i_t*)(lds + F8_SB(b) + boffH + (n) * 2048); \
        dst[n] = (v8i_t){l_[0], l_[1], l_[2], l_[3], h_[0], h_[1], h_[2], h_[3]}; } while (0)
#define F8_LDA(dst, b, h) do { F8_LDA1(dst, b, h, 0); F8_LDA1(dst, b, h, 1); F8_LDA1(dst, b, h, 2); F8_LDA1(dst, b, h, 3); } while (0)
#define F8_LDB(dst, b) do { F8_LDB1(dst, b, 0); F8_LDB1(dst, b, 1); } while (0)
#define F8_MMA1(ai, m, At, Bf) do { _Pragma("unroll") for (int n = 0; n < 2; ++n) \
        acc[ai][m][n] = __builtin_amdgcn_mfma_scale_f32_16x16x128_f8f6f4(Bf[n], At[m], acc[ai][m][n], 0, 0, 0, g.scale_b, 0, 0x7f7f7f7f); } while (0)
#define F8_WAIT_V(n) asm volatile("s_waitcnt vmcnt(" #n ")" ::: "memory")
#define F8_WAIT_L(n) asm volatile("s_waitcnt lgkmcnt(" #n ")" ::: "memory")
#define F8_BAR __builtin_amdgcn_s_barrier()
#define F8_SCHED __builtin_amdgcn_sched_barrier(0)
#define F8_GOFF(o0, o1, tab, nv) do { _Pragma("unroll") for (int _i = 0; _i < 2; ++_i) { const unsigned e0_ = (tab)[rA[_i]], e1_ = (tab)[HALF + rA[_i]]; \
        o0[_i] = ((rA[_i] < (nv)) ? (e0_ >> 1) : 0u) * (unsigned)(g.lda * 2) + cbA[_i]; o1[_i] = ((HALF + rA[_i] < (nv)) ? (e1_ >> 1) : 0u) * (unsigned)(g.lda * 2) + cbA[_i]; } } while (0)
    Unit cur, nxt; int ui = 0;
    if (!S.next(0, cur)) return;
    f32x4 acc[2][4][2];
#pragma unroll
    for (int a = 0; a < 2; ++a)
#pragma unroll
        for (int m = 0; m < 4; ++m)
#pragma unroll
            for (int n = 0; n < 2; ++n) acc[a][m][n] = (f32x4){0.f, 0.f, 0.f, 0.f};
    v8i_t AtA[4], AtB[4], BfA[2], BfB[2];
    int tbuf = 0, tnext = 1;
    { const int lo_ = S.listoff(cur.pm); if (tid < 256) tt[tid] = g.rowlist[lo_ + tid]; else tt[tid] = g.wlist[lo_ + tid - 256]; }
    asm volatile("s_waitcnt vmcnt(0) lgkmcnt(0)" ::: "memory"); F8_BAR; asm volatile("" ::: "memory");
    F8_GOFF(c0, c1, tt, S.rows(cur.pm));
    const char* cA = (const char*)g.A + S.kbytes(cur, K); const char* cB = (const char*)g.Bt + (size_t)S.expert(cur.pm) * g.bstride + (size_t)cur.pn * tstepB + S.kbytes(cur, K);
    F8_STAGE(F8_SB(0), cB, voffB); F8_STAGE(F8_SA(0, 0), cA, c0); F8_STAGE(F8_SA(0, 1), cA, c1);
    F8_STAGE(F8_SB(1), cB + kstep, voffB); F8_STAGE(F8_SA(1, 0), cA + kstep, c0); F8_STAGE(F8_SA(1, 1), cA + kstep, c1);
    F8_WAIT_V(8); F8_BAR;
    F8_LDB(BfA, 0); F8_LDA(AtA, 0, 0);
    for (;;) {
        const bool has_next = S.next(ui + 1, nxt);
        const char* nA = has_next ? (const char*)g.A + S.kbytes(nxt, K) : cA; const char* nB = has_next ? (const char*)g.Bt + (size_t)S.expert(nxt.pm) * g.bstride + (size_t)nxt.pn * tstepB + S.kbytes(nxt, K) : cB;
        if (has_next) { const unsigned* src_ = (wid < 4 ? g.rowlist : g.wlist) + S.listoff(nxt.pm) + (wid & 3) * 64 + lane;
            __builtin_amdgcn_global_load_lds(src_, (PG8_LAS unsigned*)(tt + tnext * 512 + wid * 64), 4, 0, 0); }
#pragma unroll 1
        for (int t = 0; t < nt; t += 2) {
            const bool last = (t == nt - 2);
            if (last && has_next) F8_GOFF(n0, n1, tt + tnext * 512, S.rows(nxt.pm));
            const char* a2 = last ? nA : cA + (size_t)(t + 2) * kstep; const char* b2 = last ? nB : cB + (size_t)(t + 2) * kstep;
            const char* a3 = a2 + kstep; const char* b3 = b2 + kstep;
            unsigned x0[2], x1[2];
#pragma unroll
            for (int i = 0; i < 2; ++i) { x0[i] = (last && has_next) ? n0[i] : c0[i]; x1[i] = (last && has_next) ? n1[i] : c1[i]; }
#define F8_TOP F8_WAIT_V(6); F8_WAIT_L(0); F8_BAR; F8_SCHED
#define F8_SP1(b, Bf, bp, ap, xo) F8_TOP; \
            F8_MMA1(0, 0, AtA, Bf); F8_SCHED; F8_STAGE1(F8_SB(b), bp, voffB, 0); F8_LDA1(AtB, b, 1, 0); F8_SCHED; F8_MMA1(0, 1, AtA, Bf); F8_SCHED; F8_STAGE1(F8_SB(b), bp, voffB, 1); F8_LDA1(AtB, b, 1, 1); F8_SCHED; \
            F8_MMA1(0, 2, AtA, Bf); F8_SCHED; F8_STAGE1(F8_SA(b, 0), ap, xo, 0); F8_LDA1(AtB, b, 1, 2); F8_SCHED; F8_MMA1(0, 3, AtA, Bf); F8_SCHED; F8_STAGE1(F8_SA(b, 0), ap, xo, 1); F8_LDA1(AtB, b, 1, 3); F8_SCHED
#define F8_SP2(b, Bf, Bn, ap, xo) F8_TOP; \
            F8_MMA1(1, 0, AtB, Bf); F8_SCHED; F8_STAGE1(F8_SA(b, 1), ap, xo, 0); F8_LDB1(Bn, (b) ^ 1, 0); F8_LDA1(AtA, (b) ^ 1, 0, 0); F8_SCHED; F8_MMA1(1, 1, AtB, Bf); F8_SCHED; F8_STAGE1(F8_SA(b, 1), ap, xo, 1); F8_LDB1(Bn, (b) ^ 1, 1); F8_LDA1(AtA, (b) ^ 1, 0, 1); F8_SCHED; \
            F8_MMA1(1, 2, AtB, Bf); F8_SCHED; F8_LDA1(AtA, (b) ^ 1, 0, 2); F8_SCHED; F8_MMA1(1, 3, AtB, Bf); F8_SCHED; F8_LDA1(AtA, (b) ^ 1, 0, 3); F8_SCHED
            F8_SP1(0, BfA, b2, a2, x0); F8_SP2(0, BfA, BfB, a2, x1);
            F8_SP1(1, BfB, b3, a3, x0); F8_SP2(1, BfB, BfA, a3, x1);
#undef F8_TOP
#undef F8_SP1
#undef F8_SP2
        }
        F8_WAIT_L(0);
        E(acc, cur, wr, wc, fr, fq, tt + tbuf * 512);
        if (!has_next) break;
#pragma unroll
        for (int a = 0; a < 2; ++a)
#pragma unroll
            for (int m = 0; m < 4; ++m)
#pragma unroll
                for (int n = 0; n < 2; ++n) acc[a][m][n] = (f32x4){0.f, 0.f, 0.f, 0.f};
        cur = nxt; cA = nA; cB = nB; ++ui; tbuf = tnext; tnext = (tnext == 2) ? 0 : tnext + 1;
#pragma unroll
        for (int i = 0; i < 2; ++i) { c0[i] = n0[i]; c1[i] = n1[i]; }
    }
    F8_WAIT_V(0);
    F8_BAR;
#undef F8_SA
#undef F8_SB
#undef F8_STAGE1
#undef F8_STAGE
#undef F8_LDA1
#undef F8_LDB1
#undef F8_LDA
#undef F8_LDB
#undef F8_MMA1
#undef F8_WAIT_V
#undef F8_WAIT_L
#undef F8_BAR
#undef F8_SCHED
#undef F8_GOFF
}
}
namespace attn_body {
using bf16=__hip_bfloat16;
using bf16x8=__attribute__((ext_vector_type(8)))short;
using s16x4=__attribute__((ext_vector_type(4)))short;
using f32x16=__attribute__((ext_vector_type(16)))float;
using u32x4=__attribute__((ext_vector_type(4)))unsigned;
using f32x4v=__attribute__((ext_vector_type(4)))float;
constexpr int BATCH=16,NHEAD=16,SEQ=2048,D=64,DM=NHEAD*D;
constexpr int NW=8,QBLK=32,QB=QBLK*NW,KVBLK=64,NQB=SEQ/QB;
constexpr int ATTN_PITCH=DM, ATTN_UNIT_ROWS=QB;
__device__ __forceinline__ int crow(int r,int hi){return (r&3)+8*(r>>2)+4*hi;}
#define SBAR() __builtin_amdgcn_sched_barrier(0)
__device__ __forceinline__ void cmask(f32x16&p0,f32x16&p1,int jb,int qrel,int hi){
  const float NEG=-INFINITY; int kb=64*jb+4*hi;
  #pragma unroll
  for(int r=0;r<16;++r){int kv=kb+(r&3)+8*(r>>2); if(kv>qrel)p0[r]=NEG; if(kv+32>qrel)p1[r]=NEG;}
}

constexpr int NSLOT=3, SLOTB=8192;
constexpr int LDS_K=0, LDS_V=NSLOT*SLOTB, LDS_WS=2*NSLOT*SLOTB, LDS_OST=LDS_WS+NW*64*4, LDS_FB=LDS_OST+NW*4096, LDS_BYTES=LDS_FB+SEQ*16;
constexpr float C2=0.125f*1.4426950408889634f;
__device__ __forceinline__ void glds16(const void*gsrc,unsigned lds_dst){unsigned keep;
  asm volatile("s_mov_b32 %0, m0\n\ts_mov_b32 m0, %2\n\ts_nop 0\n\tglobal_load_lds_dwordx4 %1, off\n\ts_mov_b32 m0, %0":"=&s"(keep):"v"(gsrc),"s"(lds_dst):"memory");}
__device__ __forceinline__ float max3f(float a,float b,float c){float r;asm("v_max3_f32 %0, %1, %2, %3":"=v"(r):"v"(a),"v"(b),"v"(c));return r;}
__device__ __forceinline__ float max2f(float a,float b){float r;asm("v_max_f32_e32 %0, %1, %2":"=v"(r):"v"(a),"v"(b));return r;}
__device__ __forceinline__ float fadd_s(float a,float b){float r;asm("v_add_f32_e32 %0, %1, %2":"=v"(r):"v"(a),"v"(b));return r;}
__device__ __forceinline__ float fsub_s(float a,float b){float r;asm("v_sub_f32_e32 %0, %1, %2":"=v"(r):"v"(a),"v"(b));return r;}
typedef float f32x2_t __attribute__((ext_vector_type(2))); typedef __bf16 bf16x2_t __attribute__((ext_vector_type(2)));
__device__ __forceinline__ unsigned cvtpk_s(float lo,float hi){f32x2_t v={lo,hi};bf16x2_t b=__builtin_convertvector(v,bf16x2_t);return __builtin_bit_cast(unsigned,b);}
#define WAIT_BAR(N) asm volatile("s_waitcnt vmcnt(" #N ") lgkmcnt(0)\n\ts_barrier":::"memory")

__device__ __forceinline__ bf16x8 mk_qbias(float mhat,int hi){
  const float x=-mhat; const unsigned h=cvtpk_s(x,0.f)&0xffffu; const float r1=x-__uint_as_float(h<<16); const unsigned m=cvtpk_s(r1,0.f)&0xffffu; const float r2=r1-__uint_as_float(m<<16); const unsigned l=cvtpk_s(r2,0.f)&0xffffu;
  u32x4 w; w[0]=0x3F803F80u; w[1]=0x3F80u|(h<<16); w[2]=m|(l<<16); w[3]=0u; if(hi){w[0]=0u;w[1]=0u;w[2]=0u;} return __builtin_bit_cast(bf16x8,w);
}
__device__ __forceinline__ void qkt(f32x16&p0,f32x16&p1,const char*Kslot,const bf16x8*qr,bf16x8 fk0,bf16x8 fk1,bf16x8 qbias,int r32,int hi){
  const char*kb=Kslot+hi*1024+r32*16;
  p0=__builtin_amdgcn_mfma_f32_32x32x16_bf16(fk0,qbias,f32x16{},0,0,0);p1=__builtin_amdgcn_mfma_f32_32x32x16_bf16(fk1,qbias,f32x16{},0,0,0);
  #pragma unroll
  for(int d0=0;d0<4;++d0){
    const bf16x8 b0=*reinterpret_cast<const bf16x8*>(kb+d0*2048);
    const bf16x8 b1=*reinterpret_cast<const bf16x8*>(kb+d0*2048+512);
    p0=__builtin_amdgcn_mfma_f32_32x32x16_bf16(b0,qr[d0],p0,0,0,0);p1=__builtin_amdgcn_mfma_f32_32x32x16_bf16(b1,qr[d0],p1,0,0,0);}
}
typedef __attribute__((address_space(3))) const char* lds_cptr;
typedef short v4i16_t __attribute__((ext_vector_type(4)));
__device__ __forceinline__ void kload8(bf16x8*kf,lds_cptr kp){
  kf[0]=*(const __attribute__((address_space(3))) bf16x8*)(kp);      kf[1]=*(const __attribute__((address_space(3))) bf16x8*)(kp+512);
  kf[2]=*(const __attribute__((address_space(3))) bf16x8*)(kp+2048); kf[3]=*(const __attribute__((address_space(3))) bf16x8*)(kp+2560);
  kf[4]=*(const __attribute__((address_space(3))) bf16x8*)(kp+4096); kf[5]=*(const __attribute__((address_space(3))) bf16x8*)(kp+4608);
  kf[6]=*(const __attribute__((address_space(3))) bf16x8*)(kp+6144); kf[7]=*(const __attribute__((address_space(3))) bf16x8*)(kp+6656);
}
__device__ __forceinline__ void kload2(bf16x8*kf,lds_cptr kp,int j){ kf[2*j]=*(const __attribute__((address_space(3))) bf16x8*)(kp+j*2048); kf[2*j+1]=*(const __attribute__((address_space(3))) bf16x8*)(kp+j*2048+512); }
__device__ __forceinline__ s16x4 vtr(lds_cptr p){ return __builtin_bit_cast(s16x4,__builtin_amdgcn_ds_read_tr16_b64_v4i16((__attribute__((address_space(3))) v4i16_t*)p)); }
__device__ __forceinline__ float rowmax(const f32x16&p0,const f32x16&p1){
  float a=max3f(p0[0],p0[1],p1[0]),b=max3f(p0[2],p0[3],p1[1]);a=max3f(a,p1[2],p1[3]);
  #pragma unroll
  for(int r=4;r<16;r+=4){a=max3f(a,p0[r],p0[r+1]);b=max3f(b,p0[r+2],p0[r+3]);a=max3f(a,p1[r],p1[r+1]);b=max3f(b,p1[r+2],p1[r+3]);}
  const float m=max2f(a,b);
  auto rr=__builtin_amdgcn_permlane32_swap(__float_as_uint(m),__float_as_uint(m),false,false);
  return max2f(__uint_as_float(rr[0]),__uint_as_float(rr[1]));
}
__device__ __forceinline__ void pv(f32x16*o,int vb,bf16x8 pa0,bf16x8 pa1,bf16x8 pa2,bf16x8 pa3){
  #pragma unroll
  for(int d0=0;d0<2;++d0){s16x4 lo[4],hi[4];
    #pragma unroll
    for(int ks=0;ks<4;++ks){
      asm volatile("ds_read_b64_tr_b16 %0,%1 offset:%c2":"=&v"(lo[ks]):"v"(vb),"i"(d0*4096+ks*1024):"memory");
      asm volatile("ds_read_b64_tr_b16 %0,%1 offset:%c2":"=&v"(hi[ks]):"v"(vb),"i"(d0*4096+ks*1024+512):"memory");}
    asm volatile("s_waitcnt lgkmcnt(0)":::"memory");SBAR();
    #define PK(k) (bf16x8){lo[k][0],lo[k][1],lo[k][2],lo[k][3],hi[k][0],hi[k][1],hi[k][2],hi[k][3]}
    o[d0]=__builtin_amdgcn_mfma_f32_32x32x16_bf16(pa0,PK(0),o[d0],0,0,0);
    o[d0]=__builtin_amdgcn_mfma_f32_32x32x16_bf16(pa1,PK(1),o[d0],0,0,0);
    o[d0]=__builtin_amdgcn_mfma_f32_32x32x16_bf16(pa2,PK(2),o[d0],0,0,0);
    o[d0]=__builtin_amdgcn_mfma_f32_32x32x16_bf16(pa3,PK(3),o[d0],0,0,0);
    #undef PK
  }
}

#ifndef ATTN_STORE16
#define ATTN_STORE16(p,v) (*(u32x4*)(p)=(v))
#endif
template<int THRL> __device__ __forceinline__ void attn_unit(int b,int h,int qb,const bf16*Q,const bf16*__restrict__ K,const bf16*__restrict__ V,const bf16*__restrict__ G,bf16*O,char*shm){
  int tid_=threadIdx.x; asm volatile("":"+v"(tid_)); const int tid=tid_,lane=tid&63,r32=lane&31,hi=lane>>5; const int wid=__builtin_amdgcn_readfirstlane(tid>>6);
  const long rowbase=(long)b*SEQ; const int q0=qb*QB;
  const bf16*Qw=Q+(rowbase+q0+wid*QBLK)*DM+h*D;
  const bf16*Kh=K+rowbase*DM+h*D,*Vh=V+rowbase*DM+h*D;
  const unsigned lds0=(unsigned)(uintptr_t)shm;
  float*wsf=(float*)(shm+LDS_WS)+wid*64;
  const bf16*ksrc=Kh+(long)lane*DM+wid*8;
  const bf16*vsrc=Vh+(long)(16*(wid&3)+(lane>>2))*DM+(wid>>2)*32+(lane&3)*8;
  const unsigned kdst=lds0+LDS_K+wid*1024, vdst=lds0+LDS_V+wid*1024;
  #define DMA_K(t,slot) glds16(ksrc+(long)(t)*KVBLK*DM,(unsigned)__builtin_amdgcn_readfirstlane(kdst+(slot)))
  #define DMA_V(t,slot) glds16(vsrc+(long)(t)*KVBLK*DM,(unsigned)__builtin_amdgcn_readfirstlane(vdst+(slot)))
  const int vb0=(int)(lds0+LDS_V)+((lane>>4)&1)*32+(lane&3)*8+(4*hi+((lane&15)>>2))*64;
  const char*Kbase=shm+LDS_K; bf16x8 kf[8];
  const lds_cptr shm3=(lds_cptr)shm; const lds_cptr kp0=shm3+LDS_K+hi*1024+r32*16; const lds_cptr vp0=shm3+LDS_V+((lane>>4)&1)*32+(lane&3)*8+(4*hi+((lane&15)>>2))*64;
  const int NT=(q0+QB)/KVBLK;
  DMA_K(0,0);DMA_V(0,0);DMA_K(1,SLOTB);
  bf16x8 qr[4];
  #pragma unroll
  for(int d0=0;d0<4;++d0)qr[d0]=*reinterpret_cast<const bf16x8*>(&Qw[(long)r32*DM+d0*16+hi*8]);
  float mhat; { const u32x4 eq=*(const __attribute__((address_space(3))) u32x4*)(shm3+LDS_FB+(q0+wid*QBLK+r32)*16); mhat=__uint_as_float(eq[0]<<16)+__uint_as_float(eq[0]&0xffff0000u)+__uint_as_float(eq[1]<<16); }
  float l_reg=0.f;f32x16 o[2];o[0]=f32x16{};o[1]=f32x16{};bf16x8 qbias=mk_qbias(mhat,hi);asm volatile("":"+v"(qbias));
  const int qrel=wid*QBLK+r32;
  #define CMASK(P0,P1,t) do{int jb_=(t)-(NT-4); if(jb_>=0)cmask(P0,P1,jb_,qrel,hi);}while(0)
  const lds_cptr fbt=shm3+LDS_FB+r32*16;
  #define FKLD(t,blk) (*(const __attribute__((address_space(3))) bf16x8*)(fbt+((t)*64+(blk)*32)*16))
  bool resc=false;
  #define START(P0,P1) do{ const float rm=rowmax(P0,P1); resc=false; \
    { const float dl=rm; mhat=fadd_s(mhat,dl); \
      _Pragma("unroll") for(int r=0;r<16;++r){P0[r]=fsub_s(P0[r],dl);P1[r]=fsub_s(P1[r],dl);} \
      qbias=mk_qbias(mhat,hi); asm volatile("":"+v"(qbias)); } \
    _Pragma("unroll") for(int r=0;r<16;++r)P0[r]=__builtin_amdgcn_exp2f(P0[r]); }while(0)
  #define RESC() do{ if(resc){ asm volatile("s_waitcnt lgkmcnt(0)":::"memory"); \
      _Pragma("unroll") for(int d_=0;d_<2;++d_) _Pragma("unroll") for(int r=0;r<16;++r)o[d_][r]*=wsf[crow(r,hi)]; } }while(0)
  f32x16 pA0,pA1,pB0,pB1;
  int sl_prev=0,sl_cur=0,sl_next=SLOTB;
  #define ROT() do{sl_prev=sl_cur;sl_cur=sl_next;sl_next=(sl_next==(NSLOT-1)*SLOTB)?0:sl_next+SLOTB;}while(0)
  DMA_K(2,2*SLOTB);
  WAIT_BAR(3);
  qkt(pA0,pA1,Kbase,qr,FKLD(0,0),FKLD(0,1),qbias,r32,hi);asm volatile("s_nop 15\n\ts_nop 7":"+v"(pA0),"+v"(pA1));CMASK(pA0,pA1,0);
  START(pA0,pA1);
  _Pragma("unroll") for(int r=0;r<16;++r)pA1[r]=__builtin_amdgcn_exp2f(pA1[r]);
  WAIT_BAR(0);
  DMA_K(3,0);DMA_V(1,SLOTB);
  ROT();
  kload8(kf,kp0+sl_cur);
  WAIT_BAR(2);
  s16x4 vlo[8],vhi[8]; u32x4 pw0,pw1,pw2,pw3;
  #define PKW(P,B) cvtpk_s(P[B],P[B+1])
  #define PAF(k) __builtin_bit_cast(bf16x8,pw##k)
  #define VFR(i) (bf16x8){vlo[i][0],vlo[i][1],vlo[i][2],vlo[i][3],vhi[i][0],vhi[i][1],vhi[i][2],vhi[i][3]}
  #define PIN(x) asm volatile("":"+v"(x))
  #define MX3(a,b,c) __builtin_fmaxf(__builtin_fmaxf((a),(b)),(c))
  #define GAPA(MF,A0,A1,A2,A3,W0,W1,PW) do{ MF; sacc+=A0; sacc+=A1; sacc+=A2; sacc+=A3; PIN(sacc); W0; W1; PIN(PW); SBAR(); }while(0)
  #define EX(v) __builtin_amdgcn_exp2f(v)
  #define GAPB(MF,X,B) do{ MF; X[B]=EX(X[B]); X[B+1]=EX(X[B+1]); X[B+2]=EX(X[B+2]); X[B+3]=EX(X[B+3]); PIN(X); SBAR(); }while(0)
  #define VRD(i) do{ vlo[i]=vtr(vp_+(((i)>>2)*4096+((i)&3)*1024)); vhi[i]=vtr(vp_+(((i)>>2)*4096+((i)&3)*1024+512)); }while(0)
  #define KRD(G,j) do{ if(G){ kload2(kf,kp0+sl_next,j); SBAR(); } }while(0)
  #define STEP(C0,C1,P0,P1,t,GK,GV,GL) do{ SBAR(); \
    const lds_cptr vp_=vp0+sl_prev; const bf16x8 fk0_=FKLD(t,0), fk1_=FKLD(t,1); \
    VRD(0); SBAR(); float sacc=(P0[0]+P0[1]); \
    GAPA(C0=__builtin_amdgcn_mfma_f32_32x32x16_bf16(kf[0],qr[0],f32x16{},0,0,0), P0[2],P0[3],P0[4],P0[5],     pw0[0]=PKW(P0,0), pw0[1]=PKW(P0,2), pw0); \
    VRD(4); SBAR(); GAPA(C1=__builtin_amdgcn_mfma_f32_32x32x16_bf16(kf[1],qr[0],f32x16{},0,0,0), P0[6],P0[7],P0[8],P0[9],     pw0[2]=PKW(P0,4), pw0[3]=PKW(P0,6), pw0); \
    VRD(1); SBAR(); GAPA(C0=__builtin_amdgcn_mfma_f32_32x32x16_bf16(kf[2],qr[1],C0,0,0,0),   P0[10],P0[11],P0[12],P0[13], pw1[0]=PKW(P0,8), pw1[1]=PKW(P0,10), pw1); \
    VRD(5); SBAR(); GAPA(C1=__builtin_amdgcn_mfma_f32_32x32x16_bf16(kf[3],qr[1],C1,0,0,0),   P0[14],P0[15],P1[0],P1[1],   pw1[2]=PKW(P0,12),pw1[3]=PKW(P0,14), pw1); \
    VRD(2); SBAR(); GAPA(C0=__builtin_amdgcn_mfma_f32_32x32x16_bf16(kf[4],qr[2],C0,0,0,0),   P1[2],P1[3],P1[4],P1[5],     pw2[0]=PKW(P1,0), pw2[1]=PKW(P1,2), pw2); \
    VRD(6); SBAR(); GAPA(C1=__builtin_amdgcn_mfma_f32_32x32x16_bf16(kf[5],qr[2],C1,0,0,0),   P1[6],P1[7],P1[8],P1[9],     pw2[2]=PKW(P1,4), pw2[3]=PKW(P1,6), pw2); \
    VRD(3); SBAR(); GAPA(C0=__builtin_amdgcn_mfma_f32_32x32x16_bf16(kf[6],qr[3],C0,0,0,0),   P1[10],P1[11],P1[12],P1[13], pw3[0]=PKW(P1,8), pw3[1]=PKW(P1,10), pw3); \
    VRD(7); SBAR(); GAPA(C1=__builtin_amdgcn_mfma_f32_32x32x16_bf16(kf[7],qr[3],C1,0,0,0),   P1[14],P1[15],0.f,0.f,       pw3[2]=PKW(P1,12),pw3[3]=PKW(P1,14), pw3); \
    C0=__builtin_amdgcn_mfma_f32_32x32x16_bf16(fk0_,qbias,C0,0,0,0); C1=__builtin_amdgcn_mfma_f32_32x32x16_bf16(fk1_,qbias,C1,0,0,0); \
    l_reg+=sacc; \
    if(GK){DMA_K((t)+3,sl_cur);} if(GV){DMA_V((t)+1,sl_next);} \
    CMASK(C0,C1,t); \
    { float a=MX3(C0[0],C0[1],C1[0]),b=MX3(C0[2],C0[3],C1[1]); a=MX3(a,C1[2],C1[3]); \
      _Pragma("unroll") for(int r=4;r<16;r+=4){a=MX3(a,C0[r],C0[r+1]);b=MX3(b,C0[r+2],C0[r+3]);a=MX3(a,C1[r],C1[r+1]);b=MX3(b,C1[r+2],C1[r+3]);} \
      float rm=__builtin_fmaxf(a,b); { auto rr=__builtin_amdgcn_permlane32_swap(__float_as_uint(rm),__float_as_uint(rm),false,false); rm=__builtin_fmaxf(__uint_as_float(rr[0]),__uint_as_float(rr[1])); } \
      resc=false; \
      if(__builtin_expect(__any(rm>(float)THRL),0)){ const float dl=__builtin_fmaxf(rm,0.f); mhat+=dl; \
        _Pragma("unroll") for(int r=0;r<16;++r){C0[r]-=dl;C1[r]-=dl;} \
        qbias=mk_qbias(mhat,hi); asm volatile("":"+v"(qbias)); \
        const float f=__builtin_amdgcn_exp2f(-dl); l_reg*=f; if(hi==0)wsf[r32]=f; resc=true; } } \
    SBAR(); \
    GAPB(o[0]=__builtin_amdgcn_mfma_f32_32x32x16_bf16(PAF(0),VFR(0),o[0],0,0,0), C0,0); \
    GAPB(o[1]=__builtin_amdgcn_mfma_f32_32x32x16_bf16(PAF(0),VFR(4),o[1],0,0,0), C0,4); \
    KRD(GL,0); GAPB(o[0]=__builtin_amdgcn_mfma_f32_32x32x16_bf16(PAF(1),VFR(1),o[0],0,0,0), C0,8); \
    KRD(GL,1); GAPB(o[1]=__builtin_amdgcn_mfma_f32_32x32x16_bf16(PAF(1),VFR(5),o[1],0,0,0), C0,12); \
    KRD(GL,2); GAPB(o[0]=__builtin_amdgcn_mfma_f32_32x32x16_bf16(PAF(2),VFR(2),o[0],0,0,0), C1,0); \
    KRD(GL,3); GAPB(o[1]=__builtin_amdgcn_mfma_f32_32x32x16_bf16(PAF(2),VFR(6),o[1],0,0,0), C1,4); \
    GAPB(o[0]=__builtin_amdgcn_mfma_f32_32x32x16_bf16(PAF(3),VFR(3),o[0],0,0,0), C1,8); \
    GAPB(o[1]=__builtin_amdgcn_mfma_f32_32x32x16_bf16(PAF(3),VFR(7),o[1],0,0,0), C1,12); \
    }while(0)
  int t=1;
  #undef CMASK
  #define CMASK(P0,P1,t) do{}while(0)
  for(;t+5<NT;t+=2){
    STEP(pB0,pB1,pA0,pA1,t,true,true,true);     WAIT_BAR(2); RESC(); ROT();
    STEP(pA0,pA1,pB0,pB1,t+1,true,true,true);   WAIT_BAR(2); RESC(); ROT();
  }
  #undef CMASK
  #define CMASK(P0,P1,t) do{int jb_=(t)-(NT-4); if(jb_>=0)cmask(P0,P1,jb_,qrel,hi);}while(0)
  #define ENDW(tt) do{ if((tt)+3<NT){WAIT_BAR(2);} else if((tt)+2<NT){WAIT_BAR(1);} else {WAIT_BAR(0);} }while(0)
  for(;t+1<NT;t+=2){
    STEP(pB0,pB1,pA0,pA1,t,(t+3<NT),(t+1<NT),(t+1<NT));       ENDW(t);   RESC(); ROT();
    STEP(pA0,pA1,pB0,pB1,t+1,(t+4<NT),(t+2<NT),(t+2<NT));     ENDW(t+1); RESC(); ROT();
  }
  STEP(pB0,pB1,pA0,pA1,NT-1,false,false,false); RESC();
  u32x4 ggv[4];
  { const bf16*Gw_=G+(rowbase+q0+wid*QBLK)*DM+h*D;
    #pragma unroll
    for(int i=0;i<4;++i)ggv[i]=*(const u32x4*)(Gw_+(long)(i*8+(lane>>3))*DM+(lane&7)*8); }
  { float sacc=pB0[0]+pB0[1]; _Pragma("unroll") for(int r=2;r<16;++r)sacc+=pB0[r]; _Pragma("unroll") for(int r=0;r<16;++r)sacc+=pB1[r]; l_reg+=sacc;
    pw0=(u32x4){PKW(pB0,0),PKW(pB0,2),PKW(pB0,4),PKW(pB0,6)};pw1=(u32x4){PKW(pB0,8),PKW(pB0,10),PKW(pB0,12),PKW(pB0,14)};pw2=(u32x4){PKW(pB1,0),PKW(pB1,2),PKW(pB1,4),PKW(pB1,6)};pw3=(u32x4){PKW(pB1,8),PKW(pB1,10),PKW(pB1,12),PKW(pB1,14)};
    SBAR(); pv(o,vb0+sl_cur,PAF(0),PAF(1),PAF(2),PAF(3)); }
  #undef PKW
  #undef PAF
  #undef VFR
  #undef PIN
  #undef MX3
  #undef GAPA
  #undef GAPB
  #undef EX
  #undef VRD
  #undef KRD
  #undef STEP
  #undef ENDW
  {auto rr=__builtin_amdgcn_permlane32_swap(__float_as_uint(l_reg),__float_as_uint(l_reg),false,false);l_reg=__uint_as_float(rr[0])+__uint_as_float(rr[1]);}
  if(hi==0)wsf[32+r32]=l_reg;asm volatile("s_waitcnt lgkmcnt(0)":::"memory");
  float rli[16];
  #pragma unroll
  for(int r=0;r<16;++r)rli[r]=__builtin_amdgcn_rcpf(wsf[32+crow(r,hi)]);
  bf16*Ow=O+(rowbase+q0+wid*QBLK)*DM+h*D;
  { bf16*stg=(bf16*)(shm+LDS_OST)+wid*2048;
    #pragma unroll
    for(int r=0;r<16;++r){const int orow=crow(r,hi);
      #pragma unroll
      for(int d0=0;d0<2;++d0)stg[orow*64+d0*32+r32]=__float2bfloat16(o[d0][r]*rli[r]);}
    asm volatile("s_waitcnt lgkmcnt(0)":::"memory");
    #pragma unroll
    for(int i=0;i<4;++i){const int row=i*8+(lane>>3),ch=lane&7; const u32x4 v=*(const u32x4*)(stg+row*64+ch*8); const u32x4 gg=ggv[i]; u32x4 w;
      #pragma unroll
      for(int c=0;c<4;++c){ const float lo=__uint_as_float(v[c]<<16)*__uint_as_float(gg[c]<<16), hh=__uint_as_float(v[c]&0xffff0000u)*__uint_as_float(gg[c]&0xffff0000u); w[c]=cvtpk_s(lo,hh); }
      ATTN_STORE16(Ow+(long)row*DM+ch*8,w);} }
  asm volatile("s_waitcnt lgkmcnt(0)\n\ts_barrier":::"memory");
  #undef DMA_K
  #undef DMA_V
  #undef CMASK
  #undef FKLD
  #undef START
  #undef RESC
  #undef ROT
}
constexpr int ATTN_LDS_BYTES=LDS_BYTES;
struct AttnTensors { const bf16* Q; const bf16* K; const bf16* V; const bf16* G; bf16* O; const u32x4* FBT; };
struct AttnUnit { int bh; int qb; };
struct StaticOrder {
  int vcu, G;
  __device__ __forceinline__ bool next(int i,AttnUnit&u)const{ u.bh=vcu+(i>>3)*G; if(u.bh>=BATCH*NHEAD)return false; u.qb=(i+(vcu&7))&7; return true; }
};
__device__ __forceinline__ void scan_bias_table(char*lds,const float*FG,const float*bfp,int bh,u32x4*tab){
  float*wtot=(float*)lds; const int b_=bh/NHEAD,h_=bh%NHEAD,t_=threadIdx.x,ln_=t_&63,wv_=t_>>6; const float bf_=bfp[h_]; float p_[4]; float run=0.f;
  #pragma unroll
  for(int i=0;i<4;++i){ const float xg=FG[((size_t)b_*SEQ+4*t_+i)*NHEAD+h_]+bf_; run+=(xg>=0.f?-log1pf(expf(-xg)):xg-log1pf(expf(xg))); p_[i]=run; }
  float inc=run;
  #pragma unroll
  for(int o=1;o<64;o<<=1){ const float tt=__shfl_up(inc,o); if(ln_>=o)inc+=tt; }
  __syncthreads();
  if(ln_==63)wtot[wv_]=inc;
  __syncthreads();
  float base_=inc-run; for(int w=0;w<wv_;++w)base_+=wtot[w];
  #pragma unroll
  for(int i=0;i<4;++i){ const float x=-1.4426950408889634f*(base_+p_[i]); const unsigned h=cvtpk_s(x,0.f)&0xffffu; const float r1=x-__uint_as_float(h<<16); const unsigned m=cvtpk_s(r1,0.f)&0xffffu;
    const float r2=r1-__uint_as_float(m<<16); const unsigned l=cvtpk_s(r2,0.f)&0xffffu; u32x4 w; w[0]=h|(m<<16); w[1]=l|(0x3F80u<<16); w[2]=0x3F803F80u; w[3]=0u; tab[(size_t)bh*SEQ+4*t_+i]=w; }
}
template<class Sched,int THRL=8> __device__ __forceinline__ void attn_phase(char*lds,const AttnTensors&T,const Sched&S){
  AttnUnit u; int cur=-1;
  for(int i=0;S.next(i,u);++i){
    if(u.bh!=cur){ cur=u.bh; u32x4*fb=(u32x4*)(lds+LDS_FB); const u32x4*src=T.FBT+(size_t)u.bh*SEQ;
      #pragma unroll
      for(int k=0;k<SEQ/(NW*64);++k)fb[threadIdx.x+k*NW*64]=src[threadIdx.x+k*NW*64];
      asm volatile("s_waitcnt vmcnt(0) lgkmcnt(0)\n\ts_barrier":::"memory"); }
    attn_unit<THRL>(u.bh/NHEAD,u.bh%NHEAD,u.qb,T.Q,T.K,T.V,T.G,T.O,lds);
  }
}
#undef SBAR
#undef WAIT_BAR
}
#define GAS __attribute__((address_space(1)))
#define LAS __attribute__((address_space(3)))
typedef unsigned short bf16;
typedef unsigned v4u __attribute__((ext_vector_type(4)));
typedef float f32x4 __attribute__((ext_vector_type(4)));
typedef short bf16x8 __attribute__((ext_vector_type(8)));
typedef GAS unsigned gu32;
typedef GAS unsigned long long gu64;
#define RLX_AGENT __ATOMIC_RELAXED, __HIP_MEMORY_SCOPE_AGENT
#define LDS_WAIT() asm volatile("s_waitcnt lgkmcnt(0)" ::: "memory")
#define VM_WAIT() asm volatile("s_waitcnt vmcnt(0)" ::: "memory")
__device__ __forceinline__ unsigned long long rt() { return __builtin_amdgcn_s_memrealtime(); }
__device__ __forceinline__ unsigned f2bf(float f) { unsigned u = __builtin_bit_cast(unsigned, f); return (u + 0x7fffu + ((u >> 16) & 1u)) >> 16; }
__device__ __forceinline__ unsigned pk2(float lo, float hi) { return f2bf(lo) | (f2bf(hi) << 16); }

#define XB_TMO      128
#define XB_XCNT(j)  (256  + 64 * (j))
#define XB_XSUB(j)  (1280 + 64 * (j))
#define XB_XGEN(j)  (2304 + 64 * (j))
#define XB_TOP      3328
#define XB_TOPGEN   3392
#define XCD_BAR_WORDS 3456
#define XB_SPIN_CAP (1u << 18)

__device__ __forceinline__ unsigned xb_ld(unsigned* p)              { return __hip_atomic_load(p, __ATOMIC_RELAXED, __HIP_MEMORY_SCOPE_AGENT); }
__device__ __forceinline__ unsigned xb_add(unsigned* p, unsigned v) { return __hip_atomic_fetch_add(p, v, __ATOMIC_RELAXED, __HIP_MEMORY_SCOPE_AGENT); }
__device__ __forceinline__ unsigned xb_xcc_id() { return (unsigned)__builtin_amdgcn_s_getreg((3 << 11) | 20) & 0xFu; }
#define XB_SPIN(cond, bar) do { unsigned _sp = 0; while (cond) { __builtin_amdgcn_s_sleep(1); \
    if ((++_sp & 255u) == 0u) { if (xb_ld(&(bar)[XB_TMO])) break; if (_sp > XB_SPIN_CAP) { atomicAdd(&(bar)[XB_TMO], 1u); break; } } } } while (0)

struct XcdBarrier {
    unsigned* bar; unsigned x;
    volatile LAS unsigned* st;
};

__device__ __forceinline__ XcdBarrier xcd_barrier_post(unsigned* bar, volatile LAS unsigned* st) {
    XcdBarrier b; b.bar = bar; b.x = xb_xcc_id(); b.st = st;
    if (threadIdx.x == 0) (void)xb_add(&bar[XB_XCNT(b.x)], 1u);
    return b;
}
__device__ __forceinline__ void xcd_barrier_complete(unsigned* bar, unsigned x, unsigned& nloc, unsigned& nx) {
    const unsigned G = gridDim.x * gridDim.y * gridDim.z;
    unsigned sum, cnt, mine, sp = 0u;
    for (;;) {
        sum = 0u; cnt = 0u; mine = 0u;
#pragma unroll
        for (unsigned j = 0; j < 16; ++j) { const unsigned c = xb_ld(&bar[XB_XCNT(j)]); sum += c; cnt += (c > 0u) ? 1u : 0u; mine = (j == x) ? c : mine; }
        if (sum == G) break;
        __builtin_amdgcn_s_sleep(1);
        if ((++sp & 255u) == 0u) { if (xb_ld(&bar[XB_TMO])) break; if (sp > XB_SPIN_CAP) { atomicAdd(&bar[XB_TMO], 1u); break; } }
    }
    nloc = mine > 0u ? mine : 1u; nx = cnt > 0u ? cnt : 1u;
}

__device__ __forceinline__ void xcd_barrier(const XcdBarrier& b) {
    asm volatile("s_waitcnt vmcnt(0)" ::: "memory");
    __syncthreads();
    if (threadIdx.x == 0) {
        unsigned* bar = b.bar;
        __builtin_amdgcn_s_waitcnt(0);
        unsigned nloc = b.st[0], nx = b.st[1];
        if (nloc == 0u) { xcd_barrier_complete(bar, b.x, nloc, nx); b.st[0] = nloc; b.st[1] = nx; }
        const unsigned old = xb_add(&bar[XB_XSUB(b.x)], 1u);
        const unsigned gen = old / nloc;
        if (old + 1u == (gen + 1u) * nloc) {
            __builtin_amdgcn_fence(__ATOMIC_RELEASE, "agent");
            asm volatile("s_waitcnt vmcnt(0)" ::: "memory");
            const unsigned og = xb_add(&bar[XB_TOP], 1u);
            const unsigned tg = og / nx;
            if (og + 1u == (tg + 1u) * nx) xb_add(&bar[XB_TOPGEN], 1u);
            else XB_SPIN(xb_ld(&bar[XB_TOPGEN]) == tg, bar);
            __builtin_amdgcn_fence(__ATOMIC_ACQUIRE, "agent");
            xb_add(&bar[XB_XGEN(b.x)], 1u);
            asm volatile("s_waitcnt vmcnt(0)" ::: "memory");
        } else {
            XB_SPIN(xb_ld(&bar[XB_XGEN(b.x)]) == gen, bar);
            __builtin_amdgcn_fence(__ATOMIC_ACQUIRE, "agent");
            asm volatile("s_waitcnt vmcnt(0)" ::: "memory");
        }
    }
    __syncthreads();
}

constexpr int NWAVES = 8;
constexpr int DM = 1024, BATCH = 16, SEQ = 2048, MROWS = BATCH * SEQ;
constexpr int A_FFN = 6144, A_HALF = 3072, A_GROUPS = 8, A_GD = 384, GCH = 128, CHK = 64;
constexpr int D_FF = 2816, NEXP = 8, D_EXP = 3584, NHEAD = 16, HD = 64;
constexpr int KVW_LD = 2 * DM + NHEAD;
constexpr float RMS_EPS = 1e-6f;
constexpr float W8_SCALE = 64.0f;
constexpr int W8_SCALE_E8M0 = 0x79797979;
enum { I_X = 0, I_A_NORM_G, I_A_W_IN, I_A_V_NORM_G, I_A_W_SP, I_A_B_SP, I_A_W_OUT, I_F_NORM_G, I_F_W_IN, I_F_W_OUT, I_KV_NORM_G, I_KV_W, I_KV_B_F, I_K_NORM_G,
       I_B_NORM_G, I_B_W_IN, I_Q_NORM_G, I_B_W_OUT, I_M_NORM_G, I_M_W_ROUTER, I_M_W_IN, I_M_W_OUT, N_IN };

constexpr size_t MiB = 1u << 20;
constexpr size_t WS_CTL = 0, CTL_ZERO_BYTES = 1 * MiB;
constexpr size_t WS_RSQ = 4 * MiB;
constexpr size_t WS_VPART = 286 * MiB;
constexpr size_t WS_FG = 2 * MiB;
constexpr size_t WS_GW = 6 * MiB;
constexpr size_t WS_TOKSLOT = 7 * MiB;
constexpr size_t WS_WA_IN = 8 * MiB, WS_WA_OUT = 20 * MiB, WS_WF_IN = 26 * MiB, WS_WF_OUT = 37 * MiB, WS_WKV = 43 * MiB, WS_WBIN = 47 * MiB, WS_WBOUT = 51 * MiB;
constexpr size_t WS_WM_IN = 53 * MiB, WS_WM_OUT = 165 * MiB;
constexpr size_t WS_XN = 222 * MiB, WS_XQ = 286 * MiB;
constexpr size_t WS_BIG = 350 * MiB;
constexpr int MAXSLOT = MROWS * 2 + NEXP * 256;
constexpr size_t WS_XG = 286 * MiB;
constexpr size_t WS_ACT = 418 * MiB;
constexpr size_t WS_Y = 8 * MiB;
constexpr size_t WS_ELIST = 880 * MiB, WS_EWL = 881 * MiB;
constexpr size_t WS_FBT = 700 * MiB;
constexpr int YP_ROWS = 16 * 256;
constexpr size_t WS_END = 883 * MiB;
constexpr int CW_BAR = 4096, CW_CNT = 64;

constexpr int RING_OFF = 0, RING_BYTES = 131072;
constexpr int LDSCTL_OFF = RING_BYTES, MISC_OFF = LDSCTL_OFF + 320;
constexpr int LDS_BYTES = 147456;

typedef short s16x4 __attribute__((ext_vector_type(4)));
__device__ __forceinline__ unsigned off_b(unsigned row, unsigned ch) { return 256u * row + 16u * (ch ^ (((row & 3u) << 2) | ((row >> 2) & 3u))); }
struct Frame {
    LAS unsigned char* lds; volatile LAS unsigned* MISC; gu32* ctl;
    int tid, lane, wave, vcu, G;
};
__device__ __forceinline__ float wave_sum(float v) {
#pragma unroll
    for (int o = 1; o < 64; o <<= 1) v += __shfl_xor(v, o);
    return v;
}
__device__ __forceinline__ void tr_load(float (&tmp)[32], const float* W, int ldw, int k0, int n0, int lane) {
#pragma unroll
    for (int i = 0; i < 32; ++i) { const int kk = 2 * i + (lane >> 5); tmp[i] = W[(size_t)(k0 + kk) * ldw + n0 + (lane & 31)]; }
}
template <class RowMap>
__device__ __forceinline__ void tr_store(float (&tmp)[32], int K, bf16* WT, LAS float* scr, int k0, int n0, int lane, const RowMap& rowmap, const float* gk, float f8scale = 0.f) {
    if (gk) {
#pragma unroll
        for (int i = 0; i < 32; ++i) tmp[i] *= gk[k0 + 2 * i + (lane >> 5)]; }
#pragma unroll
    for (int i = 0; i < 32; ++i) { const int kk = 2 * i + (lane >> 5); scr[kk * 33 + (lane & 31)] = tmp[i]; }
    LDS_WAIT(); asm volatile("" ::: "memory");
    const int c = lane & 7;
#pragma unroll
    for (int j = 0; j < 4; ++j) { const int n = (lane >> 3) + 8 * j; const LAS float* s = scr + (8 * c) * 33 + n;
        if (f8scale != 0.f) { unsigned lo = 0u, hi = 0u;
            lo = __builtin_amdgcn_cvt_pk_fp8_f32(s[0 * 33] * f8scale, s[1 * 33] * f8scale, lo, false); lo = __builtin_amdgcn_cvt_pk_fp8_f32(s[2 * 33] * f8scale, s[3 * 33] * f8scale, lo, true);
            hi = __builtin_amdgcn_cvt_pk_fp8_f32(s[4 * 33] * f8scale, s[5 * 33] * f8scale, hi, false); hi = __builtin_amdgcn_cvt_pk_fp8_f32(s[6 * 33] * f8scale, s[7 * 33] * f8scale, hi, true);
            *(GAS unsigned long long*)((GAS unsigned char*)WT + (size_t)rowmap(n0 + n) * K + k0 + 8 * c) = (unsigned long long)lo | ((unsigned long long)hi << 32); }
        else { v4u o; o.x = pk2(s[0 * 33], s[1 * 33]); o.y = pk2(s[2 * 33], s[3 * 33]); o.z = pk2(s[4 * 33], s[5 * 33]); o.w = pk2(s[6 * 33], s[7 * 33]);
            *(GAS v4u*)(WT + (size_t)rowmap(n0 + n) * K + k0 + 8 * c) = o; } }
    LDS_WAIT(); asm volatile("" ::: "memory");
}
struct MapId { __device__ __forceinline__ int operator()(int n) const { return n; } };
struct MapGlu { int half; __device__ __forceinline__ int operator()(int n) const { const int b = n >= half ? 1 : 0, x = n - b * half; return (x >> 7) * 256 + b * 128 + (x & 127); } };
struct MapGlu64 { int half; __device__ __forceinline__ int operator()(int n) const { const int b = n >= half ? 1 : 0, x = n - b * half, pn = x >> 6, xx = x & 63; return pn * 128 + (xx >> 4) * 32 + ((xx >> 2) & 3) * 8 + b * 4 + (xx & 3); } };
struct MapHead { __device__ __forceinline__ int operator()(int n) const { const int blk = n >> 10, hh = (n >> 6) & 15, d = n & 63; return (blk * 4 + (hh >> 2)) * 256 + (d >> 5) * 128 + (hh & 3) * 32 + (d & 31); } };
template <class RowMap>
__device__ __forceinline__ void tr_matrix(Frame& F, const float* W, int ldw, int K, int ncols, bf16* WT, const RowMap& rm, int& gwoff, const float* gk = nullptr, float f8scale = 0.f) {
    LAS float* scr = (LAS float*)(F.lds + RING_OFF + F.wave * 16384);
    const int NGW = F.G * NWAVES, nblk = ncols / 32, items = (K / 64) * nblk;
    int gw = F.vcu * NWAVES + F.wave - gwoff; if (gw < 0) gw += NGW;
    int it = gw; if (it < items) { float ta[32], tb[32]; tr_load(ta, W, ldw, 64 * (it / nblk), 32 * (it % nblk), F.lane);
        for (;;) { const int n1 = it + NGW; if (n1 < items) tr_load(tb, W, ldw, 64 * (n1 / nblk), 32 * (n1 % nblk), F.lane);
            tr_store(ta, K, WT, scr, 64 * (it / nblk), 32 * (it % nblk), F.lane, rm, gk, f8scale); if (n1 >= items) break;
            const int n2 = n1 + NGW; if (n2 < items) tr_load(ta, W, ldw, 64 * (n2 / nblk), 32 * (n2 % nblk), F.lane);
            tr_store(tb, K, WT, scr, 64 * (n1 / nblk), 32 * (n1 % nblk), F.lane, rm, gk, f8scale); if (n2 >= items) break;
            it = n2; } }
    gwoff = (gwoff + items) % NGW;
}
__device__ __forceinline__ void row_load(const float* xrow, int lane, f32x4 (&v)[4]) {
    const GAS f32x4* xr = (const GAS f32x4*)xrow + lane;
#pragma unroll
    for (int j = 0; j < 4; ++j) v[j] = xr[64 * j];
}
__device__ __forceinline__ void row_load(const bf16* xrow, int lane, f32x4 (&v)[4]) {
    const GAS unsigned long long* xr = (const GAS unsigned long long*)xrow + lane;
#pragma unroll
    for (int j = 0; j < 4; ++j) { const unsigned long long w = xr[64 * j]; const unsigned lo = (unsigned)w, hi = (unsigned)(w >> 32);
        v[j] = (f32x4){__uint_as_float(lo << 16), __uint_as_float(lo & 0xffff0000u), __uint_as_float(hi << 16), __uint_as_float(hi & 0xffff0000u)}; }
}
__device__ __forceinline__ float row_rstd(const f32x4 (&v)[4]) { float s = 0.f;
#pragma unroll
    for (int j = 0; j < 4; ++j) s += (v[j].x * v[j].x + v[j].y * v[j].y) + (v[j].z * v[j].z + v[j].w * v[j].w);
    return 1.0f / sqrtf(wave_sum(s) * (1.f / DM) + RMS_EPS);
}
#define ROW_LOOP_BEGIN(src) { f32x4 vn_[4]; if (gw < MROWS) row_load((src) + (size_t)gw * DM, F.lane, vn_); \
        for (int m = gw; m < MROWS; m += NGW) { f32x4 v[4]; _Pragma("unroll") for (int j_ = 0; j_ < 4; ++j_) v[j_] = vn_[j_]; \
            if (m + NGW < MROWS) row_load((src) + (size_t)(m + NGW) * DM, F.lane, vn_); const float r = row_rstd(v);
#define ROW_LOOP_END } }
__device__ __forceinline__ void rms_row_store(const f32x4 (&v)[4], float rstd, const float* g, bf16* orow, int lane, float extra = 1.0f) {
    const GAS f32x4* gr = (const GAS f32x4*)g + lane; GAS unsigned long long* o8 = (GAS unsigned long long*)orow + lane;
#pragma unroll
    for (int j = 0; j < 4; ++j) { const f32x4 gg = gr[64 * j]; const f32x4 y = (v[j] * rstd) * gg * extra;
        o8[64 * j] = (unsigned long long)pk2(y.x, y.y) | ((unsigned long long)pk2(y.z, y.w) << 32); }
}
template <int N> __device__ __forceinline__ float wave_tr_reduce(float (&v)[N], int lane) {
    static_assert(N == 16 || N == 8, "N");
#define TRR_STEP(M, NN) if (N >= NN) { const bool up = (lane & M) != 0; _Pragma("unroll") for (int i = 0; i < NN / 2; ++i) { const float keep = up ? v[i + NN / 2] : v[i], send = up ? v[i] : v[i + NN / 2]; v[i] = keep + __shfl_xor(send, M); } }
    TRR_STEP(8, 16) TRR_STEP(4, 8) TRR_STEP(2, 4) TRR_STEP(1, 2)
#undef TRR_STEP
    float t = v[0];
#pragma unroll
    for (int o = N; o < 64; o <<= 1) t += __shfl_xor(t, o);
    return t;
}
__device__ __forceinline__ float bflo(unsigned u) { return __uint_as_float(u << 16); }
__device__ __forceinline__ float bfhi(unsigned u) { return __uint_as_float(u & 0xffff0000u); }
__device__ __forceinline__ float log_sigmoid(float x) { return x >= 0.f ? -log1pf(expf(-x)) : x - log1pf(expf(x)); }

enum { PH_PRO = 0, PH_GEMM1, PH_SPATIAL, PH_GEMM2, PH_FFN_UP, PH_FFN_DOWN, PH_KVQ, PH_ATTN, PH_OPROJ, PH_ROUTER, PH_MOE_UP, PH_MOE_DOWN, PH_COMBINE, PH_END };
#ifndef MK_ONE_LAUNCH
#define MK_ONE_LAUNCH 1
#endif
#ifndef MK_PH_STOP
#define MK_PH_STOP PH_END
#endif

struct Args { const float* in[N_IN]; float* out; unsigned char* ws; int ph_lo, ph_hi, li, pad; };
__global__ void __launch_bounds__(NWAVES * 64, 2) yoco_fwd(Args args) {
    extern __shared__ __attribute__((aligned(16))) unsigned char lds[];
    Frame F;
    F.lds = (LAS unsigned char*)lds; F.MISC = (volatile LAS unsigned*)(F.lds + MISC_OFF);
    F.tid = threadIdx.x; F.lane = F.tid & 63; F.wave = __builtin_amdgcn_readfirstlane(F.tid >> 6);
    F.G = gridDim.x; { const int bx = blockIdx.x; F.vcu = (F.G % 8 == 0) ? (bx % 8) * (F.G / 8) + bx / 8 : bx; }
    unsigned char* ws = args.ws; F.ctl = (gu32*)(ws + WS_CTL);
    for (int u = F.tid; u < (LDS_BYTES - LDSCTL_OFF) / 4; u += NWAVES * 64) ((LAS unsigned*)(F.lds + LDSCTL_OFF))[u] = 0u;
    __syncthreads();
    XcdBarrier bar; bar.bar = (unsigned*)(F.ctl + CW_BAR) + args.li * XCD_BAR_WORDS; bar.x = 0; bar.st = nullptr;
    if (MK_ONE_LAUNCH) bar = xcd_barrier_post((unsigned*)(F.ctl + CW_BAR) + args.li * XCD_BAR_WORDS, F.MISC + 8);
#define GRID_BAR() do { if (MK_ONE_LAUNCH) xcd_barrier(bar); } while (0)
    const int lo = args.ph_lo, hi = args.ph_hi;
#ifndef MK_PHMASK
#define MK_PHMASK 0xffffffffu
#endif
#define IN(k) (((MK_PHMASK >> (k)) & 1u) && lo <= (k) && (k) < hi)
#define BOTH(k) (IN(k) && IN((k) + 1))
    const float* x = args.in[I_X]; float* H = args.out;
    bf16* WA_IN = (bf16*)(ws + WS_WA_IN); bf16* WA_OUT = (bf16*)(ws + WS_WA_OUT); bf16* WF_IN = (bf16*)(ws + WS_WF_IN); bf16* WF_OUT = (bf16*)(ws + WS_WF_OUT);
    bf16* WKV = (bf16*)(ws + WS_WKV); bf16* WBIN = (bf16*)(ws + WS_WBIN); bf16* WBOUT = (bf16*)(ws + WS_WBOUT); bf16* WM_IN = (bf16*)(ws + WS_WM_IN); bf16* WM_OUT = (bf16*)(ws + WS_WM_OUT);
    float* RX = (float*)(ws + 1 * MiB + 131072);
    bf16* WF16 = (bf16*)(ws + 1 * MiB);
    bf16* XN = (bf16*)(ws + WS_XN); bf16* XQ = (bf16*)(ws + WS_XQ); bf16* BIG = (bf16*)(ws + WS_BIG);
    float* RSQ_V = (float*)(ws + WS_VPART); float* RSQ_H1 = (float*)(ws + WS_RSQ); bf16* HB = XQ;
 float* FG = (float*)(ws + WS_FG); unsigned* IDL = (unsigned*)(ws + WS_GW + 512 * 1024);   float* GW = (float*)(ws + WS_GW); unsigned* TOKSLOT = (unsigned*)(ws + WS_TOKSLOT); unsigned* ELIST = (unsigned*)(ws + WS_ELIST); float* EWL = (float*)(ws + WS_EWL); unsigned* ERS = (unsigned*)(ws + WS_EWL + 1 * MiB);
    bf16* ACT = (bf16*)(ws + WS_ACT); bf16* YB = (bf16*)(ws + WS_Y); bf16* YP = (bf16*)(ws + WS_BIG);
    bf16* KB = BIG; bf16* VB = BIG + (size_t)MROWS * DM; bf16* QB = BIG + (size_t)2 * MROWS * DM; bf16* GB = BIG + (size_t)3 * MROWS * DM;
    const int gw = F.vcu * NWAVES + F.wave, NGW = F.G * NWAVES;

    if (IN(PH_PRO)) {
        int go = 0;
        tr_matrix(F, args.in[I_A_W_IN], A_FFN, DM, A_FFN, WA_IN, MapId{}, go, args.in[I_A_NORM_G]);
        tr_matrix(F, args.in[I_A_W_OUT], DM, A_HALF, DM, WA_OUT, MapId{}, go);
        tr_matrix(F, args.in[I_F_W_IN], 2 * D_FF, DM, 2 * D_FF, WF_IN, MapGlu{D_FF}, go, args.in[I_F_NORM_G]);
        tr_matrix(F, args.in[I_F_W_OUT], DM, D_FF, DM, WF_OUT, MapId{}, go);
        tr_matrix(F, args.in[I_KV_W], KVW_LD, DM, 2 * DM, WKV, MapHead{}, go, args.in[I_KV_NORM_G]);
        tr_matrix(F, args.in[I_B_W_IN], 2 * DM, DM, 2 * DM, WBIN, MapHead{}, go, args.in[I_B_NORM_G]);
        tr_matrix(F, args.in[I_B_W_OUT], DM, DM, DM, WBOUT, MapId{}, go);
        for (int e = 0; e < NEXP; ++e) {
            tr_matrix(F, args.in[I_M_W_IN] + (size_t)e * DM * 2 * D_EXP, 2 * D_EXP, DM, 2 * D_EXP, (bf16*)((unsigned char*)WM_IN + (size_t)e * 2 * D_EXP * DM), MapGlu{D_EXP}, go, args.in[I_M_NORM_G], W8_SCALE);
            tr_matrix(F, args.in[I_M_W_OUT] + (size_t)e * D_EXP * DM, DM, D_EXP, DM, (bf16*)((unsigned char*)WM_OUT + (size_t)e * DM * D_EXP), MapId{}, go, nullptr, W8_SCALE);
        }
        ROW_LOOP_BEGIN(x) { GAS unsigned long long* o8 = (GAS unsigned long long*)(XN + (size_t)m * DM) + F.lane;
#pragma unroll
            for (int j = 0; j < 4; ++j) o8[64 * j] = (unsigned long long)pk2(v[j].x, v[j].y) | ((unsigned long long)pk2(v[j].z, v[j].w) << 32);
            if (F.lane == 0) RX[m] = r; } ROW_LOOP_END
        for (int e = blockIdx.x * (NWAVES * 64) + F.tid; e < NHEAD * DM; e += F.G * NWAVES * 64) { const int h = e >> 10, k = e & 1023; WF16[e] = (bf16)f2bf(args.in[I_KV_W][(size_t)k * KVW_LD + 2 * DM + h] * args.in[I_KV_NORM_G][k]); }
        if (BOTH(PH_PRO)) GRID_BAR();
    }
    if (IN(PH_GEMM1)) {
        pg8::Gemm g{XN, WA_IN, MROWS, A_FFN, DM, DM, 0, nullptr, 0, nullptr, 0}; pg8::StaticOrder S; S.init(MROWS, A_FFN, F.G, (int)blockIdx.x);
        LAS float* RT = (LAS float*)(F.lds + LDSCTL_OFF + 4096);
        { pg8::Unit uu; __syncthreads();
          for (int i0 = 0; i0 < 12; i0 += 2) { const int i = i0 + (F.tid >> 8); if (!S.next(i, uu)) continue; RT[i * 256 + (F.tid & 255)] = RX[uu.pm * 256 + (F.tid & 255)]; }
          __syncthreads(); }
        pg8::EpiGeluSq E{BIG, A_FFN, RSQ_V, A_HALF / 256, RT};
        pg8::gemm_phase<pg8::EpiGeluSq, pg8::StaticOrder, true, true>(F.lds + RING_OFF, g, S, E);
        if (BOTH(PH_GEMM1)) GRID_BAR();
    }
    if (IN(PH_SPATIAL)) {
        int tid_ = threadIdx.x; asm volatile("" : "+v"(tid_));
        const int tid = tid_, lane = tid & 63, wid = __builtin_amdgcn_readfirstlane(tid >> 6), wr = wid >> 2, wc = wid & 3, L15 = lane & 15, G4 = lane >> 4, q_ = (lane & 15) >> 2, p_ = lane & 3;
        LAS unsigned char* VI = F.lds + RING_OFF; LAS unsigned char* WI = F.lds + RING_OFF + 98304; LAS float* RVS = (LAS float*)(F.lds + LDSCTL_OFF + 1024);
        const float* wsp = args.in[I_A_W_SP]; const float* bsp = args.in[I_A_B_SP]; const float* gvn = args.in[I_A_V_NORM_G];
        for (int u = F.vcu; u < (MROWS / GCH) * A_GROUPS; u += F.G) {
            const int cc = u / A_GROUPS, g = u % A_GROUPS; const size_t r0 = (size_t)cc * GCH;
            __syncthreads();
            if (tid < GCH) { const GAS f32x4* pp = (const GAS f32x4*)(RSQ_V + (r0 + tid) * 48); float t = 0.f;
#pragma unroll
                for (int k = 0; k < 12; ++k) { const f32x4 p = pp[k]; t += (p[0] + p[1]) + (p[2] + p[3]); }
                RVS[tid] = 1.0f / sqrtf(t * (1.f / A_HALF) + RMS_EPS); }
            __syncthreads();
            { const unsigned char* vbase = (const unsigned char*)(BIG + r0 * A_FFN + A_HALF + g * A_GD);
#pragma unroll
              for (int hb = 0; hb < 2; ++hb) { v4u vreg[6];
#pragma unroll
                  for (int k = 0; k < 6; ++k) { const unsigned q = tid + 512 * (6 * hb + k), row = q / 48u, c48 = q % 48u; vreg[k] = *(const GAS v4u*)(vbase + (row * A_FFN + c48 * 8u) * 2u); }
                  if (hb == 0) {
#pragma unroll
                      for (int k = 0; k < 4; ++k) { const unsigned q = tid + 512 * k, i = q >> 4, ch = q & 15; v4u o = (v4u){0u, 0u, 0u, 0u};
                          if ((ch >> 3) <= (i >> 6)) { const GAS f32x4* wp = (const GAS f32x4*)(wsp + (size_t)g * GCH * GCH + i * GCH + ch * 8); const LAS f32x4* rp = (const LAS f32x4*)(RVS + ch * 8); const f32x4 r0v = rp[0], r1v = rp[1];
                              const f32x4 w0 = wp[0] * r0v, w1 = wp[1] * r1v; o.x = pk2(w0.x, w0.y); o.y = pk2(w0.z, w0.w); o.z = pk2(w1.x, w1.y); o.w = pk2(w1.z, w1.w); }
                          *(LAS v4u*)(WI + off_b(i, ch)) = o; } }
#pragma unroll
                  for (int k = 0; k < 6; ++k) { const unsigned q = tid + 512 * (6 * hb + k), row = q / 48u, c48 = q % 48u; *(LAS v4u*)(VI + (c48 >> 4) * 32768u + off_b(row, c48 & 15u)) = vreg[k]; }
                  asm volatile("" ::: "memory"); } }
            __syncthreads();
            f32x4 acc[4][6];
#pragma unroll
            for (int m = 0; m < 4; ++m)
#pragma unroll
                for (int n = 0; n < 6; ++n) acc[m][n] = (f32x4){0.f, 0.f, 0.f, 0.f};
            const int nks = wr ? 4 : 2;
            const unsigned fW = ((L15 & 3u) << 2) | (L15 >> 2);
            const unsigned wbase = 256u * (wr * 64 + L15) + 16u * ((unsigned)G4 ^ (fW & 3u));
            const unsigned tb0 = 256u * (8 * G4 + q_) + 16u * ((unsigned)p_ ^ ((2u * G4) & 3u)), tb1 = 256u * (8 * G4 + 4 + q_) + 16u * ((unsigned)p_ ^ ((2u * G4 + 1u) & 3u));
            unsigned xc[3];
#pragma unroll
            for (int c32 = 0; c32 < 3; ++c32) { const unsigned col32 = wc * 96 + c32 * 32; xc[c32] = (col32 >> 7) * 32768u + 16u * (((col32 & 127u) >> 3) ^ ((unsigned)q_ << 2)); }
#pragma unroll 1
            for (int ks = 0; ks < nks; ++ks) {
                bf16x8 wf[4]; const LAS unsigned char* wp = WI + wbase + 16u * ((4u * ks) ^ (fW & 12u));
#pragma unroll
                for (int m = 0; m < 4; ++m) wf[m] = *(const LAS bf16x8*)(wp + m * 4096);
#pragma unroll
                for (int c32 = 0; c32 < 3; ++c32) { const LAS unsigned char* ib = VI + xc[c32] + 8192u * ks;
#pragma unroll
                    for (int nn = 0; nn < 2; ++nn) {
                        const s16x4 t0 = __builtin_bit_cast(s16x4, __builtin_amdgcn_ds_read_tr16_b64_v4i16((LAS s16x4*)(ib + tb0 + 8 * nn)));
                        const s16x4 t1 = __builtin_bit_cast(s16x4, __builtin_amdgcn_ds_read_tr16_b64_v4i16((LAS s16x4*)(ib + tb1 + 8 * nn)));
                        const bf16x8 vf = (bf16x8){t0[0], t0[1], t0[2], t0[3], t1[0], t1[1], t1[2], t1[3]};
#pragma unroll
                        for (int m = 0; m < 4; ++m) acc[m][2 * c32 + nn] = __builtin_amdgcn_mfma_f32_16x16x32_bf16(vf, wf[m], acc[m][2 * c32 + nn], 0, 0, 0); } }
            }
            f32x4 gvv[3][2];
#pragma unroll
            for (int c32 = 0; c32 < 3; ++c32) { const GAS f32x4* gp = (const GAS f32x4*)(gvn + g * A_GD + wc * 96 + c32 * 32 + 8 * G4); gvv[c32][0] = gp[0]; gvv[c32][1] = gp[1]; }
#pragma unroll
            for (int m = 0; m < 4; ++m) { const int i = wr * 64 + 16 * m + L15; const float bi = bsp[g * GCH + i]; bf16* rowp = BIG + (r0 + i) * A_FFN + g * A_GD + wc * 96 + 8 * G4;
#pragma unroll
                for (int c32 = 0; c32 < 3; ++c32) { const v4u uu = *(const GAS v4u*)(rowp + c32 * 32); const f32x4 a = acc[m][2 * c32] * gvv[c32][0] + bi, b = acc[m][2 * c32 + 1] * gvv[c32][1] + bi; v4u o;
                    o.x = pk2(bflo(uu.x) * a.x, bfhi(uu.x) * a.y); o.y = pk2(bflo(uu.y) * a.z, bfhi(uu.y) * a.w); o.z = pk2(bflo(uu.z) * b.x, bfhi(uu.z) * b.y); o.w = pk2(bflo(uu.w) * b.z, bfhi(uu.w) * b.w);
                    *(GAS v4u*)(rowp + c32 * 32) = o; } }
        }
        if (BOTH(PH_SPATIAL)) GRID_BAR();
    }
    if (IN(PH_GEMM2)) {
        pg8::Gemm g{BIG, WA_OUT, MROWS, DM, A_HALF, A_FFN, 0, nullptr, 0, nullptr, 0}; pg8::StaticOrder S; S.init(MROWS, DM, F.G, (int)blockIdx.x);
        pg8::EpiResBf<true> E{XN, HB, RSQ_H1, DM};
        pg8::gemm_phase<pg8::EpiResBf<true>, pg8::StaticOrder, true, true>(F.lds + RING_OFF, g, S, E);
        if (BOTH(PH_GEMM2)) GRID_BAR();
    }
    if (IN(PH_FFN_UP)) {
        pg8::Gemm g{HB, WF_IN, MROWS, 2 * D_FF, DM, DM, 0, nullptr, 0, nullptr, 0}; pg8::StaticOrder S; S.init(MROWS, 2 * D_FF, F.G, (int)blockIdx.x);
        LAS float* RT = (LAS float*)(F.lds + LDSCTL_OFF + 4096);
        { pg8::Unit uu; __syncthreads();
          for (int i0 = 0; i0 < 12; i0 += 2) { const int i = i0 + (F.tid >> 8); if (!S.next(i, uu)) continue; const int r = F.tid & 255; const GAS f32x4* pp = (const GAS f32x4*)(RSQ_H1 + (size_t)(uu.pm * 256 + r) * 16); float t = 0.f;
#pragma unroll
              for (int k = 0; k < 4; ++k) { const f32x4 p = pp[k]; t += (p[0] + p[1]) + (p[2] + p[3]); }
              RT[i * 256 + r] = 1.0f / sqrtf(t * (1.f / DM) + RMS_EPS); }
          __syncthreads(); }
        pg8::EpiSwiGLU E{BIG, D_FF, RT};
        pg8::gemm_phase<pg8::EpiSwiGLU, pg8::StaticOrder, true, true>(F.lds + RING_OFF, g, S, E);
        if (BOTH(PH_FFN_UP)) GRID_BAR();
    }
    if (IN(PH_FFN_DOWN)) {
        pg8::Gemm g{BIG, WF_OUT, MROWS, DM, D_FF, D_FF, 0, nullptr, 0, nullptr, 0}; pg8::StaticOrder S; S.init(MROWS, DM, F.G, (int)blockIdx.x);
        pg8::EpiResBf<true> E{HB, XN, RSQ_H1, DM};
        pg8::gemm_phase<pg8::EpiResBf<true>, pg8::StaticOrder, true, true>(F.lds + RING_OFF, g, S, E);
        if (BOTH(PH_FFN_DOWN)) GRID_BAR();
    }
    if (IN(PH_KVQ)) {
        LAS float* HG = (LAS float*)(F.lds + LDSCTL_OFF + 1024);
        LAS float* RT = (LAS float*)(F.lds + LDSCTL_OFF + 4096);
        pg8::StaticOrder S; S.init(MROWS, 4 * DM, F.G, (int)blockIdx.x);
        __syncthreads();
        if (F.tid < 64) HG[F.tid] = args.in[I_K_NORM_G][F.tid]; else if (F.tid < 128) HG[F.tid] = args.in[I_Q_NORM_G][F.tid - 64] * attn_body::C2;
        { pg8::Unit uu;
          for (int i0 = 0; i0 < 12; i0 += 2) { const int i = i0 + (F.tid >> 8); if (!S.next(i, uu)) continue; const int r = F.tid & 255; const GAS f32x4* pp = (const GAS f32x4*)(RSQ_H1 + (size_t)(uu.pm * 256 + r) * 16); float t = 0.f;
#pragma unroll
              for (int k = 0; k < 4; ++k) { const f32x4 p = pp[k]; t += (p[0] + p[1]) + (p[2] + p[3]); }
              RT[i * 256 + r] = 1.0f / sqrtf(t * (1.f / DM) + RMS_EPS); } }
        { const int L15 = F.lane & 15, KQ = F.lane >> 4; const size_t row0 = (size_t)F.vcu * 128 + F.wave * 16;
          if (row0 < MROWS) {
              const bf16* ap = XN + (row0 + L15) * DM + 8 * KQ; const bf16* bp = WF16 + (size_t)L15 * DM + 8 * KQ; f32x4 fa = (f32x4){0.f, 0.f, 0.f, 0.f};
#pragma unroll
              for (int jb = 0; jb < 4; ++jb) { bf16x8 af[8], bfr[8];
#pragma unroll
                  for (int j = 0; j < 8; ++j) { af[j] = *(const GAS bf16x8*)(ap + 32 * (8 * jb + j)); bfr[j] = *(const GAS bf16x8*)(bp + 32 * (8 * jb + j)); }
#pragma unroll
                  for (int j = 0; j < 8; ++j) fa = __builtin_amdgcn_mfma_f32_16x16x32_bf16(af[j], bfr[j], fa, 0, 0, 0); }
#pragma unroll
              for (int e = 0; e < 4; ++e) { const size_t row = row0 + 4 * KQ + e; const GAS f32x4* pp = (const GAS f32x4*)(RSQ_H1 + row * 16); float t = 0.f;
#pragma unroll
                  for (int k = 0; k < 4; ++k) { const f32x4 p = pp[k]; t += (p[0] + p[1]) + (p[2] + p[3]); }
                  FG[row * NHEAD + L15] = fa[e] * (1.0f / sqrtf(t * (1.f / DM) + RMS_EPS)); } } }
        __syncthreads();
        { pg8::Gemm g{XN, WKV, MROWS, 4 * DM, DM, DM, 0, nullptr, 0, nullptr, 0};
          pg8::EpiHead4 E{KB, (size_t)MROWS * DM, HG, RMS_EPS, RT};
          pg8::gemm_phase<pg8::EpiHead4, pg8::StaticOrder, true, true>(F.lds + RING_OFF, g, S, E); }
        if (BOTH(PH_KVQ)) GRID_BAR();
    }
    if (IN(PH_ATTN)) {
        __syncthreads();
        for (int bh = F.vcu; bh < BATCH * NHEAD; bh += F.G) attn_body::scan_bias_table((char*)lds + RING_OFF, FG, args.in[I_KV_B_F], bh, (attn_body::u32x4*)(ws + WS_FBT));
        asm volatile("s_waitcnt vmcnt(0)" ::: "memory"); __syncthreads();
        const attn_body::AttnTensors AT{(const attn_body::bf16*)QB, (const attn_body::bf16*)KB, (const attn_body::bf16*)VB, (const attn_body::bf16*)GB, (attn_body::bf16*)QB, (const attn_body::u32x4*)(ws + WS_FBT)};
        const attn_body::StaticOrder AS{F.vcu, F.G}; attn_body::attn_phase<attn_body::StaticOrder>((char*)lds + RING_OFF, AT, AS);
        if (BOTH(PH_ATTN)) GRID_BAR();
    }
    if (IN(PH_OPROJ)) {
        pg8::Gemm g{QB, WBOUT, MROWS, DM, DM, DM, 0, nullptr, 0, nullptr, 0}; pg8::StaticOrder S; S.init(MROWS, DM, F.G, (int)blockIdx.x);
        pg8::EpiResBf<true> E{XN, HB, nullptr, DM};
        pg8::gemm_phase<pg8::EpiResBf<true>, pg8::StaticOrder, true, true>(F.lds + RING_OFF, g, S, E);
        if (BOTH(PH_OPROJ)) GRID_BAR();
    }
    if (IN(PH_ROUTER)) {
        LAS float* Wr = (LAS float*)(F.lds + RING_OFF);
        LAS unsigned* CNTL = (LAS unsigned*)(F.lds + RING_OFF + 65536); LAS unsigned* RREC = CNTL + 64;
        if (F.tid < 16) CNTL[F.tid] = 0u;
        __syncthreads();
        for (int idx = F.tid; idx < DM * NEXP; idx += NWAVES * 64) { const int c = idx & 3, ln = (idx >> 2) & 63, q = (idx >> 8) & 1, kk = idx >> 9, k = 4 * ln + 256 * (kk >> 2) + (kk & 3);
            Wr[idx] = args.in[I_M_W_ROUTER][(size_t)k * NEXP + 4 * q + c]; }
        __syncthreads();
        ROW_LOOP_BEGIN(HB)
            { GAS unsigned* o8 = (GAS unsigned*)((GAS unsigned char*)XN + (size_t)m * DM) + F.lane;
#pragma unroll
              for (int j = 0; j < 4; ++j) { unsigned w = 0u; w = __builtin_amdgcn_cvt_pk_fp8_f32(v[j].x, v[j].y, w, false); w = __builtin_amdgcn_cvt_pk_fp8_f32(v[j].z, v[j].w, w, true); o8[64 * j] = w; } }
            float a[NEXP];
#pragma unroll
            for (int h = 0; h < NEXP; ++h) a[h] = 0.f;
            const GAS f32x4* gr = (const GAS f32x4*)args.in[I_M_NORM_G] + F.lane;
#pragma unroll
            for (int j = 0; j < 4; ++j) { const f32x4 s4 = (v[j] * r) * gr[64 * j];
#pragma unroll
                for (int e = 0; e < 4; ++e) { const float sk = s4[e];
#pragma unroll
                    for (int q = 0; q < 2; ++q) { const f32x4 w = *(const LAS f32x4*)(Wr + (((4 * j + e) * 2 + q) * 64 + F.lane) * 4); a[4 * q] += sk * w.x; a[4 * q + 1] += sk * w.y; a[4 * q + 2] += sk * w.z; a[4 * q + 3] += sk * w.w; } } }
            { const float mine = wave_tr_reduce<8>(a, F.lane);
#pragma unroll
              for (int h = 0; h < NEXP; ++h) a[h] = __shfl(mine, h); }
            int i1 = 0; float v1 = a[0];
#pragma unroll
            for (int h = 1; h < NEXP; ++h) if (a[h] > v1) { v1 = a[h]; i1 = h; }
            int i2 = -1; float v2 = -INFINITY;
#pragma unroll
            for (int h = 0; h < NEXP; ++h) if (h != i1 && a[h] > v2) { v2 = a[h]; i2 = h; }
            const float e2 = expf(v2 - v1), w1 = 1.0f / (1.0f + e2), w2 = e2 / (1.0f + e2);
            if (F.lane == 0) { const int k = (m - gw) / NGW; LAS unsigned* rec = RREC + (F.wave * 16 + k) * 8;
                const unsigned p1 = __hip_atomic_fetch_add(CNTL + i1, 1u, __ATOMIC_RELAXED, __HIP_MEMORY_SCOPE_WORKGROUP), p2 = __hip_atomic_fetch_add(CNTL + i2, 1u, __ATOMIC_RELAXED, __HIP_MEMORY_SCOPE_WORKGROUP);
                rec[0] = (unsigned)i1; rec[1] = p1; rec[2] = __float_as_uint(w1); rec[3] = (unsigned)i2; rec[4] = p2; rec[5] = __float_as_uint(w2); rec[6] = (unsigned)m; rec[7] = __float_as_uint(r); } ROW_LOOP_END
        __syncthreads();
        if (F.tid < NEXP) CNTL[8 + F.tid] = __hip_atomic_fetch_add(F.ctl + CW_CNT + F.tid, CNTL[F.tid], __ATOMIC_RELAXED, __HIP_MEMORY_SCOPE_AGENT);
        __syncthreads();
        if (F.lane < 16) { const int m = gw + F.lane * NGW; if (m < MROWS) { const LAS unsigned* rec = RREC + (F.wave * 16 + F.lane) * 8;
#pragma unroll
            for (int k = 0; k < 2; ++k) { const unsigned e = rec[3 * k], p = CNTL[8 + e] + rec[3 * k + 1]; ELIST[(size_t)e * MROWS + p] = rec[6] * 2u + (unsigned)k; EWL[(size_t)e * MROWS + p] = __uint_as_float(rec[3 * k + 2]); ERS[(size_t)e * MROWS + p] = rec[7]; } } }
        if (BOTH(PH_ROUTER)) GRID_BAR();
    }
    pg8::GroupedOrder GS; int ecnt[NEXP];
    if (hi > PH_ROUTER) { GS.ts[0] = 0;
#pragma unroll
        for (int e = 0; e < NEXP; ++e) { ecnt[e] = (int)__builtin_amdgcn_readfirstlane(__hip_atomic_load(F.ctl + CW_CNT + e, RLX_AGENT)); GS.cnt[e] = ecnt[e]; GS.ts[e + 1] = GS.ts[e] + (ecnt[e] + 255) / 256; } GS.cap = MROWS; }
    const int NT = GS.ts[NEXP];
    if (IN(PH_MOE_UP)) {
        for (int sl = gw * 64 + F.lane; sl < NT * 256; sl += NGW * 64) { const int tile = sl >> 8; const int e = GS.expert(tile);
            int cnt_e = GS.cnt[0], ts_e = 0;
#pragma unroll
            for (int k = 1; k < NEXP; ++k) { cnt_e = (e == k) ? GS.cnt[k] : cnt_e; ts_e = (e == k) ? GS.ts[k] : ts_e; }
            const int p = sl - ts_e * 256;
            IDL[sl] = 2u * (unsigned)sl;
            if (p < cnt_e) { const unsigned ent = ELIST[(size_t)e * MROWS + p]; GW[sl] = EWL[(size_t)e * MROWS + p]; TOKSLOT[ent] = (unsigned)sl; } else GW[sl] = 0.f; }
        pg8::Gemm g{XN, WM_IN, NT * 256, 2 * D_EXP, DM / 2, DM / 2, (size_t)2 * D_EXP * DM, ELIST, 0, ERS, W8_SCALE_E8M0}; GS.init(NT * 256, 2 * D_EXP, F.G, (int)blockIdx.x);
        pg8::EpiSwiGLU8q E{(unsigned char*)ACT, D_EXP};
        pg8::gemm_phase_f8q<pg8::EpiSwiGLU8q, pg8::GroupedOrder>(F.lds + RING_OFF, g, GS, E, (LAS unsigned*)(F.lds + LDSCTL_OFF + 2048));
        if (BOTH(PH_MOE_UP)) GRID_BAR();
    }
    const int DU = NT * 4, DLIM = (DU / F.G) * F.G, DTS = 2, DKP = D_EXP / DTS;
    if (IN(PH_MOE_DOWN)) {
        { pg8::DownMainQ DM_; (pg8::GroupedOrder&)DM_ = GS; DM_.init(NT * 256, DM, F.G, (int)blockIdx.x); DM_.v = F.vcu; DM_.lim = DLIM < DU ? DLIM : DU;
          pg8::Gemm g{ACT, WM_OUT, NT * 256, DM, D_EXP / 2, D_EXP / 2, (size_t)DM * D_EXP, IDL, 0, (const unsigned*)GW, W8_SCALE_E8M0};
          pg8::EpiY8q E{YB, DM, 0};
          pg8::gemm_phase_f8q<pg8::EpiY8q, pg8::DownMainQ>(F.lds + RING_OFF, g, DM_, E, (LAS unsigned*)(F.lds + LDSCTL_OFF + 2048)); }
        if (DU > DLIM) {
            pg8::DownTailQ DT_; (pg8::GroupedOrder&)DT_ = GS; DT_.init(NT * 256, DM, F.G, (int)blockIdx.x); DT_.v = F.vcu; DT_.lim = DLIM; DT_.S = DTS; DT_.ntask = (DU - DLIM) * DTS;
            pg8::Gemm g{ACT, WM_OUT, NT * 256, DM, DKP / 2, D_EXP / 2, (size_t)DM * D_EXP, IDL, D_EXP / 2, (const unsigned*)GW, W8_SCALE_E8M0};
            pg8::EpiY8q E{YP - (size_t)(DLIM / 4) * 256 * DM, DM, (size_t)YP_ROWS * DM};
            pg8::gemm_phase_f8q<pg8::EpiY8q, pg8::DownTailQ>(F.lds + RING_OFF, g, DT_, E, (LAS unsigned*)(F.lds + LDSCTL_OFF + 2048));
        }
        if (BOTH(PH_MOE_DOWN)) GRID_BAR();
    }
    if (IN(PH_COMBINE)) {
        const unsigned tail0 = (unsigned)(DLIM / 4) * 256u;
#define CB_YBASE(sl) ((((DU > DLIM) && (sl) >= tail0) ? YP + (size_t)((sl) - tail0) * DM : YB + (size_t)(sl) * DM))
#define CB_LOAD(hd, yd, mm, sa, sb) do { const GAS v4u* hp_ = (const GAS v4u*)(HB + (size_t)(mm) * DM) + F.lane; const GAS v4u* ya_ = (const GAS v4u*)CB_YBASE(sa) + F.lane; const GAS v4u* yb_ = (const GAS v4u*)CB_YBASE(sb) + F.lane; \
            _Pragma("unroll") for (int j = 0; j < 2; ++j) { hd[j] = hp_[64 * j]; yd[j] = ya_[64 * j]; yd[2 + j] = yb_[64 * j]; } } while (0)
        unsigned sa0 = 0, sa1 = 0, sb0 = 0, sb1 = 0; v4u hn[2]; v4u yn[4];
        if (gw < MROWS) { sa0 = TOKSLOT[2 * gw]; sa1 = TOKSLOT[2 * gw + 1]; if (gw + NGW < MROWS) { sb0 = TOKSLOT[2 * (gw + NGW)]; sb1 = TOKSLOT[2 * (gw + NGW) + 1]; } CB_LOAD(hn, yn, gw, sa0, sa1); }
        for (int m = gw; m < MROWS; m += NGW) {
            f32x4 h[4]; v4u y[4]; const unsigned s0 = sa0, s1 = sa1;
#pragma unroll
            for (int j = 0; j < 2; ++j) { const v4u a = hn[j]; h[2 * j] = (f32x4){bflo(a.x), bfhi(a.x), bflo(a.y), bfhi(a.y)}; h[2 * j + 1] = (f32x4){bflo(a.z), bfhi(a.z), bflo(a.w), bfhi(a.w)}; }
#pragma unroll
            for (int j = 0; j < 4; ++j) y[j] = yn[j];
            sa0 = sb0; sa1 = sb1;
            if (m + 2 * NGW < MROWS) { sb0 = TOKSLOT[2 * (m + 2 * NGW)]; sb1 = TOKSLOT[2 * (m + 2 * NGW) + 1]; }
            if (m + NGW < MROWS) CB_LOAD(hn, yn, m + NGW, sa0, sa1);
#pragma unroll
            for (int k = 0; k < 2; ++k) {
#pragma unroll
                for (int j = 0; j < 2; ++j) { const v4u a = y[2 * k + j];
                    h[2 * j].x += bflo(a.x); h[2 * j].y += bfhi(a.x); h[2 * j].z += bflo(a.y); h[2 * j].w += bfhi(a.y); h[2 * j + 1].x += bflo(a.z); h[2 * j + 1].y += bfhi(a.z); h[2 * j + 1].z += bflo(a.w); h[2 * j + 1].w += bfhi(a.w); }
                const unsigned sl = k ? s1 : s0;
                if ((DU > DLIM) && sl >= tail0) {
                    for (int p = 1; p < DTS; ++p) { const GAS v4u* yp = (const GAS v4u*)(YP + (size_t)(sl - tail0) * DM + (size_t)p * YP_ROWS * DM) + F.lane;
#pragma unroll
                        for (int j = 0; j < 2; ++j) { const v4u a = yp[64 * j];
                            h[2 * j].x += bflo(a.x); h[2 * j].y += bfhi(a.x); h[2 * j].z += bflo(a.y); h[2 * j].w += bfhi(a.y); h[2 * j + 1].x += bflo(a.z); h[2 * j + 1].y += bfhi(a.z); h[2 * j + 1].z += bflo(a.w); h[2 * j + 1].w += bfhi(a.w); } } } }
            GAS f32x4* hp = (GAS f32x4*)(H + (size_t)m * DM) + 2 * F.lane;
#pragma unroll
            for (int j = 0; j < 2; ++j) { hp[128 * j] = h[2 * j]; hp[128 * j + 1] = h[2 * j + 1]; } }
#undef CB_YBASE
#undef CB_LOAD
    }
#undef IN
#undef BOTH
}

extern "C" void kernel_launch(void* const* d_in, const int* in_sizes, int n_in, void* d_out, int out_size, void* d_ws, size_t ws_size, hipStream_t stream) {
    static int grid = 0;
    if (grid == 0) {
        if (n_in != N_IN || in_sizes[0] != MROWS * DM || out_size != MROWS * DM || ws_size < WS_END) { fprintf(stderr, "kernel_launch: unexpected shapes / workspace (n_in %d, in0 %d, out %d, ws %zu < %zu)\n", n_in, n_in > 0 ? in_sizes[0] : -1, out_size, ws_size, (size_t)WS_END); grid = -1; return; }
        int dev = 0, cus = 0, per_cu = 0;
        if (hipGetDevice(&dev) != hipSuccess || hipDeviceGetAttribute(&cus, hipDeviceAttributeMultiprocessorCount, dev) != hipSuccess) { grid = -1; return; }
        if (hipFuncSetAttribute((const void*)yoco_fwd, hipFuncAttributeMaxDynamicSharedMemorySize, LDS_BYTES) != hipSuccess) { fprintf(stderr, "kernel_launch: hipFuncSetAttribute failed\n"); grid = -1; return; }
        if (hipOccupancyMaxActiveBlocksPerMultiprocessor(&per_cu, (const void*)yoco_fwd, NWAVES * 64, LDS_BYTES) != hipSuccess || per_cu < 1) fprintf(stderr, "kernel_launch: occupancy query reports %d\n", per_cu);
        (void)hipGetLastError();
        if (cus != 256) { fprintf(stderr, "kernel_launch: built for a 256-CU device (got %d)\n", cus); grid = -1; return; }
        grid = cus;
    }
    if (grid < 0) return;
    if (hipMemsetAsync((char*)d_ws + WS_CTL, 0, CTL_ZERO_BYTES, stream) != hipSuccess) return;
    Args a{};
    for (int i = 0; i < N_IN; ++i) a.in[i] = (const float*)d_in[i];
    a.out = (float*)d_out; a.ws = (unsigned char*)d_ws;
#if MK_ONE_LAUNCH
    a.ph_lo = 0; a.ph_hi = MK_PH_STOP; a.li = 0;
    hipLaunchKernelGGL(yoco_fwd, dim3(grid), dim3(NWAVES * 64), LDS_BYTES, stream, a);
#else
    for (int p = 0; p < MK_PH_STOP; ++p) { a.ph_lo = p; a.ph_hi = p + 1; a.li = 0; hipLaunchKernelGGL(yoco_fwd, dim3(grid), dim3(NWAVES * 64), LDS_BYTES, stream, a); }
#endif
}
```
